# Optimizing an MI355X kernel written in HIP

```python
import math
import jax
import jax.numpy as jnp
from jax import lax
import numpy as np


D_MODEL = 1024
BATCH = 8
SEQ = 2048
DEPTH = 4

GRID_W = 64
CTX_LEN = 256
N_HEADS = 8
HEAD_DIM = 64
V_DIM = 2 * HEAD_DIM
QK_W = N_HEADS * 2 * HEAD_DIM
ATTN_W = N_HEADS * V_DIM
Q_BLOCK = 128
ROPE_BASE = 10000.0
ROPE_AXIS_DIM = HEAD_DIM // 2
SSM_W = D_MODEL // 2
SSM_GROUP = 16
SSM_GROUPS = SSM_W // SSM_GROUP
SSM_STATE = 64
N_GROUPS = 4
EXPERTS_PER_GROUP = 8
N_EXPERTS = N_GROUPS * EXPERTS_PER_GROUP
TOP_K = 2
EXPERT_HIDDEN = D_MODEL // 2
MOE_BLOCK = 128
KVU_W = QK_W + ATTN_W + SSM_W
IN_W = KVU_W + QK_W + 2 * D_MODEL
ALPHA = (2.0 * DEPTH) ** 0.25
BETA = (8.0 * DEPTH) ** -0.25
LN_EPS = 1e-5
MOD_INIT = 0.5

kernel_name = 'hybrid_diffattn_s5_hmoe_prefix_trunk'


def _layer_norm(x, g, b):
    xf = x.astype(jnp.float32)
    xc = xf - xf.mean(-1, keepdims=True)
    var = (xc * xc).mean(-1, keepdims=True)
    return (xc * lax.rsqrt(var + LN_EPS) * g + b).astype(x.dtype)


def _axial_rope_tables(n_tokens):
    rows = n_tokens // GRID_W
    row = jnp.repeat(jnp.arange(rows, dtype=jnp.float32), GRID_W)
    col = jnp.tile(jnp.arange(GRID_W, dtype=jnp.float32), rows)
    inv = 1.0 / (ROPE_BASE ** (jnp.arange(0, ROPE_AXIS_DIM, 2, dtype=jnp.float32) / ROPE_AXIS_DIM))
    ang = jnp.concatenate([row[:, None] * inv, col[:, None] * inv], axis=-1)
    return jnp.cos(ang), jnp.sin(ang)


def _apply_axial_rope(t, cos, sin):
    half = ROPE_AXIS_DIM // 2
    tr = t.reshape(t.shape[:-1] + (2, 2, half))
    t1, t2 = tr[..., 0, :], tr[..., 1, :]
    c = cos.reshape(1, cos.shape[0], 1, 1, 2, half)
    s = sin.reshape(1, sin.shape[0], 1, 1, 2, half)
    return jnp.stack([t1 * c - t2 * s, t1 * s + t2 * c], axis=-2).reshape(t.shape)


def _diff_attention(q, k, v, lam):
    s = jnp.einsum('bqhmd,bkhmd->mbhqk', q, k)
    p = jax.nn.softmax(s, axis=-1)
    a = p[0] - lam * p[1]
    return jnp.einsum('bhqk,bkhe->bqhe', a, v)


def _head_norm(o, g, lam_init):
    on = o * lax.rsqrt(jnp.mean(o * o, axis=-1, keepdims=True) + LN_EPS) * g.astype(jnp.float32) * (1.0 - lam_init)
    return on.reshape(o.shape[0], o.shape[1], ATTN_W)


def _linear_scan(a_bar, bu, reverse):
    a = jnp.broadcast_to(a_bar, bu.shape)

    def combine(e1, e2):
        a1, b1 = e1
        a2, b2 = e2
        return a1 * a2, a2 * b1 + b2

    _, h = lax.associative_scan(combine, (a, bu), axis=1, reverse=reverse)
    return h


def _s5_bidirectional(uc, ux, a_re, a_im, log_dt, b_re, b_im, c_re, c_im, d_skip, need_ctx):
    f32 = jnp.float32
    bsz, n_ctx, _ = uc.shape
    n_lat = ux.shape[1]
    ucf, uxf = uc.astype(f32), ux.astype(f32)
    ucg = ucf.reshape(bsz, n_ctx, SSM_GROUPS, SSM_GROUP)
    uxg = uxf.reshape(bsz, n_lat, SSM_GROUPS, SSM_GROUP)
    d = d_skip.astype(f32)
    yx = uxf * d
    yc = ucf * d if need_ctx else None
    for di, rev in enumerate((False, True)):
        lam = lax.complex(a_re[di].astype(f32), a_im[di].astype(f32))
        dt = jnp.exp(log_dt[di].astype(f32))[:, None]
        a_bar = jnp.exp(lam * dt)
        b_bar = ((a_bar - 1.0) / lam)[..., None] * lax.complex(b_re[di].astype(f32), b_im[di].astype(f32))
        cm = lax.complex(c_re[di].astype(f32), c_im[di].astype(f32))
        h_ctx = _linear_scan(a_bar, jnp.einsum('btgc,gpc->btgp', ucg, b_bar), rev)
        h0 = h_ctx[:, 0] if rev else h_ctx[:, -1]
        bu_x = jnp.einsum('btgc,gpc->btgp', uxg, b_bar)
        first = n_lat - 1 if rev else 0
        bu_x = bu_x.at[:, first].add(a_bar * h0)
        h_lat = _linear_scan(a_bar, bu_x, rev)
        yx = yx + jnp.einsum('btgp,gcp->btgc', h_lat, cm).real.reshape(bsz, n_lat, SSM_W)
        if need_ctx:
            yc = yc + jnp.einsum('btgp,gcp->btgc', h_ctx, cm).real.reshape(bsz, n_ctx, SSM_W)
    return yx, yc


def _glu(y, w, b):
    y = jax.nn.gelu(y)
    return y * jax.nn.sigmoid(y @ w + b)


def _merge_branches(attn, ssm, ga, gs, w_pa, w_ps, w_o):
    m = jax.nn.sigmoid(ga.astype(jnp.float32)) * (attn @ w_pa) + jax.nn.sigmoid(gs.astype(jnp.float32)) * (ssm @ w_ps)
    return (m @ w_o).astype(ga.dtype)


def _token_mixer(hx, hc, lp, lam_init, need_ctx, rope_cos, rope_sin):
    f32 = jnp.float32
    bsz, n_lat, _ = hx.shape
    splits = [QK_W, QK_W + ATTN_W, KVU_W, KVU_W + QK_W, KVU_W + QK_W + D_MODEL]
    w_in = lp['w_in']
    kx, vx, ux, qx, gax, gsx = jnp.split(hx @ w_in, splits, axis=-1)
    if need_ctx:
        kc, vc, uc, qc, gac, gsc = jnp.split(hc @ w_in, splits, axis=-1)
    else:
        kc, vc, uc = jnp.split(hc @ w_in[:, :KVU_W], splits[:2], axis=-1)
    scale = HEAD_DIM ** -0.5

    def qk_heads(t):
        return t.astype(f32).reshape(bsz, t.shape[1], N_HEADS, 2, HEAD_DIM)

    def v_heads(t):
        return t.astype(f32).reshape(bsz, t.shape[1], N_HEADS, V_DIM)

    qx4 = _apply_axial_rope(qk_heads(qx), rope_cos, rope_sin) * scale
    kx4 = _apply_axial_rope(qk_heads(kx), rope_cos, rope_sin)
    kc4, vc4 = qk_heads(kc), v_heads(vc)
    k_all = jnp.concatenate([kc4, kx4], axis=1)
    v_all = jnp.concatenate([vc4, v_heads(vx)], axis=1)
    lq1, lk1 = lp['lam_q1'].astype(f32), lp['lam_k1'].astype(f32)
    lq2, lk2 = lp['lam_q2'].astype(f32), lp['lam_k2'].astype(f32)
    lam = jnp.exp(jnp.sum(lq1 * lk1)) - jnp.exp(jnp.sum(lq2 * lk2)) + lam_init
    n_blk = n_lat // Q_BLOCK
    q_blocks = qx4.reshape(bsz, n_blk, Q_BLOCK, N_HEADS, 2, HEAD_DIM).transpose(1, 0, 2, 3, 4, 5)
    o_x = lax.map(lambda qb: _diff_attention(qb, k_all, v_all, lam), q_blocks)
    o_x = o_x.transpose(1, 0, 2, 3, 4).reshape(bsz, n_lat, N_HEADS, V_DIM)
    attn_x = _head_norm(o_x, lp['subln_g'], lam_init)

    ssm_x, ssm_c = _s5_bidirectional(uc, ux, lp['ssm_a_re'], lp['ssm_a_im'], lp['ssm_log_dt'], lp['ssm_b_re'],
                                     lp['ssm_b_im'], lp['ssm_c_re'], lp['ssm_c_im'], lp['ssm_d'], need_ctx)
    yx = _merge_branches(attn_x, _glu(ssm_x, lp['w_glu'], lp['b_glu']), gax, gsx, lp['w_pa'], lp['w_ps'], lp['w_o'])
    yc = None
    if need_ctx:
        attn_c = _head_norm(_diff_attention(qk_heads(qc) * scale, kc4, vc4, lam), lp['subln_g'], lam_init)
        yc = _merge_branches(attn_c, _glu(ssm_c, lp['w_glu'], lp['b_glu']), gac, gsc, lp['w_pa'], lp['w_ps'], lp['w_o'])
    return yx, yc


def _hier_moe(h, wg, bg, we, be, w1, w3, w2):
    f32 = jnp.float32
    n_tok, d = h.shape
    hf = h.astype(f32)
    g_logits = hf @ wg.astype(f32) + bg.astype(f32)
    g_prob = jax.nn.softmax(g_logits, axis=-1)
    g_idx = jnp.argmax(g_logits, axis=-1).astype(jnp.int32)
    g_top = jnp.take_along_axis(g_prob, g_idx[:, None], axis=1)
    e_logits = (hf @ we.astype(f32) + be.astype(f32)).reshape(n_tok, N_GROUPS, EXPERTS_PER_GROUP)
    e_sel = jnp.take_along_axis(e_logits, g_idx[:, None, None], axis=1)[:, 0]
    top_val, top_idx = lax.top_k(e_sel, TOP_K)
    weights = jax.nn.softmax(top_val, axis=-1) * g_top
    expert = g_idx[:, None] * EXPERTS_PER_GROUP + top_idx.astype(jnp.int32)
    n_rows = n_tok * TOP_K
    n_blocks = (n_rows + N_EXPERTS * (MOE_BLOCK - 1) + MOE_BLOCK - 1) // MOE_BLOCK
    cap = n_blocks * MOE_BLOCK
    flat_e = expert.reshape(-1)
    flat_t = jnp.repeat(jnp.arange(n_tok, dtype=jnp.int32), TOP_K)
    flat_w = weights.reshape(-1)
    order = jnp.argsort(flat_e)
    se = flat_e[order]
    counts = jnp.bincount(flat_e, length=N_EXPERTS).astype(jnp.int32)
    padded = (counts + MOE_BLOCK - 1) // MOE_BLOCK * MOE_BLOCK
    pad_end = jnp.cumsum(padded)
    pad_start = pad_end - padded
    start = jnp.cumsum(counts) - counts
    dest = pad_start[se] + jnp.arange(n_rows, dtype=jnp.int32) - start[se]
    row_tok = jnp.full((cap,), n_tok, jnp.int32).at[dest].set(flat_t[order])
    row_w = jnp.zeros((cap,), f32).at[dest].set(flat_w[order])
    blk_expert = jnp.minimum(jnp.searchsorted(pad_end, jnp.arange(n_blocks, dtype=jnp.int32) * MOE_BLOCK, side='right'),
                             N_EXPERTS - 1).astype(jnp.int32)
    h_pad = jnp.concatenate([h, jnp.zeros((1, d), h.dtype)], axis=0)
    xs = h_pad[row_tok].reshape(n_blocks, MOE_BLOCK, d)

    def expert_block(args):
        xb, e = args
        return (jax.nn.silu(xb @ w1[e]) * (xb @ w3[e])) @ w2[e]

    ys = lax.map(expert_block, (xs, blk_expert)).reshape(cap, d)
    out = jnp.zeros((n_tok + 1, d), ys.dtype).at[row_tok].add(ys * row_w[:, None].astype(ys.dtype))
    return out[:n_tok]


def setup_inputs(seed: int = 0) -> dict:
    key = jax.random.key(seed)
    ks = jax.random.split(key, 40)
    f32 = jnp.float32

    def nrm(i, shape, scale):
        return jax.random.normal(ks[i], shape, f32) * scale

    D = D_MODEL
    G, P, E, F = SSM_GROUPS, SSM_STATE, N_EXPERTS, EXPERT_HIDDEN
    a_im = jnp.broadcast_to(jnp.pi * jnp.arange(P, dtype=f32), (DEPTH, 2, G, P))
    return {
        'x': nrm(0, (BATCH, SEQ, D), 1.0),
        'c': nrm(1, (BATCH, D), 1.0),
        'ctx': nrm(2, (BATCH, CTX_LEN, D), 1.0),
        'c_ctx': nrm(3, (D,), 1.0),
        'w_mod': nrm(4, (DEPTH, D, 6 * D), MOD_INIT * D ** -0.5),
        'b_mod': nrm(5, (DEPTH, 6 * D), 0.01),
        'w_in': nrm(6, (DEPTH, D, IN_W), D ** -0.5),
        'lam_q1': nrm(7, (DEPTH, HEAD_DIM), 0.1),
        'lam_k1': nrm(8, (DEPTH, HEAD_DIM), 0.1),
        'lam_q2': nrm(9, (DEPTH, HEAD_DIM), 0.1),
        'lam_k2': nrm(10, (DEPTH, HEAD_DIM), 0.1),
        'subln_g': 1.0 + nrm(11, (DEPTH, V_DIM), 0.02),
        'ssm_a_re': -0.5 * (1.0 + nrm(12, (DEPTH, 2, G, P), 0.01)),
        'ssm_a_im': a_im,
        'ssm_log_dt': jax.random.uniform(ks[13], (DEPTH, 2, G), f32, math.log(1e-3), math.log(1e-1)),
        'ssm_b_re': nrm(14, (DEPTH, 2, G, P, SSM_GROUP), (2 * SSM_GROUP) ** -0.5),
        'ssm_b_im': nrm(15, (DEPTH, 2, G, P, SSM_GROUP), (2 * SSM_GROUP) ** -0.5),
        'ssm_c_re': nrm(16, (DEPTH, 2, G, SSM_GROUP, P), P ** -0.5),
        'ssm_c_im': nrm(17, (DEPTH, 2, G, SSM_GROUP, P), P ** -0.5),
        'ssm_d': nrm(18, (DEPTH, SSM_W), 0.5),
        'w_glu': nrm(19, (DEPTH, SSM_W, SSM_W), SSM_W ** -0.5),
        'b_glu': nrm(20, (DEPTH, SSM_W), 0.01),
        'w_pa': nrm(21, (DEPTH, ATTN_W, D), ATTN_W ** -0.5),
        'w_ps': nrm(22, (DEPTH, SSM_W, D), SSM_W ** -0.5),
        'w_o': nrm(23, (DEPTH, D, D), BETA * D ** -0.5),
        'ln1_g': 1.0 + nrm(24, (DEPTH, D), 0.02),
        'ln1_b': nrm(25, (DEPTH, D), 0.01),
        'router_g_w': nrm(26, (DEPTH, D, N_GROUPS), D ** -0.5),
        'router_g_b': nrm(27, (DEPTH, N_GROUPS), 0.01),
        'router_e_w': nrm(28, (DEPTH, D, E), D ** -0.5),
        'router_e_b': nrm(29, (DEPTH, E), 0.01),
        'moe_w1': nrm(30, (DEPTH, E, D, F), D ** -0.5),
        'moe_w3': nrm(31, (DEPTH, E, D, F), D ** -0.5),
        'moe_w2': nrm(32, (DEPTH, E, F, D), BETA * F ** -0.5),
        'ln2_g': 1.0 + nrm(33, (DEPTH, D), 0.02),
        'ln2_b': nrm(34, (DEPTH, D), 0.01),
    }


def reference(x, c, ctx, c_ctx, w_mod, b_mod, w_in, lam_q1, lam_k1, lam_q2, lam_k2, subln_g,
              ssm_a_re, ssm_a_im, ssm_log_dt, ssm_b_re, ssm_b_im, ssm_c_re, ssm_c_im, ssm_d,
              w_glu, b_glu, w_pa, w_ps, w_o, ln1_g, ln1_b,
              router_g_w, router_g_b, router_e_w, router_e_b, moe_w1, moe_w3, moe_w2, ln2_g, ln2_b):
    bsz, n_lat, _ = x.shape
    rope_cos, rope_sin = _axial_rope_tables(n_lat)
    silu_c = jax.nn.silu(c)
    silu_cc = jax.nn.silu(c_ctx)
    xl, xc = x, ctx
    for l in range(DEPTH):
        last = l == DEPTH - 1
        lam_init = 0.8 - 0.6 * math.exp(-0.3 * l)
        lp = dict(w_in=w_in[l], lam_q1=lam_q1[l], lam_k1=lam_k1[l], lam_q2=lam_q2[l], lam_k2=lam_k2[l],
                  subln_g=subln_g[l], ssm_a_re=ssm_a_re[l], ssm_a_im=ssm_a_im[l], ssm_log_dt=ssm_log_dt[l],
                  ssm_b_re=ssm_b_re[l], ssm_b_im=ssm_b_im[l], ssm_c_re=ssm_c_re[l], ssm_c_im=ssm_c_im[l],
                  ssm_d=ssm_d[l], w_glu=w_glu[l], b_glu=b_glu[l], w_pa=w_pa[l], w_ps=w_ps[l], w_o=w_o[l])
        mod_x = (silu_c @ w_mod[l] + b_mod[l])[:, None, :]
        sh1, sc1, g1, sh2, sc2, g2 = jnp.split(mod_x, 6, axis=-1)
        n_mod_c = 2 if last else 6
        cmod = jnp.split(silu_cc @ w_mod[l][:, :n_mod_c * D_MODEL] + b_mod[l][:n_mod_c * D_MODEL], n_mod_c)
        hx = xl * (1.0 + sc1) + sh1
        hc = xc * (1.0 + cmod[1]) + cmod[0]
        yx, yc = _token_mixer(hx, hc, lp, lam_init, not last, rope_cos, rope_sin)
        xl = _layer_norm(ALPHA * xl + g1 * yx, ln1_g[l], ln1_b[l])
        hx = xl * (1.0 + sc2) + sh2
        if last:
            fx = _hier_moe(hx.reshape(-1, D_MODEL), router_g_w[l], router_g_b[l], router_e_w[l], router_e_b[l],
                           moe_w1[l], moe_w3[l], moe_w2[l]).reshape(hx.shape)
        else:
            xc = _layer_norm(ALPHA * xc + cmod[2] * yc, ln1_g[l], ln1_b[l])
            hc = xc * (1.0 + cmod[4]) + cmod[3]
            rows = jnp.concatenate([hx.reshape(-1, D_MODEL), hc.reshape(-1, D_MODEL)], axis=0)
            f = _hier_moe(rows, router_g_w[l], router_g_b[l], router_e_w[l], router_e_b[l],
                          moe_w1[l], moe_w3[l], moe_w2[l])
            fx = f[:bsz * n_lat].reshape(hx.shape)
            fc = f[bsz * n_lat:].reshape(hc.shape)
            xc = _layer_norm(ALPHA * xc + cmod[5] * fc, ln2_g[l], ln2_b[l])
        xl = _layer_norm(ALPHA * xl + g2 * fx, ln2_g[l], ln2_b[l])
    return xl
```

```cpp
#include <hip/hip_runtime.h>
#include <cstdio>
#include <cstdint>
#include <cmath>
namespace orc {
constexpr int D = 1024, SEQ = 2048, CTX = 256, NH = 8, HD = 64, VD = 128, DEPTH = 4;
constexpr int INW = 5632, SSMW = 512, NG = 32, GS = 16, NP = 64, NE = 32, EH = 512;
constexpr int COL_K = 0, COL_V = 1024, COL_U = 2048, COL_Q = 2560, COL_GA = 3584, COL_GS = 4608;
struct Dims { int nb, b0; };
__device__ __forceinline__ int modrow(int r, Dims dm) { return r < dm.nb * SEQ ? dm.b0 + r / SEQ : 8; }
__device__ __forceinline__ float siluf(float x) { return x / (1.f + expf(-x)); }
__device__ __forceinline__ float sigmf(float x) { return 1.f / (1.f + expf(-x)); }
__device__ __forceinline__ float gelu_tanh(float x) { return 0.5f * x * (1.f + tanhf(0.7978845608028654f * (x + 0.044715f * x * x * x))); }

__global__ void k_mod(const float* c, const float* cctx, const float* w_mod, const float* b_mod, float* MOD) {
  __shared__ float s[9][1024];
  for (int i = threadIdx.x; i < 9 * 1024; i += blockDim.x) { int r = i >> 10, k = i & 1023; float v = r < 8 ? c[r * 1024 + k] : cctx[k]; s[r][k] = siluf(v); }
  __syncthreads();
  int j = blockIdx.x * blockDim.x + threadIdx.x, l = blockIdx.y;
  float acc[9];
#pragma unroll
  for (int r = 0; r < 9; ++r) acc[r] = 0.f;
  const float* w = w_mod + (size_t)l * 1024 * 6144 + j;
  for (int k = 0; k < 1024; ++k) { float wv = w[(size_t)k * 6144];
#pragma unroll
    for (int r = 0; r < 9; ++r) acc[r] += s[r][k] * wv; }
  float bb = b_mod[l * 6144 + j];
#pragma unroll
  for (int r = 0; r < 9; ++r) MOD[((size_t)l * 9 + r) * 6144 + j] = acc[r] + bb;
}
__global__ void k_load_x(const float* x, const float* ctx, float* XL, Dims dm) {
  size_t n = (size_t)dm.nb * (SEQ + CTX) * D;
  for (size_t i = (size_t)blockIdx.x * blockDim.x + threadIdx.x; i < n; i += (size_t)gridDim.x * blockDim.x) {
    size_t r = i / D; int d = i % D; float v;
    if (r < (size_t)dm.nb * SEQ) v = x[((size_t)dm.b0 * SEQ + r) * D + d]; else v = ctx[((size_t)dm.b0 * CTX + (r - (size_t)dm.nb * SEQ)) * D + d];
    XL[i] = v; }
}
__global__ void k_modulate(const float* X, float* H, const float* MODl, int shift_idx, int scale_idx, Dims dm, int row0, int nrows) {
  size_t n = (size_t)nrows * D;
  for (size_t i = (size_t)blockIdx.x * blockDim.x + threadIdx.x; i < n; i += (size_t)gridDim.x * blockDim.x) {
    int r = row0 + (int)(i / D), d = (int)(i % D); const float* m = MODl + (size_t)modrow(r, dm) * 6144;
    H[(size_t)r * D + d] = X[(size_t)r * D + d] * (1.f + m[scale_idx * 1024 + d]) + m[shift_idx * 1024 + d]; }
}
__global__ void __launch_bounds__(256) k_gemm(const float* __restrict__ A, int lda, const float* __restrict__ B, int ldb, float* __restrict__ C, int ldc, int K) {
  __shared__ float As[16][68]; __shared__ float Bs[16][68];
  const int bm = blockIdx.y * 64, bn = blockIdx.x * 64, tid = threadIdx.x, tx = tid & 15, ty = tid >> 4;
  float acc[4][4]; for (int i = 0; i < 4; ++i) for (int j = 0; j < 4; ++j) acc[i][j] = 0.f;
  const int ar = tid >> 2, ac = (tid & 3) * 4, br = tid >> 4, bc = (tid & 15) * 4;
  for (int k0 = 0; k0 < K; k0 += 16) {
    float4 av = *(const float4*)(A + (size_t)(bm + ar) * lda + k0 + ac);
    float4 bv = *(const float4*)(B + (size_t)(k0 + br) * ldb + bn + bc);
    As[ac + 0][ar] = av.x; As[ac + 1][ar] = av.y; As[ac + 2][ar] = av.z; As[ac + 3][ar] = av.w;
    *(float4*)&Bs[br][bc] = bv;
    __syncthreads();
#pragma unroll
    for (int kk = 0; kk < 16; ++kk) { float4 a = *(const float4*)&As[kk][ty * 4]; float4 b = *(const float4*)&Bs[kk][tx * 4];
      float aa[4] = {a.x, a.y, a.z, a.w}, bb[4] = {b.x, b.y, b.z, b.w};
#pragma unroll
      for (int i = 0; i < 4; ++i)
#pragma unroll
        for (int j = 0; j < 4; ++j) acc[i][j] += aa[i] * bb[j]; }
    __syncthreads();
  }
  for (int i = 0; i < 4; ++i) *(float4*)(C + (size_t)(bm + ty * 4 + i) * ldc + bn + tx * 4) = make_float4(acc[i][0], acc[i][1], acc[i][2], acc[i][3]);
}
__global__ void k_rope(float* P, Dims dm) {
  size_t n = (size_t)dm.nb * SEQ * 1024;
  for (size_t i = (size_t)blockIdx.x * blockDim.x + threadIdx.x; i < n; i += (size_t)gridDim.x * blockDim.x) {
    int r = (int)(i >> 10), j = (int)(i & 1023); int f = j & 15, axis = (j >> 4) & 1, hm = (j >> 5) & 15, which = j >> 9;
    int t = r % SEQ; float pos = axis == 0 ? (float)(t / 64) : (float)(t % 64);
    float inv = 1.0f / powf(10000.0f, (float)(2 * f) / 32.0f); float ang = pos * inv; float cs = cosf(ang), sn = sinf(ang);
    float* p = P + (size_t)r * INW + (which ? COL_Q : COL_K) + hm * 64 + axis * 32 + f;
    float t1 = p[0], t2 = p[16]; p[0] = t1 * cs - t2 * sn; p[16] = t1 * sn + t2 * cs; }
}
__global__ void __launch_bounds__(256) k_attn(const float* P, float* ATT, const float* lq1, const float* lk1, const float* lq2, const float* lk2, const float* subg, float lam_init,
                                             int q_base, int nq, int seg0_base, int seg0_n, int seg1_base, int seg1_n) {
  __shared__ float kv[32][256];
  const int tid = threadIdx.x, qi = tid & 63, sl = tid >> 6, h = blockIdx.y, lb = blockIdx.z;
  float s1 = 0.f, s2 = 0.f; for (int i = 0; i < 64; ++i) { s1 += lq1[i] * lk1[i]; s2 += lq2[i] * lk2[i]; }
  const float lam = expf(s1) - expf(s2) + lam_init;
  const int qrow = q_base + lb * nq + blockIdx.x * 64 + qi;
  float q1[64], q2[64];
#pragma unroll
  for (int d = 0; d < 64; ++d) { q1[d] = P[(size_t)qrow * INW + COL_Q + h * 128 + d] * 0.125f; q2[d] = P[(size_t)qrow * INW + COL_Q + h * 128 + 64 + d] * 0.125f; }
  float o1[32], o2[32];
#pragma unroll
  for (int j = 0; j < 32; ++j) { o1[j] = 0.f; o2[j] = 0.f; }
  float m1 = -1e30f, m2 = -1e30f, l1 = 0.f, l2 = 0.f;
  const int nkeys = seg0_n + seg1_n;
  for (int k0 = 0; k0 < nkeys; k0 += 32) {
    __syncthreads();
    for (int i = tid; i < 32 * 256; i += 256) { int kk = i >> 8, c = i & 255; int key = k0 + kk;
      int row = key < seg0_n ? seg0_base + lb * seg0_n + key : seg1_base + lb * seg1_n + (key - seg0_n);
      kv[kk][c] = c < 128 ? P[(size_t)row * INW + COL_K + h * 128 + c] : P[(size_t)row * INW + COL_V + h * 128 + (c - 128)]; }
    __syncthreads();
    for (int kk = 0; kk < 32; ++kk) {
      float a = 0.f, b = 0.f;
#pragma unroll
      for (int d = 0; d < 64; ++d) { a += q1[d] * kv[kk][d]; b += q2[d] * kv[kk][64 + d]; }
      float mn = fmaxf(m1, a), al = expf(m1 - mn), p = expf(a - mn); l1 = l1 * al + p; m1 = mn;
#pragma unroll
      for (int j = 0; j < 32; ++j) o1[j] = o1[j] * al + p * kv[kk][128 + sl * 32 + j];
      mn = fmaxf(m2, b); al = expf(m2 - mn); p = expf(b - mn); l2 = l2 * al + p; m2 = mn;
#pragma unroll
      for (int j = 0; j < 32; ++j) o2[j] = o2[j] * al + p * kv[kk][128 + sl * 32 + j];
    }
  }
  __syncthreads();
  float* red = &kv[0][0];
  float ss = 0.f; float o[32];
#pragma unroll
  for (int j = 0; j < 32; ++j) { o[j] = o1[j] / l1 - lam * o2[j] / l2; ss += o[j] * o[j]; }
  red[sl * 64 + qi] = ss; __syncthreads();
  float tot = red[qi] + red[64 + qi] + red[128 + qi] + red[192 + qi];
  float rn = rsqrtf(tot / 128.f + 1e-5f) * (1.f - lam_init);
#pragma unroll
  for (int j = 0; j < 32; ++j) ATT[(size_t)qrow * D + h * 128 + sl * 32 + j] = o[j] * rn * subg[sl * 32 + j];
}
__global__ void __launch_bounds__(128) k_ssm(const float* P, float* YF, float* YR, const float* a_re, const float* a_im, const float* log_dt, const float* b_re, const float* b_im,
                                             const float* c_re, const float* c_im, Dims dm) {
  const int g = blockIdx.x, lb = blockIdx.y, di = threadIdx.x >> 6, p = threadIdx.x & 63;
  const size_t gp = ((size_t)di * NG + g) * NP + p;
  const double are = a_re[gp], aim = a_im[gp], dt = exp((double)log_dt[di * NG + g]);
  const double er = exp(are * dt), abr = er * cos(aim * dt), abi = er * sin(aim * dt);
  const double nr = abr - 1.0, ni = abi, den = are * are + aim * aim; const double fr = (nr * are + ni * aim) / den, fi = (ni * are - nr * aim) / den;
  float bbr[16], bbi[16], ccr[16], cci[16];
#pragma unroll
  for (int c = 0; c < 16; ++c) { double br = b_re[gp * 16 + c], bi = b_im[gp * 16 + c]; bbr[c] = (float)(fr * br - fi * bi); bbi[c] = (float)(fr * bi + fi * br);
    size_t ci = (((size_t)di * NG + g) * 16 + c) * NP + p; ccr[c] = c_re[ci]; cci[c] = c_im[ci]; }
  const float ar = (float)abr, ai = (float)abi;
  float hr = 0.f, hi = 0.f; float* Y = di ? YR : YF;
  const int lat0 = lb * SEQ, ctx0 = dm.nb * SEQ + lb * CTX;
  for (int s = 0; s < CTX + SEQ; ++s) {
    int row;
    if (di == 0) row = s < CTX ? ctx0 + s : lat0 + (s - CTX); else row = s < CTX ? ctx0 + (CTX - 1 - s) : lat0 + (SEQ - 1 - (s - CTX));
    const float* u = P + (size_t)row * INW + COL_U + g * 16;
    float br = 0.f, bi = 0.f;
#pragma unroll
    for (int c = 0; c < 16; ++c) { float uv = u[c]; br += bbr[c] * uv; bi += bbi[c] * uv; }
    float nhr = ar * hr - ai * hi + br, nhi = ar * hi + ai * hr + bi; hr = nhr; hi = nhi;
    float myv = 0.f;
#pragma unroll
    for (int c = 0; c < 16; ++c) { float v = hr * ccr[c] - hi * cci[c];
      for (int o = 32; o >= 1; o >>= 1) v += __shfl_xor(v, o);
      if (p == c) myv = v; }
    if (p < 16) Y[(size_t)row * SSMW + g * 16 + p] = myv;
  }
}
__global__ void k_glu_pre(const float* P, const float* YF, const float* YR, const float* dsk, float* YG, int nrows) {
  size_t n = (size_t)nrows * SSMW;
  for (size_t i = (size_t)blockIdx.x * blockDim.x + threadIdx.x; i < n; i += (size_t)gridDim.x * blockDim.x) { size_t r = i / SSMW; int c = i % SSMW;
    float y = P[r * INW + COL_U + c] * dsk[c] + YF[i] + YR[i]; YG[i] = gelu_tanh(y); }
}
__global__ void k_glu_post(const float* YG, const float* Z, const float* bg, float* S2, int nrows) {
  size_t n = (size_t)nrows * SSMW;
  for (size_t i = (size_t)blockIdx.x * blockDim.x + threadIdx.x; i < n; i += (size_t)gridDim.x * blockDim.x) { int c = i % SSMW; S2[i] = YG[i] * sigmf(Z[i] + bg[c]); }
}
__global__ void k_merge(const float* P, const float* P1, const float* P2, float* M, int nrows) {
  size_t n = (size_t)nrows * D;
  for (size_t i = (size_t)blockIdx.x * blockDim.x + threadIdx.x; i < n; i += (size_t)gridDim.x * blockDim.x) { size_t r = i / D; int c = i % D;
    M[i] = sigmf(P[r * INW + COL_GA + c]) * P1[i] + sigmf(P[r * INW + COL_GS + c]) * P2[i]; }
}
__device__ __forceinline__ float block_sum256(float v, float* sh) {
  for (int o = 32; o >= 1; o >>= 1) v += __shfl_xor(v, o);
  __syncthreads(); if ((threadIdx.x & 63) == 0) sh[threadIdx.x >> 6] = v; __syncthreads();
  return sh[0] + sh[1] + sh[2] + sh[3];
}
__global__ void __launch_bounds__(256) k_ln(float* X, const float* T, const float* MODl, int gate_idx, const float* g, const float* b, Dims dm, int row0, float alpha) {
  __shared__ float sh[4];
  const int r = row0 + blockIdx.x; const float* m = MODl + (size_t)modrow(r, dm) * 6144 + gate_idx * 1024;
  float v[4]; float s = 0.f;
  for (int i = 0; i < 4; ++i) { int d = threadIdx.x + i * 256; v[i] = alpha * X[(size_t)r * D + d] + m[d] * T[(size_t)r * D + d]; s += v[i]; }
  const float mean = block_sum256(s, sh) / 1024.f; float q = 0.f;
  for (int i = 0; i < 4; ++i) { float dd = v[i] - mean; q += dd * dd; }
  const float var = block_sum256(q, sh) / 1024.f; const float rs = rsqrtf(var + 1e-5f);
  for (int i = 0; i < 4; ++i) { int d = threadIdx.x + i * 256; X[(size_t)r * D + d] = (v[i] - mean) * rs * g[d] + b[d]; }
}
__global__ void __launch_bounds__(256) k_moe(const float* X, float* F, const float* MODl, const float* wg, const float* bg, const float* we, const float* be,
                                            const float* w1, const float* w3, const float* w2, Dims dm, int row0, int* dbg_route) {
  __shared__ float hx[1024]; __shared__ float lg[36]; __shared__ float hid[512]; __shared__ int se[2]; __shared__ float sw[2];
  const int r = row0 + blockIdx.x, tid = threadIdx.x; const float* m = MODl + (size_t)modrow(r, dm) * 6144;
  for (int i = 0; i < 4; ++i) { int d = tid + i * 256; hx[d] = X[(size_t)r * D + d] * (1.f + m[4 * 1024 + d]) + m[3 * 1024 + d]; }
  __syncthreads();
  { const int w = tid >> 6, lane = tid & 63;
    for (int e = w; e < 36; e += 4) { float s = 0.f;
      for (int k = lane; k < 1024; k += 64) s += hx[k] * (e < 4 ? wg[k * 4 + e] : we[k * 32 + (e - 4)]);
      for (int o = 32; o >= 1; o >>= 1) s += __shfl_xor(s, o);
      if (lane == 0) lg[e] = s + (e < 4 ? bg[e] : be[e - 4]); } }
  __syncthreads();
  if (tid == 0) {
    int gi = 0; for (int j = 1; j < 4; ++j) if (lg[j] > lg[gi]) gi = j;
    float mx = lg[gi], sum = 0.f; for (int j = 0; j < 4; ++j) sum += expf(lg[j] - mx); const float gtop = 1.f / sum;
    const float* el = lg + 4 + gi * 8; int i0 = 0; for (int j = 1; j < 8; ++j) if (el[j] > el[i0]) i0 = j;
    int i1 = -1; for (int j = 0; j < 8; ++j) if (j != i0 && (i1 < 0 || el[j] > el[i1])) i1 = j;
    const float e1 = expf(el[i1] - el[i0]); const float w0 = 1.f / (1.f + e1), w1v = e1 / (1.f + e1);
    se[0] = gi * 8 + i0; se[1] = gi * 8 + i1; sw[0] = w0 * gtop; sw[1] = w1v * gtop;
    if (dbg_route) { dbg_route[r * 2] = se[0]; dbg_route[r * 2 + 1] = se[1]; }
  }
  __syncthreads();
  float out[4] = {0.f, 0.f, 0.f, 0.f};
  for (int k = 0; k < 2; ++k) {
    const int e = se[k]; const float wk = sw[k];
    const float* W1 = w1 + (size_t)e * 1024 * 512; const float* W3 = w3 + (size_t)e * 1024 * 512; const float* W2 = w2 + (size_t)e * 512 * 1024;
    float a0 = 0.f, a1 = 0.f, c0 = 0.f, c1 = 0.f;
    for (int kk = 0; kk < 1024; ++kk) { const float xv = hx[kk]; a0 += xv * W1[(size_t)kk * 512 + tid]; a1 += xv * W1[(size_t)kk * 512 + 256 + tid]; c0 += xv * W3[(size_t)kk * 512 + tid]; c1 += xv * W3[(size_t)kk * 512 + 256 + tid]; }
    __syncthreads();
    hid[tid] = siluf(a0) * c0; hid[256 + tid] = siluf(a1) * c1;
    __syncthreads();
    float o[4] = {0.f, 0.f, 0.f, 0.f};
    for (int f = 0; f < 512; ++f) { const float hv = hid[f]; for (int i = 0; i < 4; ++i) o[i] += hv * W2[(size_t)f * 1024 + tid + i * 256]; }
    for (int i = 0; i < 4; ++i) out[i] += wk * o[i];
  }
  for (int i = 0; i < 4; ++i) F[(size_t)r * D + tid + i * 256] = out[i];
}
__global__ void k_store_out(const float* XL, float* out, size_t n) { for (size_t i = (size_t)blockIdx.x * blockDim.x + threadIdx.x; i < n; i += (size_t)gridDim.x * blockDim.x) out[i] = XL[i]; }

struct In { const float *x, *c, *ctx, *c_ctx, *w_mod, *b_mod, *w_in, *lam_q1, *lam_k1, *lam_q2, *lam_k2, *subln_g, *a_re, *a_im, *log_dt, *b_re, *b_im, *c_re, *c_im, *ssm_d,
  *w_glu, *b_glu, *w_pa, *w_ps, *w_o, *ln1_g, *ln1_b, *rg_w, *rg_b, *re_w, *re_b, *w1, *w3, *w2, *ln2_g, *ln2_b; };
struct Bufs { float *MOD, *XL, *H, *P, *ATT, *YF, *YR, *YG, *H2; size_t total; };
inline Bufs carve(float* base, int nb) {
  Bufs b; size_t R = (size_t)nb * (SEQ + CTX); float* p = base;
  b.MOD = p; p += (size_t)DEPTH * 9 * 6144; b.XL = p; p += R * D; b.H = p; p += R * D; b.P = p; p += R * INW; b.ATT = p; p += R * D;
  b.YF = p; p += R * SSMW; b.YR = p; p += R * SSMW; b.YG = p; p += R * SSMW; b.H2 = p; p += R * D; b.total = (size_t)(p - base); return b;
}
typedef void (*Hook)(int layer, int stage, const Bufs&, void* user, hipStream_t);
enum { ST_MOD = 0, ST_P = 1, ST_ATT = 2, ST_SSM = 3, ST_S2 = 4, ST_M = 5, ST_XL1 = 6, ST_F = 7, ST_XL2 = 8 };
inline void run(const In& in, const Bufs& B, Dims dm, int nlayers, float* out, hipStream_t st, Hook hook = nullptr, void* user = nullptr, int* dbg_route = nullptr) {
  const int nb = dm.nb, RL = nb * SEQ, RC = nb * CTX, R = RL + RC;
  const float ALPHA = 1.681792830507429f;
  k_mod<<<dim3(6144 / 256, DEPTH), 256, 0, st>>>(in.c, in.c_ctx, in.w_mod, in.b_mod, B.MOD);
  k_load_x<<<2048, 256, 0, st>>>(in.x, in.ctx, B.XL, dm);
  if (hook) hook(0, ST_MOD, B, user, st);
  for (int l = 0; l < nlayers; ++l) {
    const bool last = (l == DEPTH - 1); const float lam_init = 0.8f - 0.6f * expf(-0.3f * (float)l);
    const float* MODl = B.MOD + (size_t)l * 9 * 6144;
    const float* w_in = in.w_in + (size_t)l * D * INW;
    k_modulate<<<2048, 256, 0, st>>>(B.XL, B.H, MODl, 0, 1, dm, 0, R);
    k_gemm<<<dim3(INW / 64, R / 64), 256, 0, st>>>(B.H, D, w_in, INW, B.P, INW, D);
    k_rope<<<2048, 256, 0, st>>>(B.P, dm);
    if (hook) hook(l, ST_P, B, user, st);
    k_attn<<<dim3(SEQ / 64, NH, nb), 256, 0, st>>>(B.P, B.ATT, in.lam_q1 + l * 64, in.lam_k1 + l * 64, in.lam_q2 + l * 64, in.lam_k2 + l * 64, in.subln_g + l * 128, lam_init,
                                                  0, SEQ, RL, CTX, 0, SEQ);
    if (!last) k_attn<<<dim3(CTX / 64, NH, nb), 256, 0, st>>>(B.P, B.ATT, in.lam_q1 + l * 64, in.lam_k1 + l * 64, in.lam_q2 + l * 64, in.lam_k2 + l * 64, in.subln_g + l * 128, lam_init,
                                                             RL, CTX, RL, CTX, 0, 0);
    if (hook) hook(l, ST_ATT, B, user, st);
    const size_t so = (size_t)l * 2 * NG * NP;
    k_ssm<<<dim3(NG, nb), 128, 0, st>>>(B.P, B.YF, B.YR, in.a_re + so, in.a_im + so, in.log_dt + (size_t)l * 2 * NG, in.b_re + so * 16, in.b_im + so * 16, in.c_re + so * 16, in.c_im + so * 16, dm);
    k_glu_pre<<<2048, 256, 0, st>>>(B.P, B.YF, B.YR, in.ssm_d + l * SSMW, B.YG, R);
    if (hook) hook(l, ST_SSM, B, user, st);
    float* Z = B.YF; float* S2 = B.YR;
    k_gemm<<<dim3(SSMW / 64, R / 64), 256, 0, st>>>(B.YG, SSMW, in.w_glu + (size_t)l * SSMW * SSMW, SSMW, Z, SSMW, SSMW);
    k_glu_post<<<2048, 256, 0, st>>>(B.YG, Z, in.b_glu + l * SSMW, S2, R);
    if (hook) hook(l, ST_S2, B, user, st);
    float* P1 = B.H; float* P2 = B.H2; float* M = B.ATT;
    k_gemm<<<dim3(D / 64, R / 64), 256, 0, st>>>(B.ATT, D, in.w_pa + (size_t)l * D * D, D, P1, D, D);
    k_gemm<<<dim3(D / 64, R / 64), 256, 0, st>>>(S2, SSMW, in.w_ps + (size_t)l * SSMW * D, D, P2, D, SSMW);
    k_merge<<<2048, 256, 0, st>>>(B.P, P1, P2, M, R);
    if (hook) hook(l, ST_M, B, user, st);
    float* T = B.H;
    k_gemm<<<dim3(D / 64, R / 64), 256, 0, st>>>(M, D, in.w_o + (size_t)l * D * D, D, T, D, D);
    k_ln<<<last ? RL : R, 256, 0, st>>>(B.XL, T, MODl, 2, in.ln1_g + l * D, in.ln1_b + l * D, dm, 0, ALPHA);
    if (hook) hook(l, ST_XL1, B, user, st);
    float* F = B.H2;
    k_moe<<<last ? RL : R, 256, 0, st>>>(B.XL, F, MODl, in.rg_w + (size_t)l * D * 4, in.rg_b + l * 4, in.re_w + (size_t)l * D * 32, in.re_b + l * 32,
                                        in.w1 + (size_t)l * NE * D * EH, in.w3 + (size_t)l * NE * D * EH, in.w2 + (size_t)l * NE * EH * D, dm, 0, dbg_route);
    if (hook) hook(l, ST_F, B, user, st);
    k_ln<<<last ? RL : R, 256, 0, st>>>(B.XL, F, MODl, 5, in.ln2_g + l * D, in.ln2_b + l * D, dm, 0, ALPHA);
    if (hook) hook(l, ST_XL2, B, user, st);
  }
  if (out) k_store_out<<<2048, 256, 0, st>>>(B.XL, out, (size_t)RL * D);
}
}
extern "C" void kernel_launch(void* const* d_in, const int* in_sizes, int n_in, void* d_out, int out_size, void* d_ws, size_t ws_size, hipStream_t stream) {
  orc::In in; const float** ip = (const float**)&in; for (int i = 0; i < 36; ++i) ip[i] = (const float*)d_in[i];
  orc::Bufs B = orc::carve((float*)d_ws, 8);
  if (B.total * 4 > ws_size) { fprintf(stderr, "ws too small: need %zu have %zu\n", B.total * 4, ws_size); return; }
  orc::Dims dm{8, 0};
  orc::run(in, B, dm, 4, (float*)d_out, stream);
}
```

```cpp
#include <hip/hip_runtime.h>
#include <cstdio>
#include <cstdint>
#include <cstring>
#include <cmath>
namespace fk {
#define LAS __attribute__((address_space(3)))
typedef unsigned short bf16_t;
typedef short bf16x8 __attribute__((ext_vector_type(8)));
typedef short s16x4 __attribute__((ext_vector_type(4)));
typedef float f32x4 __attribute__((ext_vector_type(4)));
typedef float f32x2 __attribute__((ext_vector_type(2)));
typedef float f32x16 __attribute__((ext_vector_type(16)));
typedef unsigned u32x4 __attribute__((ext_vector_type(4)));
typedef unsigned u32x2 __attribute__((ext_vector_type(2)));

constexpr int D = 1024, SEQ = 2048, CTX = 256, NB = 8, NLAT = NB * SEQ, NCTX = NB * CTX, NR = NLAT + NCTX, KVB = SEQ + CTX;
constexpr int INW = 5632, NHEAD = 8, SSMW = 512, NG = 32, NP = 64, NE = 32, EH = 512, DEPTH = 4;
constexpr int CHUNK = 32, NCHR = NR / CHUNK  , NCHP = 768  ;
constexpr int MOE_ROWS = 2 * NR + NE * 256;
constexpr float ALPHA = 1.681792830507429f;

__device__ __forceinline__ unsigned cvt_pk_bf16(float lo, float hi) { unsigned r; asm volatile("v_cvt_pk_bf16_f32 %0, %1, %2" : "=v"(r) : "v"(lo), "v"(hi)); return r; }
__device__ __forceinline__ float bf2f(unsigned short b) { return __uint_as_float(((unsigned)b) << 16); }
__device__ __forceinline__ float bflo(unsigned w) { return __uint_as_float(w << 16); }
__device__ __forceinline__ float bfhi(unsigned w) { return __uint_as_float(w & 0xffff0000u); }
__device__ __forceinline__ u32x4 pack8(const f32x4& a, const f32x4& b) { u32x4 w; w.x = cvt_pk_bf16(a[0], a[1]); w.y = cvt_pk_bf16(a[2], a[3]); w.z = cvt_pk_bf16(b[0], b[1]); w.w = cvt_pk_bf16(b[2], b[3]); return w; }
__device__ __forceinline__ void unpack8(const u32x4& w, f32x4& a, f32x4& b) { a = (f32x4){bflo(w.x), bfhi(w.x), bflo(w.y), bfhi(w.y)}; b = (f32x4){bflo(w.z), bfhi(w.z), bflo(w.w), bfhi(w.w)}; }
__device__ __forceinline__ float fast_sigmoid(float x) { return __builtin_amdgcn_rcpf(1.f + __builtin_amdgcn_exp2f(-1.4426950408889634f * x)); }
__device__ __forceinline__ float fast_silu(float x) { return x * fast_sigmoid(x); }
__device__ __forceinline__ float gelu_tanh_f(float x) { const float z = 0.7978845608028654f * (x + 0.044715f * x * x * x); return x * fast_sigmoid(2.f * z); }
__device__ __forceinline__ int otid() { int t = threadIdx.x; asm volatile("" : "+v"(t)); return t; }
__host__ __device__ __forceinline__ int perm32(int rho) { const int n = rho >> 4, i = rho & 15; return 8 * (i >> 2) + 4 * n + (i & 3); }

#define XB_TMO      128
#define XB_XCNT(j)  (256  + 64 * (j))
#define XB_XSUB(j)  (1280 + 64 * (j))
#define XB_XGEN(j)  (2304 + 64 * (j))
#define XB_TOP      3328
#define XB_TOPGEN   3392
#define XCD_BAR_WORDS 3456
#define XB_SPIN_CAP (1u << 22)
__device__ __forceinline__ unsigned xb_ld(unsigned* p)              { return __hip_atomic_load(p, __ATOMIC_RELAXED, __HIP_MEMORY_SCOPE_AGENT); }
__device__ __forceinline__ unsigned xb_add(unsigned* p, unsigned v) { return __hip_atomic_fetch_add(p, v, __ATOMIC_RELAXED, __HIP_MEMORY_SCOPE_AGENT); }
__device__ __forceinline__ unsigned xb_xcc_id() { return (unsigned)__builtin_amdgcn_s_getreg((3 << 11) | 20) & 0xFu; }
#define XB_SPIN(cond, bar) do { unsigned _sp = 0; while (cond) { __builtin_amdgcn_s_sleep(1); \
    if ((++_sp & 255u) == 0u) { if (xb_ld(&(bar)[XB_TMO])) break; if (_sp > XB_SPIN_CAP) { atomicAdd(&(bar)[XB_TMO], 1u); break; } } } } while (0)
struct XcdBarrier { unsigned* bar; unsigned x; volatile LAS unsigned* st; };
__device__ __forceinline__ XcdBarrier xcd_barrier_post(unsigned* bar, volatile LAS unsigned* st) {
    XcdBarrier b; b.bar = bar; b.x = xb_xcc_id(); b.st = st;
    if (threadIdx.x == 0) (void)xb_add(&bar[XB_XCNT(b.x)], 1u);
    return b;
}
__device__ __forceinline__ void xcd_barrier_complete(unsigned* bar, unsigned x, unsigned& nloc, unsigned& nx) {
    const unsigned G = gridDim.x * gridDim.y * gridDim.z;
    unsigned sum, cnt, mine, sp = 0u;
    for (;;) {
        sum = 0u; cnt = 0u; mine = 0u;
#pragma unroll
        for (unsigned j = 0; j < 16; ++j) { const unsigned c = xb_ld(&bar[XB_XCNT(j)]); sum += c; cnt += (c > 0u) ? 1u : 0u; mine = (j == x) ? c : mine; }
        if (sum == G) break;
        __builtin_amdgcn_s_sleep(1);
        if ((++sp & 255u) == 0u) { if (xb_ld(&bar[XB_TMO])) break; if (sp > XB_SPIN_CAP) { atomicAdd(&bar[XB_TMO], 1u); break; } }
    }
    nloc = mine > 0u ? mine : 1u; nx = cnt > 0u ? cnt : 1u;
}
__device__ __forceinline__ void xcd_barrier(const XcdBarrier& b) {
    asm volatile("s_waitcnt vmcnt(0)" ::: "memory");
    __syncthreads();
    if (threadIdx.x == 0) {
        unsigned* bar = b.bar;
        __builtin_amdgcn_s_waitcnt(0);
        unsigned nloc = b.st[0], nx = b.st[1];
        if (nloc == 0u) { xcd_barrier_complete(bar, b.x, nloc, nx); b.st[0] = nloc; b.st[1] = nx; }
        const unsigned old = xb_add(&bar[XB_XSUB(b.x)], 1u);
        const unsigned gen = old / nloc;
        if (old + 1u == (gen + 1u) * nloc) {
            __builtin_amdgcn_fence(__ATOMIC_RELEASE, "agent");
            asm volatile("s_waitcnt vmcnt(0)" ::: "memory");
            const unsigned og = xb_add(&bar[XB_TOP], 1u);
            const unsigned tg = og / nx;
            if (og + 1u == (tg + 1u) * nx) xb_add(&bar[XB_TOPGEN], 1u);
            else XB_SPIN(xb_ld(&bar[XB_TOPGEN]) == tg, bar);
            __builtin_amdgcn_fence(__ATOMIC_ACQUIRE, "agent");
            xb_add(&bar[XB_XGEN(b.x)], 1u);
            asm volatile("s_waitcnt vmcnt(0)" ::: "memory");
        } else {
            XB_SPIN(xb_ld(&bar[XB_XGEN(b.x)]) == gen, bar);
            __builtin_amdgcn_fence(__ATOMIC_ACQUIRE, "agent");
            asm volatile("s_waitcnt vmcnt(0)" ::: "memory");
        }
    }
    __syncthreads();
}

constexpr int BM = 256, BK = 64, HALF = 128, HTB = HALF * BK * 2, STAGE_BYTES = 8 * HTB;
__host__ __device__ __forceinline__ int lds_byte(int r, int c) { const int st = (r >> 4) * 2 + (c >> 5), rr = r & 15, cc = c & 31, ob = rr * 64 + cc * 2; return st * 1024 + (ob ^ (((ob >> 9) & 1) << 5)); }
__host__ __device__ __forceinline__ void stage_rc(int b, int& R, int& C) { const int st = b / 1024, sb = b % 1024, swz = sb ^ (((sb >> 9) & 1) << 5); R = (st >> 1) * 16 + swz / 64; C = (st & 1) * 32 + (swz % 64) / 2; }
struct Seg { const char* A; const char* B; int nt; int epi; int pm; int pn; int aux; int aux2; };
__device__ __forceinline__ void tile_order(int L, int nM, int nN, int& pm, int& pn) {
    const int nwg = nM * nN; int wgid = L; { const int q = nwg / 8, r = nwg % 8, xcd = wgid % 8, off = wgid / 8; wgid = (xcd < r ? xcd * (q + 1) : r * (q + 1) + (xcd - r) * q) + off; }
    const int nig = 8 * nN, gid = wgid / nig, fm = gid * 8, gsz = (nM - fm) < 8 ? (nM - fm) : 8;
    pm = fm + ((wgid % nig) % gsz); pn = (wgid % nig) / gsz;
}
template <class Epi, class Sched>
__device__ __forceinline__ void gemm_stream(LAS unsigned char* lds, const int lda, const int ldb, const Sched& S, const Epi& E) {
    const int tid = otid(), wid = __builtin_amdgcn_readfirstlane(tid >> 6), lane = tid & 63, wr = wid >> 2, wc = wid & 3, fr = lane & 15, fq = lane >> 4;
    unsigned voffA[2], voffB[2];
#pragma unroll
    for (int i = 0; i < 2; ++i) { int R, C; stage_rc(tid * 16 + i * 8192, R, C); voffA[i] = (unsigned)(R * lda + C * 2); voffB[i] = (unsigned)(R * ldb + C * 2); }
    const size_t kstep = (size_t)(BK * 2);
    const size_t hstepA = (size_t)HALF * lda, hstepB = (size_t)HALF * ldb;
    const unsigned ldsw = (unsigned)wid * 1024u;
    const int aoff = lds_byte(wr * 64 + fr, fq * 8), boff = lds_byte(wc * 32 + fr, fq * 8);
#define PG8_SA(b, h) (((b) * 2 + (h)) * HTB)
#define PG8_SB(b, h) ((4 + (b) * 2 + (h)) * HTB)
#define PG8_STAGE(bufoff, gbase, voff) do { _Pragma("unroll") for (int _i = 0; _i < 2; ++_i) \
        __builtin_amdgcn_global_load_lds((const unsigned*)((const char*)(gbase) + (voff)[_i]), (LAS unsigned*)(lds + (bufoff) + ldsw + _i * 8192), 16, 0, 0); } while (0)
#define PG8_LDA(dst, b, h) do { _Pragma("unroll") for (int m = 0; m < 4; ++m) _Pragma("unroll") for (int k = 0; k < 2; ++k) dst[m][k] = *(const LAS bf16x8*)(lds + PG8_SA(b, h) + aoff + m * 2048 + k * 1024); } while (0)
#define PG8_LDB(dst, b, h) do { _Pragma("unroll") for (int n = 0; n < 2; ++n) _Pragma("unroll") for (int k = 0; k < 2; ++k) dst[n][k] = *(const LAS bf16x8*)(lds + PG8_SB(b, h) + boff + n * 2048 + k * 1024); } while (0)
#define PG8_MMA(ai, bj, At, Bt) do { __builtin_amdgcn_s_setprio(1); _Pragma("unroll") for (int m = 0; m < 4; ++m) _Pragma("unroll") for (int n = 0; n < 2; ++n) _Pragma("unroll") for (int k = 0; k < 2; ++k) \
        acc[ai][bj][m][n] = __builtin_amdgcn_mfma_f32_16x16x32_bf16(Bt[n][k], At[m][k], acc[ai][bj][m][n], 0, 0, 0); __builtin_amdgcn_s_setprio(0); } while (0)
#define PG8_WAIT_V(n) asm volatile("s_waitcnt vmcnt(" #n ")" ::: "memory")
#define PG8_WAIT_L(n) asm volatile("s_waitcnt lgkmcnt(" #n ")" ::: "memory")
#define PG8_BAR __builtin_amdgcn_s_barrier()
#define PG8_SCHED __builtin_amdgcn_sched_barrier(0)
    Seg cur, nxt; int ui = 0;
    if (!S.next(0, cur)) return;
    f32x4 acc[2][2][4][2];
#pragma unroll
    for (int a = 0; a < 2; ++a)
#pragma unroll
        for (int b = 0; b < 2; ++b)
#pragma unroll
            for (int m = 0; m < 4; ++m)
#pragma unroll
                for (int n = 0; n < 2; ++n) acc[a][b][m][n] = (f32x4){0.f, 0.f, 0.f, 0.f};
    bf16x8 At[4][2], B0[2][2], B1[2][2];
    const char* cA = cur.A; const char* cB = cur.B;
    PG8_STAGE(PG8_SB(0, 0), cB, voffB); PG8_STAGE(PG8_SB(0, 1), cB + hstepB, voffB); PG8_STAGE(PG8_SA(0, 0), cA, voffA); PG8_STAGE(PG8_SA(0, 1), cA + hstepA, voffA);
    if (wr == 1) PG8_BAR;
    PG8_WAIT_V(2); PG8_BAR;
    PG8_STAGE(PG8_SB(1, 0), cB + kstep, voffB); PG8_STAGE(PG8_SA(1, 0), cA + kstep, voffA); PG8_STAGE(PG8_SB(1, 1), cB + hstepB + kstep, voffB);
    PG8_WAIT_V(6); PG8_BAR;
    for (;;) {
        const bool has_next = S.next(ui + 1, nxt);
        const char* nA = has_next ? nxt.A : cA; const char* nB = has_next ? nxt.B : cB;
        const int nt = cur.nt;
        for (int t = 0; t < nt; t += 2) {
            const bool last = (t == nt - 2);
            const char* a1 = cA + (size_t)(t + 1) * kstep;
            const char* a2 = last ? nA : cA + (size_t)(t + 2) * kstep; const char* b2 = last ? nB : cB + (size_t)(t + 2) * kstep;
            const char* a3 = a2 + kstep; const char* b3 = b2 + kstep;
            PG8_LDB(B0, 0, 0); PG8_LDB(B1, 0, 1); PG8_SCHED; PG8_LDA(At, 0, 0); PG8_STAGE(PG8_SA(1, 1), a1 + hstepA, voffA);
            PG8_WAIT_V(8); PG8_WAIT_L(0); PG8_BAR; PG8_MMA(0, 0, At, B0); PG8_MMA(0, 1, At, B1); PG8_BAR; PG8_SCHED;
            PG8_LDA(At, 0, 1); PG8_STAGE(PG8_SB(0, 0), b2, voffB); PG8_STAGE(PG8_SB(0, 1), b2 + hstepB, voffB); PG8_STAGE(PG8_SA(0, 0), a2, voffA);
            PG8_WAIT_V(8); PG8_WAIT_L(0); PG8_BAR; PG8_MMA(1, 0, At, B0); PG8_MMA(1, 1, At, B1); PG8_BAR; PG8_SCHED;
            PG8_LDB(B0, 1, 0); PG8_LDB(B1, 1, 1); PG8_SCHED; PG8_LDA(At, 1, 0); PG8_STAGE(PG8_SA(0, 1), a2 + hstepA, voffA);
            PG8_WAIT_V(8); PG8_WAIT_L(0); PG8_BAR; PG8_MMA(0, 0, At, B0); PG8_MMA(0, 1, At, B1); PG8_BAR; PG8_SCHED;
            PG8_LDA(At, 1, 1); PG8_STAGE(PG8_SB(1, 0), b3, voffB); PG8_STAGE(PG8_SB(1, 1), b3 + hstepB, voffB); PG8_STAGE(PG8_SA(1, 0), a3, voffA);
            PG8_WAIT_V(8); PG8_WAIT_L(0); PG8_BAR; PG8_MMA(1, 0, At, B0); PG8_MMA(1, 1, At, B1); PG8_BAR; PG8_SCHED;
        }
        if (cur.epi) {
            if (wr == 0) PG8_BAR;
            int efr = fr, efq = fq; asm volatile("" : "+v"(efr), "+v"(efq));
            const bool z = E(acc, cur, wr, wc, efr, efq);
            if (z) {
#pragma unroll
                for (int a = 0; a < 2; ++a)
#pragma unroll
                    for (int b = 0; b < 2; ++b)
#pragma unroll
                        for (int m = 0; m < 4; ++m)
#pragma unroll
                            for (int n = 0; n < 2; ++n) acc[a][b][m][n] = (f32x4){0.f, 0.f, 0.f, 0.f};
            }
            if (!has_next) break;
            if (wr == 1) PG8_BAR;
        } else if (!has_next) { if (wr == 0) PG8_BAR; break; }
        cur = nxt; cA = nA; cB = nB; ++ui;
    }
    PG8_WAIT_V(0);
    PG8_BAR;
#undef PG8_SA
#undef PG8_SB
#undef PG8_STAGE
#undef PG8_LDA
#undef PG8_LDB
#undef PG8_MMA
#undef PG8_WAIT_V
#undef PG8_WAIT_L
#undef PG8_BAR
#undef PG8_SCHED
}
}
namespace fk {
struct In { const float *x, *c, *ctx, *c_ctx, *w_mod, *b_mod, *w_in, *lam_q1, *lam_k1, *lam_q2, *lam_k2, *subln_g, *a_re, *a_im, *log_dt, *b_re, *b_im, *c_re, *c_im, *ssm_d,
  *w_glu, *b_glu, *w_pa, *w_ps, *w_o, *ln1_g, *ln1_b, *rg_w, *rg_b, *re_w, *re_b, *w1, *w3, *w2, *ln2_g, *ln2_b; };
struct Params {
  In in; float* out;
  unsigned* bar;
  unsigned* ctl;
  float* MOD;
  float* ROPE;
  float* XL;
  bf16_t* Hb;
  bf16_t* Kc; bf16_t* Vc;
  bf16_t* Qb;
  bf16_t* Ug;
  bf16_t* RG; bf16_t* GSb;
  bf16_t* ATTb;
  float* SST;
  bf16_t* YG;
  bf16_t* S2;
  bf16_t* Mb;
  bf16_t* H2b;
  int* ROUTE;
  float* RW;
  int* POS;
  int* BLKBASE;
  bf16_t* Xs;
  bf16_t* Hm;
  bf16_t* Yo;
  bf16_t* Win; bf16_t* Wglu; bf16_t* Wpa; bf16_t* Wps; bf16_t* Wo; bf16_t* W13; bf16_t* W2;
  bf16_t* Smat;
  bf16_t* TO;
  float* SAL;
  float* WR;
  int ph_lo, ph_hi;
  int pad0, pad1;
};
constexpr int CTL_CNT = 0;
constexpr int CTL_WORDS = 64 * 32 + 64;

__device__ __forceinline__ int modrow_of_tile(int pm) { return pm < 64 ? (pm >> 3) : 8; }
__device__ __forceinline__ int kvrow0_of_tile(int pm) { return pm < 64 ? (pm >> 3) * KVB + CTX + (pm & 7) * 256 : (pm - 64) * KVB; }

struct SchedPlain {
  const char* A; const char* B; int lda, ldb, nM, nN, nt, G, c, nunits; int epi;
  __device__ __forceinline__ bool next(int i, Seg& s) const {
    const int L = i * G + c; if (L >= nunits) return false;
    int pm, pn; tile_order(L, nM, nN, pm, pn);
    s.A = A + (size_t)pm * 256 * lda; s.B = B + (size_t)pn * 256 * ldb; s.nt = nt; s.epi = epi; s.pm = pm; s.pn = pn; s.aux = 0; s.aux2 = 0; return true; }
};
struct SchedMerge {
  const char* A1; const char* B1; const char* A2; const char* B2; int nM, nN, G, c, nunits;
  __device__ __forceinline__ bool next(int i, Seg& s) const {
    const int L = (i >> 1) * G + c; if (L >= nunits) return false;
    int pm, pn; tile_order(L, nM, nN, pm, pn); s.pm = pm; s.pn = pn; s.aux = 0; s.aux2 = 0;
    if ((i & 1) == 0) { s.A = A1 + (size_t)pm * 256 * 2048; s.B = B1 + (size_t)pn * 256 * 2048; s.nt = 16; s.epi = 2; }
    else { s.A = A2 + (size_t)pm * 256 * 2048; s.B = B2 + (size_t)pn * 256 * 2048; s.nt = 8; s.epi = 1; }
    return true; }
};
struct SchedSsm1 {
  const char* Ug; const char* Smat; int G, c;
  __device__ __forceinline__ bool next(int i, Seg& s) const {
    const int L = i * G + c; if (L >= NG * 3) return false;
    const int g = L / 3, pm = L % 3;
    s.A = Ug + (size_t)g * NCHP * 1536 + (size_t)pm * 256 * 1536; s.B = Smat + (size_t)g * 256 * 1536; s.nt = 8; s.epi = 1; s.pm = pm; s.pn = 0; s.aux = g; s.aux2 = 0; return true; }
};
struct SchedSsm3 {
  const char* Ug; const char* TO; int G, c;
  __device__ __forceinline__ bool next(int i, Seg& s) const {
    const int L = i * G + c; if (L >= NG * 6) return false;
    const int g = L / 6, r = L % 6, pm = r >> 1, pn = r & 1; s.pm = pm; s.pn = pn; s.aux = g; s.aux2 = 0;
    s.A = Ug + (size_t)g * NCHP * 1536 + (size_t)pm * 256 * 1536; s.B = TO + (size_t)g * 512 * 1536 + (size_t)pn * 256 * 1536; s.nt = 12; s.epi = 1; return true; }
};
struct SchedMoe {
  const char* A; const char* B; int lda, ldb; size_t estride; const LAS int* tileE; int ntiles, nN, nt, G, c;
  __device__ __forceinline__ bool next(int i, Seg& s) const {
    const int L = i * G + c; if (L >= ntiles * nN) return false;
    const int t = L / nN, pn = L % nN; const int e = tileE[t];
    s.A = A + (size_t)t * 256 * lda; s.B = B + (size_t)e * estride + (size_t)pn * 256 * ldb; s.nt = nt; s.epi = 1; s.pm = t; s.pn = pn; s.aux = e; s.aux2 = 0; return true; }
};

#define EPI_LOOP_AM for (int ai = 0; ai < 2; ++ai) _Pragma("unroll") for (int m = 0; m < 4; ++m)
struct EpiIn {
  const float* ROPE; bf16_t* Kc; bf16_t* Vc; bf16_t* Ug; bf16_t* Qb; bf16_t* RG; bf16_t* GSb;
  __device__ __forceinline__ bool operator()(f32x4 (&acc)[2][2][4][2], const Seg& s, int wr, int wc, int fr, int fq) const {
    const int pm = s.pm, pn = s.pn; const int rin0 = wr * 64 + fr;
    if (pn < 4 || (pn >= 10 && pn < 14)) {
      const bool isq = pn >= 10; const int pt = isq ? pn - 10 : pn; const int axis = wc & 1;
      bf16_t* dst = isq ? Qb : Kc; const int drow0 = isq ? pm * 256 : kvrow0_of_tile(pm); const bool lat = pm < 64;
#pragma unroll
      EPI_LOOP_AM { const int rin = ai * 128 + m * 16 + rin0; f32x4 cs = (f32x4){1.f, 1.f, 1.f, 1.f}, sn = (f32x4){0.f, 0.f, 0.f, 0.f};
        if (lat) { const int t = (pm * 256 + rin) & (SEQ - 1); const float* rp = ROPE + ((size_t)t * 2 + axis) * 32 + fq * 4; cs = *(const f32x4*)rp; sn = *(const f32x4*)(rp + 16); }
#pragma unroll
        for (int bj = 0; bj < 2; ++bj) { const f32x4 t1 = acc[ai][bj][m][0], t2 = acc[ai][bj][m][1]; const f32x4 o1 = t1 * cs - t2 * sn, o2 = t1 * sn + t2 * cs;
          *(u32x4*)(dst + (size_t)(drow0 + rin) * 1024 + (2 * pt + bj) * 128 + wc * 32 + fq * 8) = pack8(o1, o2); } }
    } else if (pn < 8) {
      const int drow0 = kvrow0_of_tile(pm);
#pragma unroll
      EPI_LOOP_AM { const int rin = ai * 128 + m * 16 + rin0;
#pragma unroll
        for (int bj = 0; bj < 2; ++bj) *(u32x4*)(Vc + (size_t)(drow0 + rin) * 1024 + (pn - 4) * 256 + bj * 128 + wc * 32 + fq * 8) = pack8(acc[ai][bj][m][0], acc[ai][bj][m][1]); }
    } else if (pn < 10) {
#pragma unroll
      EPI_LOOP_AM { const int rin = ai * 128 + m * 16 + rin0;
#pragma unroll
        for (int bj = 0; bj < 2; ++bj) { const int c0 = (pn - 8) * 256 + bj * 128 + wc * 32 + fq * 8; const int g = c0 >> 4, co = c0 & 15;
          const int R = pm * 256 + rin; *(u32x4*)(Ug + ((size_t)g * NCHP + (R >> 5)) * 768 + (R & 31) * 16 + co) = pack8(acc[ai][bj][m][0], acc[ai][bj][m][1]); } }
    } else {
      const int c0 = (pn - 14) * 128 + wc * 32 + fq * 8;
#pragma unroll
      EPI_LOOP_AM { const int rin = ai * 128 + m * 16 + rin0; f32x4 r[2], g[2];
#pragma unroll
        for (int n = 0; n < 2; ++n)
#pragma unroll
          for (int j = 0; j < 4; ++j) { const float ea = __builtin_amdgcn_exp2f(-1.4426950408889634f * acc[ai][0][m][n][j]); const float es = __builtin_amdgcn_exp2f(-1.4426950408889634f * fmaxf(acc[ai][1][m][n][j], -60.f));
            g[n][j] = __builtin_amdgcn_rcpf(1.f + es); r[n][j] = (1.f + es) * __builtin_amdgcn_rcpf(1.f + ea); }
        *(u32x4*)(RG + (size_t)(pm * 256 + rin) * 1024 + c0) = pack8(r[0], r[1]); *(u32x4*)(GSb + (size_t)(pm * 256 + rin) * 1024 + c0) = pack8(g[0], g[1]); }
    }
    return true;
  }
};
struct EpiState {
  float* SST;
  __device__ __forceinline__ bool operator()(f32x4 (&acc)[2][2][4][2], const Seg& s, int wr, int wc, int fr, int fq) const {
    const int g = s.aux;
#pragma unroll
    EPI_LOOP_AM { const int row = s.pm * 256 + ai * 128 + m * 16 + wr * 64 + fr;
      if (row < NCHR) {
#pragma unroll
        for (int bj = 0; bj < 2; ++bj) { float* p = SST + ((size_t)g * NCHP + row) * 256 + bj * 128 + wc * 32 + fq * 8; *(f32x4*)p = acc[ai][bj][m][0]; *(f32x4*)(p + 4) = acc[ai][bj][m][1]; } } }
    return true;
  }
};
struct EpiSsmOut {
  bf16_t* YG;
  __device__ __forceinline__ bool operator()(f32x4 (&acc)[2][2][4][2], const Seg& s, int wr, int wc, int fr, int fq) const {
    const int g = s.aux;
#pragma unroll
    EPI_LOOP_AM { const int row = s.pm * 256 + ai * 128 + m * 16 + wr * 64 + fr;
      if (row < NCHR) {
#pragma unroll
        for (int bj = 0; bj < 2; ++bj) { const int c0 = s.pn * 256 + bj * 128 + wc * 32 + fq * 8; const int t = c0 >> 4, co = c0 & 15; f32x4 a = acc[ai][bj][m][0], b = acc[ai][bj][m][1];
#pragma unroll
          for (int j = 0; j < 4; ++j) { a[j] = gelu_tanh_f(a[j]); b[j] = gelu_tanh_f(b[j]); }
          *(u32x4*)(YG + ((size_t)row * CHUNK + t) * SSMW + g * 16 + co) = pack8(a, b); } } }
    return true;
  }
};
struct EpiGlu {
  const bf16_t* YG; bf16_t* S2; const float* bias;
  __device__ __forceinline__ bool operator()(f32x4 (&acc)[2][2][4][2], const Seg& s, int wr, int wc, int fr, int fq) const {
#pragma unroll
    for (int bj = 0; bj < 2; ++bj) { const int c0 = s.pn * 256 + bj * 128 + wc * 32 + fq * 8; const f32x4 b0 = *(const f32x4*)(bias + c0), b1 = *(const f32x4*)(bias + c0 + 4);
#pragma unroll
      EPI_LOOP_AM { const int row = s.pm * 256 + ai * 128 + m * 16 + wr * 64 + fr; const u32x4 yw = *(const u32x4*)(YG + (size_t)row * SSMW + c0); f32x4 y0, y1; unpack8(yw, y0, y1);
        f32x4 z0 = acc[ai][bj][m][0] + b0, z1 = acc[ai][bj][m][1] + b1;
#pragma unroll
        for (int j = 0; j < 4; ++j) { z0[j] = y0[j] * fast_sigmoid(z0[j]); z1[j] = y1[j] * fast_sigmoid(z1[j]); }
        *(u32x4*)(S2 + (size_t)row * 1024 + c0) = pack8(z0, z1); } }
    return true;
  }
};
struct EpiMerge {
  const bf16_t* RG; const bf16_t* GSb; bf16_t* Mb;
  __device__ __forceinline__ bool operator()(f32x4 (&acc)[2][2][4][2], const Seg& s, int wr, int wc, int fr, int fq) const {
    const bool mid = s.epi == 2; const bf16_t* src = mid ? RG : GSb;
#pragma unroll
    EPI_LOOP_AM { const int row = s.pm * 256 + ai * 128 + m * 16 + wr * 64 + fr;
#pragma unroll
      for (int bj = 0; bj < 2; ++bj) { const int c0 = s.pn * 256 + bj * 128 + wc * 32 + fq * 8; const u32x4 w = *(const u32x4*)(src + (size_t)row * 1024 + c0); f32x4 g0, g1; unpack8(w, g0, g1);
        acc[ai][bj][m][0] *= g0; acc[ai][bj][m][1] *= g1;
        if (!mid) *(u32x4*)(Mb + (size_t)row * 1024 + c0) = pack8(acc[ai][bj][m][0], acc[ai][bj][m][1]); } }
    return !mid;
  }
};
struct EpiWo {
  const float* xin_lat; const float* xin_ctx; float* XL; const float* MODl;
  __device__ __forceinline__ bool operator()(f32x4 (&acc)[2][2][4][2], const Seg& s, int wr, int wc, int fr, int fq) const {
    const int pm = s.pm; const float* gate = MODl + (size_t)modrow_of_tile(pm) * 6144 + 2 * 1024;
    const float* xin = pm < 64 ? xin_lat + (size_t)pm * 256 * 1024 : xin_ctx + (size_t)(pm - 64) * 256 * 1024;
#pragma unroll
    for (int bj = 0; bj < 2; ++bj) { const int c0 = s.pn * 256 + bj * 128 + wc * 32 + fq * 8; const f32x4 g0 = *(const f32x4*)(gate + c0), g1 = *(const f32x4*)(gate + c0 + 4);
#pragma unroll
      EPI_LOOP_AM { const int rin = ai * 128 + m * 16 + wr * 64 + fr; const float* xp = xin + (size_t)rin * 1024 + c0; float* op = XL + (size_t)(pm * 256 + rin) * 1024 + c0;
        const f32x4 x0 = *(const f32x4*)xp, x1 = *(const f32x4*)(xp + 4);
        *(f32x4*)op = x0 * ALPHA + g0 * acc[ai][bj][m][0]; *(f32x4*)(op + 4) = x1 * ALPHA + g1 * acc[ai][bj][m][1]; } }
    return true;
  }
};
struct EpiMoe1 {
  bf16_t* Hm;
  __device__ __forceinline__ bool operator()(f32x4 (&acc)[2][2][4][2], const Seg& s, int wr, int wc, int fr, int fq) const {
    const int c0 = s.pn * 128 + wc * 32 + fq * 8;
#pragma unroll
    EPI_LOOP_AM { const int row = s.pm * 256 + ai * 128 + m * 16 + wr * 64 + fr; f32x4 h0, h1;
#pragma unroll
      for (int j = 0; j < 4; ++j) { h0[j] = fast_silu(acc[ai][0][m][0][j]) * acc[ai][1][m][0][j]; h1[j] = fast_silu(acc[ai][0][m][1][j]) * acc[ai][1][m][1][j]; }
      *(u32x4*)(Hm + (size_t)row * EH + c0) = pack8(h0, h1); }
    return true;
  }
};
struct EpiMoe2 {
  bf16_t* Yo;
  __device__ __forceinline__ bool operator()(f32x4 (&acc)[2][2][4][2], const Seg& s, int wr, int wc, int fr, int fq) const {
#pragma unroll
    EPI_LOOP_AM { const int row = s.pm * 256 + ai * 128 + m * 16 + wr * 64 + fr;
#pragma unroll
      for (int bj = 0; bj < 2; ++bj) *(u32x4*)(Yo + (size_t)row * 1024 + s.pn * 256 + bj * 128 + wc * 32 + fq * 8) = pack8(acc[ai][bj][m][0], acc[ai][bj][m][1]); }
    return true;
  }
};
}
namespace fk {
constexpr int ATT_SHM_V = 64 * 128 * 2, ATT_SHM_K = 64 * 128 * 2;
constexpr int ATT_LDS = 2 * ATT_SHM_V + 2 * ATT_SHM_K + 8 * 256;
#define KSWZ(row, colB) ((row) * 256 + ((colB) ^ (((row) & 7) << 4)))
#define SBAR() __builtin_amdgcn_sched_barrier(0)
__device__ __forceinline__ int crow(int r, int hi) { return (r & 3) + 8 * (r >> 2) + 4 * hi; }
constexpr float ATT_SCALE = 0.125f, ATT_THR = 8.f;
__device__ __forceinline__ void partialSM(f32x16& p0, f32x16& p1, float& m_reg, float& mn, float& alpha) {
  constexpr float C = ATT_SCALE * 1.4426950408889634f;
  float pmax = p0[0];
#pragma unroll
  for (int r = 1; r < 16; ++r) pmax = fmaxf(pmax, p0[r]);
#pragma unroll
  for (int r = 0; r < 16; ++r) pmax = fmaxf(pmax, p1[r]);
  { auto rr = __builtin_amdgcn_permlane32_swap(__float_as_uint(pmax), __float_as_uint(pmax), false, false);
    pmax = fmaxf(__uint_as_float(rr[0]), __uint_as_float(rr[1])); }
  if (__builtin_expect(__all(pmax - m_reg <= ATT_THR / ATT_SCALE), 1)) { mn = m_reg; alpha = 1.f; }
  else { mn = fmaxf(m_reg, pmax); alpha = __builtin_amdgcn_exp2f((m_reg - mn) * C); m_reg = mn; }
  const float mnC = -mn * C;
#pragma unroll
  for (int r = 0; r < 16; ++r) p0[r] = fmaf(p0[r], C, mnC);
#pragma unroll
  for (int r = 0; r < 16; ++r) p1[r] = fmaf(p1[r], C, mnC);
#pragma unroll
  for (int r = 0; r < 16; ++r) p0[r] = __builtin_amdgcn_exp2f(p0[r]);
}
__device__ __forceinline__ void finishSM(f32x16& p0, f32x16& p1, float alpha, float& l_reg, bf16x8& pa0, bf16x8& pa1, bf16x8& pa2, bf16x8& pa3) {
#pragma unroll
  for (int r = 0; r < 16; ++r) p1[r] = __builtin_amdgcn_exp2f(p1[r]);
  float ps = 0;
#pragma unroll
  for (int r = 0; r < 16; ++r) ps += p0[r];
#pragma unroll
  for (int r = 0; r < 16; ++r) ps += p1[r];
  { auto rr = __builtin_amdgcn_permlane32_swap(__float_as_uint(ps), __float_as_uint(ps), false, false);
    ps = __uint_as_float(rr[0]) + __uint_as_float(rr[1]); }
  l_reg = l_reg * alpha + ps;
#define PK4(P, BASE, OUT) do { unsigned a0 = cvt_pk_bf16(P[BASE + 0], P[BASE + 1]), a1 = cvt_pk_bf16(P[BASE + 2], P[BASE + 3]);   \
    unsigned b0 = cvt_pk_bf16(P[BASE + 4], P[BASE + 5]), b1 = cvt_pk_bf16(P[BASE + 6], P[BASE + 7]);                              \
    auto r0 = __builtin_amdgcn_permlane32_swap(a0, b0, false, false); auto r1 = __builtin_amdgcn_permlane32_swap(a1, b1, false, false); \
    u32x4 w = {r0[0], r1[0], r0[1], r1[1]}; OUT = *reinterpret_cast<bf16x8*>(&w); } while (0)
  PK4(p0, 0, pa0); PK4(p0, 8, pa1); PK4(p1, 0, pa2); PK4(p1, 8, pa3);
#undef PK4
}
__device__ __forceinline__ void qkt(f32x16& p0, f32x16& p1, const LAS char* Ks, const bf16x8* qr, int mapcolB, int r32, int hi) {
  p0 = f32x16{}; p1 = f32x16{};
#pragma unroll
  for (int d0 = 0; d0 < 4; ++d0) { const int cb = mapcolB + (d0 * 16 + hi * 8) * 2;
    const bf16x8 b0 = *(const LAS bf16x8*)(Ks + KSWZ(r32, cb));
    const bf16x8 b1 = *(const LAS bf16x8*)(Ks + KSWZ(32 + r32, cb));
    p0 = __builtin_amdgcn_mfma_f32_32x32x16_bf16(b0, qr[d0], p0, 0, 0, 0);
    p1 = __builtin_amdgcn_mfma_f32_32x32x16_bf16(b1, qr[d0], p1, 0, 0, 0); }
}
__device__ __forceinline__ int v_st(int k, int c) { const int kk = (k & ~0xC) | ((k & 4) << 1) | ((k & 8) >> 1); return ((kk >> 3) * 4 + (c >> 5)) * 512 + ((kk & 7) * 32 + (c & 31)) * 2; }
__device__ __forceinline__ int v_rd_base(int lane) { return ((lane & 3) << 3) | (((lane >> 2) & 3) << 6) | (((lane >> 4) & 1) << 5) | (((lane >> 5) & 1) << 8); }
constexpr int v_rd_off(int d0, int ks, int half) { return d0 * 512 + ks * 4096 + half * 2048; }
template <int OFF> __device__ __forceinline__ s16x4 tr_read(int vb) {
  s16x4 r; asm volatile("ds_read_b64_tr_b16 %0, %1 offset:%2" : "=&v"(r) : "v"(vb), "i"(OFF) : "memory"); return r;
}
template <int D0> __device__ __forceinline__ void pv_one(f32x16& od, int vb, bf16x8 pa0, bf16x8 pa1, bf16x8 pa2, bf16x8 pa3) {
  const s16x4 l0 = tr_read<v_rd_off(D0, 0, 0)>(vb), h0 = tr_read<v_rd_off(D0, 0, 1)>(vb), l1 = tr_read<v_rd_off(D0, 1, 0)>(vb), h1 = tr_read<v_rd_off(D0, 1, 1)>(vb);
  const s16x4 l2 = tr_read<v_rd_off(D0, 2, 0)>(vb), h2 = tr_read<v_rd_off(D0, 2, 1)>(vb), l3 = tr_read<v_rd_off(D0, 3, 0)>(vb), h3 = tr_read<v_rd_off(D0, 3, 1)>(vb);
  asm volatile("s_waitcnt lgkmcnt(0)" ::: "memory"); SBAR();
#define PK(L, H) (bf16x8){L[0], L[1], L[2], L[3], H[0], H[1], H[2], H[3]}
  od = __builtin_amdgcn_mfma_f32_32x32x16_bf16(pa0, PK(l0, h0), od, 0, 0, 0);
  od = __builtin_amdgcn_mfma_f32_32x32x16_bf16(pa1, PK(l1, h1), od, 0, 0, 0);
  od = __builtin_amdgcn_mfma_f32_32x32x16_bf16(pa2, PK(l2, h2), od, 0, 0, 0);
  od = __builtin_amdgcn_mfma_f32_32x32x16_bf16(pa3, PK(l3, h3), od, 0, 0, 0);
#undef PK
}
__device__ __forceinline__ void pv_d0(f32x16* o, int vb, bf16x8 pa0, bf16x8 pa1, bf16x8 pa2, bf16x8 pa3) {
  pv_one<0>(o[0], vb, pa0, pa1, pa2, pa3); pv_one<1>(o[1], vb, pa0, pa1, pa2, pa3); pv_one<2>(o[2], vb, pa0, pa1, pa2, pa3); pv_one<3>(o[3], vb, pa0, pa1, pa2, pa3);
}
__device__ __forceinline__ void attn_unit(const bf16_t* __restrict__ Qg, const bf16_t* __restrict__ Kg, const bf16_t* __restrict__ Vg, bf16_t* __restrict__ Og,
                                          int qrow0, int kv0, int nkeys, int h, float lam, float lam_init, const float* __restrict__ subg, LAS char* lds) {
  const int tid = otid(), wid = tid >> 6, lane = tid & 63, r32 = lane & 31, hi = lane >> 5, map = wid >> 2, wq = wid & 3;
  LAS char* V_lds = lds; LAS char* K_lds = lds + 2 * ATT_SHM_V;
  LAS float* wsf = (LAS float*)(lds + 2 * ATT_SHM_V + 2 * ATT_SHM_K) + wid * 64; LAS float* li_l = wsf; LAS float* al_l = wsf + 32;
  float m_reg = -1e30f, l_reg = 0; f32x16 o[4] = {}; bf16x8 qr[4];
  const bf16_t* Qw = Qg + (size_t)(qrow0 + wq * 32 + r32) * 1024 + h * 128 + map * 64 + hi * 8;
#pragma unroll
  for (int d0 = 0; d0 < 4; ++d0) qr[d0] = *(const bf16x8*)(Qw + d0 * 16);
  const bf16_t* Kh = Kg + (size_t)kv0 * 1024 + h * 128; const bf16_t* Vh = Vg + (size_t)kv0 * 1024 + h * 128;
  const int sr = tid >> 4, sc = (tid & 15) * 8, vst0 = v_st(sr, sc), vst1 = v_st(32 + sr, sc);
  const int vb0 = (int)(uintptr_t)V_lds + v_rd_base(lane);
  const int mapcolB = map * 128;
  struct { bf16x8 vs0, vs1, ks0, ks1; } sr_[2];
#define SLOAD(i, k0) do { sr_[i].vs0 = *(const bf16x8*)(&Vh[(size_t)((k0) + sr) * 1024 + sc]); sr_[i].vs1 = *(const bf16x8*)(&Vh[(size_t)((k0) + 32 + sr) * 1024 + sc]); \
    sr_[i].ks0 = *(const bf16x8*)(&Kh[(size_t)((k0) + sr) * 1024 + sc]); sr_[i].ks1 = *(const bf16x8*)(&Kh[(size_t)((k0) + 32 + sr) * 1024 + sc]); } while (0)
#define SWRITE(b, i) do { *(LAS bf16x8*)(V_lds + (b) * ATT_SHM_V + vst0) = sr_[i].vs0;          \
    *(LAS bf16x8*)(V_lds + (b) * ATT_SHM_V + vst1) = sr_[i].vs1; const int kc = sc * 2;               \
    *(LAS bf16x8*)(K_lds + (b) * ATT_SHM_K + KSWZ(sr, kc)) = sr_[i].ks0;                       \
    *(LAS bf16x8*)(K_lds + (b) * ATT_SHM_K + KSWZ(32 + sr, kc)) = sr_[i].ks1; } while (0)
#define SWAIT() asm volatile("s_waitcnt vmcnt(4)" ::: "memory")
#define RESC(a) do { if (__any((a) < 1.f)) { if (hi == 0) al_l[r32] = (a); asm volatile("s_waitcnt lgkmcnt(0)" ::: "memory"); \
    _Pragma("unroll") for (int d = 0; d < 4; ++d) _Pragma("unroll") for (int r = 0; r < 16; ++r) o[d][r] *= al_l[crow(r, hi)]; } } while (0)
  f32x16 pA0, pA1, pB0, pB1; float mnA, mnB, alA, alB; bf16x8 pa0, pa1, pa2, pa3; const int NT = nkeys / 64;
  constexpr int SE = 0, SO = 1;
  SLOAD(SE, 0); asm volatile("s_waitcnt vmcnt(0)" ::: "memory"); SWRITE(0, SE); __syncthreads();
  qkt(pA0, pA1, K_lds, qr, mapcolB, r32, hi); partialSM(pA0, pA1, m_reg, mnA, alA);
  SLOAD(SO, 64); if (2 < NT) SLOAD(SE, 128);
  SWAIT(); SWRITE(1, SO); __syncthreads();
  for (int j = 1; j + 1 < NT; j += 2) {
    SBAR(); qkt(pB0, pB1, K_lds + ATT_SHM_K, qr, mapcolB, r32, hi);
    finishSM(pA0, pA1, alA, l_reg, pa0, pa1, pa2, pa3); SBAR();
    SLOAD(SO, (j + 2) * 64); SBAR();
    pv_d0(o, vb0, pa0, pa1, pa2, pa3); partialSM(pB0, pB1, m_reg, mnB, alB);
    __syncthreads(); SWAIT(); SWRITE(0, SE);
    RESC(alB); __syncthreads();
    SBAR(); qkt(pA0, pA1, K_lds, qr, mapcolB, r32, hi);
    finishSM(pB0, pB1, alB, l_reg, pa0, pa1, pa2, pa3); SBAR();
    if (j + 3 < NT) SLOAD(SE, (j + 3) * 64); SBAR();
    pv_d0(o, vb0 + ATT_SHM_V, pa0, pa1, pa2, pa3); partialSM(pA0, pA1, m_reg, mnA, alA);
    __syncthreads(); SWAIT(); SWRITE(1, SO);
    RESC(alA); __syncthreads();
  }
  SBAR(); qkt(pB0, pB1, K_lds + ATT_SHM_K, qr, mapcolB, r32, hi);
  finishSM(pA0, pA1, alA, l_reg, pa0, pa1, pa2, pa3); SBAR();
  pv_d0(o, vb0, pa0, pa1, pa2, pa3); partialSM(pB0, pB1, m_reg, mnB, alB);
  __syncthreads(); RESC(alB);
  finishSM(pB0, pB1, alB, l_reg, pa0, pa1, pa2, pa3); SBAR();
  pv_d0(o, vb0 + ATT_SHM_V, pa0, pa1, pa2, pa3);
  if (hi == 0) li_l[r32] = l_reg; asm volatile("s_waitcnt lgkmcnt(0)" ::: "memory");
  float rli[16]; const float fac = map ? lam : 1.f;
#pragma unroll
  for (int r = 0; r < 16; ++r) rli[r] = fac * __builtin_amdgcn_rcpf(li_l[crow(r, hi)]);
  __syncthreads();
  LAS float* stg = (LAS float*)lds + wid * (32 * 128);
#pragma unroll
  for (int r = 0; r < 16; ++r)
#pragma unroll
    for (int d0 = 0; d0 < 4; ++d0) stg[crow(r, hi) * 128 + d0 * 32 + r32] = o[d0][r] * rli[r];
  __syncthreads();
  {
    const int qi = 16 * map + (lane >> 2), qt = lane & 3;
    const LAS float* pa = (const LAS float*)lds + wq * (32 * 128) + qi * 128 + qt * 32;
    const LAS float* pb = (const LAS float*)lds + (4 + wq) * (32 * 128) + qi * 128 + qt * 32;
    float v[32]; float ss = 0.f;
#pragma unroll
    for (int k = 0; k < 8; ++k) { const f32x4 a = *(const LAS f32x4*)(pa + 4 * k), b = *(const LAS f32x4*)(pb + 4 * k);
#pragma unroll
      for (int j = 0; j < 4; ++j) { const float x = a[j] - b[j]; v[4 * k + j] = x; ss += x * x; } }
    ss += __shfl_xor(ss, 1); ss += __shfl_xor(ss, 2);
    const float rn = __builtin_amdgcn_rsqf(ss * (1.f / 128.f) + 1e-5f) * (1.f - lam_init);
    bf16_t* op = Og + (size_t)(qrow0 + wq * 32 + qi) * 1024 + h * 128 + qt * 32; const float* gp = subg + qt * 32;
#pragma unroll
    for (int k = 0; k < 4; ++k) { f32x4 a, b;
#pragma unroll
      for (int j = 0; j < 4; ++j) { a[j] = v[8 * k + j] * rn * gp[8 * k + j]; b[j] = v[8 * k + 4 + j] * rn * gp[8 * k + 4 + j]; }
      *(u32x4*)(op + 8 * k) = pack8(a, b); }
  }
  __syncthreads();
#undef SLOAD
#undef SWRITE
#undef SWAIT
#undef RESC
}
__device__ __forceinline__ void attn_phase(const Params& p, int l, LAS char* lds) {
  const int tid = otid(), lane = tid & 63; const bool last = (l == DEPTH - 1);
  float s1 = p.in.lam_q1[l * 64 + lane] * p.in.lam_k1[l * 64 + lane], s2 = p.in.lam_q2[l * 64 + lane] * p.in.lam_k2[l * 64 + lane];
#pragma unroll
  for (int o = 32; o >= 1; o >>= 1) { s1 += __shfl_xor(s1, o); s2 += __shfl_xor(s2, o); }
  const float lam_init = 0.8f - 0.6f * expf(-0.3f * (float)l); const float lam = expf(s1) - expf(s2) + lam_init;
  const int c = blockIdx.x, x = c & 7, jl = c >> 3, per = gridDim.x >> 3;
  const int nloc = last ? 128 : 144;
  for (int q = jl; q < nloc; q += per) {
    int qrow0, nkeys, h;
    if (q < 128) { h = q >> 4; qrow0 = x * SEQ + (q & 15) * 128; nkeys = KVB; }
    else { const int qq = q - 128; h = qq >> 1; qrow0 = NLAT + x * CTX + (qq & 1) * 128; nkeys = CTX; }
    attn_unit(p.Qb, p.Kc, p.Vc, p.ATTb, qrow0, x * KVB, nkeys, h, lam, lam_init, p.in.subln_g + l * 128, lds);
  }
}

__device__ __forceinline__ float wave_sum(float v) {
#pragma unroll
  for (int o = 32; o >= 1; o >>= 1) v += __shfl_xor(v, o);
  return v; }
__device__ __forceinline__ void row_ld(const float* p, int lane, f32x4 (&v)[4]) {
#pragma unroll
  for (int i = 0; i < 4; ++i) v[i] = *(const f32x4*)(p + 4 * lane + 256 * i); }
__device__ __forceinline__ void row_st(float* p, int lane, const f32x4 (&v)[4]) {
#pragma unroll
  for (int i = 0; i < 4; ++i) *(f32x4*)(p + 4 * lane + 256 * i) = v[i]; }
__device__ __forceinline__ void row_st_bf16(bf16_t* p, int lane, const f32x4 (&v)[4]) {
#pragma unroll
  for (int i = 0; i < 4; ++i) { u32x2 w; w.x = cvt_pk_bf16(v[i][0], v[i][1]); w.y = cvt_pk_bf16(v[i][2], v[i][3]); *(u32x2*)(p + 4 * lane + 256 * i) = w; } }
__device__ __forceinline__ void row_ld_bf16(const bf16_t* p, int lane, f32x4 (&v)[4]) {
#pragma unroll
  for (int i = 0; i < 4; ++i) { const u32x2 w = *(const u32x2*)(p + 4 * lane + 256 * i); v[i] = (f32x4){bflo(w.x), bfhi(w.x), bflo(w.y), bfhi(w.y)}; } }
__device__ __forceinline__ void row_ln(f32x4 (&v)[4], const float* g, const float* b, int lane) {
  float s = 0.f;
#pragma unroll
  for (int i = 0; i < 4; ++i) s += (v[i][0] + v[i][1]) + (v[i][2] + v[i][3]);
  const float mean = wave_sum(s) * (1.f / 1024.f); float q = 0.f;
#pragma unroll
  for (int i = 0; i < 4; ++i) { v[i] -= mean; q += (v[i][0] * v[i][0] + v[i][1] * v[i][1]) + (v[i][2] * v[i][2] + v[i][3] * v[i][3]); }
  const float rs = __builtin_amdgcn_rsqf(wave_sum(q) * (1.f / 1024.f) + 1e-5f);
#pragma unroll
  for (int i = 0; i < 4; ++i) { const f32x4 gg = *(const f32x4*)(g + 4 * lane + 256 * i), bb = *(const f32x4*)(b + 4 * lane + 256 * i); v[i] = v[i] * rs * gg + bb; }
}
__device__ __forceinline__ void row_mod(f32x4 (&h)[4], const f32x4 (&v)[4], const float* modrow, int shift_idx, int scale_idx, int lane) {
#pragma unroll
  for (int i = 0; i < 4; ++i) { const f32x4 sc = *(const f32x4*)(modrow + scale_idx * 1024 + 4 * lane + 256 * i), sh = *(const f32x4*)(modrow + shift_idx * 1024 + 4 * lane + 256 * i); h[i] = v[i] * (1.f + sc) + sh; }
}
__device__ __forceinline__ int modrow_of_row(int r) { return r < NLAT ? (r >> 11) : 8; }

__device__ __forceinline__ void h0_phase(const Params& p) {
  const int tid = otid(); const int lane = tid & 63, gw = blockIdx.x * 8 + (tid >> 6), nw = gridDim.x * 8;
  for (int r = gw; r < NR; r += nw) {
    const float* src = r < NLAT ? p.in.x + (size_t)r * D : p.in.ctx + (size_t)(r - NLAT) * D;
    f32x4 v[4], h[4]; row_ld(src, lane, v); row_mod(h, v, p.MOD + (size_t)modrow_of_row(r) * 6144, 0, 1, lane); row_st_bf16(p.Hb + (size_t)r * D, lane, h); }
}
__device__ __forceinline__ void ln1_phase(const Params& p, int l, LAS char* lds) {
  const int tid = otid(), lane = tid & 63, wid = tid >> 6, gw = blockIdx.x * 8 + wid; const bool last = (l == DEPTH - 1);
  LAS float* W = (LAS float*)lds;
  LAS int* lcnt = (LAS int*)(lds + 36 * 1024 * 4);
  for (int i = tid; i < 36 * 256; i += 512) *(LAS f32x4*)(W + 4 * i) = *(const f32x4*)(p.WR + 4 * i);
  if (tid < 32) lcnt[tid] = 0;
  __syncthreads();
  const float* MODl = p.MOD + (size_t)l * 9 * 6144;
  const int nrow = last ? NLAT : NR;
  for (int r = gw; r < nrow; r += 2048) {
    f32x4 v[4], h[4]; row_ld(p.XL + (size_t)r * D, lane, v); row_ln(v, p.in.ln1_g + l * D, p.in.ln1_b + l * D, lane); row_st(p.XL + (size_t)r * D, lane, v);
    row_mod(h, v, MODl + (size_t)modrow_of_row(r) * 6144, 3, 4, lane); row_st_bf16(p.H2b + (size_t)r * D, lane, h);
    float lg[36];
#pragma unroll
    for (int e = 0; e < 36; ++e) { float s = 0.f;
#pragma unroll
      for (int i = 0; i < 4; ++i) { const f32x4 w = *(const LAS f32x4*)(W + e * 1024 + 4 * lane + 256 * i); s += (h[i][0] * w[0] + h[i][1] * w[1]) + (h[i][2] * w[2] + h[i][3] * w[3]); }
      lg[e] = wave_sum(s) + (e < 4 ? p.in.rg_b[l * 4 + e] : p.in.re_b[l * 32 + e - 4]); }
    int gi = 0; float gm = lg[0];
#pragma unroll
    for (int j = 1; j < 4; ++j) if (lg[j] > gm) { gm = lg[j]; gi = j; }
    float gs = 0.f;
#pragma unroll
    for (int j = 0; j < 4; ++j) gs += expf(lg[j] - gm);
    const float gtop = 1.f / gs;
    float el[8];
#pragma unroll
    for (int j = 0; j < 8; ++j) el[j] = gi == 0 ? lg[4 + j] : gi == 1 ? lg[12 + j] : gi == 2 ? lg[20 + j] : lg[28 + j];
    int i0 = 0; float v0 = el[0];
#pragma unroll
    for (int j = 1; j < 8; ++j) if (el[j] > v0) { v0 = el[j]; i0 = j; }
    int i1 = -1; float v1 = -3.0e38f;
#pragma unroll
    for (int j = 0; j < 8; ++j) if (j != i0 && el[j] > v1) { v1 = el[j]; i1 = j; }
    const float e1 = expf(v1 - v0); const float w0 = gtop / (1.f + e1), w1 = gtop * e1 / (1.f + e1);
    const int e0i = gi * 8 + i0, e1i = gi * 8 + i1;
    if (lane == 0) { const int lr0 = __hip_atomic_fetch_add(&lcnt[e0i], 1, __ATOMIC_RELAXED, __HIP_MEMORY_SCOPE_WORKGROUP); const int lr1 = __hip_atomic_fetch_add(&lcnt[e1i], 1, __ATOMIC_RELAXED, __HIP_MEMORY_SCOPE_WORKGROUP);
      *(int4*)(p.ROUTE + (size_t)r * 4) = make_int4(e0i, e1i, lr0, lr1); *(float2*)(p.RW + (size_t)r * 2) = make_float2(w0, w1); }
  }
  __syncthreads();
  if (tid < 32) p.BLKBASE[blockIdx.x * 32 + tid] = (int)atomicAdd(p.ctl + l * CTL_WORDS + CTL_CNT + 64 * tid, (unsigned)lcnt[tid]);
}
__device__ __forceinline__ void moe_offsets(const Params& p, int l, LAS int* off) {
  if (otid() == 0) { int a = 0; for (int e = 0; e < 32; ++e) { off[e] = a; const int c = (int)__hip_atomic_load(p.ctl + l * CTL_WORDS + CTL_CNT + 64 * e, __ATOMIC_RELAXED, __HIP_MEMORY_SCOPE_AGENT); a += (c + 255) & ~255; } off[32] = a; }
  __syncthreads();
}
__device__ __forceinline__ void gather_phase(const Params& p, int l, LAS char* lds) {
  const int tid = otid(), lane = tid & 63, wid = tid >> 6, gw = blockIdx.x * 8 + wid; const bool last = (l == DEPTH - 1);
  LAS int* off = (LAS int*)lds; moe_offsets(p, l, off);
  const int nrow = last ? NLAT : NR;
  for (int r = gw; r < nrow; r += 2048) {
    const int4 rt = *(const int4*)(p.ROUTE + (size_t)r * 4); const int blk = (r & 2047) >> 3;
    const int pos0 = off[rt.x] + p.BLKBASE[blk * 32 + rt.x] + rt.z, pos1 = off[rt.y] + p.BLKBASE[blk * 32 + rt.y] + rt.w;
    const u32x4 a = *(const u32x4*)(p.H2b + (size_t)r * D + lane * 8), b = *(const u32x4*)(p.H2b + (size_t)r * D + 512 + lane * 8);
    *(u32x4*)(p.Xs + (size_t)pos0 * D + lane * 8) = a; *(u32x4*)(p.Xs + (size_t)pos0 * D + 512 + lane * 8) = b;
    *(u32x4*)(p.Xs + (size_t)pos1 * D + lane * 8) = a; *(u32x4*)(p.Xs + (size_t)pos1 * D + 512 + lane * 8) = b;
    if (lane == 0) *(int2*)(p.POS + (size_t)r * 2) = make_int2(pos0, pos1);
  }
}
__device__ __forceinline__ int moe_tiles(const Params& p, int l, LAS int* tbl) {
  if (otid() == 0) { int t = 0; for (int e = 0; e < 32; ++e) { const int c = (int)__hip_atomic_load(p.ctl + l * CTL_WORDS + CTL_CNT + 64 * e, __ATOMIC_RELAXED, __HIP_MEMORY_SCOPE_AGENT); const int n = (c + 255) >> 8; for (int i = 0; i < n; ++i) tbl[1 + t++] = e; } tbl[0] = t; }
  __syncthreads();
  return tbl[0];
}
__device__ __forceinline__ void ln2_phase(const Params& p, int l) {
  const int tid = otid(), lane = tid & 63, wid = tid >> 6, gw = blockIdx.x * 8 + wid; const bool last = (l == DEPTH - 1);
  const float* MODl = p.MOD + (size_t)l * 9 * 6144; const int nrow = last ? NLAT : NR;
  for (int r = gw; r < nrow; r += 2048) {
    const int2 ps = *(const int2*)(p.POS + (size_t)r * 2); const float2 w = *(const float2*)(p.RW + (size_t)r * 2);
    f32x4 v[4], y0[4], y1[4]; row_ld(p.XL + (size_t)r * D, lane, v); row_ld_bf16(p.Yo + (size_t)ps.x * D, lane, y0); row_ld_bf16(p.Yo + (size_t)ps.y * D, lane, y1);
    const float* mr = MODl + (size_t)modrow_of_row(r) * 6144;
#pragma unroll
    for (int i = 0; i < 4; ++i) { const f32x4 g2 = *(const f32x4*)(mr + 5 * 1024 + 4 * lane + 256 * i); v[i] = v[i] * ALPHA + g2 * (y0[i] * w.x + y1[i] * w.y); }
    row_ln(v, p.in.ln2_g + l * D, p.in.ln2_b + l * D, lane);
    if (!last) { row_st(p.XL + (size_t)r * D, lane, v); f32x4 h[4]; row_mod(h, v, p.MOD + ((size_t)(l + 1) * 9 + modrow_of_row(r)) * 6144, 0, 1, lane); row_st_bf16(p.Hb + (size_t)r * D, lane, h); }
    else row_st(p.out + (size_t)r * D, lane, v);
  }
}
__device__ __forceinline__ void s2_phase(const Params& p) {
  const int tid = otid(); if (tid >= 128) return;
  const int g = blockIdx.x >> 3, b = blockIdx.x & 7, dir = tid >> 6, pp = tid & 63;
  const f32x2 aL = *(const f32x2*)(p.SAL + ((size_t)(g * 2 + dir) * 64 + pp) * 2);
  const float* S = p.SST + (size_t)g * NCHP * 256 + dir * 128 + 2 * pp; bf16_t* A = p.Ug + (size_t)g * NCHP * 768 + 512 + dir * 128 + 2 * pp;
  float hr = 0.f, hi = 0.f;
#pragma unroll 1
  for (int s0 = 0; s0 < 72; s0 += 24) {
    f32x2 sv[24];
#pragma unroll
    for (int k = 0; k < 24; ++k) { const int s = s0 + k; int row; if (dir == 0) row = s < 8 ? 512 + b * 8 + s : b * 64 + (s - 8); else row = s < 8 ? 512 + b * 8 + (7 - s) : b * 64 + (63 - (s - 8));
      sv[k] = *(const f32x2*)(S + (size_t)row * 256); }
#pragma unroll
    for (int k = 0; k < 24; ++k) { const int s = s0 + k; int row; if (dir == 0) row = s < 8 ? 512 + b * 8 + s : b * 64 + (s - 8); else row = s < 8 ? 512 + b * 8 + (7 - s) : b * 64 + (63 - (s - 8));
      *(unsigned*)(A + (size_t)row * 768) = cvt_pk_bf16(hr, hi);
      const float nr = aL.x * hr - aL.y * hi + sv[k].x, ni = aL.x * hi + aL.y * hr + sv[k].y; hr = nr; hi = ni; }
  }
}

struct ConvJob { const float* src; const float* src2; bf16_t* dst; int ldd, lds_, kind, nK; };
__device__ __forceinline__ void conv_tile(const ConvJob& j, int nt, int kt, LAS float* T  ) {
  const int tid = otid(); const int n0 = nt * 64, k0 = kt * 64;
  { const int nn = tid & 63; const int n = n0 + nn; const float* s = j.src; int col;
    if (j.kind == 0) col = (n & ~31) + perm32(n & 31);
    else if (j.kind == 1) { const int pn = n >> 8; if (pn < 4 || (pn >= 10 && pn < 14)) col = n; else if (pn < 10) col = (n & ~31) + perm32(n & 31);
      else { const int bj = (n >> 7) & 1, w = n & 127; col = (bj ? 4608 : 3584) + (pn - 14) * 128 + (w & ~31) + perm32(w & 31); } }
    else { const int bj = (n >> 7) & 1, w = n & 127; col = (n >> 8) * 128 + (w & ~31) + perm32(w & 31); if (bj) s = j.src2; }
#pragma unroll
    for (int q = 0; q < 8; ++q) { const int kk = (tid >> 6) + 8 * q; T[kk * 65 + nn] = s[(size_t)(k0 + kk) * j.lds_ + col]; } }
  __syncthreads();
  { const int n = tid >> 3, k8 = (tid & 7) * 8; f32x4 a, b;
#pragma unroll
    for (int q = 0; q < 4; ++q) { a[q] = T[(k8 + q) * 65 + n]; b[q] = T[(k8 + 4 + q) * 65 + n]; }
    *(u32x4*)(j.dst + (size_t)(n0 + n) * j.ldd + k0 + k8) = pack8(a, b); }
  __syncthreads();
}
__device__ __forceinline__ void ssm_mats(const Params& p, int l, int g, LAS char* lds) {
  const int tid = otid();
  LAS f32x2* AP = (LAS f32x2*)lds;
  LAS f32x2* BB = AP + 2 * 64 * 34;
  LAS f32x2* CC = BB + 2 * 64 * 16;
  LAS float* KT = (LAS float*)(CC + 2 * 16 * 64);
  const size_t so = (size_t)l * 2 * NG * NP;
  if (tid < 128) { const int dir = tid >> 6, pp = tid & 63; const size_t gp = so + ((size_t)dir * NG + g) * NP + pp;
    const double are = p.in.a_re[gp], aim = p.in.a_im[gp], dt = exp((double)p.in.log_dt[(size_t)l * 2 * NG + dir * NG + g]);
    for (int t = 0; t < 34; ++t) { const double er = exp(are * dt * t); AP[(dir * 64 + pp) * 34 + t] = (f32x2){(float)(er * cos(aim * dt * t)), (float)(er * sin(aim * dt * t))}; }
    const double er = exp(are * dt), abr = er * cos(aim * dt), abi = er * sin(aim * dt); const double nr = abr - 1.0, ni = abi, den = are * are + aim * aim; const double fr = (nr * are + ni * aim) / den, fi = (ni * are - nr * aim) / den;
    for (int c = 0; c < 16; ++c) { const double br = p.in.b_re[gp * 16 + c], bi = p.in.b_im[gp * 16 + c]; BB[(dir * 64 + pp) * 16 + c] = (f32x2){(float)(fr * br - fi * bi), (float)(fr * bi + fi * br)}; }
    const double e32 = exp(are * dt * 32); *(f32x2*)(p.SAL + ((size_t)(g * 2 + dir) * 64 + pp) * 2) = (f32x2){(float)(e32 * cos(aim * dt * 32)), (float)(e32 * sin(aim * dt * 32))};
  }
  for (int i = tid; i < 2 * 16 * 64; i += 512) { const int dir = i >> 10, c = (i >> 6) & 15, pp = i & 63; const size_t ci = (so + ((size_t)dir * NG + g) * NP) * 16 + (size_t)c * NP + pp; CC[i] = (f32x2){p.in.c_re[ci], p.in.c_im[ci]}; }
  __syncthreads();
  for (int i = tid; i < 2 * 32 * 256; i += 512) { const int dir = i >> 13, tau = (i >> 8) & 31, co = (i >> 4) & 15, ci = i & 15; float s = 0.f;
    for (int pp = 0; pp < 64; ++pp) { const f32x2 a = AP[(dir * 64 + pp) * 34 + tau], b = BB[(dir * 64 + pp) * 16 + ci], c = CC[(dir * 16 + co) * 64 + pp];
      const float abr = a.x * b.x - a.y * b.y, abi = a.x * b.y + a.y * b.x; s += c.x * abr - c.y * abi; }
    KT[i] = s; }
  __syncthreads();
  bf16_t* Sm = p.Smat + (size_t)g * 256 * 768;
  for (int i = tid; i < 256 * 64; i += 512) { const int n = i >> 6, k8 = (i & 63) * 8; const int Lc = (n & ~31) + perm32(n & 31); const int dir = Lc >> 7, pp = (Lc & 127) >> 1, ri = Lc & 1; const int t = k8 >> 4, c0 = k8 & 15;
    const f32x2 a = AP[(dir * 64 + pp) * 34 + (dir == 0 ? 31 - t : t)]; float v[8];
#pragma unroll
    for (int q = 0; q < 8; ++q) { const f32x2 b = BB[(dir * 64 + pp) * 16 + c0 + q]; v[q] = ri == 0 ? a.x * b.x - a.y * b.y : a.x * b.y + a.y * b.x; }
    *(u32x4*)(Sm + (size_t)n * 768 + k8) = pack8((f32x4){v[0], v[1], v[2], v[3]}, (f32x4){v[4], v[5], v[6], v[7]}); }
  bf16_t* To = p.TO + (size_t)g * 512 * 768; const float* dsk = p.in.ssm_d + l * SSMW + g * 16;
  for (int i = tid; i < 512 * 96; i += 512) { const int n = i / 96, k8 = (i % 96) * 8; const int Lc = (n & ~31) + perm32(n & 31); const int t = Lc >> 4, co = Lc & 15; float v[8];
    if (k8 < 512) { const int s = k8 >> 4, c0 = k8 & 15;
#pragma unroll
      for (int q = 0; q < 8; ++q) { const int ci = c0 + q; float x = 0.f; if (s <= t) x += KT[((0 * 32 + (t - s)) * 16 + co) * 16 + ci]; if (s >= t) x += KT[((1 * 32 + (s - t)) * 16 + co) * 16 + ci]; if (s == t && ci == co) x += dsk[co]; v[q] = x; } }
    else { const int hc0 = k8 - 512;
#pragma unroll
      for (int q = 0; q < 8; ++q) { const int hc = hc0 + q; const int dir = hc >> 7, pp = (hc & 127) >> 1, ri = hc & 1; const f32x2 a = AP[(dir * 64 + pp) * 34 + (dir == 0 ? t + 1 : 32 - t)], c = CC[(dir * 16 + co) * 64 + pp];
        const float car = c.x * a.x - c.y * a.y, cai = c.x * a.y + c.y * a.x; v[q] = ri == 0 ? car : -cai; } }
    *(u32x4*)(To + (size_t)n * 768 + k8) = pack8((f32x4){v[0], v[1], v[2], v[3]}, (f32x4){v[4], v[5], v[6], v[7]}); }
  __syncthreads();
}
__device__ __forceinline__ void mod_item(const Params& p, int l, int j0, LAS char* lds) {
  const int tid = otid(); LAS float* sl = (LAS float*)lds;
  LAS float* part = sl + 9 * 1024;
  for (int i = tid; i < 9 * 1024; i += 512) { const int r = i >> 10, k = i & 1023; const float v = r < 8 ? p.in.c[r * 1024 + k] : p.in.c_ctx[k]; sl[i] = v / (1.f + expf(-v)); }
  __syncthreads();
  const int jj = tid & 63, ks = tid >> 6; float acc[9];
#pragma unroll
  for (int r = 0; r < 9; ++r) acc[r] = 0.f;
  const float* w = p.in.w_mod + (size_t)l * 1024 * 6144 + j0 + jj;
  for (int k = ks * 128; k < ks * 128 + 128; ++k) { const float wv = w[(size_t)k * 6144];
#pragma unroll
    for (int r = 0; r < 9; ++r) acc[r] += sl[r * 1024 + k] * wv; }
#pragma unroll
  for (int r = 0; r < 9; ++r) part[(ks * 9 + r) * 64 + jj] = acc[r];
  __syncthreads();
  for (int i = tid; i < 9 * 64; i += 512) { const int r = i >> 6, j = i & 63; float s = 0.f;
#pragma unroll
    for (int k = 0; k < 8; ++k) s += part[(k * 9 + r) * 64 + j];
    p.MOD[((size_t)l * 9 + r) * 6144 + j0 + j] = s + p.in.b_mod[l * 6144 + j0 + j]; }
  __syncthreads();
}
__device__ __forceinline__ void conv_phase(const Params& p, int l, LAS char* lds) {
  const int tid = otid();
  const int n_mod = (l == 0) ? 4 * 96 : 0, n_rope = (l == 0) ? 1 : 0;
  const int NCH = 14400 / 8;
  const int total = NG + 1 + n_mod + n_rope + NCH;
  for (int it = blockIdx.x; it < total; it += gridDim.x) {
    int i = it;
    if (i < NG) { ssm_mats(p, l, i, lds); continue; } i -= NG;
    if (i < 1) { for (int q = tid; q < 36 * 1024; q += 512) { const int e = q >> 10, k = q & 1023; p.WR[q] = e < 4 ? p.in.rg_w[((size_t)l * 1024 + k) * 4 + e] : p.in.re_w[((size_t)l * 1024 + k) * 32 + (e - 4)]; } continue; } i -= 1;
    if (i < n_mod) { mod_item(p, i / 96, (i % 96) * 64, lds); continue; } i -= n_mod;
    if (i < n_rope) { for (int q = tid; q < 2048 * 32; q += 512) { const int t = q >> 5, axis = (q >> 4) & 1, f = q & 15; const float pos = axis == 0 ? (float)(t >> 6) : (float)(t & 63);
        const float inv = 1.0f / powf(10000.0f, (float)(2 * f) / 32.0f); const float ang = pos * inv; p.ROPE[((size_t)t * 2 + axis) * 32 + f] = cosf(ang); p.ROPE[((size_t)t * 2 + axis) * 32 + 16 + f] = sinf(ang); } continue; } i -= n_rope;
    for (int q = 0; q < 8; ++q) { int t = i * 8 + q; ConvJob j; int nK;
      if (t < 1408) { j.src = p.in.w_in + (size_t)l * 1024 * INW; j.src2 = nullptr; j.dst = p.Win; j.ldd = 1024; j.lds_ = INW; j.kind = 1; nK = 16; }
      else if ((t -= 1408) < 64) { j.src = p.in.w_glu + (size_t)l * 512 * 512; j.src2 = nullptr; j.dst = p.Wglu; j.ldd = 512; j.lds_ = 512; j.kind = 0; nK = 8; }
      else if ((t -= 64) < 256) { j.src = p.in.w_pa + (size_t)l * 1024 * 1024; j.src2 = nullptr; j.dst = p.Wpa; j.ldd = 1024; j.lds_ = 1024; j.kind = 0; nK = 16; }
      else if ((t -= 256) < 128) { j.src = p.in.w_ps + (size_t)l * 512 * 1024; j.src2 = nullptr; j.dst = p.Wps; j.ldd = 1024; j.lds_ = 1024; j.kind = 0; nK = 8; }
      else if ((t -= 128) < 256) { j.src = p.in.w_o + (size_t)l * 1024 * 1024; j.src2 = nullptr; j.dst = p.Wo; j.ldd = 1024; j.lds_ = 1024; j.kind = 0; nK = 16; }
      else if ((t -= 256) < 8192) { const int e = t >> 8; t &= 255; j.src = p.in.w1 + ((size_t)l * NE + e) * 1024 * 512; j.src2 = p.in.w3 + ((size_t)l * NE + e) * 1024 * 512; j.dst = p.W13 + (size_t)e * 1024 * 1024; j.ldd = 1024; j.lds_ = 512; j.kind = 2; nK = 16; }
      else { t -= 8192; const int e = t >> 7; t &= 127; j.src = p.in.w2 + ((size_t)l * NE + e) * 512 * 1024; j.src2 = nullptr; j.dst = p.W2 + (size_t)e * 1024 * 512; j.ldd = 512; j.lds_ = 1024; j.kind = 0; nK = 8; }
      conv_tile(j, t / nK, t % nK, (LAS float*)lds); }
  }
}
}
namespace fk {
constexpr int LDS_BYTES = 36 * 1024 * 4 + 256;
constexpr int NPH = 15;
enum { PH_CONV = 0, PH_H0, PH_GEMM1, PH_S1, PH_S2, PH_S3, PH_ATT, PH_GLU, PH_MERGE, PH_WO, PH_LN1, PH_GATHER, PH_MOE1, PH_MOE2, PH_LN2 };

__device__ __forceinline__ void run_phase(const Params& p, int l, int ph, LAS unsigned char* lds) {
  const int G = gridDim.x, c = blockIdx.x; const bool last = (l == DEPTH - 1);
  const float* MODl = p.MOD + (size_t)l * 9 * 6144;
  switch (ph) {
    case PH_CONV: conv_phase(p, l, (LAS char*)lds); break;
    case PH_H0: if (l == 0) h0_phase(p); break;
    case PH_GEMM1: { SchedPlain S; S.A = (const char*)p.Hb; S.B = (const char*)p.Win; S.lda = 2048; S.ldb = 2048; S.nM = NR / 256; S.nN = INW / 256; S.nt = 16; S.G = G; S.c = c; S.nunits = S.nM * S.nN; S.epi = 1;
      EpiIn E{p.ROPE, p.Kc, p.Vc, p.Ug, p.Qb, p.RG, p.GSb}; gemm_stream(lds, 2048, 2048, S, E); } break;
    case PH_S1: { SchedSsm1 S{(const char*)p.Ug, (const char*)p.Smat, G, c}; EpiState E{p.SST}; gemm_stream(lds, 1536, 1536, S, E); } break;
    case PH_S2: s2_phase(p); break;
    case PH_S3: { SchedSsm3 S{(const char*)p.Ug, (const char*)p.TO, G, c}; EpiSsmOut E{p.YG}; gemm_stream(lds, 1536, 1536, S, E); } break;
    case PH_ATT: attn_phase(p, l, (LAS char*)lds); break;
    case PH_GLU: { SchedPlain S; S.A = (const char*)p.YG; S.B = (const char*)p.Wglu; S.lda = 1024; S.ldb = 1024; S.nM = NR / 256; S.nN = 2; S.nt = 8; S.G = G; S.c = c; S.nunits = S.nM * 2; S.epi = 1;
      EpiGlu E{p.YG, p.S2, p.in.b_glu + l * SSMW}; gemm_stream(lds, 1024, 1024, S, E); } break;
    case PH_MERGE: { SchedMerge S{(const char*)p.ATTb, (const char*)p.Wpa, (const char*)p.S2, (const char*)p.Wps, NR / 256, 4, G, c, (NR / 256) * 4};
      EpiMerge E{p.RG, p.GSb, p.Mb}; gemm_stream(lds, 2048, 2048, S, E); } break;
    case PH_WO: { SchedPlain S; S.A = (const char*)p.Mb; S.B = (const char*)p.Wo; S.lda = 2048; S.ldb = 2048; S.nM = last ? NLAT / 256 : NR / 256; S.nN = 4; S.nt = 16; S.G = G; S.c = c; S.nunits = S.nM * 4; S.epi = 1;
      EpiWo E{l == 0 ? p.in.x : p.XL, l == 0 ? p.in.ctx : p.XL + (size_t)NLAT * D, p.XL, MODl}; gemm_stream(lds, 2048, 2048, S, E); } break;
    case PH_LN1: ln1_phase(p, l, (LAS char*)lds); break;
    case PH_GATHER: gather_phase(p, l, (LAS char*)lds); break;
    case PH_MOE1: { LAS int* tbl = (LAS int*)(lds + STAGE_BYTES); const int ntiles = moe_tiles(p, l, tbl);
      SchedMoe S{(const char*)p.Xs, (const char*)p.W13, 2048, 2048, (size_t)1024 * 2048, tbl + 1, ntiles, 4, 16, G, c}; EpiMoe1 E{p.Hm}; gemm_stream(lds, 2048, 2048, S, E); } break;
    case PH_MOE2: { LAS int* tbl = (LAS int*)(lds + STAGE_BYTES); const int ntiles = moe_tiles(p, l, tbl);
      SchedMoe S{(const char*)p.Hm, (const char*)p.W2, 1024, 1024, (size_t)1024 * 1024, tbl + 1, ntiles, 4, 8, G, c}; EpiMoe2 E{p.Yo}; gemm_stream(lds, 1024, 1024, S, E); } break;
    case PH_LN2: ln2_phase(p, l); break;
  }
}

__global__ void __launch_bounds__(512, 2) mega(Params p) {
  extern __shared__ __attribute__((aligned(16))) unsigned char smem[];
  LAS unsigned char* lds = (LAS unsigned char*)smem;
  LAS unsigned* xbw = (LAS unsigned*)(lds + LDS_BYTES - 16);
  if (threadIdx.x == 0) { xbw[0] = 0u; xbw[1] = 0u; xbw[2] = 0u; xbw[3] = 0u; }
  __syncthreads();
  XcdBarrier bar = xcd_barrier_post(p.bar, (volatile LAS unsigned*)xbw);
  for (int l = 0; l < DEPTH; ++l) {
#define PHASE(ID) do { const int gph = l * NPH + (ID); if (gph >= p.ph_lo && gph < p.ph_hi && !((ID) == PH_H0 && l > 0)) { \
      if ((ID) == PH_LN1) {   } \
      run_phase(p, l, (ID), lds); if (gph + 1 < p.ph_hi) xcd_barrier(bar); } } while (0)
    PHASE(PH_CONV); PHASE(PH_H0); PHASE(PH_GEMM1); PHASE(PH_S1); PHASE(PH_S2); PHASE(PH_S3); PHASE(PH_ATT); PHASE(PH_GLU); PHASE(PH_MERGE); PHASE(PH_WO);
    PHASE(PH_LN1); PHASE(PH_GATHER); PHASE(PH_MOE1); PHASE(PH_MOE2); PHASE(PH_LN2);
#undef PHASE
  }
}

struct Host { Params p; size_t ws_used; };
inline size_t al256(size_t x) { return (x + 255) & ~(size_t)255; }
inline Host make_params(void* const* d_in, void* d_out, void* d_ws) {
  Host H; memset(&H, 0, sizeof(H)); Params& p = H.p;
  const float** ip = (const float**)&p.in; for (int i = 0; i < 36; ++i) ip[i] = (const float*)d_in[i];
  p.out = (float*)d_out;
  char* base = (char*)d_ws; size_t off = 0;
  auto take = [&](size_t bytes) { char* r = base + off; off = al256(off + bytes); return r; };
  p.bar = (unsigned*)take(XCD_BAR_WORDS * 4); p.ctl = (unsigned*)take((size_t)DEPTH * CTL_WORDS * 4);
  p.MOD = (float*)take((size_t)DEPTH * 9 * 6144 * 4); p.ROPE = (float*)take((size_t)2048 * 64 * 4);
  p.SAL = (float*)take((size_t)NG * 2 * 64 * 2 * 4); p.WR = (float*)take((size_t)36 * 1024 * 4);
  p.ROUTE = (int*)take((size_t)NR * 4 * 4); p.RW = (float*)take((size_t)NR * 2 * 4); p.POS = (int*)take((size_t)NR * 2 * 4); p.BLKBASE = (int*)take((size_t)256 * 32 * 4);
  p.XL = (float*)take((size_t)NR * D * 4); p.Hb = (bf16_t*)take((size_t)NR * D * 2); p.H2b = (bf16_t*)take((size_t)NR * D * 2); p.Mb = (bf16_t*)take((size_t)NR * D * 2);
  p.Win = (bf16_t*)take((size_t)INW * 1024 * 2); p.Wglu = (bf16_t*)take((size_t)512 * 512 * 2); p.Wpa = (bf16_t*)take((size_t)1024 * 1024 * 2); p.Wps = (bf16_t*)take((size_t)1024 * 1024 * 2);
  p.Wo = (bf16_t*)take((size_t)1024 * 1024 * 2); p.W13 = (bf16_t*)take((size_t)NE * 1024 * 1024 * 2); p.W2 = (bf16_t*)take((size_t)NE * 1024 * 512 * 2);
  p.Smat = (bf16_t*)take((size_t)NG * 256 * 768 * 2); p.TO = (bf16_t*)take((size_t)NG * 512 * 768 * 2);
  const size_t mix0 = off;
  p.Kc = (bf16_t*)take((size_t)NB * KVB * D * 2); p.Vc = (bf16_t*)take((size_t)NB * KVB * D * 2); p.Qb = (bf16_t*)take((size_t)NR * D * 2);
  p.Ug = (bf16_t*)take((size_t)NG * NCHP * 768 * 2 + 4096); p.RG = (bf16_t*)take((size_t)NR * D * 2); p.GSb = (bf16_t*)take((size_t)NR * D * 2); p.ATTb = (bf16_t*)take((size_t)NR * D * 2);
  p.SST = (float*)take((size_t)NG * NCHP * 256 * 4); p.YG = (bf16_t*)take((size_t)NR * SSMW * 2); p.S2 = (bf16_t*)take((size_t)NR * D * 2);
  const size_t mix1 = off; off = mix0;
  p.Xs = (bf16_t*)take((size_t)MOE_ROWS * D * 2); p.Hm = (bf16_t*)take((size_t)MOE_ROWS * EH * 2); p.Yo = (bf16_t*)take((size_t)MOE_ROWS * D * 2);
  if (off < mix1) off = mix1;
  H.ws_used = off; p.ph_lo = 0; p.ph_hi = DEPTH * NPH;
  return H;
}
inline int grid_size() {
  static int grid = 0;
  if (!grid) { hipFuncSetAttribute((const void*)mega, hipFuncAttributeMaxDynamicSharedMemorySize, LDS_BYTES);
    int dev = 0, cus = 0, per_cu = 0; hipGetDevice(&dev); hipDeviceGetAttribute(&cus, hipDeviceAttributeMultiprocessorCount, dev);
    hipOccupancyMaxActiveBlocksPerMultiprocessor(&per_cu, mega, 512, LDS_BYTES);
    grid = (per_cu >= 1 && cus >= 256) ? 256 : 0;
    if (!grid) fprintf(stderr, "mega: cannot be resident (cus %d per_cu %d)\n", cus, per_cu); }
  return grid;
}
inline void launch_range(Host& H, int lo, int hi, hipStream_t st) {
  const int grid = grid_size(); if (!grid) return;
  H.p.ph_lo = lo; H.p.ph_hi = hi;
  hipLaunchKernelGGL(mega, dim3(grid), dim3(512), LDS_BYTES, st, H.p);
}
}
extern "C" void kernel_launch(void* const* d_in, const int* in_sizes, int n_in, void* d_out, int out_size, void* d_ws, size_t ws_size, hipStream_t stream) {
  fk::Host H = fk::make_params(d_in, d_out, d_ws);
  if (H.ws_used > ws_size) { fprintf(stderr, "ws too small: need %zu have %zu\n", H.ws_used, ws_size); return; }
  hipMemsetAsync(H.p.bar, 0, (size_t)((char*)H.p.MOD - (char*)H.p.bar), stream);
  fk::launch_range(H, 0, fk::DEPTH * fk::NPH, stream);
}
```

```cpp
#include <hip/hip_runtime.h>
#include <cstdio>
#include <cstdint>
#include <cstring>
#include <cmath>
namespace fk {
#define LAS __attribute__((address_space(3)))
typedef unsigned short bf16_t;
typedef short bf16x8 __attribute__((ext_vector_type(8)));
typedef short s16x4 __attribute__((ext_vector_type(4)));
typedef float f32x4 __attribute__((ext_vector_type(4)));
typedef float f32x2 __attribute__((ext_vector_type(2)));
typedef float f32x16 __attribute__((ext_vector_type(16)));
typedef unsigned u32x4 __attribute__((ext_vector_type(4)));
typedef unsigned u32x2 __attribute__((ext_vector_type(2)));

constexpr int D = 1024, SEQ = 2048, CTX = 256, NB = 8, NLAT = NB * SEQ, NCTX = NB * CTX, NR = NLAT + NCTX, KVB = SEQ + CTX;
constexpr int INW = 5632, NHEAD = 8, SSMW = 512, NG = 32, NP = 64, NE = 32, EH = 512, DEPTH = 4;
constexpr int CHUNK = 32, NCHR = NR / CHUNK  , NCHP = 768  ;
constexpr int MOE_ROWS = 2 * NR + NE * 256;
constexpr float ALPHA = 1.681792830507429f;

__device__ __forceinline__ unsigned cvt_pk_bf16(float lo, float hi) { unsigned r; asm volatile("v_cvt_pk_bf16_f32 %0, %1, %2" : "=v"(r) : "v"(lo), "v"(hi)); return r; }
__device__ __forceinline__ float bf2f(unsigned short b) { return __uint_as_float(((unsigned)b) << 16); }
__device__ __forceinline__ float bflo(unsigned w) { return __uint_as_float(w << 16); }
__device__ __forceinline__ float bfhi(unsigned w) { return __uint_as_float(w & 0xffff0000u); }
__device__ __forceinline__ u32x4 pack8(const f32x4& a, const f32x4& b) { u32x4 w; w.x = cvt_pk_bf16(a[0], a[1]); w.y = cvt_pk_bf16(a[2], a[3]); w.z = cvt_pk_bf16(b[0], b[1]); w.w = cvt_pk_bf16(b[2], b[3]); return w; }
__device__ __forceinline__ void unpack8(const u32x4& w, f32x4& a, f32x4& b) { a = (f32x4){bflo(w.x), bfhi(w.x), bflo(w.y), bfhi(w.y)}; b = (f32x4){bflo(w.z), bfhi(w.z), bflo(w.w), bfhi(w.w)}; }
__device__ __forceinline__ float fast_sigmoid(float x) { return __builtin_amdgcn_rcpf(1.f + __builtin_amdgcn_exp2f(-1.4426950408889634f * x)); }
__device__ __forceinline__ float fast_silu(float x) { return x * fast_sigmoid(x); }
__device__ __forceinline__ float gelu_tanh_f(float x) { const float z = 0.7978845608028654f * (x + 0.044715f * x * x * x); return x * fast_sigmoid(2.f * z); }
__device__ __forceinline__ int otid_w(int wv) { int t; asm volatile("v_mbcnt_lo_u32_b32 %0, -1, 0\n\tv_mbcnt_hi_u32_b32 %0, -1, %0\n\tv_lshl_add_u32 %0, %1, 6, %0" : "=&v"(t) : "s"(wv)); return t; }
__device__ __forceinline__ int obid() { int b = blockIdx.x; asm volatile("" : "+s"(b)); return b; }
__device__ __forceinline__ int ogd() { int g = gridDim.x; asm volatile("" : "+s"(g)); return g; }
#define otid() otid_w(g_wv)
template <int CTRL, int RM> __device__ __forceinline__ float dpp_f(float v) { return __builtin_bit_cast(float, __builtin_amdgcn_update_dpp(0, __builtin_bit_cast(int, v), CTRL, RM, 0xF, false)); }
__device__ __forceinline__ float wave_sum_u(float v) {
  v += dpp_f<0xB1, 0xF>(v); v += dpp_f<0x4E, 0xF>(v); v += dpp_f<0x141, 0xF>(v); v += dpp_f<0x140, 0xF>(v); v += dpp_f<0x142, 0xA>(v); v += dpp_f<0x143, 0xC>(v);
  return __builtin_bit_cast(float, __builtin_amdgcn_readlane(__builtin_bit_cast(int, v), 63)); }
__host__ __device__ __forceinline__ int perm32(int rho) { const int n = rho >> 4, i = rho & 15; return 8 * (i >> 2) + 4 * n + (i & 3); }

#define XB_TMO      128
#define XB_XCNT(j)  (256  + 64 * (j))
#define XB_XSUB(j)  (1280 + 64 * (j))
#define XB_XGEN(j)  (2304 + 64 * (j))
#define XB_TOP      3328
#define XB_TOPGEN   3392
#define XCD_BAR_WORDS 3456
#define XB_SPIN_CAP (1u << 22)
__device__ __forceinline__ unsigned xb_ld(unsigned* p)              { return __hip_atomic_load(p, __ATOMIC_RELAXED, __HIP_MEMORY_SCOPE_AGENT); }
__device__ __forceinline__ unsigned xb_add(unsigned* p, unsigned v) { return __hip_atomic_fetch_add(p, v, __ATOMIC_RELAXED, __HIP_MEMORY_SCOPE_AGENT); }
__device__ __forceinline__ unsigned xb_xcc_id() { return (unsigned)__builtin_amdgcn_s_getreg((3 << 11) | 20) & 0xFu; }
#define XB_SPIN(cond, bar) do { unsigned _sp = 0; while (cond) { __builtin_amdgcn_s_sleep(1); \
    if ((++_sp & 255u) == 0u) { if (xb_ld(&(bar)[XB_TMO])) break; if (_sp > XB_SPIN_CAP) { atomicAdd(&(bar)[XB_TMO], 1u); break; } } } } while (0)
struct XcdBarrier { unsigned* bar; unsigned x; volatile LAS unsigned* st; };
__device__ __forceinline__ XcdBarrier xcd_barrier_post(unsigned* bar, volatile LAS unsigned* st) {
    XcdBarrier b; b.bar = bar; b.x = xb_xcc_id(); b.st = st;
    if (threadIdx.x == 0) (void)xb_add(&bar[XB_XCNT(b.x)], 1u);
    return b;
}
__device__ __forceinline__ void xcd_barrier_complete(unsigned* bar, unsigned x, unsigned& nloc, unsigned& nx) {
    const unsigned G = gridDim.x * gridDim.y * gridDim.z;
    unsigned sum, cnt, mine, sp = 0u;
    for (;;) {
        sum = 0u; cnt = 0u; mine = 0u;
#pragma unroll
        for (unsigned j = 0; j < 16; ++j) { const unsigned c = xb_ld(&bar[XB_XCNT(j)]); sum += c; cnt += (c > 0u) ? 1u : 0u; mine = (j == x) ? c : mine; }
        if (sum == G) break;
        __builtin_amdgcn_s_sleep(1);
        if ((++sp & 255u) == 0u) { if (xb_ld(&bar[XB_TMO])) break; if (sp > XB_SPIN_CAP) { atomicAdd(&bar[XB_TMO], 1u); break; } }
    }
    nloc = mine > 0u ? mine : 1u; nx = cnt > 0u ? cnt : 1u;
}
__device__ __forceinline__ void xcd_barrier(const XcdBarrier& b) {
    asm volatile("s_waitcnt vmcnt(0)" ::: "memory");
    __syncthreads();
    if (threadIdx.x == 0) {
        unsigned* bar = b.bar;
        __builtin_amdgcn_s_waitcnt(0);
        unsigned nloc = b.st[0], nx = b.st[1];
        if (nloc == 0u) { xcd_barrier_complete(bar, b.x, nloc, nx); b.st[0] = nloc; b.st[1] = nx; }
        const unsigned old = xb_add(&bar[XB_XSUB(b.x)], 1u);
        const unsigned gen = old / nloc;
        if (old + 1u == (gen + 1u) * nloc) {
            __builtin_amdgcn_fence(__ATOMIC_RELEASE, "agent");
            asm volatile("s_waitcnt vmcnt(0)" ::: "memory");
            const unsigned og = xb_add(&bar[XB_TOP], 1u);
            const unsigned tg = og / nx;
            if (og + 1u == (tg + 1u) * nx) xb_add(&bar[XB_TOPGEN], 1u);
            else XB_SPIN(xb_ld(&bar[XB_TOPGEN]) == tg, bar);
            __builtin_amdgcn_fence(__ATOMIC_ACQUIRE, "agent");
            xb_add(&bar[XB_XGEN(b.x)], 1u);
            asm volatile("s_waitcnt vmcnt(0)" ::: "memory");
        } else {
            XB_SPIN(xb_ld(&bar[XB_XGEN(b.x)]) == gen, bar);
            __builtin_amdgcn_fence(__ATOMIC_ACQUIRE, "agent");
            asm volatile("s_waitcnt vmcnt(0)" ::: "memory");
        }
    }
    __syncthreads();
}

constexpr int BM = 256, BK = 64, HALF = 128, HTB = HALF * BK * 2, STAGE_BYTES = 8 * HTB;
__host__ __device__ __forceinline__ int lds_byte(int r, int c) { const int st = (r >> 4) * 2 + (c >> 5), rr = r & 15, cc = c & 31, ob = rr * 64 + cc * 2; return st * 1024 + (ob ^ (((ob >> 9) & 1) << 5)); }
__host__ __device__ __forceinline__ void stage_rc(int b, int& R, int& C) { const int st = b / 1024, sb = b % 1024, swz = sb ^ (((sb >> 9) & 1) << 5); R = (st >> 1) * 16 + swz / 64; C = (st & 1) * 32 + (swz % 64) / 2; }
struct Seg { const char* A; const char* B; int nt; int epi; int pm; int pn; int aux; int aux2; };
__device__ __forceinline__ void tile_order(int L, int nM, int nN, int& pm, int& pn) {
    const int nwg = nM * nN; int wgid = L; { const int q = nwg / 8, r = nwg % 8, xcd = wgid % 8, off = wgid / 8; wgid = (xcd < r ? xcd * (q + 1) : r * (q + 1) + (xcd - r) * q) + off; }
    const int nig = 8 * nN, gid = wgid / nig, fm = gid * 8, gsz = (nM - fm) < 8 ? (nM - fm) : 8;
    pm = fm + ((wgid % nig) % gsz); pn = (wgid % nig) / gsz;
}
template <class Epi, class Sched, bool GATHER = false>
__device__ __forceinline__ void gemm_stream(LAS unsigned char* lds, const int lda, const int ldb, const Sched& S, const Epi& E, const int g_wv) {
    const int tid = otid(), wid = __builtin_amdgcn_readfirstlane(tid >> 6), lane = tid & 63, wr = wid >> 2, wc = wid & 3, fr = lane & 15, fq = lane >> 4;
    unsigned voffA[2], voffB[2];
#pragma unroll
    for (int i = 0; i < 2; ++i) { int R, C; stage_rc(tid * 16 + i * 8192, R, C); voffA[i] = (unsigned)(R * lda + C * 2); voffB[i] = (unsigned)(R * ldb + C * 2); }
    unsigned gvc[2][2], gvn[2][2];
#define PG8_GV(dst, seg) do { _Pragma("unroll") for (int _i = 0; _i < 2; ++_i) { int _R, _C; stage_rc(otid() * 16 + _i * 8192, _R, _C); _Pragma("unroll") for (int _h = 0; _h < 2; ++_h) dst[_h][_i] = S.gvoff(seg, _h * HALF + _R) + (unsigned)(_C * 2); } } while (0)
    const size_t kstep = (size_t)(BK * 2);
    const size_t hstepA = (size_t)HALF * lda, hstepB = (size_t)HALF * ldb;
    const unsigned ldsw = (unsigned)wid * 1024u;
    const int aoff = lds_byte(wr * 64 + fr, fq * 8), boff = lds_byte(wc * 32 + fr, fq * 8);
#define PG8_SA(b, h) (((b) * 2 + (h)) * HTB)
#define PG8_SB(b, h) ((4 + (b) * 2 + (h)) * HTB)
#define PG8_STAGE(bufoff, gbase, voff) do { _Pragma("unroll") for (int _i = 0; _i < 2; ++_i) \
        __builtin_amdgcn_global_load_lds((const unsigned*)((const char*)(gbase) + (voff)[_i]), (LAS unsigned*)(lds + (bufoff) + ldsw + _i * 8192), 16, 0, 0); } while (0)
#define PG8_LDA(dst, b, h) do { _Pragma("unroll") for (int m = 0; m < 4; ++m) _Pragma("unroll") for (int k = 0; k < 2; ++k) dst[m][k] = *(const LAS bf16x8*)(lds + PG8_SA(b, h) + aoff + m * 2048 + k * 1024); } while (0)
#define PG8_LDB(dst, b, h) do { _Pragma("unroll") for (int n = 0; n < 2; ++n) _Pragma("unroll") for (int k = 0; k < 2; ++k) dst[n][k] = *(const LAS bf16x8*)(lds + PG8_SB(b, h) + boff + n * 2048 + k * 1024); } while (0)
#define PG8_MMA(ai, bj, At, Bt) do { __builtin_amdgcn_s_setprio(1); _Pragma("unroll") for (int m = 0; m < 4; ++m) _Pragma("unroll") for (int n = 0; n < 2; ++n) _Pragma("unroll") for (int k = 0; k < 2; ++k) \
        acc[ai][bj][m][n] = __builtin_amdgcn_mfma_f32_16x16x32_bf16(Bt[n][k], At[m][k], acc[ai][bj][m][n], 0, 0, 0); __builtin_amdgcn_s_setprio(0); } while (0)
#define PG8_WAIT_V(n) asm volatile("s_waitcnt vmcnt(" #n ")" ::: "memory")
#define PG8_WAIT_L(n) asm volatile("s_waitcnt lgkmcnt(" #n ")" ::: "memory")
#define PG8_BAR __builtin_amdgcn_s_barrier()
#define PG8_SCHED __builtin_amdgcn_sched_barrier(0)
    Seg cur, nxt; int ui = 0;
    if (!S.next(0, cur)) return;
    f32x4 acc[2][2][4][2];
#pragma unroll
    for (int a = 0; a < 2; ++a)
#pragma unroll
        for (int b = 0; b < 2; ++b)
#pragma unroll
            for (int m = 0; m < 4; ++m)
#pragma unroll
                for (int n = 0; n < 2; ++n) acc[a][b][m][n] = (f32x4){0.f, 0.f, 0.f, 0.f};
    bf16x8 At[4][2], B0[2][2], B1[2][2];
    const char* cA = cur.A; const char* cB = cur.B;
    if constexpr (GATHER) { PG8_GV(gvc, cur); }
#define PG8_STAGE_A(bufoff, kbase, h, usenext) do { if constexpr (GATHER) { unsigned _v[2] = {(usenext) ? gvn[h][0] : gvc[h][0], (usenext) ? gvn[h][1] : gvc[h][1]}; PG8_STAGE(bufoff, kbase, _v); } \
        else { PG8_STAGE(bufoff, (kbase) + (h) * hstepA, voffA); } } while (0)
    PG8_STAGE(PG8_SB(0, 0), cB, voffB); PG8_STAGE(PG8_SB(0, 1), cB + hstepB, voffB); PG8_STAGE_A(PG8_SA(0, 0), cA, 0, false); PG8_STAGE_A(PG8_SA(0, 1), cA, 1, false);
    if (wr == 1) PG8_BAR;
    PG8_WAIT_V(2); PG8_BAR;
    PG8_STAGE(PG8_SB(1, 0), cB + kstep, voffB); PG8_STAGE_A(PG8_SA(1, 0), cA + kstep, 0, false); PG8_STAGE(PG8_SB(1, 1), cB + hstepB + kstep, voffB);
    PG8_WAIT_V(6); PG8_BAR;
    for (;;) {
        const bool has_next = S.next(ui + 1, nxt);
        const char* nA = has_next ? nxt.A : cA; const char* nB = has_next ? nxt.B : cB;
        const int nt = cur.nt;
        for (int t = 0; t < nt; t += 2) {
            const bool last = (t == nt - 2);
            if constexpr (GATHER) { if (last) { if (has_next) { PG8_GV(gvn, nxt); } else { _Pragma("unroll") for (int _h = 0; _h < 2; ++_h) _Pragma("unroll") for (int _i = 0; _i < 2; ++_i) gvn[_h][_i] = gvc[_h][_i]; } } }
            const char* a1 = cA + (size_t)(t + 1) * kstep;
            const char* a2 = last ? nA : cA + (size_t)(t + 2) * kstep; const char* b2 = last ? nB : cB + (size_t)(t + 2) * kstep;
            const char* a3 = a2 + kstep; const char* b3 = b2 + kstep;
            PG8_LDB(B0, 0, 0); PG8_LDB(B1, 0, 1); PG8_SCHED; PG8_LDA(At, 0, 0); PG8_STAGE_A(PG8_SA(1, 1), a1, 1, false);
            PG8_WAIT_V(8); PG8_WAIT_L(0); PG8_BAR; PG8_MMA(0, 0, At, B0); PG8_MMA(0, 1, At, B1); PG8_BAR; PG8_SCHED;
            PG8_LDA(At, 0, 1); PG8_STAGE(PG8_SB(0, 0), b2, voffB); PG8_STAGE(PG8_SB(0, 1), b2 + hstepB, voffB); PG8_STAGE_A(PG8_SA(0, 0), a2, 0, last);
            PG8_WAIT_V(8); PG8_WAIT_L(0); PG8_BAR; PG8_MMA(1, 0, At, B0); PG8_MMA(1, 1, At, B1); PG8_BAR; PG8_SCHED;
            PG8_LDB(B0, 1, 0); PG8_LDB(B1, 1, 1); PG8_SCHED; PG8_LDA(At, 1, 0); PG8_STAGE_A(PG8_SA(0, 1), a2, 1, last);
            PG8_WAIT_V(8); PG8_WAIT_L(0); PG8_BAR; PG8_MMA(0, 0, At, B0); PG8_MMA(0, 1, At, B1); PG8_BAR; PG8_SCHED;
            PG8_LDA(At, 1, 1); PG8_STAGE(PG8_SB(1, 0), b3, voffB); PG8_STAGE(PG8_SB(1, 1), b3 + hstepB, voffB); PG8_STAGE_A(PG8_SA(1, 0), a3, 0, last);
            PG8_WAIT_V(8); PG8_WAIT_L(0); PG8_BAR; PG8_MMA(1, 0, At, B0); PG8_MMA(1, 1, At, B1); PG8_BAR; PG8_SCHED;
        }
        if (cur.epi) {
            if (wr == 0) PG8_BAR;
            int efr = fr, efq = fq; asm volatile("" : "+v"(efr), "+v"(efq));
            const bool z = E(acc, cur, wr, wc, efr, efq);
            if (z) {
#pragma unroll
                for (int a = 0; a < 2; ++a)
#pragma unroll
                    for (int b = 0; b < 2; ++b)
#pragma unroll
                        for (int m = 0; m < 4; ++m)
#pragma unroll
                            for (int n = 0; n < 2; ++n) acc[a][b][m][n] = (f32x4){0.f, 0.f, 0.f, 0.f};
            }
            if (!has_next) break;
            if (wr == 1) PG8_BAR;
        } else if (!has_next) { if (wr == 0) PG8_BAR; break; }
        cur = nxt; cA = nA; cB = nB; ++ui;
        if constexpr (GATHER) {
#pragma unroll
            for (int h = 0; h < 2; ++h)
#pragma unroll
                for (int i = 0; i < 2; ++i) gvc[h][i] = gvn[h][i]; }
    }
    PG8_WAIT_V(0);
    PG8_BAR;
#undef PG8_SA
#undef PG8_SB
#undef PG8_STAGE
#undef PG8_STAGE_A
#undef PG8_GV
#undef PG8_LDA
#undef PG8_LDB
#undef PG8_MMA
#undef PG8_WAIT_V
#undef PG8_WAIT_L
#undef PG8_BAR
#undef PG8_SCHED
}
}
namespace fk {
struct In { const float *x, *c, *ctx, *c_ctx, *w_mod, *b_mod, *w_in, *lam_q1, *lam_k1, *lam_q2, *lam_k2, *subln_g, *a_re, *a_im, *log_dt, *b_re, *b_im, *c_re, *c_im, *ssm_d,
  *w_glu, *b_glu, *w_pa, *w_ps, *w_o, *ln1_g, *ln1_b, *rg_w, *rg_b, *re_w, *re_b, *w1, *w3, *w2, *ln2_g, *ln2_b; };
struct Params {
  In in; float* out;
  unsigned* bar;
  unsigned* ctl;
  float* MOD;
  float* ROPE;
  float* XL;
  bf16_t* Hb;
  bf16_t* Kc; bf16_t* Vc;
  bf16_t* Qb;
  bf16_t* Ug;
  bf16_t* RG; bf16_t* GSb;
  bf16_t* ATTb;
  float* SST;
  bf16_t* YG;
  bf16_t* S2;
  bf16_t* Mb;
  bf16_t* H2b;
  int* ROUTE;
  float* RW;
  int* TOK;
  bf16_t* Hm;
  bf16_t* Yo;
  bf16_t* Win; bf16_t* Wglu; bf16_t* Wpa; bf16_t* Wps; bf16_t* Wo; bf16_t* W13; bf16_t* W2;
  bf16_t* Smat;
  bf16_t* TO;
  float* SAL;
  float* WR;
  int ph_lo, ph_hi;
  int pad0, pad1;
};
typedef const __attribute__((address_space(4))) Params& KP;
constexpr int CTL_CNT = 0;
constexpr int CTL_WORDS = 64 * 32 + 64;

__device__ __forceinline__ int modrow_of_tile(int pm) { return pm < 64 ? (pm >> 3) : 8; }
__device__ __forceinline__ int kvrow0_of_tile(int pm) { return pm < 64 ? (pm >> 3) * KVB + CTX + (pm & 7) * 256 : (pm - 64) * KVB; }

struct SchedPlain {
  const char* A; const char* B; int lda, ldb, nM, nN, nt, G, c, nunits; int epi;
  __device__ __forceinline__ bool next(int i, Seg& s) const {
    const int L = i * G + c; if (L >= nunits) return false;
    int pm, pn; tile_order(L, nM, nN, pm, pn);
    s.A = A + (size_t)pm * 256 * lda; s.B = B + (size_t)pn * 256 * ldb; s.nt = nt; s.epi = epi; s.pm = pm; s.pn = pn; s.aux = 0; s.aux2 = 0; return true; }
};
struct SchedMerge {
  const char* A1; const char* B1; const char* A2; const char* B2; int nM, nN, G, c, nunits;
  __device__ __forceinline__ bool next(int i, Seg& s) const {
    const int L = (i >> 1) * G + c; if (L >= nunits) return false;
    int pm, pn; tile_order(L, nM, nN, pm, pn); s.pm = pm; s.pn = pn; s.aux = 0; s.aux2 = 0;
    if ((i & 1) == 0) { s.A = A1 + (size_t)pm * 256 * 2048; s.B = B1 + (size_t)pn * 256 * 2048; s.nt = 16; s.epi = 2; }
    else { s.A = A2 + (size_t)pm * 256 * 2048; s.B = B2 + (size_t)pn * 256 * 2048; s.nt = 8; s.epi = 1; }
    return true; }
};
struct SchedSsm1 {
  const char* Ug; const char* Smat; int G, c;
  __device__ __forceinline__ bool next(int i, Seg& s) const {
    const int L = i * G + c; if (L >= NG * 3) return false;
    const int g = L / 3, pm = L % 3;
    s.A = Ug + (size_t)g * NCHP * 1536 + (size_t)pm * 256 * 1536; s.B = Smat + (size_t)g * 256 * 1536; s.nt = 8; s.epi = 1; s.pm = pm; s.pn = 0; s.aux = g; s.aux2 = 0; return true; }
};
struct SchedSsm3 {
  const char* Ug; const char* TO; int G, c;
  __device__ __forceinline__ bool next(int i, Seg& s) const {
    const int L = i * G + c; if (L >= NG * 6) return false;
    const int g = L / 6, r = L % 6, pm = r >> 1, pn = r & 1; s.pm = pm; s.pn = pn; s.aux = g; s.aux2 = 0;
    s.A = Ug + (size_t)g * NCHP * 1536 + (size_t)pm * 256 * 1536; s.B = TO + (size_t)g * 512 * 1536 + (size_t)pn * 256 * 1536; s.nt = 12; s.epi = 1; return true; }
};
struct MoeTab { int ntiles; int tileE[176]; int tileR0[176]; int cnt[32]; int tbase[33]; };
struct SchedMoe {
  const char* A; const char* B; int lda, ldb; size_t estride; const LAS MoeTab* tab; const int* TOK; int nN, nt, G, c; bool gather;
  __device__ __forceinline__ bool next(int i, Seg& s) const {
    const int L = i * G + c; if (L >= tab->ntiles * nN) return false;
    const int t = L / nN, pn = L % nN; const int e = tab->tileE[t];
    s.A = gather ? A : A + (size_t)t * 256 * lda; s.B = B + (size_t)e * estride + (size_t)pn * 256 * ldb; s.nt = nt; s.epi = 1; s.pm = t; s.pn = pn; s.aux = e; s.aux2 = tab->tileR0[t]; return true; }
  __device__ __forceinline__ unsigned gvoff(const Seg& s, int R) const { const int r = s.aux2 + R; const int tok = r < tab->cnt[s.aux] ? TOK[(size_t)s.aux * NR + r] : 0; return (unsigned)tok * (unsigned)lda; }
};
struct SchedG1 {
  const char* A; const char* B; int G, c, u0, u1; bool last;
  __device__ __forceinline__ bool next(int i, Seg& s) const {
    const int L = u0 + i * G + c; if (L >= u1) return false; int pm, pn;
    if (!last) { if (L < 144) { pm = L >> 1; pn = 8 + (L & 1); } else { int q; tile_order(L - 144, NR / 256, 20, pm, q); pn = q < 8 ? q : q + 2; } }
    else { if (L < 1408) tile_order(L, NLAT / 256, 22, pm, pn); else { const int L2 = L - 1408; pm = 64 + L2 / 10; pn = L2 % 10; } }
    s.A = A + (size_t)pm * 256 * 2048; s.B = B + (size_t)pn * 256 * 2048; s.nt = 16; s.epi = 1; s.pm = pm; s.pn = pn; s.aux = 0; s.aux2 = 0; return true; }
};
#define EPI_LOOP_AM for (int ai = 0; ai < 2; ++ai) _Pragma("unroll") for (int m = 0; m < 4; ++m)
struct EpiIn {
  const float* ROPE; bf16_t* Kc; bf16_t* Vc; bf16_t* Ug; bf16_t* Qb; bf16_t* RG; bf16_t* GSb;
  __device__ __forceinline__ bool operator()(f32x4 (&acc)[2][2][4][2], const Seg& s, int wr, int wc, int fr, int fq) const {
    const int pm = s.pm, pn = s.pn; const int rin0 = wr * 64 + fr;
    if (pn < 4 || (pn >= 10 && pn < 14)) {
      const bool isq = pn >= 10; const int pt = isq ? pn - 10 : pn; const int axis = wc & 1;
      bf16_t* dst = isq ? Qb : Kc; const int drow0 = isq ? pm * 256 : kvrow0_of_tile(pm); const bool lat = pm < 64;
#pragma unroll
      EPI_LOOP_AM { const int rin = ai * 128 + m * 16 + rin0; const int t = (pm * 256 + rin) & (SEQ - 1); const float* rp = ROPE + ((size_t)t * 2 + axis) * 32 + fq * 4;
        f32x4 cs, sn; if (lat) { cs = *(const f32x4*)rp; sn = *(const f32x4*)(rp + 16); }
#pragma unroll
        for (int bj = 0; bj < 2; ++bj) { f32x4 o1 = acc[ai][bj][m][0], o2 = acc[ai][bj][m][1]; if (lat) { const f32x4 t1 = o1, t2 = o2; o1 = t1 * cs - t2 * sn; o2 = t1 * sn + t2 * cs; }
          *(u32x4*)(dst + (size_t)(drow0 + rin) * 1024 + (2 * pt + bj) * 128 + wc * 32 + fq * 8) = pack8(o1, o2); } }
    } else if (pn < 8) {
      const int drow0 = kvrow0_of_tile(pm);
#pragma unroll
      EPI_LOOP_AM { const int rin = ai * 128 + m * 16 + rin0;
#pragma unroll
        for (int bj = 0; bj < 2; ++bj) *(u32x4*)(Vc + (size_t)(drow0 + rin) * 1024 + (pn - 4) * 256 + bj * 128 + wc * 32 + fq * 8) = pack8(acc[ai][bj][m][0], acc[ai][bj][m][1]); }
    } else if (pn < 10) {
#pragma unroll
      EPI_LOOP_AM { const int rin = ai * 128 + m * 16 + rin0;
#pragma unroll
        for (int bj = 0; bj < 2; ++bj) { const int c0 = (pn - 8) * 256 + bj * 128 + wc * 32 + fq * 8; const int g = c0 >> 4, co = c0 & 15;
          const int R = pm * 256 + rin; *(u32x4*)(Ug + ((size_t)g * NCHP + (R >> 5)) * 768 + (R & 31) * 16 + co) = pack8(acc[ai][bj][m][0], acc[ai][bj][m][1]); } }
    } else {
      const int c0 = (pn - 14) * 128 + wc * 32 + fq * 8;
#pragma unroll
      EPI_LOOP_AM { const int rin = ai * 128 + m * 16 + rin0; f32x4 r[2], g[2];
#pragma unroll
        for (int n = 0; n < 2; ++n)
#pragma unroll
          for (int j = 0; j < 4; ++j) { const float ea = __builtin_amdgcn_exp2f(-1.4426950408889634f * acc[ai][0][m][n][j]); const float es = __builtin_amdgcn_exp2f(-1.4426950408889634f * fmaxf(acc[ai][1][m][n][j], -60.f));
            g[n][j] = __builtin_amdgcn_rcpf(1.f + es); r[n][j] = (1.f + es) * __builtin_amdgcn_rcpf(1.f + ea); }
        *(u32x4*)(RG + (size_t)(pm * 256 + rin) * 1024 + c0) = pack8(r[0], r[1]); *(u32x4*)(GSb + (size_t)(pm * 256 + rin) * 1024 + c0) = pack8(g[0], g[1]); }
    }
    return true;
  }
};
struct EpiState {
  float* SST;
  __device__ __forceinline__ bool operator()(f32x4 (&acc)[2][2][4][2], const Seg& s, int wr, int wc, int fr, int fq) const {
    const int g = s.aux;
#pragma unroll
    EPI_LOOP_AM { const int row = s.pm * 256 + ai * 128 + m * 16 + wr * 64 + fr;
      if (row < NCHR) {
#pragma unroll
        for (int bj = 0; bj < 2; ++bj) { float* p = SST + ((size_t)g * NCHP + row) * 256 + bj * 128 + wc * 32 + fq * 8; *(f32x4*)p = acc[ai][bj][m][0]; *(f32x4*)(p + 4) = acc[ai][bj][m][1]; } } }
    return true;
  }
};
struct EpiSsmOut {
  bf16_t* YG;
  __device__ __forceinline__ bool operator()(f32x4 (&acc)[2][2][4][2], const Seg& s, int wr, int wc, int fr, int fq) const {
    const int g = s.aux;
#pragma unroll
    EPI_LOOP_AM { const int row = s.pm * 256 + ai * 128 + m * 16 + wr * 64 + fr;
      if (row < NCHR) {
#pragma unroll
        for (int bj = 0; bj < 2; ++bj) { const int c0 = s.pn * 256 + bj * 128 + wc * 32 + fq * 8; const int t = c0 >> 4, co = c0 & 15; f32x4 a = acc[ai][bj][m][0], b = acc[ai][bj][m][1];
#pragma unroll
          for (int j = 0; j < 4; ++j) { a[j] = gelu_tanh_f(a[j]); b[j] = gelu_tanh_f(b[j]); }
          *(u32x4*)(YG + ((size_t)row * CHUNK + t) * SSMW + g * 16 + co) = pack8(a, b); } } }
    return true;
  }
};
struct EpiGlu {
  const bf16_t* YG; bf16_t* S2; const float* bias;
  __device__ __forceinline__ bool operator()(f32x4 (&acc)[2][2][4][2], const Seg& s, int wr, int wc, int fr, int fq) const {
#pragma unroll
    for (int bj = 0; bj < 2; ++bj) { const int c0 = s.pn * 256 + bj * 128 + wc * 32 + fq * 8; const f32x4 b0 = *(const f32x4*)(bias + c0), b1 = *(const f32x4*)(bias + c0 + 4);
#pragma unroll
      EPI_LOOP_AM { const int row = s.pm * 256 + ai * 128 + m * 16 + wr * 64 + fr; const u32x4 yw = *(const u32x4*)(YG + (size_t)row * SSMW + c0); f32x4 y0, y1; unpack8(yw, y0, y1);
        f32x4 z0 = acc[ai][bj][m][0] + b0, z1 = acc[ai][bj][m][1] + b1;
#pragma unroll
        for (int j = 0; j < 4; ++j) { z0[j] = y0[j] * fast_sigmoid(z0[j]); z1[j] = y1[j] * fast_sigmoid(z1[j]); }
        *(u32x4*)(S2 + (size_t)row * 1024 + c0) = pack8(z0, z1); } }
    return true;
  }
};
struct EpiMerge {
  const bf16_t* RG; const bf16_t* GSb; bf16_t* Mb;
  __device__ __forceinline__ bool operator()(f32x4 (&acc)[2][2][4][2], const Seg& s, int wr, int wc, int fr, int fq) const {
    const bool mid = s.epi == 2; const bf16_t* src = mid ? RG : GSb;
#pragma unroll
    EPI_LOOP_AM { const int row = s.pm * 256 + ai * 128 + m * 16 + wr * 64 + fr;
#pragma unroll
      for (int bj = 0; bj < 2; ++bj) { const int c0 = s.pn * 256 + bj * 128 + wc * 32 + fq * 8; const u32x4 w = *(const u32x4*)(src + (size_t)row * 1024 + c0); f32x4 g0, g1; unpack8(w, g0, g1);
        acc[ai][bj][m][0] *= g0; acc[ai][bj][m][1] *= g1;
        if (!mid) *(u32x4*)(Mb + (size_t)row * 1024 + c0) = pack8(acc[ai][bj][m][0], acc[ai][bj][m][1]); } }
    return !mid;
  }
};
struct EpiWo {
  const float* xin_lat; const float* xin_ctx; float* XL; const float* MODl;
  __device__ __forceinline__ bool operator()(f32x4 (&acc)[2][2][4][2], const Seg& s, int wr, int wc, int fr, int fq) const {
    const int pm = s.pm; const float* gate = MODl + (size_t)modrow_of_tile(pm) * 6144 + 2 * 1024;
    const float* xin = pm < 64 ? xin_lat + (size_t)pm * 256 * 1024 : xin_ctx + (size_t)(pm - 64) * 256 * 1024;
#pragma unroll
    for (int bj = 0; bj < 2; ++bj) { const int c0 = s.pn * 256 + bj * 128 + wc * 32 + fq * 8; const f32x4 g0 = *(const f32x4*)(gate + c0), g1 = *(const f32x4*)(gate + c0 + 4);
#pragma unroll
      EPI_LOOP_AM { const int rin = ai * 128 + m * 16 + wr * 64 + fr; const float* xp = xin + (size_t)rin * 1024 + c0; float* op = XL + (size_t)(pm * 256 + rin) * 1024 + c0;
        const f32x4 x0 = *(const f32x4*)xp, x1 = *(const f32x4*)(xp + 4);
        *(f32x4*)op = x0 * ALPHA + g0 * acc[ai][bj][m][0]; *(f32x4*)(op + 4) = x1 * ALPHA + g1 * acc[ai][bj][m][1]; } }
    return true;
  }
};
struct EpiMoe1 {
  bf16_t* Hm;
  __device__ __forceinline__ bool operator()(f32x4 (&acc)[2][2][4][2], const Seg& s, int wr, int wc, int fr, int fq) const {
    const int c0 = s.pn * 128 + wc * 32 + fq * 8;
#pragma unroll
    EPI_LOOP_AM { const int row = s.pm * 256 + ai * 128 + m * 16 + wr * 64 + fr; f32x4 h0, h1;
#pragma unroll
      for (int j = 0; j < 4; ++j) { h0[j] = fast_silu(acc[ai][0][m][0][j]) * acc[ai][1][m][0][j]; h1[j] = fast_silu(acc[ai][0][m][1][j]) * acc[ai][1][m][1][j]; }
      *(u32x4*)(Hm + (size_t)row * EH + c0) = pack8(h0, h1); }
    return true;
  }
};
struct EpiMoe2 {
  bf16_t* Yo;
  __device__ __forceinline__ bool operator()(f32x4 (&acc)[2][2][4][2], const Seg& s, int wr, int wc, int fr, int fq) const {
#pragma unroll
    EPI_LOOP_AM { const int row = s.pm * 256 + ai * 128 + m * 16 + wr * 64 + fr;
#pragma unroll
      for (int bj = 0; bj < 2; ++bj) *(u32x4*)(Yo + (size_t)row * 1024 + s.pn * 256 + bj * 128 + wc * 32 + fq * 8) = pack8(acc[ai][bj][m][0], acc[ai][bj][m][1]); }
    return true;
  }
};
}
namespace fk {
constexpr int ATT_SHM_V = 64 * 128 * 2, ATT_SHM_K = 64 * 128 * 2;
constexpr int ATT_LDS = 2 * ATT_SHM_V + 2 * ATT_SHM_K + 8 * 256;
#define KSWZ(row, colB) ((row) * 256 + ((colB) ^ (((row) & 7) << 4)))
#define SBAR() __builtin_amdgcn_sched_barrier(0)
__device__ __forceinline__ int crow(int r, int hi) { return (r & 3) + 8 * (r >> 2) + 4 * hi; }
constexpr float ATT_SCALE = 0.125f, ATT_THR = 8.f;
__device__ __forceinline__ void partialSM(f32x16& p0, f32x16& p1, float& m_reg, float& mn, float& alpha) {
  constexpr float C = ATT_SCALE * 1.4426950408889634f;
  float pmax = p0[0];
#pragma unroll
  for (int r = 1; r < 16; ++r) pmax = fmaxf(pmax, p0[r]);
#pragma unroll
  for (int r = 0; r < 16; ++r) pmax = fmaxf(pmax, p1[r]);
  { auto rr = __builtin_amdgcn_permlane32_swap(__float_as_uint(pmax), __float_as_uint(pmax), false, false);
    pmax = fmaxf(__uint_as_float(rr[0]), __uint_as_float(rr[1])); }
  if (__builtin_expect(__all(pmax - m_reg <= ATT_THR / ATT_SCALE), 1)) { mn = m_reg; alpha = 1.f; }
  else { mn = fmaxf(m_reg, pmax); alpha = __builtin_amdgcn_exp2f((m_reg - mn) * C); m_reg = mn; }
  const float mnC = -mn * C;
#pragma unroll
  for (int r = 0; r < 16; ++r) p0[r] = fmaf(p0[r], C, mnC);
#pragma unroll
  for (int r = 0; r < 16; ++r) p1[r] = fmaf(p1[r], C, mnC);
#pragma unroll
  for (int r = 0; r < 16; ++r) p0[r] = __builtin_amdgcn_exp2f(p0[r]);
}
__device__ __forceinline__ void finishSM(f32x16& p0, f32x16& p1, float alpha, float& l_reg, bf16x8& pa0, bf16x8& pa1, bf16x8& pa2, bf16x8& pa3) {
#pragma unroll
  for (int r = 0; r < 16; ++r) p1[r] = __builtin_amdgcn_exp2f(p1[r]);
  float ps = 0;
#pragma unroll
  for (int r = 0; r < 16; ++r) ps += p0[r];
#pragma unroll
  for (int r = 0; r < 16; ++r) ps += p1[r];
  { auto rr = __builtin_amdgcn_permlane32_swap(__float_as_uint(ps), __float_as_uint(ps), false, false);
    ps = __uint_as_float(rr[0]) + __uint_as_float(rr[1]); }
  l_reg = l_reg * alpha + ps;
#define PK4(P, BASE, OUT) do { unsigned a0 = cvt_pk_bf16(P[BASE + 0], P[BASE + 1]), a1 = cvt_pk_bf16(P[BASE + 2], P[BASE + 3]);   \
    unsigned b0 = cvt_pk_bf16(P[BASE + 4], P[BASE + 5]), b1 = cvt_pk_bf16(P[BASE + 6], P[BASE + 7]);                              \
    auto r0 = __builtin_amdgcn_permlane32_swap(a0, b0, false, false); auto r1 = __builtin_amdgcn_permlane32_swap(a1, b1, false, false); \
    u32x4 w = {r0[0], r1[0], r0[1], r1[1]}; OUT = *reinterpret_cast<bf16x8*>(&w); } while (0)
  PK4(p0, 0, pa0); PK4(p0, 8, pa1); PK4(p1, 0, pa2); PK4(p1, 8, pa3);
#undef PK4
}
__device__ __forceinline__ void qkt(f32x16& p0, f32x16& p1, const LAS char* Ks, const bf16x8* qr, int mapcolB, int r32, int hi) {
  p0 = f32x16{}; p1 = f32x16{};
#pragma unroll
  for (int d0 = 0; d0 < 4; ++d0) { const int cb = mapcolB + (d0 * 16 + hi * 8) * 2;
    const bf16x8 b0 = *(const LAS bf16x8*)(Ks + KSWZ(r32, cb));
    const bf16x8 b1 = *(const LAS bf16x8*)(Ks + KSWZ(32 + r32, cb));
    p0 = __builtin_amdgcn_mfma_f32_32x32x16_bf16(b0, qr[d0], p0, 0, 0, 0);
    p1 = __builtin_amdgcn_mfma_f32_32x32x16_bf16(b1, qr[d0], p1, 0, 0, 0); }
}
__device__ __forceinline__ int v_st(int k, int c) { const int kk = (k & ~0xC) | ((k & 4) << 1) | ((k & 8) >> 1); return ((kk >> 3) * 4 + (c >> 5)) * 512 + ((kk & 7) * 32 + (c & 31)) * 2; }
__device__ __forceinline__ int v_rd_base(int lane) { return ((lane & 3) << 3) | (((lane >> 2) & 3) << 6) | (((lane >> 4) & 1) << 5) | (((lane >> 5) & 1) << 8); }
constexpr int v_rd_off(int d0, int ks, int half) { return d0 * 512 + ks * 4096 + half * 2048; }
template <int OFF> __device__ __forceinline__ s16x4 tr_read(int vb) {
  s16x4 r; asm volatile("ds_read_b64_tr_b16 %0, %1 offset:%2" : "=&v"(r) : "v"(vb), "i"(OFF) : "memory"); return r;
}
template <int D0> __device__ __forceinline__ void pv_one(f32x16& od, int vb, bf16x8 pa0, bf16x8 pa1, bf16x8 pa2, bf16x8 pa3) {
  const s16x4 l0 = tr_read<v_rd_off(D0, 0, 0)>(vb), h0 = tr_read<v_rd_off(D0, 0, 1)>(vb), l1 = tr_read<v_rd_off(D0, 1, 0)>(vb), h1 = tr_read<v_rd_off(D0, 1, 1)>(vb);
  const s16x4 l2 = tr_read<v_rd_off(D0, 2, 0)>(vb), h2 = tr_read<v_rd_off(D0, 2, 1)>(vb), l3 = tr_read<v_rd_off(D0, 3, 0)>(vb), h3 = tr_read<v_rd_off(D0, 3, 1)>(vb);
  asm volatile("s_waitcnt lgkmcnt(0)" ::: "memory"); SBAR();
#define PK(L, H) (bf16x8){L[0], L[1], L[2], L[3], H[0], H[1], H[2], H[3]}
  od = __builtin_amdgcn_mfma_f32_32x32x16_bf16(pa0, PK(l0, h0), od, 0, 0, 0);
  od = __builtin_amdgcn_mfma_f32_32x32x16_bf16(pa1, PK(l1, h1), od, 0, 0, 0);
  od = __builtin_amdgcn_mfma_f32_32x32x16_bf16(pa2, PK(l2, h2), od, 0, 0, 0);
  od = __builtin_amdgcn_mfma_f32_32x32x16_bf16(pa3, PK(l3, h3), od, 0, 0, 0);
#undef PK
}
__device__ __forceinline__ void pv_d0(f32x16* o, int vb, bf16x8 pa0, bf16x8 pa1, bf16x8 pa2, bf16x8 pa3) {
  pv_one<0>(o[0], vb, pa0, pa1, pa2, pa3); pv_one<1>(o[1], vb, pa0, pa1, pa2, pa3); pv_one<2>(o[2], vb, pa0, pa1, pa2, pa3); pv_one<3>(o[3], vb, pa0, pa1, pa2, pa3);
}
__device__ __forceinline__ void attn_unit(const bf16_t* __restrict__ Qg, const bf16_t* __restrict__ Kg, const bf16_t* __restrict__ Vg, bf16_t* __restrict__ Og,
                                          int qrow0, int kv0, int nkeys, int h, float lam, float lam_init, const float* __restrict__ subg, LAS char* lds, const int g_wv) {
  const int tid = otid(), wid = tid >> 6, lane = tid & 63, r32 = lane & 31, hi = lane >> 5, map = wid >> 2, wq = wid & 3;
  LAS char* V_lds = lds; LAS char* K_lds = lds + 2 * ATT_SHM_V;
  LAS float* wsf = (LAS float*)(lds + 2 * ATT_SHM_V + 2 * ATT_SHM_K) + wid * 64; LAS float* li_l = wsf; LAS float* al_l = wsf + 32;
  float m_reg = -1e30f, l_reg = 0; f32x16 o[4] = {}; bf16x8 qr[4];
  const bf16_t* Qw = Qg + (size_t)(qrow0 + wq * 32 + r32) * 1024 + h * 128 + map * 64 + hi * 8;
#pragma unroll
  for (int d0 = 0; d0 < 4; ++d0) qr[d0] = *(const bf16x8*)(Qw + d0 * 16);
  const bf16_t* Kh = Kg + (size_t)kv0 * 1024 + h * 128; const bf16_t* Vh = Vg + (size_t)kv0 * 1024 + h * 128;
  const int sr = tid >> 4, sc = (tid & 15) * 8, vst0 = v_st(sr, sc), vst1 = v_st(32 + sr, sc);
  const int vb0 = (int)(uintptr_t)V_lds + v_rd_base(lane);
  const int mapcolB = map * 128;
  struct { bf16x8 vs0, vs1, ks0, ks1; } sr_[1];
#define SLOAD(i, k0) do { sr_[i].vs0 = *(const bf16x8*)(&Vh[(size_t)((k0) + sr) * 1024 + sc]); sr_[i].vs1 = *(const bf16x8*)(&Vh[(size_t)((k0) + 32 + sr) * 1024 + sc]); \
    sr_[i].ks0 = *(const bf16x8*)(&Kh[(size_t)((k0) + sr) * 1024 + sc]); sr_[i].ks1 = *(const bf16x8*)(&Kh[(size_t)((k0) + 32 + sr) * 1024 + sc]); } while (0)
#define SWRITE(b, i) do { *(LAS bf16x8*)(V_lds + (b) * ATT_SHM_V + vst0) = sr_[i].vs0;          \
    *(LAS bf16x8*)(V_lds + (b) * ATT_SHM_V + vst1) = sr_[i].vs1; const int kc = sc * 2;               \
    *(LAS bf16x8*)(K_lds + (b) * ATT_SHM_K + KSWZ(sr, kc)) = sr_[i].ks0;                       \
    *(LAS bf16x8*)(K_lds + (b) * ATT_SHM_K + KSWZ(32 + sr, kc)) = sr_[i].ks1; } while (0)
#define SWAIT() asm volatile("s_waitcnt vmcnt(0)" ::: "memory")
#define RESC(a) do { if (__any((a) < 1.f)) { if (hi == 0) al_l[r32] = (a); asm volatile("s_waitcnt lgkmcnt(0)" ::: "memory"); \
    _Pragma("unroll") for (int d = 0; d < 4; ++d) _Pragma("unroll") for (int r = 0; r < 16; ++r) o[d][r] *= al_l[crow(r, hi)]; } } while (0)
  f32x16 pA0, pA1, pB0, pB1; float mnA, mnB, alA, alB; bf16x8 pa0, pa1, pa2, pa3; const int NT = nkeys / 64;
  constexpr int SE = 0, SO = 0;
  SLOAD(SE, 0); asm volatile("s_waitcnt vmcnt(0)" ::: "memory"); SWRITE(0, SE); __syncthreads();
  qkt(pA0, pA1, K_lds, qr, mapcolB, r32, hi); partialSM(pA0, pA1, m_reg, mnA, alA);
  SLOAD(SO, 64);
  SWAIT(); SWRITE(1, SO); __syncthreads();
  for (int j = 1; j + 1 < NT; j += 2) {
    SBAR(); qkt(pB0, pB1, K_lds + ATT_SHM_K, qr, mapcolB, r32, hi);
    finishSM(pA0, pA1, alA, l_reg, pa0, pa1, pa2, pa3); SBAR();
    SLOAD(SE, (j + 1) * 64); SBAR();
    pv_d0(o, vb0, pa0, pa1, pa2, pa3); partialSM(pB0, pB1, m_reg, mnB, alB);
    __syncthreads(); SWAIT(); SWRITE(0, SE);
    RESC(alB); __syncthreads();
    SBAR(); qkt(pA0, pA1, K_lds, qr, mapcolB, r32, hi);
    finishSM(pB0, pB1, alB, l_reg, pa0, pa1, pa2, pa3); SBAR();
    SLOAD(SO, (j + 2) * 64); SBAR();
    pv_d0(o, vb0 + ATT_SHM_V, pa0, pa1, pa2, pa3); partialSM(pA0, pA1, m_reg, mnA, alA);
    __syncthreads(); SWAIT(); SWRITE(1, SO);
    RESC(alA); __syncthreads();
  }
  SBAR(); qkt(pB0, pB1, K_lds + ATT_SHM_K, qr, mapcolB, r32, hi);
  finishSM(pA0, pA1, alA, l_reg, pa0, pa1, pa2, pa3); SBAR();
  pv_d0(o, vb0, pa0, pa1, pa2, pa3); partialSM(pB0, pB1, m_reg, mnB, alB);
  __syncthreads(); RESC(alB);
  finishSM(pB0, pB1, alB, l_reg, pa0, pa1, pa2, pa3); SBAR();
  pv_d0(o, vb0 + ATT_SHM_V, pa0, pa1, pa2, pa3);
  if (hi == 0) li_l[r32] = l_reg; asm volatile("s_waitcnt lgkmcnt(0)" ::: "memory");
  float rli[16]; const float fac = map ? lam : 1.f;
#pragma unroll
  for (int r = 0; r < 16; ++r) rli[r] = fac * __builtin_amdgcn_rcpf(li_l[crow(r, hi)]);
  __syncthreads();
  LAS float* stg = (LAS float*)lds + wid * (32 * 128);
#pragma unroll
  for (int r = 0; r < 16; ++r)
#pragma unroll
    for (int d0 = 0; d0 < 4; ++d0) stg[crow(r, hi) * 128 + d0 * 32 + r32] = o[d0][r] * rli[r];
  __syncthreads();
  {
    const int qi = 16 * map + (lane >> 2), qt = lane & 3;
    const LAS float* pa = (const LAS float*)lds + wq * (32 * 128) + qi * 128 + qt * 32;
    const LAS float* pb = (const LAS float*)lds + (4 + wq) * (32 * 128) + qi * 128 + qt * 32;
    float v[32]; float ss = 0.f;
#pragma unroll
    for (int k = 0; k < 8; ++k) { const f32x4 a = *(const LAS f32x4*)(pa + 4 * k), b = *(const LAS f32x4*)(pb + 4 * k);
#pragma unroll
      for (int j = 0; j < 4; ++j) { const float x = a[j] - b[j]; v[4 * k + j] = x; ss += x * x; } }
    ss += dpp_f<0xB1, 0xF>(ss); ss += dpp_f<0x4E, 0xF>(ss);
    const float rn = __builtin_amdgcn_rsqf(ss * (1.f / 128.f) + 1e-5f) * (1.f - lam_init);
    bf16_t* op = Og + (size_t)(qrow0 + wq * 32 + qi) * 1024 + h * 128 + qt * 32; const float* gp = subg + qt * 32;
#pragma unroll
    for (int k = 0; k < 4; ++k) { f32x4 a, b;
#pragma unroll
      for (int j = 0; j < 4; ++j) { a[j] = v[8 * k + j] * rn * gp[8 * k + j]; b[j] = v[8 * k + 4 + j] * rn * gp[8 * k + 4 + j]; }
      *(u32x4*)(op + 8 * k) = pack8(a, b); }
  }
  __syncthreads();
#undef SLOAD
#undef SWRITE
#undef SWAIT
#undef RESC
}
__device__ __forceinline__ void attn_phase(KP p, int l, LAS char* lds, const int g_wv) {
  const int tid = otid(), lane = tid & 63; const bool last = (l == DEPTH - 1);
  float s1 = p.in.lam_q1[l * 64 + lane] * p.in.lam_k1[l * 64 + lane], s2 = p.in.lam_q2[l * 64 + lane] * p.in.lam_k2[l * 64 + lane];
  s1 = wave_sum_u(s1); s2 = wave_sum_u(s2);
  const float lam_init = 0.8f - 0.6f * expf(-0.3f * (float)l); const float lam = expf(s1) - expf(s2) + lam_init;
  const int c = obid(), x = c & 7, jl = c >> 3, per = ogd() >> 3;
  const int nloc = last ? 128 : 144;
  for (int q = jl; q < nloc; q += per) {
    int qrow0, nkeys, h;
    if (q < 128) { h = q >> 4; qrow0 = x * SEQ + (q & 15) * 128; nkeys = KVB; }
    else { const int qq = q - 128; h = qq >> 1; qrow0 = NLAT + x * CTX + (qq & 1) * 128; nkeys = CTX; }
    attn_unit(p.Qb, p.Kc, p.Vc, p.ATTb, qrow0, x * KVB, nkeys, h, lam, lam_init, p.in.subln_g + l * 128, lds, g_wv);
  }
}

__device__ __forceinline__ float wave_sum(float v) { return wave_sum_u(v); }
__device__ __forceinline__ void row_ld(const float* p, int lane, f32x4 (&v)[4]) {
#pragma unroll
  for (int i = 0; i < 4; ++i) v[i] = *(const f32x4*)(p + 4 * lane + 256 * i); }
__device__ __forceinline__ void row_st(float* p, int lane, const f32x4 (&v)[4]) {
#pragma unroll
  for (int i = 0; i < 4; ++i) *(f32x4*)(p + 4 * lane + 256 * i) = v[i]; }
__device__ __forceinline__ void row_st_bf16(bf16_t* p, int lane, const f32x4 (&v)[4]) {
#pragma unroll
  for (int i = 0; i < 4; ++i) { u32x2 w; w.x = cvt_pk_bf16(v[i][0], v[i][1]); w.y = cvt_pk_bf16(v[i][2], v[i][3]); *(u32x2*)(p + 4 * lane + 256 * i) = w; } }
__device__ __forceinline__ void row_ld_bf16(const bf16_t* p, int lane, f32x4 (&v)[4]) {
#pragma unroll
  for (int i = 0; i < 4; ++i) { const u32x2 w = *(const u32x2*)(p + 4 * lane + 256 * i); v[i] = (f32x4){bflo(w.x), bfhi(w.x), bflo(w.y), bfhi(w.y)}; } }
__device__ __forceinline__ void row_ln(f32x4 (&v)[4], const float* g, const float* b, int lane) {
  float s = 0.f;
#pragma unroll
  for (int i = 0; i < 4; ++i) s += (v[i][0] + v[i][1]) + (v[i][2] + v[i][3]);
  const float mean = wave_sum(s) * (1.f / 1024.f); float q = 0.f;
#pragma unroll
  for (int i = 0; i < 4; ++i) { v[i] -= mean; q += (v[i][0] * v[i][0] + v[i][1] * v[i][1]) + (v[i][2] * v[i][2] + v[i][3] * v[i][3]); }
  const float rs = __builtin_amdgcn_rsqf(wave_sum(q) * (1.f / 1024.f) + 1e-5f);
#pragma unroll
  for (int i = 0; i < 4; ++i) { const f32x4 gg = *(const f32x4*)(g + 4 * lane + 256 * i), bb = *(const f32x4*)(b + 4 * lane + 256 * i); v[i] = v[i] * rs * gg + bb; }
}
__device__ __forceinline__ void row_mod(f32x4 (&h)[4], const f32x4 (&v)[4], const float* modrow, int shift_idx, int scale_idx, int lane) {
#pragma unroll
  for (int i = 0; i < 4; ++i) { const f32x4 sc = *(const f32x4*)(modrow + scale_idx * 1024 + 4 * lane + 256 * i), sh = *(const f32x4*)(modrow + shift_idx * 1024 + 4 * lane + 256 * i); h[i] = v[i] * (1.f + sc) + sh; }
}
__device__ __forceinline__ int modrow_of_row(int r) { return r < NLAT ? (r >> 11) : 8; }

__device__ __forceinline__ void h0_phase(KP p, const int g_wv) {
  const int tid = otid(); const int lane = tid & 63, gw = obid() * 8 + (tid >> 6), nw = ogd() * 8;
  for (int r = gw; r < NR; r += nw) {
    const float* src = r < NLAT ? p.in.x + (size_t)r * D : p.in.ctx + (size_t)(r - NLAT) * D;
    f32x4 v[4], h[4]; row_ld(src, lane, v); row_mod(h, v, p.MOD + (size_t)modrow_of_row(r) * 6144, 0, 1, lane); row_st_bf16(p.Hb + (size_t)r * D, lane, h); }
}
constexpr int LN1_OFF_LCNT = 36 * 1024 * 4, LN1_OFF_LBASE = LN1_OFF_LCNT + 128, LN1_OFF_ENT = LN1_OFF_LBASE + 128, LN1_END = LN1_OFF_ENT + 72 * 16;
__device__ __forceinline__ void ln1_phase(KP p, int l, LAS char* lds, const int g_wv) {
  const int tid = otid(), lane = tid & 63, wid = tid >> 6, gw = obid() * 8 + wid; const bool last = (l == DEPTH - 1);
  LAS float* W = (LAS float*)lds;
  LAS int* lcnt = (LAS int*)(lds + LN1_OFF_LCNT); LAS int* lbase = (LAS int*)(lds + LN1_OFF_LBASE); LAS int* ent = (LAS int*)(lds + LN1_OFF_ENT);
  for (int i = tid; i < 36 * 256; i += 512) *(LAS f32x4*)(W + 4 * i) = *(const f32x4*)(p.WR + 4 * i);
  if (tid < 32) lcnt[tid] = 0;
  __syncthreads();
  const float* MODl = p.MOD + (size_t)l * 9 * 6144;
  const int nrow = last ? NLAT : NR, ni = nrow / 2048;
#pragma unroll 1
  for (int i0 = 0; i0 < ni; i0 += 3) {
    f32x4 h[3][4];
#pragma unroll
    for (int j = 0; j < 3; ++j) { const int r = gw + 2048 * (i0 + j);
      if (i0 + j < ni) { f32x4 v[4]; row_ld(p.XL + (size_t)r * D, lane, v); row_ln(v, p.in.ln1_g + l * D, p.in.ln1_b + l * D, lane); row_st(p.XL + (size_t)r * D, lane, v);
        row_mod(h[j], v, MODl + (size_t)modrow_of_row(r) * 6144, 3, 4, lane); row_st_bf16(p.H2b + (size_t)r * D, lane, h[j]); }
      else {
#pragma unroll
        for (int q = 0; q < 4; ++q) h[j][q] = (f32x4){0.f, 0.f, 0.f, 0.f}; } }
    float lg[3][36];
#pragma unroll
    for (int e = 0; e < 36; ++e) { float s0 = 0.f, s1 = 0.f, s2 = 0.f;
#pragma unroll
      for (int q = 0; q < 4; ++q) { const f32x4 w = *(const LAS f32x4*)(W + e * 1024 + 4 * lane + 256 * q);
        s0 += (h[0][q][0] * w[0] + h[0][q][1] * w[1]) + (h[0][q][2] * w[2] + h[0][q][3] * w[3]);
        s1 += (h[1][q][0] * w[0] + h[1][q][1] * w[1]) + (h[1][q][2] * w[2] + h[1][q][3] * w[3]);
        s2 += (h[2][q][0] * w[0] + h[2][q][1] * w[1]) + (h[2][q][2] * w[2] + h[2][q][3] * w[3]); }
      const float bias = e < 4 ? p.in.rg_b[l * 4 + e] : p.in.re_b[l * 32 + e - 4];
      lg[0][e] = wave_sum_u(s0) + bias; lg[1][e] = wave_sum_u(s1) + bias; lg[2][e] = wave_sum_u(s2) + bias; }
#pragma unroll
    for (int j = 0; j < 3; ++j) { if (i0 + j < ni) { const int r = gw + 2048 * (i0 + j);
      int gi = 0; float gm = lg[j][0];
#pragma unroll
      for (int q = 1; q < 4; ++q) if (lg[j][q] > gm) { gm = lg[j][q]; gi = q; }
      float gs = 0.f;
#pragma unroll
      for (int q = 0; q < 4; ++q) gs += expf(lg[j][q] - gm);
      const float gtop = 1.f / gs; float el[8];
#pragma unroll
      for (int q = 0; q < 8; ++q) el[q] = gi == 0 ? lg[j][4 + q] : gi == 1 ? lg[j][12 + q] : gi == 2 ? lg[j][20 + q] : lg[j][28 + q];
      int i0e = 0; float v0 = el[0];
#pragma unroll
      for (int q = 1; q < 8; ++q) if (el[q] > v0) { v0 = el[q]; i0e = q; }
      int i1e = -1; float v1 = -3.0e38f;
#pragma unroll
      for (int q = 0; q < 8; ++q) if (q != i0e && el[q] > v1) { v1 = el[q]; i1e = q; }
      const float e1 = expf(v1 - v0); const float w0 = gtop / (1.f + e1), w1 = gtop * e1 / (1.f + e1);
      const int e0i = gi * 8 + i0e, e1i = gi * 8 + i1e;
      if (lane == 0) { const int lr0 = __hip_atomic_fetch_add(&lcnt[e0i], 1, __ATOMIC_RELAXED, __HIP_MEMORY_SCOPE_WORKGROUP); const int lr1 = __hip_atomic_fetch_add(&lcnt[e1i], 1, __ATOMIC_RELAXED, __HIP_MEMORY_SCOPE_WORKGROUP);
        { LAS int* ep = ent + ((i0 + j) * 8 + wid) * 4; ep[0] = e0i; ep[1] = e1i; ep[2] = lr0; ep[3] = lr1; } *(float2*)(p.RW + (size_t)r * 2) = make_float2(w0, w1); } } }
  }
  __syncthreads();
  if (tid < 32) lbase[tid] = (int)atomicAdd(p.ctl + l * CTL_WORDS + CTL_CNT + 64 * tid, (unsigned)lcnt[tid]);
  __syncthreads();
  if (tid < ni * 8) { const int i = tid >> 3, w = tid & 7; const int r = obid() * 8 + w + 2048 * i; const LAS int* ep = ent + tid * 4; const int4 en = make_int4(ep[0], ep[1], ep[2], ep[3]); const int g0 = lbase[en.x] + en.z, g1 = lbase[en.y] + en.w;
    p.TOK[(size_t)en.x * NR + g0] = r; p.TOK[(size_t)en.y * NR + g1] = r; *(int4*)(p.ROUTE + (size_t)r * 4) = make_int4(en.x, en.y, g0, g1); }
}
__device__ __forceinline__ void moe_table(KP p, int l, LAS MoeTab* tab, const int g_wv) {
  if (otid() == 0) { int t = 0; for (int e = 0; e < 32; ++e) { const int c = (int)__hip_atomic_load(p.ctl + l * CTL_WORDS + CTL_CNT + 64 * e, __ATOMIC_RELAXED, __HIP_MEMORY_SCOPE_AGENT); tab->cnt[e] = c; tab->tbase[e] = t;
      const int n = (c + 255) >> 8; for (int i = 0; i < n; ++i) { tab->tileE[t] = e; tab->tileR0[t] = i * 256; ++t; } } tab->tbase[32] = t; tab->ntiles = t; }
  __syncthreads();
}
__device__ __forceinline__ void ln2_phase(KP p, int l, LAS char* lds, const int g_wv) {
  const int tid = otid(), lane = tid & 63, wid = tid >> 6, gw = obid() * 8 + wid; const bool last = (l == DEPTH - 1);
  LAS MoeTab* tab = (LAS MoeTab*)lds; moe_table(p, l, tab, g_wv);
  const float* MODl = p.MOD + (size_t)l * 9 * 6144; const int nrow = last ? NLAT : NR;
  for (int r = gw; r < nrow; r += 2048) {
    const int4 rt = *(const int4*)(p.ROUTE + (size_t)r * 4); const float2 w = *(const float2*)(p.RW + (size_t)r * 2);
    const int pos0 = (tab->tbase[rt.x] + (rt.z >> 8)) * 256 + (rt.z & 255), pos1 = (tab->tbase[rt.y] + (rt.w >> 8)) * 256 + (rt.w & 255);
    f32x4 v[4], y0[4], y1[4]; row_ld(p.XL + (size_t)r * D, lane, v); row_ld_bf16(p.Yo + (size_t)pos0 * D, lane, y0); row_ld_bf16(p.Yo + (size_t)pos1 * D, lane, y1);
    const float* mr = MODl + (size_t)modrow_of_row(r) * 6144;
#pragma unroll
    for (int i = 0; i < 4; ++i) { const f32x4 g2 = *(const f32x4*)(mr + 5 * 1024 + 4 * lane + 256 * i); v[i] = v[i] * ALPHA + g2 * (y0[i] * w.x + y1[i] * w.y); }
    row_ln(v, p.in.ln2_g + l * D, p.in.ln2_b + l * D, lane);
    if (!last) { row_st(p.XL + (size_t)r * D, lane, v); f32x4 h[4]; row_mod(h, v, p.MOD + ((size_t)(l + 1) * 9 + modrow_of_row(r)) * 6144, 0, 1, lane); row_st_bf16(p.Hb + (size_t)r * D, lane, h); }
    else row_st(p.out + (size_t)r * D, lane, v);
  }
}
__device__ __forceinline__ void s2_phase(KP p, const int g_wv) {
  const int tid = otid(); if (tid >= 128) return;
  const int g = obid() >> 3, b = obid() & 7, dir = tid >> 6, pp = tid & 63;
  const f32x2 aL = *(const f32x2*)(p.SAL + ((size_t)(g * 2 + dir) * 64 + pp) * 2);
  const float* S = p.SST + (size_t)g * NCHP * 256 + dir * 128 + 2 * pp; bf16_t* A = p.Ug + (size_t)g * NCHP * 768 + 512 + dir * 128 + 2 * pp;
  float hr = 0.f, hi = 0.f;
#pragma unroll 1
  for (int s0 = 0; s0 < 72; s0 += 24) {
    f32x2 sv[24];
#pragma unroll
    for (int k = 0; k < 24; ++k) { const int s = s0 + k; int row; if (dir == 0) row = s < 8 ? 512 + b * 8 + s : b * 64 + (s - 8); else row = s < 8 ? 512 + b * 8 + (7 - s) : b * 64 + (63 - (s - 8));
      sv[k] = *(const f32x2*)(S + (size_t)row * 256); }
#pragma unroll
    for (int k = 0; k < 24; ++k) { const int s = s0 + k; int row; if (dir == 0) row = s < 8 ? 512 + b * 8 + s : b * 64 + (s - 8); else row = s < 8 ? 512 + b * 8 + (7 - s) : b * 64 + (63 - (s - 8));
      *(unsigned*)(A + (size_t)row * 768) = cvt_pk_bf16(hr, hi);
      const float nr = aL.x * hr - aL.y * hi + sv[k].x, ni = aL.x * hi + aL.y * hr + sv[k].y; hr = nr; hi = ni; }
  }
}

struct ConvJob { const float* src; const float* src2; bf16_t* dst; int ldd, lds_, kind, nK; };
__device__ __forceinline__ void conv_step(const ConvJob& j, int nt, int kt, int lane) {
  const int q = lane & 15, kq = lane >> 4; const int n = nt * 64 + 4 * q, k0 = kt * 64 + kq * 8; const float* s = j.src; int col;
  if (j.kind == 0) col = (n & ~31) + perm32(n & 31);
  else if (j.kind == 1) { const int pn = n >> 8; if (pn < 4 || (pn >= 10 && pn < 14)) col = n; else if (pn < 10) col = (n & ~31) + perm32(n & 31);
    else { const int bj = (n >> 7) & 1, w = n & 127; col = (bj ? 4608 : 3584) + (pn - 14) * 128 + (w & ~31) + perm32(w & 31); } }
  else { const int bj = (n >> 7) & 1, w = n & 127; col = (n >> 8) * 128 + (w & ~31) + perm32(w & 31); if (bj) s = j.src2; }
  const float* sp = s + (size_t)k0 * j.lds_ + col; f32x4 v[16];
#pragma unroll
  for (int i = 0; i < 8; ++i) { v[i] = *(const f32x4*)(sp + (size_t)i * j.lds_); v[8 + i] = *(const f32x4*)(sp + (size_t)(32 + i) * j.lds_); }
  bf16_t* dp = j.dst + (size_t)n * j.ldd + k0;
#pragma unroll
  for (int r = 0; r < 4; ++r) {
    *(u32x4*)(dp + (size_t)r * j.ldd) = pack8((f32x4){v[0][r], v[1][r], v[2][r], v[3][r]}, (f32x4){v[4][r], v[5][r], v[6][r], v[7][r]});
    *(u32x4*)(dp + (size_t)r * j.ldd + 32) = pack8((f32x4){v[8][r], v[9][r], v[10][r], v[11][r]}, (f32x4){v[12][r], v[13][r], v[14][r], v[15][r]}); }
}
__device__ __forceinline__ void ssm_mats(KP p, int l, int g, int hf, LAS char* lds, const int g_wv) {
  const int tid = otid();
  LAS f32x2* AP = (LAS f32x2*)lds;
  LAS f32x2* BB = AP + 2 * 64 * 34;
  LAS f32x2* CC = BB + 2 * 64 * 16;
  LAS float* KT = (LAS float*)(CC + 2 * 16 * 64);
  const size_t so = (size_t)l * 2 * NG * NP;
  if (tid < 128) { const int dir = tid >> 6, pp = tid & 63; const size_t gp = so + ((size_t)dir * NG + g) * NP + pp;
    const float dtf = expf(p.in.log_dt[(size_t)l * 2 * NG + dir * NG + g]); const double are = p.in.a_re[gp], aim = p.in.a_im[gp], dt = (double)dtf;
    double ang = aim * dt; ang -= 6.283185307179586476925 * (double)(long long)(ang * 0.15915494309189533577 + (ang >= 0 ? 0.5 : -0.5));
    const float e1f = expf((float)(are * dt)), angf = (float)ang; const double c1r = (double)(e1f * cosf(angf)), c1i = (double)(e1f * sinf(angf));
    { float onef = 1.f; asm volatile("" : "+v"(onef)); double cr = (double)onef, ci = 0.0;
      for (int t = 0; t < 34; ++t) { AP[(dir * 64 + pp) * 34 + t] = (f32x2){(float)cr, (float)ci}; if (t == 32 && hf == 0) *(f32x2*)(p.SAL + ((size_t)(g * 2 + dir) * 64 + pp) * 2) = (f32x2){(float)cr, (float)ci}; const double nr2 = cr * c1r - ci * c1i, ni2 = cr * c1i + ci * c1r; cr = nr2; ci = ni2; } }
    const float sh = sinf(0.5f * angf); const double nr = (double)(expm1f((float)(are * dt)) * cosf(angf) - 2.f * sh * sh), ni = c1i, den = are * are + aim * aim; const double fr = (nr * are + ni * aim) / den, fi = (ni * are - nr * aim) / den;
    for (int c = 0; c < 16; ++c) { const double br = p.in.b_re[gp * 16 + c], bi = p.in.b_im[gp * 16 + c]; BB[(dir * 64 + pp) * 16 + c] = (f32x2){(float)(fr * br - fi * bi), (float)(fr * bi + fi * br)}; }
  }
  for (int i = tid; i < 2 * 16 * 64; i += 512) { const int dir = i >> 10, c = (i >> 6) & 15, pp = i & 63; const size_t ci = (so + ((size_t)dir * NG + g) * NP) * 16 + (size_t)c * NP + pp; CC[i] = (f32x2){p.in.c_re[ci], p.in.c_im[ci]}; }
  __syncthreads();
  { const int dir = tid >> 8, co = (tid >> 4) & 15, ci = tid & 15; float acc[32];
#pragma unroll
    for (int t = 0; t < 32; ++t) acc[t] = 0.f;
    for (int pp = 0; pp < 64; ++pp) { const f32x2 c = CC[(dir * 16 + co) * 64 + pp], bq = BB[(dir * 64 + pp) * 16 + ci]; const float cbr = c.x * bq.x - c.y * bq.y, cbi = c.x * bq.y + c.y * bq.x;
      const LAS f32x4* ap = (const LAS f32x4*)(AP + (dir * 64 + pp) * 34);
#pragma unroll
      for (int t2 = 0; t2 < 16; ++t2) { const f32x4 a = ap[t2]; acc[2 * t2] += cbr * a[0] - cbi * a[1]; acc[2 * t2 + 1] += cbr * a[2] - cbi * a[3]; } }
#pragma unroll
    for (int t = 0; t < 32; ++t) KT[((dir * 32 + t) * 16 + co) * 16 + ci] = acc[t]; }
  __syncthreads();
  bf16_t* Sm = p.Smat + (size_t)g * 256 * 768;
  for (int i = tid; i < 128 * 64; i += 512) { const int n = hf * 128 + (i >> 6), k8 = (i & 63) * 8; const int Lc = (n & ~31) + perm32(n & 31); const int dir = Lc >> 7, pp = (Lc & 127) >> 1, ri = Lc & 1; const int t = k8 >> 4, c0 = k8 & 15;
    const f32x2 a = AP[(dir * 64 + pp) * 34 + (dir == 0 ? 31 - t : t)]; float v[8];
#pragma unroll
    for (int q = 0; q < 8; ++q) { const f32x2 bq = BB[(dir * 64 + pp) * 16 + c0 + q]; v[q] = ri == 0 ? a.x * bq.x - a.y * bq.y : a.x * bq.y + a.y * bq.x; }
    *(u32x4*)(Sm + (size_t)n * 768 + k8) = pack8((f32x4){v[0], v[1], v[2], v[3]}, (f32x4){v[4], v[5], v[6], v[7]}); }
  bf16_t* To = p.TO + (size_t)g * 512 * 768; const float* dsk = p.in.ssm_d + l * SSMW + g * 16;
  for (int i = tid; i < 256 * 96; i += 512) { const int n = hf * 256 + i / 96, k8 = (i % 96) * 8; const int Lc = (n & ~31) + perm32(n & 31); const int t = Lc >> 4, co = Lc & 15; f32x4 v0, v1;
    if (k8 < 512) { const int s = k8 >> 4, c0 = k8 & 15; const float mf = s <= t ? 1.f : 0.f, mr = s >= t ? 1.f : 0.f; const int tf = s <= t ? t - s : 0, tr = s >= t ? s - t : 0;
      const LAS f32x4* kf = (const LAS f32x4*)(KT + ((0 * 32 + tf) * 16 + co) * 16 + c0); const LAS f32x4* kr = (const LAS f32x4*)(KT + ((1 * 32 + tr) * 16 + co) * 16 + c0);
      v0 = kf[0] * mf + kr[0] * mr; v1 = kf[1] * mf + kr[1] * mr;
      if (s == t) { const float dv = dsk[co]; const int qd = co - c0;
#pragma unroll
        for (int q = 0; q < 4; ++q) { if (qd == q) v0[q] += dv; if (qd == 4 + q) v1[q] += dv; } } }
    else { const int hc0 = k8 - 512; const int dir = hc0 >> 7, pp0 = (hc0 & 127) >> 1; float v[8];
#pragma unroll
      for (int q = 0; q < 4; ++q) { const f32x2 a = AP[(dir * 64 + pp0 + q) * 34 + (dir == 0 ? t + 1 : 32 - t)], c = CC[(dir * 16 + co) * 64 + pp0 + q];
        v[2 * q] = c.x * a.x - c.y * a.y; v[2 * q + 1] = -(c.x * a.y + c.y * a.x); }
      v0 = (f32x4){v[0], v[1], v[2], v[3]}; v1 = (f32x4){v[4], v[5], v[6], v[7]}; }
    *(u32x4*)(To + (size_t)n * 768 + k8) = pack8(v0, v1); }
  __syncthreads();
}
__device__ __forceinline__ void mod_item(KP p, int l, int j0, LAS char* lds, const int g_wv) {
  const int tid = otid(); LAS float* sl = (LAS float*)lds;
  LAS float* part = sl + 9 * 1024;
  for (int i = tid; i < 9 * 1024; i += 512) { const int r = i >> 10, k = i & 1023; const float v = r < 8 ? p.in.c[r * 1024 + k] : p.in.c_ctx[k]; sl[i] = v / (1.f + expf(-v)); }
  __syncthreads();
  const int jj = tid & 63, ks = tid >> 6; float acc[9];
#pragma unroll
  for (int r = 0; r < 9; ++r) acc[r] = 0.f;
  const float* w = p.in.w_mod + (size_t)l * 1024 * 6144 + j0 + jj;
  for (int k = ks * 128; k < ks * 128 + 128; ++k) { const float wv = w[(size_t)k * 6144];
#pragma unroll
    for (int r = 0; r < 9; ++r) acc[r] += sl[r * 1024 + k] * wv; }
#pragma unroll
  for (int r = 0; r < 9; ++r) part[(ks * 9 + r) * 64 + jj] = acc[r];
  __syncthreads();
  for (int i = tid; i < 9 * 64; i += 512) { const int r = i >> 6, j = i & 63; float s = 0.f;
#pragma unroll
    for (int k = 0; k < 8; ++k) s += part[(k * 9 + r) * 64 + j];
    p.MOD[((size_t)l * 9 + r) * 6144 + j0 + j] = s + p.in.b_mod[l * 6144 + j0 + j]; }
  __syncthreads();
}
__device__ __forceinline__ void conv_phase(KP p, int l, LAS char* lds, const int g_wv) {
  const int tid = otid(); const int b = obid();
  constexpr int NSB = 2 * NG;
  if (b < NSB) {
    if (b == 0) { for (int q = tid; q < 36 * 1024; q += 512) { const int e = q >> 10, k = q & 1023; p.WR[q] = e < 4 ? p.in.rg_w[((size_t)l * 1024 + k) * 4 + e] : p.in.re_w[((size_t)l * 1024 + k) * 32 + (e - 4)]; } }
    if (b == 1 && l == 0) { for (int q = tid; q < 2048 * 32; q += 512) { const int t = q >> 5, axis = (q >> 4) & 1, f = q & 15; const float pos = axis == 0 ? (float)(t >> 6) : (float)(t & 63);
        const float inv = 1.0f / powf(10000.0f, (float)(2 * f) / 32.0f); const float ang = pos * inv; p.ROPE[((size_t)t * 2 + axis) * 32 + f] = cosf(ang); p.ROPE[((size_t)t * 2 + axis) * 32 + 16 + f] = sinf(ang); } }
    ssm_mats(p, l, b >> 1, b & 1, lds, g_wv);
    return;
  }
  const int nconv = ogd() - NSB;
  if (l == 0) { for (int it = b - NSB; it < 4 * 96; it += nconv) mod_item(p, it / 96, (it % 96) * 64, lds, g_wv); }
  const int lane = tid & 63, gw = (b - NSB) * 8 + (tid >> 6), nw = nconv * 8;
  for (int t0 = gw; t0 < 14400; t0 += nw) { int t = t0; ConvJob j; int nK;
    if (t < 1408) { j.src = p.in.w_in + (size_t)l * 1024 * INW; j.src2 = nullptr; j.dst = p.Win; j.ldd = 1024; j.lds_ = INW; j.kind = 1; nK = 16; }
    else if ((t -= 1408) < 64) { j.src = p.in.w_glu + (size_t)l * 512 * 512; j.src2 = nullptr; j.dst = p.Wglu; j.ldd = 512; j.lds_ = 512; j.kind = 0; nK = 8; }
    else if ((t -= 64) < 256) { j.src = p.in.w_pa + (size_t)l * 1024 * 1024; j.src2 = nullptr; j.dst = p.Wpa; j.ldd = 1024; j.lds_ = 1024; j.kind = 0; nK = 16; }
    else if ((t -= 256) < 128) { j.src = p.in.w_ps + (size_t)l * 512 * 1024; j.src2 = nullptr; j.dst = p.Wps; j.ldd = 1024; j.lds_ = 1024; j.kind = 0; nK = 8; }
    else if ((t -= 128) < 256) { j.src = p.in.w_o + (size_t)l * 1024 * 1024; j.src2 = nullptr; j.dst = p.Wo; j.ldd = 1024; j.lds_ = 1024; j.kind = 0; nK = 16; }
    else if ((t -= 256) < 8192) { const int e = t >> 8; t &= 255; j.src = p.in.w1 + ((size_t)l * NE + e) * 1024 * 512; j.src2 = p.in.w3 + ((size_t)l * NE + e) * 1024 * 512; j.dst = p.W13 + (size_t)e * 1024 * 1024; j.ldd = 1024; j.lds_ = 512; j.kind = 2; nK = 16; }
    else { t -= 8192; const int e = t >> 7; t &= 127; j.src = p.in.w2 + ((size_t)l * NE + e) * 512 * 1024; j.src2 = nullptr; j.dst = p.W2 + (size_t)e * 1024 * 512; j.ldd = 512; j.lds_ = 1024; j.kind = 0; nK = 8; }
    conv_step(j, t / nK, t % nK, lane); }
}
}
namespace fk {
constexpr int LDS_BYTES = 149504;
#ifndef PROBE_MASK
#define PROBE_MASK 0
#endif
constexpr int NPH = 14;
enum { PH_CONV = 0, PH_H0, PH_GEMM1, PH_S1, PH_S2, PH_S3, PH_ATT, PH_GLU, PH_MERGE, PH_WO, PH_LN1, PH_MOE1, PH_MOE2, PH_LN2 };

__device__ __forceinline__ void run_phase(KP p, int l, int ph, LAS unsigned char* lds, const int g_wv) {
  const int G = ogd(), c = obid(); const bool last = (l == DEPTH - 1);
  const float* MODl = p.MOD + (size_t)l * 9 * 6144;
  switch (ph) {
    case PH_CONV: conv_phase(p, l, (LAS char*)lds, g_wv); break;
    case PH_H0: if (l == 0) h0_phase(p, g_wv); break;
    case PH_GEMM1: { SchedG1 S{(const char*)p.Hb, (const char*)p.Win, G, c, 0, last ? 1488 : 1536, last};
      EpiIn E{p.ROPE, p.Kc, p.Vc, p.Ug, p.Qb, p.RG, p.GSb}; gemm_stream(lds, 2048, 2048, S, E, g_wv); } break;
    case PH_S1: if (c < 96) { SchedSsm1 S{(const char*)p.Ug, (const char*)p.Smat, 96, c}; EpiState E{p.SST}; gemm_stream(lds, 1536, 1536, S, E, g_wv); }
      else if (!last) { SchedG1 S{(const char*)p.Hb, (const char*)p.Win, G - 96, c - 96, 1536, 1584, false}; EpiIn E{p.ROPE, p.Kc, p.Vc, p.Ug, p.Qb, p.RG, p.GSb}; gemm_stream(lds, 2048, 2048, S, E, g_wv); } break;
    case PH_S2: s2_phase(p, g_wv); break;
    case PH_S3: { SchedSsm3 S{(const char*)p.Ug, (const char*)p.TO, G, c}; EpiSsmOut E{p.YG}; gemm_stream(lds, 1536, 1536, S, E, g_wv); } break;
    case PH_ATT: attn_phase(p, l, (LAS char*)lds, g_wv); break;
    case PH_GLU: { SchedPlain S; S.A = (const char*)p.YG; S.B = (const char*)p.Wglu; S.lda = 1024; S.ldb = 1024; S.nM = NR / 256; S.nN = 2; S.nt = 8; S.G = G; S.c = c; S.nunits = S.nM * 2; S.epi = 1;
      EpiGlu E{p.YG, p.S2, p.in.b_glu + l * SSMW}; gemm_stream(lds, 1024, 1024, S, E, g_wv); } break;
    case PH_MERGE: { SchedMerge S{(const char*)p.ATTb, (const char*)p.Wpa, (const char*)p.S2, (const char*)p.Wps, NR / 256, 4, G, c, (NR / 256) * 4};
      EpiMerge E{p.RG, p.GSb, p.Mb}; gemm_stream(lds, 2048, 2048, S, E, g_wv); } break;
    case PH_WO: { SchedPlain S; S.A = (const char*)p.Mb; S.B = (const char*)p.Wo; S.lda = 2048; S.ldb = 2048; S.nM = last ? NLAT / 256 : NR / 256; S.nN = 4; S.nt = 16; S.G = G; S.c = c; S.nunits = S.nM * 4; S.epi = 1;
      EpiWo E{l == 0 ? p.in.x : p.XL, l == 0 ? p.in.ctx : p.XL + (size_t)NLAT * D, p.XL, MODl}; gemm_stream(lds, 2048, 2048, S, E, g_wv); } break;
    case PH_LN1: ln1_phase(p, l, (LAS char*)lds, g_wv); break;
    case PH_MOE1: { LAS MoeTab* tab = (LAS MoeTab*)(lds + STAGE_BYTES); moe_table(p, l, tab, g_wv);
      SchedMoe S{(const char*)p.H2b, (const char*)p.W13, 2048, 2048, (size_t)1024 * 2048, tab, p.TOK, 4, 16, G, c, true}; EpiMoe1 E{p.Hm}; gemm_stream<EpiMoe1, SchedMoe, true>(lds, 2048, 2048, S, E, g_wv); } break;
    case PH_MOE2: { LAS MoeTab* tab = (LAS MoeTab*)(lds + STAGE_BYTES); moe_table(p, l, tab, g_wv);
      SchedMoe S{(const char*)p.Hm, (const char*)p.W2, 1024, 1024, (size_t)1024 * 1024, tab, p.TOK, 4, 8, G, c, false}; EpiMoe2 E{p.Yo}; gemm_stream(lds, 1024, 1024, S, E, g_wv); } break;
    case PH_LN2: ln2_phase(p, l, (LAS char*)lds, g_wv); break;
  }
}

__global__ void __launch_bounds__(512, 2) mega(Params p) {
  extern __shared__ __attribute__((aligned(16))) unsigned char smem[];
  LAS unsigned char* lds = (LAS unsigned char*)smem;
  LAS unsigned* xbw = (LAS unsigned*)(lds + LDS_BYTES - 16);
  if (threadIdx.x == 0) { xbw[0] = 0u; xbw[1] = 0u; xbw[2] = 0u; xbw[3] = 0u; }
  __syncthreads();
  XcdBarrier bar = xcd_barrier_post(p.bar, (volatile LAS unsigned*)xbw);
  const int ph_lo = p.ph_lo, ph_hi = p.ph_hi; const int g_wv = __builtin_amdgcn_readfirstlane((int)threadIdx.x >> 6);
  for (int l = 0; l < DEPTH; ++l) {
#define PHASE(ID) do { const int gph = l * NPH + (ID); if (gph >= ph_lo && gph < ph_hi && !((ID) == PH_H0 && l > 0)) { \
      const __attribute__((address_space(4))) Params* kp = (const __attribute__((address_space(4))) Params*)__builtin_amdgcn_kernarg_segment_ptr(); int lv = l; int wvp = g_wv; \
      asm volatile("" : "+s"(kp), "+s"(lv), "+s"(wvp));     \
      run_phase(*kp, lv, (ID), lds, wvp); if (gph + 1 < ph_hi) xcd_barrier(bar); } } while (0)
    PHASE(PH_CONV); PHASE(PH_H0); PHASE(PH_GEMM1); PHASE(PH_S1); PHASE(PH_S2); PHASE(PH_S3); PHASE(PH_ATT); PHASE(PH_GLU); PHASE(PH_MERGE); PHASE(PH_WO);
    PHASE(PH_LN1); PHASE(PH_MOE1); PHASE(PH_MOE2); PHASE(PH_LN2);
#undef PHASE
  }
}

struct Host { Params p; size_t ws_used; };
inline size_t al256(size_t x) { return (x + 255) & ~(size_t)255; }
inline Host make_params(void* const* d_in, void* d_out, void* d_ws) {
  Host H; memset(&H, 0, sizeof(H)); Params& p = H.p;
  const float** ip = (const float**)&p.in; for (int i = 0; i < 36; ++i) ip[i] = (const float*)d_in[i];
  p.out = (float*)d_out;
  char* base = (char*)d_ws; size_t off = 0;
  auto take = [&](size_t bytes) { char* r = base + off; off = al256(off + bytes); return r; };
  p.bar = (unsigned*)take(XCD_BAR_WORDS * 4); p.ctl = (unsigned*)take((size_t)DEPTH * CTL_WORDS * 4);
  p.MOD = (float*)take((size_t)DEPTH * 9 * 6144 * 4); p.ROPE = (float*)take((size_t)2048 * 64 * 4);
  p.SAL = (float*)take((size_t)NG * 2 * 64 * 2 * 4); p.WR = (float*)take((size_t)36 * 1024 * 4);
  p.ROUTE = (int*)take((size_t)NR * 4 * 4); p.RW = (float*)take((size_t)NR * 2 * 4); p.TOK = (int*)take((size_t)NE * NR * 4);
  p.XL = (float*)take((size_t)NR * D * 4); p.Hb = (bf16_t*)take((size_t)NR * D * 2); p.H2b = (bf16_t*)take((size_t)NR * D * 2); p.Mb = (bf16_t*)take((size_t)NR * D * 2);
  p.Win = (bf16_t*)take((size_t)INW * 1024 * 2); p.Wglu = (bf16_t*)take((size_t)512 * 512 * 2); p.Wpa = (bf16_t*)take((size_t)1024 * 1024 * 2); p.Wps = (bf16_t*)take((size_t)1024 * 1024 * 2);
  p.Wo = (bf16_t*)take((size_t)1024 * 1024 * 2); p.W13 = (bf16_t*)take((size_t)NE * 1024 * 1024 * 2); p.W2 = (bf16_t*)take((size_t)NE * 1024 * 512 * 2);
  p.Smat = (bf16_t*)take((size_t)NG * 256 * 768 * 2); p.TO = (bf16_t*)take((size_t)NG * 512 * 768 * 2);
  const size_t mix0 = off;
  p.Kc = (bf16_t*)take((size_t)NB * KVB * D * 2); p.Vc = (bf16_t*)take((size_t)NB * KVB * D * 2); p.Qb = (bf16_t*)take((size_t)NR * D * 2);
  p.Ug = (bf16_t*)take((size_t)NG * NCHP * 768 * 2 + 4096); p.RG = (bf16_t*)take((size_t)NR * D * 2); p.GSb = (bf16_t*)take((size_t)NR * D * 2); p.ATTb = (bf16_t*)take((size_t)NR * D * 2);
  p.SST = (float*)take((size_t)NG * NCHP * 256 * 4); p.YG = (bf16_t*)take((size_t)NR * SSMW * 2); p.S2 = (bf16_t*)take((size_t)NR * D * 2);
  const size_t mix1 = off; off = mix0;
  p.Hm = (bf16_t*)take((size_t)MOE_ROWS * EH * 2); p.Yo = (bf16_t*)take((size_t)MOE_ROWS * D * 2);
  if (off < mix1) off = mix1;
  H.ws_used = off; p.ph_lo = 0; p.ph_hi = DEPTH * NPH;
  return H;
}
inline int grid_size() {
  static int grid = 0;
  if (!grid) { hipFuncSetAttribute((const void*)mega, hipFuncAttributeMaxDynamicSharedMemorySize, LDS_BYTES);
    int dev = 0, cus = 0, per_cu = 0; hipGetDevice(&dev); hipDeviceGetAttribute(&cus, hipDeviceAttributeMultiprocessorCount, dev);
    hipOccupancyMaxActiveBlocksPerMultiprocessor(&per_cu, mega, 512, LDS_BYTES);
    grid = (per_cu >= 1 && cus >= 256) ? 256 : 0;
    if (!grid) fprintf(stderr, "mega: cannot be resident (cus %d per_cu %d)\n", cus, per_cu); }
  return grid;
}
inline void launch_range(Host& H, int lo, int hi, hipStream_t st) {
  const int grid = grid_size(); if (!grid) return;
  H.p.ph_lo = lo; H.p.ph_hi = hi;
  hipLaunchKernelGGL(mega, dim3(grid), dim3(512), LDS_BYTES, st, H.p);
}
}
#ifndef PROBE_K
#define PROBE_K 8
#endif
extern "C" void kernel_launch(void* const* d_in, const int* in_sizes, int n_in, void* d_out, int out_size, void* d_ws, size_t ws_size, hipStream_t stream) {
  fk::Host H = fk::make_params(d_in, d_out, d_ws);
  if (H.ws_used > ws_size) { fprintf(stderr, "ws too small: need %zu have %zu\n", H.ws_used, ws_size); return; }
  hipMemsetAsync(H.p.bar, 0, (size_t)((char*)H.p.MOD - (char*)H.p.bar), stream);
#if PROBE_MASK
  int start = 0; const int NALL = fk::DEPTH * fk::NPH;
  for (int id = 0; id < fk::NPH; ++id) if ((PROBE_MASK >> id) & 1) { const int g = fk::NPH + id;
    fk::launch_range(H, start, g + 1, stream);
    for (int k = 0; k < PROBE_K; ++k) { hipMemsetAsync(H.p.bar, 0, XCD_BAR_WORDS * 4, stream); fk::launch_range(H, g, g + 1, stream); }
    hipMemsetAsync(H.p.bar, 0, XCD_BAR_WORDS * 4, stream); start = g + 1; }
  fk::launch_range(H, start, NALL, stream);
#else
  fk::launch_range(H, 0, fk::DEPTH * fk::NPH, stream);
#endif
}
```

```cpp
#include <hip/hip_runtime.h>
#include <cstdio>
#include <cstdint>
#include <cstring>
#include <cmath>
namespace fk {
#define LAS __attribute__((address_space(3)))
typedef unsigned short bf16_t;
typedef short bf16x8 __attribute__((ext_vector_type(8)));
typedef short s16x4 __attribute__((ext_vector_type(4)));
typedef float f32x4 __attribute__((ext_vector_type(4)));
typedef float f32x2 __attribute__((ext_vector_type(2)));
typedef float f32x16 __attribute__((ext_vector_type(16)));
typedef unsigned u32x4 __attribute__((ext_vector_type(4)));
typedef unsigned u32x2 __attribute__((ext_vector_type(2)));

constexpr int D = 1024, SEQ = 2048, CTX = 256, NB = 8, NLAT = NB * SEQ, NCTX = NB * CTX, NR = NLAT + NCTX, KVB = SEQ + CTX;
constexpr int INW = 5632, NHEAD = 8, SSMW = 512, NG = 32, NP = 64, NE = 32, EH = 512, DEPTH = 4;
constexpr int CHUNK = 32, NCHR = NR / CHUNK  , NCHP = 768  ;
constexpr int MOE_ROWS = 2 * NR + NE * 256;
constexpr float ALPHA = 1.681792830507429f;

__device__ __forceinline__ unsigned cvt_pk_bf16(float lo, float hi) { unsigned r; asm volatile("v_cvt_pk_bf16_f32 %0, %1, %2" : "=v"(r) : "v"(lo), "v"(hi)); return r; }
__device__ __forceinline__ float bf2f(unsigned short b) { return __uint_as_float(((unsigned)b) << 16); }
__device__ __forceinline__ float bflo(unsigned w) { return __uint_as_float(w << 16); }
__device__ __forceinline__ float bfhi(unsigned w) { return __uint_as_float(w & 0xffff0000u); }
__device__ __forceinline__ u32x4 pack8(const f32x4& a, const f32x4& b) { u32x4 w; w.x = cvt_pk_bf16(a[0], a[1]); w.y = cvt_pk_bf16(a[2], a[3]); w.z = cvt_pk_bf16(b[0], b[1]); w.w = cvt_pk_bf16(b[2], b[3]); return w; }
__device__ __forceinline__ void unpack8(const u32x4& w, f32x4& a, f32x4& b) { a = (f32x4){bflo(w.x), bfhi(w.x), bflo(w.y), bfhi(w.y)}; b = (f32x4){bflo(w.z), bfhi(w.z), bflo(w.w), bfhi(w.w)}; }
__device__ __forceinline__ float fast_sigmoid(float x) { return __builtin_amdgcn_rcpf(1.f + __builtin_amdgcn_exp2f(-1.4426950408889634f * x)); }
__device__ __forceinline__ float fast_silu(float x) { return x * fast_sigmoid(x); }
__device__ __forceinline__ float gelu_tanh_f(float x) { const float z = 0.7978845608028654f * (x + 0.044715f * x * x * x); return x * fast_sigmoid(2.f * z); }
__device__ __forceinline__ int otid_w(int wv) { int t; asm volatile("v_mbcnt_lo_u32_b32 %0, -1, 0\n\tv_mbcnt_hi_u32_b32 %0, -1, %0\n\tv_lshl_add_u32 %0, %1, 6, %0" : "=&v"(t) : "s"(wv)); return t; }
__device__ __forceinline__ float ozero() { float z = 0.f; asm volatile("" : "+v"(z)); return z; }
__device__ __forceinline__ int obid() { int b = blockIdx.x; asm volatile("" : "+s"(b)); return b; }
__device__ __forceinline__ int ogd() { int g = gridDim.x; asm volatile("" : "+s"(g)); return g; }
#define otid() otid_w(g_wv)
template <int CTRL, int RM> __device__ __forceinline__ float dpp_f(float v) { return __builtin_bit_cast(float, __builtin_amdgcn_update_dpp(0, __builtin_bit_cast(int, v), CTRL, RM, 0xF, false)); }
__device__ __forceinline__ float wave_sum_u(float v) {
  v += dpp_f<0xB1, 0xF>(v); v += dpp_f<0x4E, 0xF>(v); v += dpp_f<0x141, 0xF>(v); v += dpp_f<0x140, 0xF>(v); v += dpp_f<0x142, 0xA>(v); v += dpp_f<0x143, 0xC>(v);
  return __builtin_bit_cast(float, __builtin_amdgcn_readlane(__builtin_bit_cast(int, v), 63)); }
__host__ __device__ __forceinline__ int perm32(int rho) { const int n = rho >> 4, i = rho & 15; return 8 * (i >> 2) + 4 * n + (i & 3); }

#define XB_TMO      128
#define XB_XCNT(j)  (256  + 64 * (j))
#define XB_XSUB(j)  (1280 + 64 * (j))
#define XB_XGEN(j)  (2304 + 64 * (j))
#define XB_TOP      3328
#define XB_TOPGEN   3392
#define XCD_BAR_WORDS 3456
#define XB_SPIN_CAP (1u << 22)
__device__ __forceinline__ unsigned xb_ld(unsigned* p)              { return __hip_atomic_load(p, __ATOMIC_RELAXED, __HIP_MEMORY_SCOPE_AGENT); }
__device__ __forceinline__ unsigned xb_add(unsigned* p, unsigned v) { return __hip_atomic_fetch_add(p, v, __ATOMIC_RELAXED, __HIP_MEMORY_SCOPE_AGENT); }
__device__ __forceinline__ unsigned xb_xcc_id() { return (unsigned)__builtin_amdgcn_s_getreg((3 << 11) | 20) & 0xFu; }
#define XB_SPIN(cond, bar) do { unsigned _sp = 0; while (cond) { __builtin_amdgcn_s_sleep(1); \
    if ((++_sp & 255u) == 0u) { if (xb_ld(&(bar)[XB_TMO])) break; if (_sp > XB_SPIN_CAP) { atomicAdd(&(bar)[XB_TMO], 1u); break; } } } } while (0)
struct XcdBarrier { unsigned* bar; unsigned x; volatile LAS unsigned* st; };
__device__ __forceinline__ XcdBarrier xcd_barrier_post(unsigned* bar, volatile LAS unsigned* st) {
    XcdBarrier b; b.bar = bar; b.x = xb_xcc_id(); b.st = st;
    if (threadIdx.x == 0) (void)xb_add(&bar[XB_XCNT(b.x)], 1u);
    return b;
}
__device__ __forceinline__ void xcd_barrier_complete(unsigned* bar, unsigned x, unsigned& nloc, unsigned& nx) {
    const unsigned G = gridDim.x * gridDim.y * gridDim.z;
    unsigned sum, cnt, mine, sp = 0u;
    for (;;) {
        sum = 0u; cnt = 0u; mine = 0u;
#pragma unroll
        for (unsigned j = 0; j < 16; ++j) { const unsigned c = xb_ld(&bar[XB_XCNT(j)]); sum += c; cnt += (c > 0u) ? 1u : 0u; mine = (j == x) ? c : mine; }
        if (sum == G) break;
        __builtin_amdgcn_s_sleep(1);
        if ((++sp & 255u) == 0u) { if (xb_ld(&bar[XB_TMO])) break; if (sp > XB_SPIN_CAP) { atomicAdd(&bar[XB_TMO], 1u); break; } }
    }
    nloc = mine > 0u ? mine : 1u; nx = cnt > 0u ? cnt : 1u;
}
__device__ __forceinline__ void xcd_barrier(const XcdBarrier& b) {
    asm volatile("s_waitcnt vmcnt(0)" ::: "memory");
    __syncthreads();
    if (threadIdx.x == 0) {
        unsigned* bar = b.bar;
        __builtin_amdgcn_s_waitcnt(0);
        unsigned nloc = b.st[0], nx = b.st[1];
        if (nloc == 0u) { xcd_barrier_complete(bar, b.x, nloc, nx); b.st[0] = nloc; b.st[1] = nx; }
        const unsigned old = xb_add(&bar[XB_XSUB(b.x)], 1u);
        const unsigned gen = old / nloc;
        if (old + 1u == (gen + 1u) * nloc) {
            __builtin_amdgcn_fence(__ATOMIC_RELEASE, "agent");
            asm volatile("s_waitcnt vmcnt(0)" ::: "memory");
            const unsigned og = xb_add(&bar[XB_TOP], 1u);
            const unsigned tg = og / nx;
            if (og + 1u == (tg + 1u) * nx) xb_add(&bar[XB_TOPGEN], 1u);
            else XB_SPIN(xb_ld(&bar[XB_TOPGEN]) == tg, bar);
            __builtin_amdgcn_fence(__ATOMIC_ACQUIRE, "agent");
            xb_add(&bar[XB_XGEN(b.x)], 1u);
            asm volatile("s_waitcnt vmcnt(0)" ::: "memory");
        } else {
            XB_SPIN(xb_ld(&bar[XB_XGEN(b.x)]) == gen, bar);
            __builtin_amdgcn_fence(__ATOMIC_ACQUIRE, "agent");
            asm volatile("s_waitcnt vmcnt(0)" ::: "memory");
        }
    }
    __syncthreads();
}

constexpr int BM = 256, BK = 64, HALF = 128, HTB = HALF * BK * 2, STAGE_BYTES = 8 * HTB;
__host__ __device__ __forceinline__ int lds_byte(int r, int c) { const int st = (r >> 4) * 2 + (c >> 5), rr = r & 15, cc = c & 31, ob = rr * 64 + cc * 2; return st * 1024 + (ob ^ (((ob >> 9) & 1) << 5)); }
__host__ __device__ __forceinline__ void stage_rc(int b, int& R, int& C) { const int st = b / 1024, sb = b % 1024, swz = sb ^ (((sb >> 9) & 1) << 5); R = (st >> 1) * 16 + swz / 64; C = (st & 1) * 32 + (swz % 64) / 2; }
struct Seg { const char* A; const char* B; int nt; int epi; int pm; int pn; int aux; int aux2; };
__device__ __forceinline__ void tile_order(int L, int nM, int nN, int& pm, int& pn) {
    const int nwg = nM * nN; int wgid = L; { const int q = nwg / 8, r = nwg % 8, xcd = wgid % 8, off = wgid / 8; wgid = (xcd < r ? xcd * (q + 1) : r * (q + 1) + (xcd - r) * q) + off; }
    const int nig = 8 * nN, gid = wgid / nig, fm = gid * 8, gsz = (nM - fm) < 8 ? (nM - fm) : 8;
    pm = fm + ((wgid % nig) % gsz); pn = (wgid % nig) / gsz;
}
template <class Epi, class Sched, bool GATHER = false, int AMODE = 0>
__device__ __forceinline__ void gemm_stream(LAS unsigned char* lds, const int lda, const int ldb, const Sched& S, const Epi& E, const int g_wv) {
    const int tid = otid(), wid = __builtin_amdgcn_readfirstlane(tid >> 6), lane = tid & 63, wr = wid >> 2, wc = wid & 3, fr = lane & 15, fq = lane >> 4;
    unsigned voffA[2], voffB[2];
#pragma unroll
    for (int i = 0; i < 2; ++i) { int R, C; stage_rc(tid * 16 + i * 8192, R, C); voffA[i] = AMODE == 1 ? (unsigned)((C >> 4) * lda + R * 32 + (C & 15) * 2) : (unsigned)(R * lda + C * 2); voffB[i] = (unsigned)(R * ldb + C * 2); }
    unsigned gvc[2][2], gvn[2][2];
#define PG8_GV(dst, seg) do { _Pragma("unroll") for (int _i = 0; _i < 2; ++_i) { int _R, _C; stage_rc(otid() * 16 + _i * 8192, _R, _C); _Pragma("unroll") for (int _h = 0; _h < 2; ++_h) dst[_h][_i] = S.gvoff(seg, _h * HALF + _R) + (unsigned)(_C * 2); } } while (0)
    const size_t kstep = (size_t)(BK * 2), kstepA = AMODE == 1 ? (size_t)4 * lda : kstep;
    const size_t hstepA = AMODE == 1 ? (size_t)HALF * 32 : (size_t)HALF * lda, hstepB = (size_t)HALF * ldb;
    const unsigned ldsw = (unsigned)wid * 1024u;
    const int aoff = lds_byte(wr * 64 + fr, fq * 8), boff = lds_byte(wc * 32 + fr, fq * 8);
#define PG8_SA(b, h) (((b) * 2 + (h)) * HTB)
#define PG8_SB(b, h) ((4 + (b) * 2 + (h)) * HTB)
#define PG8_STAGE(bufoff, gbase, voff) do { _Pragma("unroll") for (int _i = 0; _i < 2; ++_i) \
        __builtin_amdgcn_global_load_lds((const unsigned*)((const char*)(gbase) + (voff)[_i]), (LAS unsigned*)(lds + (bufoff) + ldsw + _i * 8192), 16, 0, 0); } while (0)
#define PG8_LDA(dst, b, h) do { _Pragma("unroll") for (int m = 0; m < 4; ++m) _Pragma("unroll") for (int k = 0; k < 2; ++k) dst[m][k] = *(const LAS bf16x8*)(lds + PG8_SA(b, h) + aoff + m * 2048 + k * 1024); } while (0)
#define PG8_LDB(dst, b, h) do { _Pragma("unroll") for (int n = 0; n < 2; ++n) _Pragma("unroll") for (int k = 0; k < 2; ++k) dst[n][k] = *(const LAS bf16x8*)(lds + PG8_SB(b, h) + boff + n * 2048 + k * 1024); } while (0)
#define PG8_MMA(ai, bj, At, Bt) do { __builtin_amdgcn_s_setprio(1); _Pragma("unroll") for (int m = 0; m < 4; ++m) _Pragma("unroll") for (int n = 0; n < 2; ++n) _Pragma("unroll") for (int k = 0; k < 2; ++k) \
        acc[ai][bj][m][n] = __builtin_amdgcn_mfma_f32_16x16x32_bf16(Bt[n][k], At[m][k], acc[ai][bj][m][n], 0, 0, 0); __builtin_amdgcn_s_setprio(0); } while (0)
#define PG8_WAIT_V(n) asm volatile("s_waitcnt vmcnt(" #n ")" ::: "memory")
#define PG8_WAIT_L(n) asm volatile("s_waitcnt lgkmcnt(" #n ")" ::: "memory")
#define PG8_BAR __builtin_amdgcn_s_barrier()
#define PG8_SCHED __builtin_amdgcn_sched_barrier(0)
    Seg cur, nxt; int ui = 0;
    if (!S.next(0, cur)) return;
    f32x4 acc[2][2][4][2];
#pragma unroll
    for (int a = 0; a < 2; ++a)
#pragma unroll
        for (int b = 0; b < 2; ++b)
#pragma unroll
            for (int m = 0; m < 4; ++m)
#pragma unroll
                for (int n = 0; n < 2; ++n) acc[a][b][m][n] = (f32x4){0.f, 0.f, 0.f, 0.f};
    bf16x8 At[4][2], B0[2][2], B1[2][2];
    const char* cA = cur.A; const char* cB = cur.B;
    if constexpr (GATHER) { PG8_GV(gvc, cur); }
#define PG8_STAGE_A(bufoff, kbase, h, usenext) do { if constexpr (GATHER) { unsigned _v[2] = {(usenext) ? gvn[h][0] : gvc[h][0], (usenext) ? gvn[h][1] : gvc[h][1]}; PG8_STAGE(bufoff, kbase, _v); } \
        else { PG8_STAGE(bufoff, (kbase) + (h) * hstepA, voffA); } } while (0)
    PG8_STAGE(PG8_SB(0, 0), cB, voffB); PG8_STAGE(PG8_SB(0, 1), cB + hstepB, voffB); PG8_STAGE_A(PG8_SA(0, 0), cA, 0, false); PG8_STAGE_A(PG8_SA(0, 1), cA, 1, false);
    if (wr == 1) PG8_BAR;
    PG8_WAIT_V(2); PG8_BAR;
    PG8_STAGE(PG8_SB(1, 0), cB + kstep, voffB); PG8_STAGE_A(PG8_SA(1, 0), cA + kstepA, 0, false); PG8_STAGE(PG8_SB(1, 1), cB + hstepB + kstep, voffB);
    PG8_WAIT_V(6); PG8_BAR;
    for (;;) {
        const bool has_next = S.next(ui + 1, nxt);
        const char* nA = has_next ? nxt.A : cA; const char* nB = has_next ? nxt.B : cB;
        const int nt = cur.nt;
        for (int t = 0; t < nt; t += 2) {
            const bool last = (t == nt - 2);
            if constexpr (GATHER) { if (last) { if (has_next) { PG8_GV(gvn, nxt); } else { _Pragma("unroll") for (int _h = 0; _h < 2; ++_h) _Pragma("unroll") for (int _i = 0; _i < 2; ++_i) gvn[_h][_i] = gvc[_h][_i]; } } }
            const char* a1 = cA + (size_t)(t + 1) * kstepA;
            const char* a2 = last ? nA : cA + (size_t)(t + 2) * kstepA; const char* b2 = last ? nB : cB + (size_t)(t + 2) * kstep;
            const char* a3 = a2 + kstepA; const char* b3 = b2 + kstep;
            PG8_LDB(B0, 0, 0); PG8_LDB(B1, 0, 1); PG8_SCHED; PG8_LDA(At, 0, 0); PG8_STAGE_A(PG8_SA(1, 1), a1, 1, false);
            PG8_WAIT_V(8); PG8_WAIT_L(0); PG8_BAR; PG8_MMA(0, 0, At, B0); PG8_MMA(0, 1, At, B1); PG8_BAR; PG8_SCHED;
            PG8_LDA(At, 0, 1); PG8_STAGE(PG8_SB(0, 0), b2, voffB); PG8_STAGE(PG8_SB(0, 1), b2 + hstepB, voffB); PG8_STAGE_A(PG8_SA(0, 0), a2, 0, last);
            PG8_WAIT_V(8); PG8_WAIT_L(0); PG8_BAR; PG8_MMA(1, 0, At, B0); PG8_MMA(1, 1, At, B1); PG8_BAR; PG8_SCHED;
            PG8_LDB(B0, 1, 0); PG8_LDB(B1, 1, 1); PG8_SCHED; PG8_LDA(At, 1, 0); PG8_STAGE_A(PG8_SA(0, 1), a2, 1, last);
            PG8_WAIT_V(8); PG8_WAIT_L(0); PG8_BAR; PG8_MMA(0, 0, At, B0); PG8_MMA(0, 1, At, B1); PG8_BAR; PG8_SCHED;
            PG8_LDA(At, 1, 1); PG8_STAGE(PG8_SB(1, 0), b3, voffB); PG8_STAGE(PG8_SB(1, 1), b3 + hstepB, voffB); PG8_STAGE_A(PG8_SA(1, 0), a3, 0, last);
            PG8_WAIT_V(8); PG8_WAIT_L(0); PG8_BAR; PG8_MMA(1, 0, At, B0); PG8_MMA(1, 1, At, B1); PG8_BAR; PG8_SCHED;
        }
        if (cur.epi) {
            if (wr == 0) PG8_BAR;
            const int el = otid() & 63; const int efr = el & 15, efq = el >> 4;
            const bool z = E(acc, cur, wr, wc, efr, efq);
            if (z) {
#pragma unroll
                for (int a = 0; a < 2; ++a)
#pragma unroll
                    for (int b = 0; b < 2; ++b)
#pragma unroll
                        for (int m = 0; m < 4; ++m)
#pragma unroll
                            for (int n = 0; n < 2; ++n) acc[a][b][m][n] = (f32x4){0.f, 0.f, 0.f, 0.f};
            }
            if (!has_next) break;
            if (wr == 1) PG8_BAR;
        } else if (!has_next) { if (wr == 0) PG8_BAR; break; }
        cur = nxt; cA = nA; cB = nB; ++ui;
        if constexpr (GATHER) {
#pragma unroll
            for (int h = 0; h < 2; ++h)
#pragma unroll
                for (int i = 0; i < 2; ++i) gvc[h][i] = gvn[h][i]; }
    }
    PG8_WAIT_V(0);
    PG8_BAR;
#undef PG8_SA
#undef PG8_SB
#undef PG8_STAGE
#undef PG8_STAGE_A
#undef PG8_GV
#undef PG8_LDA
#undef PG8_LDB
#undef PG8_MMA
#undef PG8_WAIT_V
#undef PG8_WAIT_L
#undef PG8_BAR
#undef PG8_SCHED
}
}
namespace fk {
struct In { const float *x, *c, *ctx, *c_ctx, *w_mod, *b_mod, *w_in, *lam_q1, *lam_k1, *lam_q2, *lam_k2, *subln_g, *a_re, *a_im, *log_dt, *b_re, *b_im, *c_re, *c_im, *ssm_d,
  *w_glu, *b_glu, *w_pa, *w_ps, *w_o, *ln1_g, *ln1_b, *rg_w, *rg_b, *re_w, *re_b, *w1, *w3, *w2, *ln2_g, *ln2_b; };
struct WSet { bf16_t *Win, *Wglu, *Wpa, *Wps, *Wo, *W13, *W2; };
struct SSet { bf16_t *Smat, *TO; float *SAL, *WR; };
struct Params {
  In in; float* out;
  unsigned* bar;
  unsigned* ctl;
  float* MOD;
  float* ROPE;
  float* XL;
  bf16_t* Hb;
  bf16_t* Kc; bf16_t* Vc;
  bf16_t* Qb;
  bf16_t* Ug;
  bf16_t* RG; bf16_t* GSb;
  bf16_t* ATTb;
  float* SST;
  bf16_t* YG;
  bf16_t* S2;
  bf16_t* Mb;
  bf16_t* H2b;
  int* ROUTE;
  float* RW;
  int* TOK;
  bf16_t* Hm;
  bf16_t* Yo;
  SSet s[4];
  WSet w[2];
  int ph_lo, ph_hi;
  int pad0, pad1;
};
typedef const __attribute__((address_space(4))) Params& KP; typedef const __attribute__((address_space(4))) WSet& KW; typedef const __attribute__((address_space(4))) SSet& KS;
constexpr int CTL_CNT = 0;
constexpr int CTL_WORDS = 64 * 32 + 64;

__device__ __forceinline__ int modrow_of_tile(int pm) { return pm < 64 ? (pm >> 3) : 8; }
__device__ __forceinline__ int kvrow0_of_tile(int pm) { return pm < 64 ? (pm >> 3) * KVB + CTX + (pm & 7) * 256 : (pm - 64) * KVB; }

struct SchedPlain {
  const char* A; const char* B; int lda, ldb, nM, nN, nt, G, c, nunits; int epi; int atile;
  __device__ __forceinline__ bool next(int i, Seg& s) const {
    const int L = i * G + c; if (L >= nunits) return false;
    int pm, pn; tile_order(L, nM, nN, pm, pn);
    s.A = A + (size_t)pm * atile; s.B = B + (size_t)pn * 256 * ldb; s.nt = nt; s.epi = epi; s.pm = pm; s.pn = pn; s.aux = 0; s.aux2 = 0; return true; }
};
struct SchedMerge {
  const char* A1; const char* B1; const char* A2; const char* B2; int nM, nN, G, c, nunits;
  __device__ __forceinline__ bool next(int i, Seg& s) const {
    const int L = (i >> 1) * G + c; if (L >= nunits) return false;
    int pm, pn; tile_order(L, nM, nN, pm, pn); s.pm = pm; s.pn = pn; s.aux = 0; s.aux2 = 0;
    if ((i & 1) == 0) { s.A = A1 + (size_t)pm * 256 * 2048; s.B = B1 + (size_t)pn * 256 * 2048; s.nt = 16; s.epi = 2; }
    else { s.A = A2 + (size_t)pm * 256 * 2048; s.B = B2 + (size_t)pn * 256 * 2048; s.nt = 8; s.epi = 1; }
    return true; }
};
struct SchedSsm1 {
  const char* Ug; const char* Smat; int G, c;
  __device__ __forceinline__ bool next(int i, Seg& s) const {
    const int L = i * G + c; if (L >= NG * 3) return false;
    const int g = L / 3, pm = L % 3;
    s.A = Ug + (size_t)g * NCHP * 1536 + (size_t)pm * 256 * 1536; s.B = Smat + (size_t)g * 256 * 1536; s.nt = 8; s.epi = 1; s.pm = pm; s.pn = 0; s.aux = g; s.aux2 = 0; return true; }
};
struct SchedSsm3 {
  const char* Ug; const char* TO; int G, c;
  __device__ __forceinline__ bool next(int i, Seg& s) const {
    const int L = i * G + c; if (L >= NG * 6) return false;
    const int g = L / 6, r = L % 6, pm = r >> 1, pn = r & 1; s.pm = pm; s.pn = pn; s.aux = g; s.aux2 = 0;
    s.A = Ug + (size_t)g * NCHP * 1536 + (size_t)pm * 256 * 1536; s.B = TO + (size_t)g * 512 * 1536 + (size_t)pn * 256 * 1536; s.nt = 12; s.epi = 1; return true; }
};
struct MoeTab { int ntiles; int tileE[176]; int tileR0[176]; int cnt[32]; int tbase[33]; };
struct SchedMoe {
  const char* A; const char* B; int lda, ldb; size_t estride; const LAS MoeTab* tab; const int* TOK; int nN, nt, G, c; bool gather;
  __device__ __forceinline__ bool next(int i, Seg& s) const {
    const int L = i * G + c; if (L >= tab->ntiles * nN) return false;
    const int t = L / nN, pn = L % nN; const int e = tab->tileE[t];
    s.A = gather ? A : A + (size_t)t * 256 * lda; s.B = B + (size_t)e * estride + (size_t)pn * 256 * ldb; s.nt = nt; s.epi = 1; s.pm = t; s.pn = pn; s.aux = e; s.aux2 = tab->tileR0[t]; return true; }
  __device__ __forceinline__ unsigned gvoff(const Seg& s, int R) const { const int r = s.aux2 + R; const int tok = r < tab->cnt[s.aux] ? TOK[(size_t)s.aux * NR + r] : 0; return (unsigned)tok * (unsigned)lda; }
};
struct SchedG1 {
  const char* A; const char* B; int G, c, u0, u1; bool last;
  __device__ __forceinline__ bool next(int i, Seg& s) const {
    const int L = u0 + i * G + c; if (L >= u1) return false; int pm, pn;
    if (!last) { if (L < 144) { pm = L >> 1; pn = 8 + (L & 1); } else { int q; tile_order(L - 144, NR / 256, 20, pm, q); pn = q < 8 ? q : q + 2; } }
    else { if (L < 1408) tile_order(L, NLAT / 256, 22, pm, pn); else { const int L2 = L - 1408; pm = 64 + L2 / 10; pn = L2 % 10; } }
    s.A = A + (size_t)pm * 256 * 2048; s.B = B + (size_t)pn * 256 * 2048; s.nt = 16; s.epi = 1; s.pm = pm; s.pn = pn; s.aux = 0; s.aux2 = 0; return true; }
};
#define EPI_LOOP_AM for (int ai = 0; ai < 2; ++ai) _Pragma("unroll") for (int m = 0; m < 4; ++m)
struct EpiIn {
  const float* ROPE; bf16_t* Kc; bf16_t* Vc; bf16_t* Ug; bf16_t* Qb; bf16_t* RG; bf16_t* GSb;
  __device__ __forceinline__ bool operator()(f32x4 (&acc)[2][2][4][2], const Seg& s, int wr, int wc, int fr, int fq) const {
    const int pm = s.pm, pn = s.pn; const int rin0 = wr * 64 + fr;
    if (pn < 4 || (pn >= 10 && pn < 14)) {
      const bool isq = pn >= 10; const int pt = isq ? pn - 10 : pn; const int axis = wc & 1;
      bf16_t* dst = isq ? Qb : Kc; const int drow0 = isq ? pm * 256 : kvrow0_of_tile(pm); const bool lat = pm < 64;
#pragma unroll
      EPI_LOOP_AM { const int rin = ai * 128 + m * 16 + rin0; const int t = (pm * 256 + rin) & (SEQ - 1); const float* rp = ROPE + ((size_t)t * 2 + axis) * 32 + fq * 4;
        f32x4 cs, sn; if (lat) { cs = *(const f32x4*)rp; sn = *(const f32x4*)(rp + 16); }
#pragma unroll
        for (int bj = 0; bj < 2; ++bj) { f32x4 o1 = acc[ai][bj][m][0], o2 = acc[ai][bj][m][1]; if (lat) { const f32x4 t1 = o1, t2 = o2; o1 = t1 * cs - t2 * sn; o2 = t1 * sn + t2 * cs; }
          *(u32x4*)(dst + (size_t)(drow0 + rin) * 1024 + (2 * pt + bj) * 128 + wc * 32 + fq * 8) = pack8(o1, o2); } }
    } else if (pn < 8) {
      const int drow0 = kvrow0_of_tile(pm);
#pragma unroll
      EPI_LOOP_AM { const int rin = ai * 128 + m * 16 + rin0;
#pragma unroll
        for (int bj = 0; bj < 2; ++bj) *(u32x4*)(Vc + (size_t)(drow0 + rin) * 1024 + (pn - 4) * 256 + bj * 128 + wc * 32 + fq * 8) = pack8(acc[ai][bj][m][0], acc[ai][bj][m][1]); }
    } else if (pn < 10) {
#pragma unroll
      EPI_LOOP_AM { const int rin = ai * 128 + m * 16 + rin0;
#pragma unroll
        for (int bj = 0; bj < 2; ++bj) { const int c0 = (pn - 8) * 256 + bj * 128 + wc * 32 + fq * 8; const int g = c0 >> 4, co = c0 & 15;
          const int R = pm * 256 + rin; *(u32x4*)(Ug + ((size_t)g * NCHP + (R >> 5)) * 768 + (R & 31) * 16 + co) = pack8(acc[ai][bj][m][0], acc[ai][bj][m][1]); } }
    } else {
      const int c0 = (pn - 14) * 128 + wc * 32 + fq * 8;
#pragma unroll
      EPI_LOOP_AM { const int rin = ai * 128 + m * 16 + rin0; f32x4 r[2], g[2];
#pragma unroll
        for (int n = 0; n < 2; ++n)
#pragma unroll
          for (int j = 0; j < 4; ++j) { const float ea = __builtin_amdgcn_exp2f(-1.4426950408889634f * acc[ai][0][m][n][j]); const float es = __builtin_amdgcn_exp2f(-1.4426950408889634f * fmaxf(acc[ai][1][m][n][j], -60.f));
            g[n][j] = __builtin_amdgcn_rcpf(1.f + es); r[n][j] = (1.f + es) * __builtin_amdgcn_rcpf(1.f + ea); }
        *(u32x4*)(RG + (size_t)(pm * 256 + rin) * 1024 + c0) = pack8(r[0], r[1]); *(u32x4*)(GSb + (size_t)(pm * 256 + rin) * 1024 + c0) = pack8(g[0], g[1]); }
    }
    return true;
  }
};
struct EpiState {
  float* SST;
  __device__ __forceinline__ bool operator()(f32x4 (&acc)[2][2][4][2], const Seg& s, int wr, int wc, int fr, int fq) const {
    const int g = s.aux;
#pragma unroll
    EPI_LOOP_AM { const int row = s.pm * 256 + ai * 128 + m * 16 + wr * 64 + fr;
      if (row < NCHR) {
#pragma unroll
        for (int bj = 0; bj < 2; ++bj) { float* p = SST + ((size_t)g * NCHP + row) * 256 + bj * 128 + wc * 32 + fq * 8; *(f32x4*)p = acc[ai][bj][m][0]; *(f32x4*)(p + 4) = acc[ai][bj][m][1]; } } }
    return true;
  }
};
struct EpiSsmOut {
  bf16_t* YG;
  __device__ __forceinline__ bool operator()(f32x4 (&acc)[2][2][4][2], const Seg& s, int wr, int wc, int fr, int fq) const {
    const int g = s.aux;
#pragma unroll
    EPI_LOOP_AM { const int row = s.pm * 256 + ai * 128 + m * 16 + wr * 64 + fr;
      if (row < NCHR) {
#pragma unroll
        for (int bj = 0; bj < 2; ++bj) { const int c0 = s.pn * 256 + bj * 128 + wc * 32 + fq * 8; const int t = c0 >> 4, co = c0 & 15; f32x4 a = acc[ai][bj][m][0], b = acc[ai][bj][m][1];
#pragma unroll
          for (int j = 0; j < 4; ++j) { a[j] = gelu_tanh_f(a[j]); b[j] = gelu_tanh_f(b[j]); }
          *(u32x4*)(YG + ((size_t)g * NR + (size_t)row * CHUNK + t) * 16 + co) = pack8(a, b); } } }
    return true;
  }
};
struct EpiGlu {
  const bf16_t* YG; bf16_t* S2; const float* bias;
  __device__ __forceinline__ bool operator()(f32x4 (&acc)[2][2][4][2], const Seg& s, int wr, int wc, int fr, int fq) const {
#pragma unroll
    for (int bj = 0; bj < 2; ++bj) { const int c0 = s.pn * 256 + bj * 128 + wc * 32 + fq * 8; const f32x4 b0 = *(const f32x4*)(bias + c0), b1 = *(const f32x4*)(bias + c0 + 4);
#pragma unroll
      EPI_LOOP_AM { const int row = s.pm * 256 + ai * 128 + m * 16 + wr * 64 + fr; const u32x4 yw = *(const u32x4*)(YG + ((size_t)(c0 >> 4) * NR + row) * 16 + (c0 & 15)); f32x4 y0, y1; unpack8(yw, y0, y1);
        f32x4 z0 = acc[ai][bj][m][0] + b0, z1 = acc[ai][bj][m][1] + b1;
#pragma unroll
        for (int j = 0; j < 4; ++j) { z0[j] = y0[j] * fast_sigmoid(z0[j]); z1[j] = y1[j] * fast_sigmoid(z1[j]); }
        *(u32x4*)(S2 + (size_t)row * 1024 + c0) = pack8(z0, z1); } }
    return true;
  }
};
struct EpiMerge {
  const bf16_t* RG; const bf16_t* GSb; bf16_t* Mb;
  __device__ __forceinline__ bool operator()(f32x4 (&acc)[2][2][4][2], const Seg& s, int wr, int wc, int fr, int fq) const {
    const bool mid = s.epi == 2; const bf16_t* src = mid ? RG : GSb;
#pragma unroll
    EPI_LOOP_AM { const int row = s.pm * 256 + ai * 128 + m * 16 + wr * 64 + fr;
#pragma unroll
      for (int bj = 0; bj < 2; ++bj) { const int c0 = s.pn * 256 + bj * 128 + wc * 32 + fq * 8; const u32x4 w = *(const u32x4*)(src + (size_t)row * 1024 + c0); f32x4 g0, g1; unpack8(w, g0, g1);
        acc[ai][bj][m][0] *= g0; acc[ai][bj][m][1] *= g1;
        if (!mid) *(u32x4*)(Mb + (size_t)row * 1024 + c0) = pack8(acc[ai][bj][m][0], acc[ai][bj][m][1]); } }
    return !mid;
  }
};
struct EpiWo {
  const float* xin_lat; const float* xin_ctx; float* XL; const float* MODl;
  __device__ __forceinline__ bool operator()(f32x4 (&acc)[2][2][4][2], const Seg& s, int wr, int wc, int fr, int fq) const {
    const int pm = s.pm; const float* gate = MODl + (size_t)modrow_of_tile(pm) * 6144 + 2 * 1024;
    const float* xin = pm < 64 ? xin_lat + (size_t)pm * 256 * 1024 : xin_ctx + (size_t)(pm - 64) * 256 * 1024;
#pragma unroll
    for (int bj = 0; bj < 2; ++bj) { const int c0 = s.pn * 256 + bj * 128 + wc * 32 + fq * 8; const f32x4 g0 = *(const f32x4*)(gate + c0), g1 = *(const f32x4*)(gate + c0 + 4);
#pragma unroll
      EPI_LOOP_AM { const int rin = ai * 128 + m * 16 + wr * 64 + fr; const float* xp = xin + (size_t)rin * 1024 + c0; float* op = XL + (size_t)(pm * 256 + rin) * 1024 + c0;
        const f32x4 x0 = *(const f32x4*)xp, x1 = *(const f32x4*)(xp + 4);
        *(f32x4*)op = x0 * ALPHA + g0 * acc[ai][bj][m][0]; *(f32x4*)(op + 4) = x1 * ALPHA + g1 * acc[ai][bj][m][1]; } }
    return true;
  }
};
struct EpiMoe1 {
  bf16_t* Hm;
  __device__ __forceinline__ bool operator()(f32x4 (&acc)[2][2][4][2], const Seg& s, int wr, int wc, int fr, int fq) const {
    const int c0 = s.pn * 128 + wc * 32 + fq * 8;
#pragma unroll
    EPI_LOOP_AM { const int row = s.pm * 256 + ai * 128 + m * 16 + wr * 64 + fr; f32x4 h0, h1;
#pragma unroll
      for (int j = 0; j < 4; ++j) { h0[j] = fast_silu(acc[ai][0][m][0][j]) * acc[ai][1][m][0][j]; h1[j] = fast_silu(acc[ai][0][m][1][j]) * acc[ai][1][m][1][j]; }
      *(u32x4*)(Hm + (size_t)row * EH + c0) = pack8(h0, h1); }
    return true;
  }
};
struct EpiMoe2 {
  bf16_t* Yo;
  __device__ __forceinline__ bool operator()(f32x4 (&acc)[2][2][4][2], const Seg& s, int wr, int wc, int fr, int fq) const {
#pragma unroll
    EPI_LOOP_AM { const int row = s.pm * 256 + ai * 128 + m * 16 + wr * 64 + fr;
#pragma unroll
      for (int bj = 0; bj < 2; ++bj) *(u32x4*)(Yo + (size_t)row * 1024 + s.pn * 256 + bj * 128 + wc * 32 + fq * 8) = pack8(acc[ai][bj][m][0], acc[ai][bj][m][1]); }
    return true;
  }
};
}
namespace fk {
constexpr int ATT_SHM_V = 64 * 128 * 2, ATT_SHM_K = 64 * 128 * 2;
constexpr int ATT_LDS = 2 * ATT_SHM_V + 2 * ATT_SHM_K + 8 * 256;
#define KSWZ(row, colB) ((row) * 256 + ((colB) ^ (((row) & 7) << 4)))
#define SBAR() __builtin_amdgcn_sched_barrier(0)
__device__ __forceinline__ int crow(int r, int hi) { return (r & 3) + 8 * (r >> 2) + 4 * hi; }
constexpr float ATT_SCALE = 0.125f, ATT_THR = 8.f;
__device__ __forceinline__ void partialSM(f32x16& p0, f32x16& p1, float& m_reg, float& mn, float& alpha) {
  constexpr float C = ATT_SCALE * 1.4426950408889634f;
  float pmax = p0[0];
#pragma unroll
  for (int r = 1; r < 16; ++r) pmax = fmaxf(pmax, p0[r]);
#pragma unroll
  for (int r = 0; r < 16; ++r) pmax = fmaxf(pmax, p1[r]);
  { auto rr = __builtin_amdgcn_permlane32_swap(__float_as_uint(pmax), __float_as_uint(pmax), false, false);
    pmax = fmaxf(__uint_as_float(rr[0]), __uint_as_float(rr[1])); }
  if (__builtin_expect(__all(pmax - m_reg <= ATT_THR / ATT_SCALE), 1)) { mn = m_reg; alpha = 1.f; }
  else { mn = fmaxf(m_reg, pmax); alpha = __builtin_amdgcn_exp2f((m_reg - mn) * C); m_reg = mn; }
  const float mnC = -mn * C;
#pragma unroll
  for (int r = 0; r < 16; ++r) p0[r] = fmaf(p0[r], C, mnC);
#pragma unroll
  for (int r = 0; r < 16; ++r) p1[r] = fmaf(p1[r], C, mnC);
#pragma unroll
  for (int r = 0; r < 16; ++r) p0[r] = __builtin_amdgcn_exp2f(p0[r]);
}
__device__ __forceinline__ void finishSM(f32x16& p0, f32x16& p1, float alpha, float& l_reg, bf16x8& pa0, bf16x8& pa1, bf16x8& pa2, bf16x8& pa3) {
#pragma unroll
  for (int r = 0; r < 16; ++r) p1[r] = __builtin_amdgcn_exp2f(p1[r]);
  float ps = 0;
#pragma unroll
  for (int r = 0; r < 16; ++r) ps += p0[r];
#pragma unroll
  for (int r = 0; r < 16; ++r) ps += p1[r];
  { auto rr = __builtin_amdgcn_permlane32_swap(__float_as_uint(ps), __float_as_uint(ps), false, false);
    ps = __uint_as_float(rr[0]) + __uint_as_float(rr[1]); }
  l_reg = l_reg * alpha + ps;
#define PK4(P, BASE, OUT) do { unsigned a0 = cvt_pk_bf16(P[BASE + 0], P[BASE + 1]), a1 = cvt_pk_bf16(P[BASE + 2], P[BASE + 3]);   \
    unsigned b0 = cvt_pk_bf16(P[BASE + 4], P[BASE + 5]), b1 = cvt_pk_bf16(P[BASE + 6], P[BASE + 7]);                              \
    auto r0 = __builtin_amdgcn_permlane32_swap(a0, b0, false, false); auto r1 = __builtin_amdgcn_permlane32_swap(a1, b1, false, false); \
    u32x4 w = {r0[0], r1[0], r0[1], r1[1]}; OUT = *reinterpret_cast<bf16x8*>(&w); } while (0)
  PK4(p0, 0, pa0); PK4(p0, 8, pa1); PK4(p1, 0, pa2); PK4(p1, 8, pa3);
#undef PK4
}
__device__ __forceinline__ void qkt(f32x16& p0, f32x16& p1, const LAS char* Ks, const bf16x8* qr, int mapcolB, int r32, int hi) {
  p0 = f32x16{}; p1 = f32x16{};
#pragma unroll
  for (int d0 = 0; d0 < 4; ++d0) { const int cb = mapcolB + (d0 * 16 + hi * 8) * 2;
    const bf16x8 b0 = *(const LAS bf16x8*)(Ks + KSWZ(r32, cb));
    const bf16x8 b1 = *(const LAS bf16x8*)(Ks + KSWZ(32 + r32, cb));
    p0 = __builtin_amdgcn_mfma_f32_32x32x16_bf16(b0, qr[d0], p0, 0, 0, 0);
    p1 = __builtin_amdgcn_mfma_f32_32x32x16_bf16(b1, qr[d0], p1, 0, 0, 0); }
}
__device__ __forceinline__ int v_st(int k, int c) { const int kk = (k & ~0xC) | ((k & 4) << 1) | ((k & 8) >> 1); return ((kk >> 3) * 4 + (c >> 5)) * 512 + ((kk & 7) * 32 + (c & 31)) * 2; }
__device__ __forceinline__ int v_rd_base(int lane) { return ((lane & 3) << 3) | (((lane >> 2) & 3) << 6) | (((lane >> 4) & 1) << 5) | (((lane >> 5) & 1) << 8); }
constexpr int v_rd_off(int d0, int ks, int half) { return d0 * 512 + ks * 4096 + half * 2048; }
template <int OFF> __device__ __forceinline__ s16x4 tr_read(int vb) {
  s16x4 r; asm volatile("ds_read_b64_tr_b16 %0, %1 offset:%2" : "=&v"(r) : "v"(vb), "i"(OFF) : "memory"); return r;
}
template <int D0> __device__ __forceinline__ void pv_one(f32x16& od, int vb, bf16x8 pa0, bf16x8 pa1, bf16x8 pa2, bf16x8 pa3) {
  const s16x4 l0 = tr_read<v_rd_off(D0, 0, 0)>(vb), h0 = tr_read<v_rd_off(D0, 0, 1)>(vb), l1 = tr_read<v_rd_off(D0, 1, 0)>(vb), h1 = tr_read<v_rd_off(D0, 1, 1)>(vb);
  const s16x4 l2 = tr_read<v_rd_off(D0, 2, 0)>(vb), h2 = tr_read<v_rd_off(D0, 2, 1)>(vb), l3 = tr_read<v_rd_off(D0, 3, 0)>(vb), h3 = tr_read<v_rd_off(D0, 3, 1)>(vb);
  asm volatile("s_waitcnt lgkmcnt(0)" ::: "memory"); SBAR();
#define PK(L, H) (bf16x8){L[0], L[1], L[2], L[3], H[0], H[1], H[2], H[3]}
  od = __builtin_amdgcn_mfma_f32_32x32x16_bf16(pa0, PK(l0, h0), od, 0, 0, 0);
  od = __builtin_amdgcn_mfma_f32_32x32x16_bf16(pa1, PK(l1, h1), od, 0, 0, 0);
  od = __builtin_amdgcn_mfma_f32_32x32x16_bf16(pa2, PK(l2, h2), od, 0, 0, 0);
  od = __builtin_amdgcn_mfma_f32_32x32x16_bf16(pa3, PK(l3, h3), od, 0, 0, 0);
#undef PK
}
__device__ __forceinline__ void pv_d0(f32x16* o, int vb, bf16x8 pa0, bf16x8 pa1, bf16x8 pa2, bf16x8 pa3) {
  pv_one<0>(o[0], vb, pa0, pa1, pa2, pa3); pv_one<1>(o[1], vb, pa0, pa1, pa2, pa3); pv_one<2>(o[2], vb, pa0, pa1, pa2, pa3); pv_one<3>(o[3], vb, pa0, pa1, pa2, pa3);
}
__device__ __forceinline__ void attn_unit(const bf16_t* __restrict__ Qg, const bf16_t* __restrict__ Kg, const bf16_t* __restrict__ Vg, bf16_t* __restrict__ Og,
                                          int qrow0, int kv0, int nkeys, int h, float lam, float lam_init, const float* __restrict__ subg, LAS char* lds, const int g_wv) {
  const int tid = otid(), wid = tid >> 6, lane = tid & 63, r32 = lane & 31, hi = lane >> 5, map = wid >> 2, wq = wid & 3;
  LAS char* V_lds = lds; LAS char* K_lds = lds + 2 * ATT_SHM_V;
  LAS float* wsf = (LAS float*)(lds + 2 * ATT_SHM_V + 2 * ATT_SHM_K) + wid * 64; LAS float* li_l = wsf; LAS float* al_l = wsf + 32;
  float m_reg = -1e30f, l_reg = 0; f32x16 o[4] = {}; bf16x8 qr[4];
  const bf16_t* Qw = Qg + (size_t)(qrow0 + wq * 32 + r32) * 1024 + h * 128 + map * 64 + hi * 8;
#pragma unroll
  for (int d0 = 0; d0 < 4; ++d0) qr[d0] = *(const bf16x8*)(Qw + d0 * 16);
  const bf16_t* Kh = Kg + (size_t)kv0 * 1024 + h * 128; const bf16_t* Vh = Vg + (size_t)kv0 * 1024 + h * 128;
  const int sr = tid >> 4, sc = (tid & 15) * 8, vst0 = v_st(sr, sc), vst1 = v_st(32 + sr, sc);
  const int vb0 = (int)(uintptr_t)V_lds + v_rd_base(lane);
  const int mapcolB = map * 128;
  struct { bf16x8 vs0, vs1, ks0, ks1; } sr_[1];
#define SLOAD(i, k0) do { sr_[i].vs0 = *(const bf16x8*)(&Vh[(size_t)((k0) + sr) * 1024 + sc]); sr_[i].vs1 = *(const bf16x8*)(&Vh[(size_t)((k0) + 32 + sr) * 1024 + sc]); \
    sr_[i].ks0 = *(const bf16x8*)(&Kh[(size_t)((k0) + sr) * 1024 + sc]); sr_[i].ks1 = *(const bf16x8*)(&Kh[(size_t)((k0) + 32 + sr) * 1024 + sc]); } while (0)
#define SWRITE(b, i) do { *(LAS bf16x8*)(V_lds + (b) * ATT_SHM_V + vst0) = sr_[i].vs0;          \
    *(LAS bf16x8*)(V_lds + (b) * ATT_SHM_V + vst1) = sr_[i].vs1; const int kc = sc * 2;               \
    *(LAS bf16x8*)(K_lds + (b) * ATT_SHM_K + KSWZ(sr, kc)) = sr_[i].ks0;                       \
    *(LAS bf16x8*)(K_lds + (b) * ATT_SHM_K + KSWZ(32 + sr, kc)) = sr_[i].ks1; } while (0)
#define SWAIT() asm volatile("s_waitcnt vmcnt(0)" ::: "memory")
#define RESC(a) do { if (__any((a) < 1.f)) { if (hi == 0) al_l[r32] = (a); asm volatile("s_waitcnt lgkmcnt(0)" ::: "memory"); \
    _Pragma("unroll") for (int d = 0; d < 4; ++d) _Pragma("unroll") for (int r = 0; r < 16; ++r) o[d][r] *= al_l[crow(r, hi)]; } } while (0)
  f32x16 pA0, pA1, pB0, pB1; float mnA, mnB, alA, alB; bf16x8 pa0, pa1, pa2, pa3; const int NT = nkeys / 64;
  constexpr int SE = 0, SO = 0;
  SLOAD(SE, 0); asm volatile("s_waitcnt vmcnt(0)" ::: "memory"); SWRITE(0, SE); __syncthreads();
  qkt(pA0, pA1, K_lds, qr, mapcolB, r32, hi); partialSM(pA0, pA1, m_reg, mnA, alA);
  SLOAD(SO, 64);
  SWAIT(); SWRITE(1, SO); __syncthreads();
  for (int j = 1; j + 1 < NT; j += 2) {
    SBAR(); qkt(pB0, pB1, K_lds + ATT_SHM_K, qr, mapcolB, r32, hi);
    finishSM(pA0, pA1, alA, l_reg, pa0, pa1, pa2, pa3); SBAR();
    SLOAD(SE, (j + 1) * 64); SBAR();
    pv_d0(o, vb0, pa0, pa1, pa2, pa3); partialSM(pB0, pB1, m_reg, mnB, alB);
    __syncthreads(); SWAIT(); SWRITE(0, SE);
    RESC(alB); __syncthreads();
    SBAR(); qkt(pA0, pA1, K_lds, qr, mapcolB, r32, hi);
    finishSM(pB0, pB1, alB, l_reg, pa0, pa1, pa2, pa3); SBAR();
    SLOAD(SO, (j + 2) * 64); SBAR();
    pv_d0(o, vb0 + ATT_SHM_V, pa0, pa1, pa2, pa3); partialSM(pA0, pA1, m_reg, mnA, alA);
    __syncthreads(); SWAIT(); SWRITE(1, SO);
    RESC(alA); __syncthreads();
  }
  SBAR(); qkt(pB0, pB1, K_lds + ATT_SHM_K, qr, mapcolB, r32, hi);
  finishSM(pA0, pA1, alA, l_reg, pa0, pa1, pa2, pa3); SBAR();
  pv_d0(o, vb0, pa0, pa1, pa2, pa3); partialSM(pB0, pB1, m_reg, mnB, alB);
  __syncthreads(); RESC(alB);
  finishSM(pB0, pB1, alB, l_reg, pa0, pa1, pa2, pa3); SBAR();
  pv_d0(o, vb0 + ATT_SHM_V, pa0, pa1, pa2, pa3);
  if (hi == 0) li_l[r32] = l_reg; asm volatile("s_waitcnt lgkmcnt(0)" ::: "memory");
  float rli[16]; const float fac = map ? lam : 1.f;
#pragma unroll
  for (int r = 0; r < 16; ++r) rli[r] = fac * __builtin_amdgcn_rcpf(li_l[crow(r, hi)]);
  __syncthreads();
  LAS float* stg = (LAS float*)lds + wid * (32 * 128);
#pragma unroll
  for (int r = 0; r < 16; ++r)
#pragma unroll
    for (int d0 = 0; d0 < 4; ++d0) stg[crow(r, hi) * 128 + d0 * 32 + r32] = o[d0][r] * rli[r];
  __syncthreads();
  {
    const int qi = 16 * map + (lane >> 2), qt = lane & 3;
    const LAS float* pa = (const LAS float*)lds + wq * (32 * 128) + qi * 128 + qt * 32;
    const LAS float* pb = (const LAS float*)lds + (4 + wq) * (32 * 128) + qi * 128 + qt * 32;
    float v[32]; float ss = 0.f;
#pragma unroll
    for (int k = 0; k < 8; ++k) { const f32x4 a = *(const LAS f32x4*)(pa + 4 * k), b = *(const LAS f32x4*)(pb + 4 * k);
#pragma unroll
      for (int j = 0; j < 4; ++j) { const float x = a[j] - b[j]; v[4 * k + j] = x; ss += x * x; } }
    ss += dpp_f<0xB1, 0xF>(ss); ss += dpp_f<0x4E, 0xF>(ss);
    const float rn = __builtin_amdgcn_rsqf(ss * (1.f / 128.f) + 1e-5f) * (1.f - lam_init);
    bf16_t* op = Og + (size_t)(qrow0 + wq * 32 + qi) * 1024 + h * 128 + qt * 32; const float* gp = subg + qt * 32;
#pragma unroll
    for (int k = 0; k < 4; ++k) { f32x4 a, b;
#pragma unroll
      for (int j = 0; j < 4; ++j) { a[j] = v[8 * k + j] * rn * gp[8 * k + j]; b[j] = v[8 * k + 4 + j] * rn * gp[8 * k + 4 + j]; }
      *(u32x4*)(op + 8 * k) = pack8(a, b); }
  }
  __syncthreads();
#undef SLOAD
#undef SWRITE
#undef SWAIT
#undef RESC
}
__device__ __forceinline__ void attn_phase(KP p, int l, LAS char* lds, const int g_wv) {
  const int tid = otid(), lane = tid & 63; const bool last = (l == DEPTH - 1);
  float s1 = p.in.lam_q1[l * 64 + lane] * p.in.lam_k1[l * 64 + lane], s2 = p.in.lam_q2[l * 64 + lane] * p.in.lam_k2[l * 64 + lane];
  s1 = wave_sum_u(s1); s2 = wave_sum_u(s2);
  const float lam_init = 0.8f - 0.6f * expf(-0.3f * (float)l); const float lam = expf(s1) - expf(s2) + lam_init;
  const int c = obid(), x = c & 7, jl = c >> 3, per = ogd() >> 3;
  const int nloc = last ? 128 : 144;
  for (int q = jl; q < nloc; q += per) {
    int qrow0, nkeys, h;
    if (q < 128) { h = q >> 4; qrow0 = x * SEQ + (q & 15) * 128; nkeys = KVB; }
    else { const int qq = q - 128; h = qq >> 1; qrow0 = NLAT + x * CTX + (qq & 1) * 128; nkeys = CTX; }
    attn_unit(p.Qb, p.Kc, p.Vc, p.ATTb, qrow0, x * KVB, nkeys, h, lam, lam_init, p.in.subln_g + l * 128, lds, g_wv);
  }
}

__device__ __forceinline__ float wave_sum(float v) { return wave_sum_u(v); }
__device__ __forceinline__ void row_ld(const float* p, int lane, f32x4 (&v)[4]) {
#pragma unroll
  for (int i = 0; i < 4; ++i) v[i] = *(const f32x4*)(p + 4 * lane + 256 * i); }
__device__ __forceinline__ void row_st(float* p, int lane, const f32x4 (&v)[4]) {
#pragma unroll
  for (int i = 0; i < 4; ++i) *(f32x4*)(p + 4 * lane + 256 * i) = v[i]; }
__device__ __forceinline__ void row_st_bf16(bf16_t* p, int lane, const f32x4 (&v)[4]) {
#pragma unroll
  for (int i = 0; i < 4; ++i) { u32x2 w; w.x = cvt_pk_bf16(v[i][0], v[i][1]); w.y = cvt_pk_bf16(v[i][2], v[i][3]); *(u32x2*)(p + 4 * lane + 256 * i) = w; } }
__device__ __forceinline__ void row_ld_bf16(const bf16_t* p, int lane, f32x4 (&v)[4]) {
#pragma unroll
  for (int i = 0; i < 4; ++i) { const u32x2 w = *(const u32x2*)(p + 4 * lane + 256 * i); v[i] = (f32x4){bflo(w.x), bfhi(w.x), bflo(w.y), bfhi(w.y)}; } }
__device__ __forceinline__ void row_ln(f32x4 (&v)[4], const float* g, const float* b, int lane) {
  float s = 0.f;
#pragma unroll
  for (int i = 0; i < 4; ++i) s += (v[i][0] + v[i][1]) + (v[i][2] + v[i][3]);
  const float mean = wave_sum(s) * (1.f / 1024.f); float q = 0.f;
#pragma unroll
  for (int i = 0; i < 4; ++i) { v[i] -= mean; q += (v[i][0] * v[i][0] + v[i][1] * v[i][1]) + (v[i][2] * v[i][2] + v[i][3] * v[i][3]); }
  const float rs = __builtin_amdgcn_rsqf(wave_sum(q) * (1.f / 1024.f) + 1e-5f);
#pragma unroll
  for (int i = 0; i < 4; ++i) { const f32x4 gg = *(const f32x4*)(g + 4 * lane + 256 * i), bb = *(const f32x4*)(b + 4 * lane + 256 * i); v[i] = v[i] * rs * gg + bb; }
}
__device__ __forceinline__ void row_mod(f32x4 (&h)[4], const f32x4 (&v)[4], const float* modrow, int shift_idx, int scale_idx, int lane) {
#pragma unroll
  for (int i = 0; i < 4; ++i) { const f32x4 sc = *(const f32x4*)(modrow + scale_idx * 1024 + 4 * lane + 256 * i), sh = *(const f32x4*)(modrow + shift_idx * 1024 + 4 * lane + 256 * i); h[i] = v[i] * (1.f + sc) + sh; }
}
__device__ __forceinline__ int modrow_of_row(int r) { return r < NLAT ? (r >> 11) : 8; }

__device__ __forceinline__ void h0_phase(KP p, const int g_wv) {
  const int tid = otid(); const int lane = tid & 63, gw = obid() * 8 + (tid >> 6), nw = ogd() * 8;
  for (int r = gw; r < NR; r += nw) {
    const float* src = r < NLAT ? p.in.x + (size_t)r * D : p.in.ctx + (size_t)(r - NLAT) * D;
    f32x4 v[4], h[4]; row_ld(src, lane, v); row_mod(h, v, p.MOD + (size_t)modrow_of_row(r) * 6144, 0, 1, lane); row_st_bf16(p.Hb + (size_t)r * D, lane, h); }
}
constexpr int LN1_RS = 1032, LN1_HXB = 32 * LN1_RS * 2, LN1_OFF_LCNT = 2 * LN1_HXB, LN1_OFF_LBASE = LN1_OFF_LCNT + 128, LN1_OFF_ENT = LN1_OFF_LBASE + 128, LN1_END = LN1_OFF_ENT + 72 * 16;
__device__ __forceinline__ void ln1_phase(KP p, int l, LAS char* lds, const int g_wv) {
  const int tid = otid(), lane = tid & 63, wid = tid >> 6, gw = obid() * 8 + wid; const bool last = (l == DEPTH - 1);
  LAS bf16_t* HXhi = (LAS bf16_t*)lds; LAS bf16_t* HXlo = (LAS bf16_t*)(lds + LN1_HXB); LAS float* RED = (LAS float*)lds;
  LAS int* lcnt = (LAS int*)(lds + LN1_OFF_LCNT); LAS int* lbase = (LAS int*)(lds + LN1_OFF_LBASE); LAS int* ent = (LAS int*)(lds + LN1_OFF_ENT);
  if (tid < 32) lcnt[tid] = 0;
  const float* MODl = p.MOD + (size_t)l * 9 * 6144; const bf16_t* WRh = (const bf16_t*)p.s[l].WR; const bf16_t* WRl = WRh + 64 * 1024;
  const int nrow = last ? NLAT : NR, ni = nrow / 2048; const int c32 = lane & 31, hh = lane >> 5;
#pragma unroll 1
  for (int i0 = 0; i0 < ni; i0 += 3) {
#pragma unroll
    for (int j = 0; j < 3; ++j) { const int r = gw + 2048 * (i0 + j); const int slot = wid * 3 + j;
      if (i0 + j < ni) { f32x4 v[4], h[4]; row_ld(p.XL + (size_t)r * D, lane, v); row_ln(v, p.in.ln1_g + l * D, p.in.ln1_b + l * D, lane); row_st(p.XL + (size_t)r * D, lane, v);
        row_mod(h, v, MODl + (size_t)modrow_of_row(r) * 6144, 3, 4, lane);
#pragma unroll
        for (int q = 0; q < 4; ++q) { u32x2 wh; wh.x = cvt_pk_bf16(h[q][0], h[q][1]); wh.y = cvt_pk_bf16(h[q][2], h[q][3]); *(u32x2*)(p.H2b + (size_t)r * D + 4 * lane + 256 * q) = wh;
          u32x2 wl; wl.x = cvt_pk_bf16(h[q][0] - bflo(wh.x), h[q][1] - bfhi(wh.x)); wl.y = cvt_pk_bf16(h[q][2] - bflo(wh.y), h[q][3] - bfhi(wh.y));
          *(LAS u32x2*)(HXhi + slot * LN1_RS + 4 * lane + 256 * q) = wh; *(LAS u32x2*)(HXlo + slot * LN1_RS + 4 * lane + 256 * q) = wl; } }
      else {
#pragma unroll
        for (int q = 0; q < 4; ++q) { *(LAS u32x2*)(HXhi + slot * LN1_RS + 4 * lane + 256 * q) = (u32x2){0u, 0u}; *(LAS u32x2*)(HXlo + slot * LN1_RS + 4 * lane + 256 * q) = (u32x2){0u, 0u}; } } }
    __syncthreads();
    f32x16 acc0 = {}, acc1 = {};
#pragma unroll 2
    for (int s8 = 0; s8 < 8; ++s8) { const int ko = (wid * 8 + s8) * 16 + hh * 8;
      const bf16x8 bh = *(const LAS bf16x8*)(HXhi + c32 * LN1_RS + ko), bl = *(const LAS bf16x8*)(HXlo + c32 * LN1_RS + ko);
      const bf16x8 ah0 = *(const bf16x8*)(WRh + (size_t)c32 * 1024 + ko), al0 = *(const bf16x8*)(WRl + (size_t)c32 * 1024 + ko);
      const bf16x8 ah1 = *(const bf16x8*)(WRh + (size_t)(32 + c32) * 1024 + ko), al1 = *(const bf16x8*)(WRl + (size_t)(32 + c32) * 1024 + ko);
      acc0 = __builtin_amdgcn_mfma_f32_32x32x16_bf16(ah0, bh, acc0, 0, 0, 0); acc0 = __builtin_amdgcn_mfma_f32_32x32x16_bf16(ah0, bl, acc0, 0, 0, 0); acc0 = __builtin_amdgcn_mfma_f32_32x32x16_bf16(al0, bh, acc0, 0, 0, 0);
      acc1 = __builtin_amdgcn_mfma_f32_32x32x16_bf16(ah1, bh, acc1, 0, 0, 0); acc1 = __builtin_amdgcn_mfma_f32_32x32x16_bf16(ah1, bl, acc1, 0, 0, 0); acc1 = __builtin_amdgcn_mfma_f32_32x32x16_bf16(al1, bh, acc1, 0, 0, 0); }
    __syncthreads();
#pragma unroll
    for (int r = 0; r < 16; ++r) { RED[(wid * 64 + crow(r, hh)) * 32 + c32] = acc0[r]; RED[(wid * 64 + 32 + crow(r, hh)) * 32 + c32] = acc1[r]; }
    __syncthreads();
    { LAS float* SUM = (LAS float*)(lds + LN1_HXB);
#pragma unroll
      for (int k = 0; k < 4; ++k) { const int idx = tid + 512 * k; float sacc = 0.f;
#pragma unroll
        for (int w = 0; w < 8; ++w) sacc += RED[w * 2048 + idx];
        SUM[idx] = sacc; } }
    __syncthreads();
    if (wid == 0 && lane < 24) { const int ws = lane / 3, j = lane - 3 * ws;
      if (i0 + j < ni) { const int r = obid() * 8 + ws + 2048 * (i0 + j); float lg[36]; const LAS float* SUM = (const LAS float*)(lds + LN1_HXB);
#pragma unroll
        for (int e = 0; e < 36; ++e) lg[e] = SUM[e * 32 + lane] + (e < 4 ? p.in.rg_b[l * 4 + e] : p.in.re_b[l * 32 + e - 4]);
        int gi = 0; float gm = lg[0];
#pragma unroll
        for (int q = 1; q < 4; ++q) if (lg[q] > gm) { gm = lg[q]; gi = q; }
        float gs = 0.f;
#pragma unroll
        for (int q = 0; q < 4; ++q) gs += expf(lg[q] - gm);
        const float gtop = 1.f / gs; float el[8];
#pragma unroll
        for (int q = 0; q < 8; ++q) el[q] = gi == 0 ? lg[4 + q] : gi == 1 ? lg[12 + q] : gi == 2 ? lg[20 + q] : lg[28 + q];
        int i0e = 0; float v0 = el[0];
#pragma unroll
        for (int q = 1; q < 8; ++q) if (el[q] > v0) { v0 = el[q]; i0e = q; }
        int i1e = -1; float v1 = -3.0e38f;
#pragma unroll
        for (int q = 0; q < 8; ++q) if (q != i0e && el[q] > v1) { v1 = el[q]; i1e = q; }
        const float e1 = expf(v1 - v0); const float w0 = gtop / (1.f + e1), w1 = gtop * e1 / (1.f + e1);
        const int e0i = gi * 8 + i0e, e1i = gi * 8 + i1e;
        const int lr0 = __hip_atomic_fetch_add(&lcnt[e0i], 1, __ATOMIC_RELAXED, __HIP_MEMORY_SCOPE_WORKGROUP); const int lr1 = __hip_atomic_fetch_add(&lcnt[e1i], 1, __ATOMIC_RELAXED, __HIP_MEMORY_SCOPE_WORKGROUP);
        { LAS int* ep = ent + ((i0 + j) * 8 + ws) * 4; ep[0] = e0i; ep[1] = e1i; ep[2] = lr0; ep[3] = lr1; } *(float2*)(p.RW + (size_t)r * 2) = make_float2(w0, w1); } }
    __syncthreads();
  }
  if (tid < 32) lbase[tid] = (int)atomicAdd(p.ctl + l * CTL_WORDS + CTL_CNT + 64 * tid, (unsigned)lcnt[tid]);
  __syncthreads();
  if (tid < ni * 8) { const int i = tid >> 3, w = tid & 7; const int r = obid() * 8 + w + 2048 * i; const LAS int* ep = ent + tid * 4; const int4 en = make_int4(ep[0], ep[1], ep[2], ep[3]); const int g0 = lbase[en.x] + en.z, g1 = lbase[en.y] + en.w;
    p.TOK[(size_t)en.x * NR + g0] = r; p.TOK[(size_t)en.y * NR + g1] = r; *(int4*)(p.ROUTE + (size_t)r * 4) = make_int4(en.x, en.y, g0, g1); }
}
__device__ __forceinline__ void moe_table(KP p, int l, LAS MoeTab* tab, const int g_wv) {
  const int tid = otid();
  if (tid < 32) tab->cnt[tid] = (int)__hip_atomic_load(p.ctl + l * CTL_WORDS + CTL_CNT + 64 * tid, __ATOMIC_RELAXED, __HIP_MEMORY_SCOPE_AGENT);
  __syncthreads();
  if (tid == 0) { int t = 0; for (int e = 0; e < 32; ++e) { const int c = tab->cnt[e]; tab->tbase[e] = t; const int n = (c + 255) >> 8; for (int i = 0; i < n; ++i) { tab->tileE[t] = e; tab->tileR0[t] = i * 256; ++t; } } tab->tbase[32] = t; tab->ntiles = t; }
  __syncthreads();
}
__device__ __forceinline__ void ln2_phase(KP p, int l, LAS char* lds, const int g_wv) {
  const int tid = otid(), lane = tid & 63, wid = tid >> 6, gw = obid() * 8 + wid; const bool last = (l == DEPTH - 1);
  LAS MoeTab* tab = (LAS MoeTab*)lds; moe_table(p, l, tab, g_wv);
  const float* MODl = p.MOD + (size_t)l * 9 * 6144; const int ni = last ? NLAT / 2048 : NR / 2048;
  int4 rt[9]; float2 rw[9];
#pragma unroll
  for (int i = 0; i < 9; ++i) if (i < ni) { const int r = gw + 2048 * i; rt[i] = *(const int4*)(p.ROUTE + (size_t)r * 4); rw[i] = *(const float2*)(p.RW + (size_t)r * 2); }
  f32x4 v[4]; u32x2 ya[4], yb[4];
#define LN2_LOAD(i) do { const int r_ = gw + 2048 * (i); const int p0_ = (tab->tbase[rt[i].x] + (rt[i].z >> 8)) * 256 + (rt[i].z & 255), p1_ = (tab->tbase[rt[i].y] + (rt[i].w >> 8)) * 256 + (rt[i].w & 255); \
    row_ld(p.XL + (size_t)r_ * D, lane, v); _Pragma("unroll") for (int q_ = 0; q_ < 4; ++q_) { ya[q_] = *(const u32x2*)(p.Yo + (size_t)p0_ * D + 4 * lane + 256 * q_); yb[q_] = *(const u32x2*)(p.Yo + (size_t)p1_ * D + 4 * lane + 256 * q_); } } while (0)
  LN2_LOAD(0);
#pragma unroll
  for (int i = 0; i < 9; ++i) if (i < ni) { const int r = gw + 2048 * i; const float2 w = rw[i]; f32x4 x[4];
    const float* mr = MODl + (size_t)modrow_of_row(r) * 6144;
#pragma unroll
    for (int q = 0; q < 4; ++q) { const f32x4 g2 = *(const f32x4*)(mr + 5 * 1024 + 4 * lane + 256 * q); const f32x4 y0 = (f32x4){bflo(ya[q].x), bfhi(ya[q].x), bflo(ya[q].y), bfhi(ya[q].y)}, y1 = (f32x4){bflo(yb[q].x), bfhi(yb[q].x), bflo(yb[q].y), bfhi(yb[q].y)};
      x[q] = v[q] * ALPHA + g2 * (y0 * w.x + y1 * w.y); }
    if (i + 1 < ni) LN2_LOAD(i + 1);
    row_ln(x, p.in.ln2_g + l * D, p.in.ln2_b + l * D, lane);
    if (!last) { row_st(p.XL + (size_t)r * D, lane, x); f32x4 h[4]; row_mod(h, x, p.MOD + ((size_t)(l + 1) * 9 + modrow_of_row(r)) * 6144, 0, 1, lane); row_st_bf16(p.Hb + (size_t)r * D, lane, h); }
    else row_st(p.out + (size_t)r * D, lane, x); }
#undef LN2_LOAD
}
__device__ __forceinline__ void s2_phase(KP p, int l, const int g_wv) {
  const int tid = otid(); if (tid >= 128) return;
  const int g = obid() >> 3, b = obid() & 7, dir = tid >> 6, pp = tid & 63;
  const f32x2 aL = *(const f32x2*)(p.s[l].SAL + ((size_t)(g * 2 + dir) * 64 + pp) * 2);
  const float* S = p.SST + (size_t)g * NCHP * 256 + dir * 128 + 2 * pp; bf16_t* A = p.Ug + (size_t)g * NCHP * 768 + 512 + dir * 128 + 2 * pp;
  float hr = 0.f, hi = 0.f;
#pragma unroll 1
  for (int s0 = 0; s0 < 72; s0 += 24) {
    f32x2 sv[24];
#pragma unroll
    for (int k = 0; k < 24; ++k) { const int s = s0 + k; int row; if (dir == 0) row = s < 8 ? 512 + b * 8 + s : b * 64 + (s - 8); else row = s < 8 ? 512 + b * 8 + (7 - s) : b * 64 + (63 - (s - 8));
      sv[k] = *(const f32x2*)(S + (size_t)row * 256); }
#pragma unroll
    for (int k = 0; k < 24; ++k) { const int s = s0 + k; int row; if (dir == 0) row = s < 8 ? 512 + b * 8 + s : b * 64 + (s - 8); else row = s < 8 ? 512 + b * 8 + (7 - s) : b * 64 + (63 - (s - 8));
      *(unsigned*)(A + (size_t)row * 768) = cvt_pk_bf16(hr, hi);
      const float nr = aL.x * hr - aL.y * hi + sv[k].x, ni = aL.x * hi + aL.y * hr + sv[k].y; hr = nr; hi = ni; }
  }
}

struct ConvJob { const float* src; const float* src2; bf16_t* dst; int ldd, lds_, kind, nK; };
__device__ __forceinline__ void conv_step(const ConvJob& j, int nt, int kt, int lane) {
  const int q = lane & 15, kq = lane >> 4; const int n = nt * 64 + 4 * q, k0 = kt * 64 + kq * 8; const float* s = j.src; int col;
  if (j.kind == 0) col = (n & ~31) + perm32(n & 31);
  else if (j.kind == 1) { const int pn = n >> 8; if (pn < 4 || (pn >= 10 && pn < 14)) col = n; else if (pn < 10) col = (n & ~31) + perm32(n & 31);
    else { const int bj = (n >> 7) & 1, w = n & 127; col = (bj ? 4608 : 3584) + (pn - 14) * 128 + (w & ~31) + perm32(w & 31); } }
  else { const int bj = (n >> 7) & 1, w = n & 127; col = (n >> 8) * 128 + (w & ~31) + perm32(w & 31); if (bj) s = j.src2; }
  const float* sp = s + (size_t)k0 * j.lds_ + col; f32x4 v[16];
#pragma unroll
  for (int i = 0; i < 8; ++i) { v[i] = *(const f32x4*)(sp + (size_t)i * j.lds_); v[8 + i] = *(const f32x4*)(sp + (size_t)(32 + i) * j.lds_); }
  bf16_t* dp = j.dst + (size_t)n * j.ldd + k0;
#pragma unroll
  for (int r = 0; r < 4; ++r) {
    *(u32x4*)(dp + (size_t)r * j.ldd) = pack8((f32x4){v[0][r], v[1][r], v[2][r], v[3][r]}, (f32x4){v[4][r], v[5][r], v[6][r], v[7][r]});
    *(u32x4*)(dp + (size_t)r * j.ldd + 32) = pack8((f32x4){v[8][r], v[9][r], v[10][r], v[11][r]}, (f32x4){v[12][r], v[13][r], v[14][r], v[15][r]}); }
}
__device__ __forceinline__ void ssm_mats(KP p, KS W, int l, int g, int hf, LAS char* lds, const int g_wv) {
  const int tid = otid();
  LAS f32x2* AP = (LAS f32x2*)lds;
  LAS f32x2* BB = AP + 2 * 64 * 34;
  LAS f32x2* CC = BB + 2 * 64 * 16;
  LAS float* KT = (LAS float*)(CC + 2 * 16 * 64);
  const size_t so = (size_t)l * 2 * NG * NP;
  if (tid < 128) { const int dir = tid >> 6, pp = tid & 63; const size_t gp = so + ((size_t)dir * NG + g) * NP + pp;
    const float dtf = expf(p.in.log_dt[(size_t)l * 2 * NG + dir * NG + g]); const double are = p.in.a_re[gp], aim = p.in.a_im[gp], dt = (double)dtf;
    double ang = aim * dt; ang -= 6.283185307179586476925 * (double)(long long)(ang * 0.15915494309189533577 + (ang >= 0 ? 0.5 : -0.5));
    const float e1f = expf((float)(are * dt)), angf = (float)ang; const double c1r = (double)(e1f * cosf(angf)), c1i = (double)(e1f * sinf(angf));
    { float onef = 1.f; asm volatile("" : "+v"(onef)); double cr = (double)onef, ci = 0.0;
      for (int t = 0; t < 34; ++t) { AP[(dir * 64 + pp) * 34 + t] = (f32x2){(float)cr, (float)ci}; if (t == 32 && hf == 0) *(f32x2*)(W.SAL + ((size_t)(g * 2 + dir) * 64 + pp) * 2) = (f32x2){(float)cr, (float)ci}; const double nr2 = cr * c1r - ci * c1i, ni2 = cr * c1i + ci * c1r; cr = nr2; ci = ni2; } }
    const float sh = sinf(0.5f * angf); const double nr = (double)(expm1f((float)(are * dt)) * cosf(angf) - 2.f * sh * sh), ni = c1i, den = are * are + aim * aim; const double fr = (nr * are + ni * aim) / den, fi = (ni * are - nr * aim) / den;
    for (int c = 0; c < 16; ++c) { const double br = p.in.b_re[gp * 16 + c], bi = p.in.b_im[gp * 16 + c]; BB[(dir * 64 + pp) * 16 + c] = (f32x2){(float)(fr * br - fi * bi), (float)(fr * bi + fi * br)}; }
  }
  for (int i = tid; i < 2 * 16 * 64; i += 512) { const int dir = i >> 10, c = (i >> 6) & 15, pp = i & 63; const size_t ci = (so + ((size_t)dir * NG + g) * NP) * 16 + (size_t)c * NP + pp; CC[i] = (f32x2){p.in.c_re[ci], p.in.c_im[ci]}; }
  __syncthreads();
  LAS float* K0o = KT + 32 * 260;
  { const int own = tid < 256, dir = own ? hf : 1 - hf, co = (tid >> 4) & 15, ci = tid & 15; float acc[32];
#pragma unroll
    for (int t = 0; t < 32; ++t) acc[t] = 0.f;
    if (own) {
      for (int pp = 0; pp < 64; ++pp) { const f32x2 c = CC[(dir * 16 + co) * 64 + pp], bq = BB[(dir * 64 + pp) * 16 + ci]; const float cbr = c.x * bq.x - c.y * bq.y, cbi = c.x * bq.y + c.y * bq.x;
        const LAS f32x4* ap = (const LAS f32x4*)(AP + (dir * 64 + pp) * 34);
#pragma unroll
        for (int t2 = 0; t2 < 16; ++t2) { const f32x4 a = ap[t2]; acc[2 * t2] += cbr * a[0] - cbi * a[1]; acc[2 * t2 + 1] += cbr * a[2] - cbi * a[3]; } }
#pragma unroll
      for (int t = 0; t < 32; ++t) KT[t * 260 + co * 16 + ci] = acc[t];
    } else { float s0 = 0.f;
      for (int pp = 0; pp < 64; ++pp) { const f32x2 c = CC[(dir * 16 + co) * 64 + pp], bq = BB[(dir * 64 + pp) * 16 + ci]; s0 += c.x * bq.x - c.y * bq.y; }
      K0o[co * 16 + ci] = s0; } }
  __syncthreads();
  bf16_t* Sm = W.Smat + (size_t)g * 256 * 768;
  for (int i = tid; i < 128 * 64; i += 512) { const int n = hf * 128 + (i >> 6), k8 = (i & 63) * 8; const int Lc = (n & ~31) + perm32(n & 31); const int dir = Lc >> 7, pp = (Lc & 127) >> 1, ri = Lc & 1; const int t = k8 >> 4, c0 = k8 & 15;
    const f32x2 a = AP[(dir * 64 + pp) * 34 + (dir == 0 ? 31 - t : t)]; float v[8];
#pragma unroll
    for (int q = 0; q < 8; ++q) { const f32x2 bq = BB[(dir * 64 + pp) * 16 + c0 + q]; v[q] = ri == 0 ? a.x * bq.x - a.y * bq.y : a.x * bq.y + a.y * bq.x; }
    *(u32x4*)(Sm + (size_t)n * 768 + k8) = pack8((f32x4){v[0], v[1], v[2], v[3]}, (f32x4){v[4], v[5], v[6], v[7]}); }
  bf16_t* To = W.TO + (size_t)g * 512 * 768; const float* dsk = p.in.ssm_d + l * SSMW + g * 16;
  for (int i = tid; i < 512 * 96; i += 512) { const int n = i / 96, k8 = (i % 96) * 8; const int Lc = (n & ~31) + perm32(n & 31); const int t = Lc >> 4, co = Lc & 15; f32x4 v0, v1;
    if (k8 < 512) { const int s = k8 >> 4, c0 = k8 & 15; if (hf == 0 ? s > t : s <= t) continue;
      const int tau = hf == 0 ? t - s : s - t; const LAS f32x4* kk = (const LAS f32x4*)(KT + tau * 260 + co * 16 + c0); v0 = kk[0]; v1 = kk[1];
      if (s == t) { const LAS f32x4* ko = (const LAS f32x4*)(K0o + co * 16 + c0); v0 += ko[0]; v1 += ko[1]; const float dv = dsk[co]; const int qd = co - c0;
#pragma unroll
        for (int q = 0; q < 4; ++q) { if (qd == q) v0[q] += dv; if (qd == 4 + q) v1[q] += dv; } } }
    else { const int hc0 = k8 - 512; const int dir = hc0 >> 7, pp0 = (hc0 & 127) >> 1; if (dir != hf) continue; float v[8];
#pragma unroll
      for (int q = 0; q < 4; ++q) { const f32x2 a = AP[(dir * 64 + pp0 + q) * 34 + (dir == 0 ? t + 1 : 32 - t)], c = CC[(dir * 16 + co) * 64 + pp0 + q];
        v[2 * q] = c.x * a.x - c.y * a.y; v[2 * q + 1] = -(c.x * a.y + c.y * a.x); }
      v0 = (f32x4){v[0], v[1], v[2], v[3]}; v1 = (f32x4){v[4], v[5], v[6], v[7]}; }
    *(u32x4*)(To + (size_t)n * 768 + k8) = pack8(v0, v1); }
  __syncthreads();
}
__device__ __forceinline__ void mod_item(KP p, int l, int j0, LAS char* lds, const int g_wv) {
  const int tid = otid(); LAS float* sl = (LAS float*)lds;
  LAS float* part = sl + 9 * 1024;
  for (int i = tid; i < 9 * 1024; i += 512) { const int r = i >> 10, k = i & 1023; const float v = r < 8 ? p.in.c[r * 1024 + k] : p.in.c_ctx[k]; sl[i] = v / (1.f + expf(-v)); }
  __syncthreads();
  const int jj = tid & 63, ks = tid >> 6; float acc[9];
#pragma unroll
  for (int r = 0; r < 9; ++r) acc[r] = 0.f;
  const float* w = p.in.w_mod + (size_t)l * 1024 * 6144 + j0 + jj;
  for (int k = ks * 128; k < ks * 128 + 128; ++k) { const float wv = w[(size_t)k * 6144];
#pragma unroll
    for (int r = 0; r < 9; ++r) acc[r] += sl[r * 1024 + k] * wv; }
#pragma unroll
  for (int r = 0; r < 9; ++r) part[(ks * 9 + r) * 64 + jj] = acc[r];
  __syncthreads();
  for (int i = tid; i < 9 * 64; i += 512) { const int r = i >> 6, j = i & 63; float s = 0.f;
#pragma unroll
    for (int k = 0; k < 8; ++k) s += part[(k * 9 + r) * 64 + j];
    p.MOD[((size_t)l * 9 + r) * 6144 + j0 + j] = s + p.in.b_mod[l * 6144 + j0 + j]; }
  __syncthreads();
}
__device__ __forceinline__ void conv_steps(KP p, KW W, int l, int s0, int s1, int gw, int nw, int lane) {
  for (int t0 = s0 + gw; t0 < s1; t0 += nw) { int t = t0; ConvJob j; int nK;
    if (t < 1408) { j.src = p.in.w_in + (size_t)l * 1024 * INW; j.src2 = nullptr; j.dst = W.Win; j.ldd = 1024; j.lds_ = INW; j.kind = 1; nK = 16; }
    else if ((t -= 1408) < 64) { j.src = p.in.w_glu + (size_t)l * 512 * 512; j.src2 = nullptr; j.dst = W.Wglu; j.ldd = 512; j.lds_ = 512; j.kind = 0; nK = 8; }
    else if ((t -= 64) < 256) { j.src = p.in.w_pa + (size_t)l * 1024 * 1024; j.src2 = nullptr; j.dst = W.Wpa; j.ldd = 1024; j.lds_ = 1024; j.kind = 0; nK = 16; }
    else if ((t -= 256) < 128) { j.src = p.in.w_ps + (size_t)l * 512 * 1024; j.src2 = nullptr; j.dst = W.Wps; j.ldd = 1024; j.lds_ = 1024; j.kind = 0; nK = 8; }
    else if ((t -= 128) < 256) { j.src = p.in.w_o + (size_t)l * 1024 * 1024; j.src2 = nullptr; j.dst = W.Wo; j.ldd = 1024; j.lds_ = 1024; j.kind = 0; nK = 16; }
    else if ((t -= 256) < 8192) { const int e = t >> 8; t &= 255; j.src = p.in.w1 + ((size_t)l * NE + e) * 1024 * 512; j.src2 = p.in.w3 + ((size_t)l * NE + e) * 1024 * 512; j.dst = W.W13 + (size_t)e * 1024 * 1024; j.ldd = 1024; j.lds_ = 512; j.kind = 2; nK = 16; }
    else { t -= 8192; const int e = t >> 7; t &= 127; j.src = p.in.w2 + ((size_t)l * NE + e) * 512 * 1024; j.src2 = nullptr; j.dst = W.W2 + (size_t)e * 1024 * 512; j.ldd = 512; j.lds_ = 1024; j.kind = 0; nK = 8; }
    conv_step(j, t / nK, t % nK, lane); }
}
__device__ __forceinline__ void router_tab(KP p, KS W, int l, int tid) {
  bf16_t* Wh = (bf16_t*)W.WR; bf16_t* Wl = Wh + 64 * 1024;
  for (int q = tid; q < 64 * 1024; q += 512) { const int e = q >> 10, k = q & 1023; const float w = e < 4 ? p.in.rg_w[((size_t)l * 1024 + k) * 4 + e] : e < 36 ? p.in.re_w[((size_t)l * 1024 + k) * 32 + (e - 4)] : 0.f;
    const unsigned hi = cvt_pk_bf16(w, 0.f) & 0xffffu; const unsigned lo = cvt_pk_bf16(w - bflo(hi), 0.f) & 0xffffu; Wh[q] = (bf16_t)hi; Wl[q] = (bf16_t)lo; }
}
constexpr int CONV_STEPS = 14400, CONV_S1 = 2350, CONV_S2 = 9550;
__device__ __forceinline__ void conv_phase(KP p, int l, LAS char* lds, const int g_wv) {
  const int tid = otid(); const int b = obid(); const int nb = ogd();
  for (int it = b; it < DEPTH * 2 * NG; it += nb) { const int ls = it >> 6, r = it & 63; ssm_mats(p, p.s[ls], ls, r >> 1, r & 1, lds, g_wv); }
  if (b < DEPTH) router_tab(p, p.s[b], b, tid);
  if (b == 4) { for (int q = tid; q < 2048 * 32; q += 512) { const int t = q >> 5, axis = (q >> 4) & 1, f = q & 15; const float pos = axis == 0 ? (float)(t >> 6) : (float)(t & 63);
      const float inv = 1.0f / powf(10000.0f, (float)(2 * f) / 32.0f); const float ang = pos * inv; p.ROPE[((size_t)t * 2 + axis) * 32 + f] = cosf(ang); p.ROPE[((size_t)t * 2 + axis) * 32 + 16 + f] = sinf(ang); } }
  for (int it = b; it < 4 * 96; it += nb) mod_item(p, it / 96, (it % 96) * 64, lds, g_wv);
  conv_steps(p, p.w[0], 0, 0, CONV_STEPS, b * 8 + (tid >> 6), nb * 8, tid & 63);
}
__device__ __forceinline__ void conv_tail(KP p, int l, int part, const int g_wv) {
  const int b = obid(); if (l >= DEPTH - 1) return;
  const int tid = otid(); const int ln = l + 1; KW W = p.w[ln & 1];
  if (part == 2) { if (b >= 144) conv_steps(p, W, ln, 0, CONV_S1, (b - 144) * 8 + (tid >> 6), (ogd() - 144) * 8, tid & 63); return; }
  if (b < 32) return;
  if (part == 0) conv_steps(p, W, ln, CONV_S1, CONV_S2, (b - 32) * 8 + (tid >> 6), (ogd() - 32) * 8, tid & 63);
  else conv_steps(p, W, ln, CONV_S2, CONV_STEPS, (b - 32) * 8 + (tid >> 6), (ogd() - 32) * 8, tid & 63);
}
}
namespace fk {
constexpr int LDS_BYTES = 149504;
#ifndef PROBE_MASK
#define PROBE_MASK 0
#endif
constexpr int NPH = 14;
enum { PH_CONV = 0, PH_H0, PH_GEMM1, PH_S1, PH_S2, PH_S3, PH_ATT, PH_GLU, PH_MERGE, PH_WO, PH_LN1, PH_MOE1, PH_MOE2, PH_LN2 };

__device__ __forceinline__ void run_phase(KP p, int l, int ph, LAS unsigned char* lds, const int g_wv) {
  const int G = ogd(), c = obid(); const bool last = (l == DEPTH - 1);
  const float* MODl = p.MOD + (size_t)l * 9 * 6144; KW W = p.w[l & 1]; KS SS = p.s[l];
  switch (ph) {
    case PH_CONV: if (l == 0) conv_phase(p, l, (LAS char*)lds, g_wv); break;
    case PH_H0: if (l == 0) h0_phase(p, g_wv); break;
    case PH_GEMM1: { SchedG1 S{(const char*)p.Hb, (const char*)W.Win, G, c, 0, last ? 1488 : 1536, last};
      EpiIn E{p.ROPE, p.Kc, p.Vc, p.Ug, p.Qb, p.RG, p.GSb}; gemm_stream(lds, 2048, 2048, S, E, g_wv); } break;
    case PH_S1: if (c < 96) { SchedSsm1 S{(const char*)p.Ug, (const char*)SS.Smat, 96, c}; EpiState E{p.SST}; gemm_stream(lds, 1536, 1536, S, E, g_wv); }
      else if (!last && c < 144) { SchedG1 S{(const char*)p.Hb, (const char*)W.Win, 48, c - 96, 1536, 1584, false}; EpiIn E{p.ROPE, p.Kc, p.Vc, p.Ug, p.Qb, p.RG, p.GSb}; gemm_stream(lds, 2048, 2048, S, E, g_wv); }
      else conv_tail(p, l, 2, g_wv);
      break;
    case PH_S2: s2_phase(p, l, g_wv); break;
    case PH_S3: { SchedSsm3 S{(const char*)p.Ug, (const char*)SS.TO, G, c}; EpiSsmOut E{p.YG}; gemm_stream(lds, 1536, 1536, S, E, g_wv); } break;
    case PH_ATT: attn_phase(p, l, (LAS char*)lds, g_wv); break;
    case PH_GLU: { SchedPlain S; S.A = (const char*)p.YG; S.B = (const char*)W.Wglu; S.lda = NR * 32; S.ldb = 1024; S.nM = last ? NLAT / 256 : NR / 256; S.nN = 2; S.nt = 8; S.G = G; S.c = c; S.nunits = S.nM * 2; S.epi = 1; S.atile = 256 * 32;
      EpiGlu E{p.YG, p.S2, p.in.b_glu + l * SSMW}; gemm_stream<EpiGlu, SchedPlain, false, 1>(lds, NR * 32, 1024, S, E, g_wv); } break;
    case PH_MERGE: { SchedMerge S{(const char*)p.ATTb, (const char*)W.Wpa, (const char*)p.S2, (const char*)W.Wps, last ? NLAT / 256 : NR / 256, 4, G, c, (last ? NLAT / 256 : NR / 256) * 4};
      EpiMerge E{p.RG, p.GSb, p.Mb}; gemm_stream(lds, 2048, 2048, S, E, g_wv); } conv_tail(p, l, 0, g_wv); break;
    case PH_WO: { SchedPlain S; S.A = (const char*)p.Mb; S.B = (const char*)W.Wo; S.lda = 2048; S.ldb = 2048; S.nM = last ? NLAT / 256 : NR / 256; S.nN = 4; S.nt = 16; S.G = G; S.c = c; S.nunits = S.nM * 4; S.epi = 1; S.atile = 256 * 2048;
      EpiWo E{l == 0 ? p.in.x : p.XL, l == 0 ? p.in.ctx : p.XL + (size_t)NLAT * D, p.XL, MODl}; gemm_stream(lds, 2048, 2048, S, E, g_wv); } conv_tail(p, l, 1, g_wv); break;
    case PH_LN1: ln1_phase(p, l, (LAS char*)lds, g_wv); break;
    case PH_MOE1: { LAS MoeTab* tab = (LAS MoeTab*)(lds + STAGE_BYTES); moe_table(p, l, tab, g_wv);
      SchedMoe S{(const char*)p.H2b, (const char*)W.W13, 2048, 2048, (size_t)1024 * 2048, tab, p.TOK, 4, 16, G, c, true}; EpiMoe1 E{p.Hm}; gemm_stream<EpiMoe1, SchedMoe, true>(lds, 2048, 2048, S, E, g_wv); } break;
    case PH_MOE2: { LAS MoeTab* tab = (LAS MoeTab*)(lds + STAGE_BYTES); moe_table(p, l, tab, g_wv);
      SchedMoe S{(const char*)p.Hm, (const char*)W.W2, 1024, 1024, (size_t)1024 * 1024, tab, p.TOK, 4, 8, G, c, false}; EpiMoe2 E{p.Yo}; gemm_stream(lds, 1024, 1024, S, E, g_wv); } break;
    case PH_LN2: ln2_phase(p, l, (LAS char*)lds, g_wv); break;
  }
}

__global__ void __launch_bounds__(512, 2) mega(Params p) {
  extern __shared__ __attribute__((aligned(16))) unsigned char smem[];
  LAS unsigned char* lds = (LAS unsigned char*)smem;
  LAS unsigned* xbw = (LAS unsigned*)(lds + LDS_BYTES - 16);
  if (threadIdx.x == 0) { xbw[0] = 0u; xbw[1] = 0u; xbw[2] = 0u; xbw[3] = 0u; }
  __syncthreads();
  XcdBarrier bar = xcd_barrier_post(p.bar, (volatile LAS unsigned*)xbw);
  const int ph_lo = p.ph_lo, ph_hi = p.ph_hi; const int g_wv = __builtin_amdgcn_readfirstlane((int)threadIdx.x >> 6);
  for (int l = 0; l < DEPTH; ++l) {
#define PHASE(ID) do { const int gph = l * NPH + (ID); if (gph >= ph_lo && gph < ph_hi && !(((ID) == PH_H0 || (ID) == PH_CONV) && l > 0)) { \
      const __attribute__((address_space(4))) Params* kp = (const __attribute__((address_space(4))) Params*)__builtin_amdgcn_kernarg_segment_ptr(); int lv = l; int wvp = g_wv; \
      asm volatile("" : "+s"(kp), "+s"(lv), "+s"(wvp));     \
      run_phase(*kp, lv, (ID), lds, wvp); if (gph + 1 < ph_hi) xcd_barrier(bar); } } while (0)
    PHASE(PH_CONV); PHASE(PH_H0); PHASE(PH_GEMM1); PHASE(PH_S1); PHASE(PH_S2); PHASE(PH_S3); PHASE(PH_ATT); PHASE(PH_GLU); PHASE(PH_MERGE); PHASE(PH_WO);
    PHASE(PH_LN1); PHASE(PH_MOE1); PHASE(PH_MOE2); PHASE(PH_LN2);
#undef PHASE
  }
}

struct Host { Params p; size_t ws_used; };
inline size_t al256(size_t x) { return (x + 255) & ~(size_t)255; }
inline Host make_params(void* const* d_in, void* d_out, void* d_ws) {
  Host H; memset(&H, 0, sizeof(H)); Params& p = H.p;
  const float** ip = (const float**)&p.in; for (int i = 0; i < 36; ++i) ip[i] = (const float*)d_in[i];
  p.out = (float*)d_out;
  char* base = (char*)d_ws; size_t off = 0;
  auto take = [&](size_t bytes) { char* r = base + off; off = al256(off + bytes); return r; };
  p.bar = (unsigned*)take(XCD_BAR_WORDS * 4); p.ctl = (unsigned*)take((size_t)DEPTH * CTL_WORDS * 4);
  p.MOD = (float*)take((size_t)DEPTH * 9 * 6144 * 4); p.ROPE = (float*)take((size_t)2048 * 64 * 4);
  p.ROUTE = (int*)take((size_t)NR * 4 * 4); p.RW = (float*)take((size_t)NR * 2 * 4); p.TOK = (int*)take((size_t)NE * NR * 4);
  p.XL = (float*)take((size_t)NR * D * 4); p.Hb = (bf16_t*)take((size_t)NR * D * 2); p.H2b = (bf16_t*)take((size_t)NR * D * 2); p.Mb = (bf16_t*)take((size_t)NR * D * 2);
  for (int k = 0; k < 4; ++k) { SSet& w = p.s[k]; w.SAL = (float*)take((size_t)NG * 2 * 64 * 2 * 4); w.WR = (float*)take((size_t)2 * 64 * 1024 * 2);
    w.Smat = (bf16_t*)take((size_t)NG * 256 * 768 * 2); w.TO = (bf16_t*)take((size_t)NG * 512 * 768 * 2); }
  for (int k = 0; k < 2; ++k) { WSet& w = p.w[k];
    w.Win = (bf16_t*)take((size_t)INW * 1024 * 2); w.Wglu = (bf16_t*)take((size_t)512 * 512 * 2); w.Wpa = (bf16_t*)take((size_t)1024 * 1024 * 2); w.Wps = (bf16_t*)take((size_t)1024 * 1024 * 2);
    w.Wo = (bf16_t*)take((size_t)1024 * 1024 * 2); w.W13 = (bf16_t*)take((size_t)NE * 1024 * 1024 * 2); w.W2 = (bf16_t*)take((size_t)NE * 1024 * 512 * 2); }
  const size_t mix0 = off;
  p.Kc = (bf16_t*)take((size_t)NB * KVB * D * 2); p.Vc = (bf16_t*)take((size_t)NB * KVB * D * 2); p.Qb = (bf16_t*)take((size_t)NR * D * 2);
  p.Ug = (bf16_t*)take((size_t)NG * NCHP * 768 * 2 + 4096); p.RG = (bf16_t*)take((size_t)NR * D * 2); p.GSb = (bf16_t*)take((size_t)NR * D * 2); p.ATTb = (bf16_t*)take((size_t)NR * D * 2);
  p.SST = (float*)take((size_t)NG * NCHP * 256 * 4); p.YG = (bf16_t*)take((size_t)NR * SSMW * 2); p.S2 = (bf16_t*)take((size_t)NR * D * 2);
  const size_t mix1 = off; off = mix0;
  p.Hm = (bf16_t*)take((size_t)MOE_ROWS * EH * 2); p.Yo = (bf16_t*)take((size_t)MOE_ROWS * D * 2);
  if (off < mix1) off = mix1;
  H.ws_used = off; p.ph_lo = 0; p.ph_hi = DEPTH * NPH;
  return H;
}
inline int grid_size() {
  static int grid = 0;
  if (!grid) { hipFuncSetAttribute((const void*)mega, hipFuncAttributeMaxDynamicSharedMemorySize, LDS_BYTES);
    int dev = 0, cus = 0, per_cu = 0; hipGetDevice(&dev); hipDeviceGetAttribute(&cus, hipDeviceAttributeMultiprocessorCount, dev);
    hipOccupancyMaxActiveBlocksPerMultiprocessor(&per_cu, mega, 512, LDS_BYTES);
    grid = (per_cu >= 1 && cus >= 256) ? 256 : 0;
    if (!grid) fprintf(stderr, "mega: cannot be resident (cus %d per_cu %d)\n", cus, per_cu); }
  return grid;
}
inline void launch_range(Host& H, int lo, int hi, hipStream_t st) {
  const int grid = grid_size(); if (!grid) return;
  H.p.ph_lo = lo; H.p.ph_hi = hi;
  hipLaunchKernelGGL(mega, dim3(grid), dim3(512), LDS_BYTES, st, H.p);
}
}
#ifndef PROBE_K
#define PROBE_K 8
#endif
extern "C" void kernel_launch(void* const* d_in, const int* in_sizes, int n_in, void* d_out, int out_size, void* d_ws, size_t ws_size, hipStream_t stream) {
  fk::Host H = fk::make_params(d_in, d_out, d_ws);
  if (H.ws_used > ws_size) { fprintf(stderr, "ws too small: need %zu have %zu\n", H.ws_used, ws_size); return; }
  hipMemsetAsync(H.p.bar, 0, (size_t)((char*)H.p.MOD - (char*)H.p.bar), stream);
  fk::launch_range(H, 0, fk::DEPTH * fk::NPH, stream);
#if PROBE_MASK
  for (int id = 0; id < fk::NPH; ++id) if ((PROBE_MASK >> id) & 1) { const int g = fk::NPH + id;
    for (int k = 0; k < PROBE_K; ++k) { hipMemsetAsync(H.p.bar, 0, XCD_BAR_WORDS * 4, stream); fk::launch_range(H, g, g + 1, stream); } }
#endif
}
```

```cpp
#include <hip/hip_runtime.h>
#include <cstdio>
#include <cstdint>
#include <cstring>
#include <cmath>
namespace fk {
#define LAS __attribute__((address_space(3)))
typedef unsigned short bf16_t;
typedef short bf16x8 __attribute__((ext_vector_type(8)));
typedef short s16x4 __attribute__((ext_vector_type(4)));
typedef float f32x4 __attribute__((ext_vector_type(4)));
typedef float f32x2 __attribute__((ext_vector_type(2)));
typedef float f32x16 __attribute__((ext_vector_type(16)));
typedef unsigned u32x4 __attribute__((ext_vector_type(4)));
typedef unsigned u32x2 __attribute__((ext_vector_type(2)));

constexpr int D = 1024, SEQ = 2048, CTX = 256, NB = 8, NLAT = NB * SEQ, NCTX = NB * CTX, NR = NLAT + NCTX, KVB = SEQ + CTX;
constexpr int INW = 5632, NHEAD = 8, SSMW = 512, NG = 32, NP = 64, NE = 32, EH = 512, DEPTH = 4;
constexpr int CHUNK = 32, NCHR = NR / CHUNK  , NCHP = 768  ;
constexpr int MOE_ROWS = 2 * NR + NE * 256;
constexpr float ALPHA = 1.681792830507429f;

__device__ __forceinline__ unsigned cvt_pk_bf16(float lo, float hi) { unsigned r; asm volatile("v_cvt_pk_bf16_f32 %0, %1, %2" : "=v"(r) : "v"(lo), "v"(hi)); return r; }
__device__ __forceinline__ float bf2f(unsigned short b) { return __uint_as_float(((unsigned)b) << 16); }
__device__ __forceinline__ float bflo(unsigned w) { return __uint_as_float(w << 16); }
__device__ __forceinline__ float bfhi(unsigned w) { return __uint_as_float(w & 0xffff0000u); }
__device__ __forceinline__ u32x4 pack8(const f32x4& a, const f32x4& b) { u32x4 w; w.x = cvt_pk_bf16(a[0], a[1]); w.y = cvt_pk_bf16(a[2], a[3]); w.z = cvt_pk_bf16(b[0], b[1]); w.w = cvt_pk_bf16(b[2], b[3]); return w; }
__device__ __forceinline__ void unpack8(const u32x4& w, f32x4& a, f32x4& b) { a = (f32x4){bflo(w.x), bfhi(w.x), bflo(w.y), bfhi(w.y)}; b = (f32x4){bflo(w.z), bfhi(w.z), bflo(w.w), bfhi(w.w)}; }
__device__ __forceinline__ float fast_sigmoid(float x) { return __builtin_amdgcn_rcpf(1.f + __builtin_amdgcn_exp2f(-1.4426950408889634f * x)); }
__device__ __forceinline__ float fast_silu(float x) { return x * fast_sigmoid(x); }
__device__ __forceinline__ float gelu_tanh_f(float x) { const float z = 0.7978845608028654f * (x + 0.044715f * x * x * x); return x * fast_sigmoid(2.f * z); }
__device__ __forceinline__ int otid_w(int wv) { int t; asm volatile("v_mbcnt_lo_u32_b32 %0, -1, 0\n\tv_mbcnt_hi_u32_b32 %0, -1, %0\n\tv_lshl_add_u32 %0, %1, 6, %0" : "=&v"(t) : "s"(wv)); return t; }
__device__ __forceinline__ float ozero() { float z = 0.f; asm volatile("" : "+v"(z)); return z; }
__device__ __forceinline__ int obid() { int b = blockIdx.x; asm volatile("" : "+s"(b)); return b; }
__device__ __forceinline__ int ogd() { int g = gridDim.x; asm volatile("" : "+s"(g)); return g; }
#define otid() otid_w(g_wv)
template <int CTRL, int RM> __device__ __forceinline__ float dpp_f(float v) { return __builtin_bit_cast(float, __builtin_amdgcn_update_dpp(0, __builtin_bit_cast(int, v), CTRL, RM, 0xF, false)); }
__device__ __forceinline__ float wave_sum_u(float v) {
  v += dpp_f<0xB1, 0xF>(v); v += dpp_f<0x4E, 0xF>(v); v += dpp_f<0x141, 0xF>(v); v += dpp_f<0x140, 0xF>(v); v += dpp_f<0x142, 0xA>(v); v += dpp_f<0x143, 0xC>(v);
  return __builtin_bit_cast(float, __builtin_amdgcn_readlane(__builtin_bit_cast(int, v), 63)); }
__host__ __device__ __forceinline__ int perm32(int rho) { const int n = rho >> 4, i = rho & 15; return 8 * (i >> 2) + 4 * n + (i & 3); }

#define XB_TMO      128
#define XB_XCNT(j)  (256  + 64 * (j))
#define XB_XSUB(j)  (1280 + 64 * (j))
#define XB_XGEN(j)  (2304 + 64 * (j))
#define XB_TOP      3328
#define XB_TOPGEN   3392
#define XCD_BAR_WORDS 3456
#define XB_SPIN_CAP (1u << 22)
__device__ __forceinline__ unsigned xb_ld(unsigned* p)              { return __hip_atomic_load(p, __ATOMIC_RELAXED, __HIP_MEMORY_SCOPE_AGENT); }
__device__ __forceinline__ unsigned xb_add(unsigned* p, unsigned v) { return __hip_atomic_fetch_add(p, v, __ATOMIC_RELAXED, __HIP_MEMORY_SCOPE_AGENT); }
__device__ __forceinline__ unsigned xb_xcc_id() { return (unsigned)__builtin_amdgcn_s_getreg((3 << 11) | 20) & 0xFu; }
#define XB_SPIN(cond, bar) do { unsigned _sp = 0; while (cond) { __builtin_amdgcn_s_sleep(1); \
    if ((++_sp & 255u) == 0u) { if (xb_ld(&(bar)[XB_TMO])) break; if (_sp > XB_SPIN_CAP) { atomicAdd(&(bar)[XB_TMO], 1u); break; } } } } while (0)
struct XcdBarrier { unsigned* bar; unsigned x; volatile LAS unsigned* st; };
__device__ __forceinline__ XcdBarrier xcd_barrier_post(unsigned* bar, volatile LAS unsigned* st) {
    XcdBarrier b; b.bar = bar; b.x = xb_xcc_id(); b.st = st;
    if (threadIdx.x == 0) (void)xb_add(&bar[XB_XCNT(b.x)], 1u);
    return b;
}
__device__ __forceinline__ void xcd_barrier_complete(unsigned* bar, unsigned x, unsigned& nloc, unsigned& nx) {
    const unsigned G = gridDim.x * gridDim.y * gridDim.z;
    unsigned sum, cnt, mine, sp = 0u;
    for (;;) {
        sum = 0u; cnt = 0u; mine = 0u;
#pragma unroll
        for (unsigned j = 0; j < 16; ++j) { const unsigned c = xb_ld(&bar[XB_XCNT(j)]); sum += c; cnt += (c > 0u) ? 1u : 0u; mine = (j == x) ? c : mine; }
        if (sum == G) break;
        __builtin_amdgcn_s_sleep(1);
        if ((++sp & 255u) == 0u) { if (xb_ld(&bar[XB_TMO])) break; if (sp > XB_SPIN_CAP) { atomicAdd(&bar[XB_TMO], 1u); break; } }
    }
    nloc = mine > 0u ? mine : 1u; nx = cnt > 0u ? cnt : 1u;
}
__device__ __forceinline__ void xcd_barrier(const XcdBarrier& b) {
    asm volatile("s_waitcnt vmcnt(0)" ::: "memory");
    __syncthreads();
    if (threadIdx.x == 0) {
        unsigned* bar = b.bar;
        __builtin_amdgcn_s_waitcnt(0);
        unsigned nloc = b.st[0], nx = b.st[1];
        if (nloc == 0u) { xcd_barrier_complete(bar, b.x, nloc, nx); b.st[0] = nloc; b.st[1] = nx; }
        const unsigned old = xb_add(&bar[XB_XSUB(b.x)], 1u);
        const unsigned gen = old / nloc;
        if (old + 1u == (gen + 1u) * nloc) {
            __builtin_amdgcn_fence(__ATOMIC_RELEASE, "agent");
            asm volatile("s_waitcnt vmcnt(0)" ::: "memory");
            const unsigned og = xb_add(&bar[XB_TOP], 1u);
            const unsigned tg = og / nx;
            if (og + 1u == (tg + 1u) * nx) xb_add(&bar[XB_TOPGEN], 1u);
            else XB_SPIN(xb_ld(&bar[XB_TOPGEN]) == tg, bar);
            __builtin_amdgcn_fence(__ATOMIC_ACQUIRE, "agent");
            xb_add(&bar[XB_XGEN(b.x)], 1u);
            asm volatile("s_waitcnt vmcnt(0)" ::: "memory");
        } else {
            XB_SPIN(xb_ld(&bar[XB_XGEN(b.x)]) == gen, bar);
            __builtin_amdgcn_fence(__ATOMIC_ACQUIRE, "agent");
            asm volatile("s_waitcnt vmcnt(0)" ::: "memory");
        }
    }
    __syncthreads();
}

constexpr int BM = 256, BK = 64, HALF = 128, HTB = HALF * BK * 2, STAGE_BYTES = 8 * HTB;
__host__ __device__ __forceinline__ int lds_byte(int r, int c) { const int st = (r >> 4) * 2 + (c >> 5), rr = r & 15, cc = c & 31, ob = rr * 64 + cc * 2; return st * 1024 + (ob ^ (((ob >> 9) & 1) << 5)); }
__host__ __device__ __forceinline__ void stage_rc(int b, int& R, int& C) { const int st = b / 1024, sb = b % 1024, swz = sb ^ (((sb >> 9) & 1) << 5); R = (st >> 1) * 16 + swz / 64; C = (st & 1) * 32 + (swz % 64) / 2; }
struct Seg { const char* A; const char* B; int nt; int epi; int pm; int pn; int aux; int aux2; };
__device__ __forceinline__ void tile_order(int L, int nM, int nN, int& pm, int& pn) {
    const int nwg = nM * nN; int wgid = L; { const int q = nwg / 8, r = nwg % 8, xcd = wgid % 8, off = wgid / 8; wgid = (xcd < r ? xcd * (q + 1) : r * (q + 1) + (xcd - r) * q) + off; }
    const int nig = 8 * nN, gid = wgid / nig, fm = gid * 8, gsz = (nM - fm) < 8 ? (nM - fm) : 8;
    pm = fm + ((wgid % nig) % gsz); pn = (wgid % nig) / gsz;
}
template <class Epi, class Sched, bool GATHER = false, int AMODE = 0>
__device__ __forceinline__ void gemm_stream(LAS unsigned char* lds, const int lda, const int ldb, const Sched& S, const Epi& E, const int g_wv) {
    const int tid = otid(), wid = __builtin_amdgcn_readfirstlane(tid >> 6), lane = tid & 63, wr = wid >> 2, wc = wid & 3, fr = lane & 15, fq = lane >> 4;
    unsigned voffA[2], voffB[2];
#pragma unroll
    for (int i = 0; i < 2; ++i) { int R, C; stage_rc(tid * 16 + i * 8192, R, C); voffA[i] = AMODE == 1 ? (unsigned)((C >> 4) * lda + R * 32 + (C & 15) * 2) : (unsigned)(R * lda + C * 2); voffB[i] = (unsigned)(R * ldb + C * 2); }
    LAS unsigned* gst = (LAS unsigned*)(lds + STAGE_BYTES + 8192) + tid * 4;
    unsigned gCb = 0; if constexpr (GATHER) { int R_, C_; stage_rc(tid * 16, R_, C_); gCb = (unsigned)(C_ * 2); }
#define PG8_GV(slot, seg) do { int _R, _C; stage_rc(otid() * 16, _R, _C); _Pragma("unroll") for (int _h = 0; _h < 2; ++_h) gst[(slot) * 2 + _h] = S.grow(seg, _h * HALF + _R) | (S.grow(seg, _h * HALF + _R + 64) << 16); } while (0)
    const size_t kstep = (size_t)(BK * 2), kstepA = AMODE == 1 ? (size_t)4 * lda : kstep;
    const size_t hstepA = AMODE == 1 ? (size_t)HALF * 32 : (size_t)HALF * lda, hstepB = (size_t)HALF * ldb;
    const unsigned ldsw = (unsigned)wid * 1024u;
    const int aoff = lds_byte(wr * 64 + fr, fq * 8), boff = lds_byte(wc * 32 + fr, fq * 8);
#define PG8_SA(b, h) (((b) * 2 + (h)) * HTB)
#define PG8_SB(b, h) ((4 + (b) * 2 + (h)) * HTB)
#define PG8_STAGE(bufoff, gbase, voff) do { _Pragma("unroll") for (int _i = 0; _i < 2; ++_i) \
        __builtin_amdgcn_global_load_lds((const unsigned*)((const char*)(gbase) + (voff)[_i]), (LAS unsigned*)(lds + (bufoff) + ldsw + _i * 8192), 16, 0, 0); } while (0)
#define PG8_LDA(dst, b, h) do { _Pragma("unroll") for (int m = 0; m < 4; ++m) _Pragma("unroll") for (int k = 0; k < 2; ++k) dst[m][k] = *(const LAS bf16x8*)(lds + PG8_SA(b, h) + aoff + m * 2048 + k * 1024); } while (0)
#define PG8_LDB(dst, b, h) do { _Pragma("unroll") for (int n = 0; n < 2; ++n) _Pragma("unroll") for (int k = 0; k < 2; ++k) dst[n][k] = *(const LAS bf16x8*)(lds + PG8_SB(b, h) + boff + n * 2048 + k * 1024); } while (0)
#define PG8_MMA(ai, bj, At, Bt) do { __builtin_amdgcn_s_setprio(1); _Pragma("unroll") for (int m = 0; m < 4; ++m) _Pragma("unroll") for (int n = 0; n < 2; ++n) _Pragma("unroll") for (int k = 0; k < 2; ++k) \
        acc[ai][bj][m][n] = __builtin_amdgcn_mfma_f32_16x16x32_bf16(Bt[n][k], At[m][k], acc[ai][bj][m][n], 0, 0, 0); __builtin_amdgcn_s_setprio(0); } while (0)
#define PG8_WAIT_V(n) asm volatile("s_waitcnt vmcnt(" #n ")" ::: "memory")
#define PG8_WAIT_L(n) asm volatile("s_waitcnt lgkmcnt(" #n ")" ::: "memory")
#define PG8_BAR __builtin_amdgcn_s_barrier()
#define PG8_SCHED __builtin_amdgcn_sched_barrier(0)
    Seg cur, nxt; int ui = 0;
    if (!S.next(0, cur)) return;
    f32x4 acc[2][2][4][2];
#pragma unroll
    for (int a = 0; a < 2; ++a)
#pragma unroll
        for (int b = 0; b < 2; ++b)
#pragma unroll
            for (int m = 0; m < 4; ++m)
#pragma unroll
                for (int n = 0; n < 2; ++n) acc[a][b][m][n] = (f32x4){0.f, 0.f, 0.f, 0.f};
    bf16x8 At[4][2], B0[2][2], B1[2][2];
    const char* cA = cur.A; const char* cB = cur.B;
    if constexpr (GATHER) { PG8_GV(0, cur); gst[2] = gst[0]; gst[3] = gst[1]; }
#define PG8_STAGE_A(bufoff, kbase, h, usenext) do { if constexpr (GATHER) { const unsigned _p = gst[((usenext) ? 2 : 0) + (h)]; unsigned _v[2] = {(_p & 0xffffu) * (unsigned)lda + gCb, (_p >> 16) * (unsigned)lda + gCb}; PG8_STAGE(bufoff, kbase, _v); } \
        else { PG8_STAGE(bufoff, (kbase) + (h) * hstepA, voffA); } } while (0)
    PG8_STAGE(PG8_SB(0, 0), cB, voffB); PG8_STAGE(PG8_SB(0, 1), cB + hstepB, voffB); PG8_STAGE_A(PG8_SA(0, 0), cA, 0, false); PG8_STAGE_A(PG8_SA(0, 1), cA, 1, false);
    if (wr == 1) PG8_BAR;
    PG8_WAIT_V(2); PG8_BAR;
    PG8_STAGE(PG8_SB(1, 0), cB + kstep, voffB); PG8_STAGE_A(PG8_SA(1, 0), cA + kstepA, 0, false); PG8_STAGE(PG8_SB(1, 1), cB + hstepB + kstep, voffB);
    PG8_WAIT_V(6); PG8_BAR;
    for (;;) {
        const bool has_next = S.next(ui + 1, nxt);
        const char* nA = has_next ? nxt.A : cA; const char* nB = has_next ? nxt.B : cB;
        const int nt = cur.nt;
        for (int t = 0; t < nt; t += 2) {
            const bool last = (t == nt - 2);
            if constexpr (GATHER) { if (last) { if (has_next) { PG8_GV(1, nxt); } else { gst[2] = gst[0]; gst[3] = gst[1]; } } }
            const char* a1 = cA + (size_t)(t + 1) * kstepA;
            const char* a2 = last ? nA : cA + (size_t)(t + 2) * kstepA; const char* b2 = last ? nB : cB + (size_t)(t + 2) * kstep;
            const char* a3 = a2 + kstepA; const char* b3 = b2 + kstep;
            PG8_LDB(B0, 0, 0); PG8_LDB(B1, 0, 1); PG8_SCHED; PG8_LDA(At, 0, 0); PG8_STAGE_A(PG8_SA(1, 1), a1, 1, false);
            PG8_WAIT_V(8); PG8_WAIT_L(0); PG8_BAR; PG8_MMA(0, 0, At, B0); PG8_MMA(0, 1, At, B1); PG8_BAR; PG8_SCHED;
            PG8_LDA(At, 0, 1); PG8_STAGE(PG8_SB(0, 0), b2, voffB); PG8_STAGE(PG8_SB(0, 1), b2 + hstepB, voffB); PG8_STAGE_A(PG8_SA(0, 0), a2, 0, last);
            PG8_WAIT_V(8); PG8_WAIT_L(0); PG8_BAR; PG8_MMA(1, 0, At, B0); PG8_MMA(1, 1, At, B1); PG8_BAR; PG8_SCHED;
            PG8_LDB(B0, 1, 0); PG8_LDB(B1, 1, 1); PG8_SCHED; PG8_LDA(At, 1, 0); PG8_STAGE_A(PG8_SA(0, 1), a2, 1, last);
            PG8_WAIT_V(8); PG8_WAIT_L(0); PG8_BAR; PG8_MMA(0, 0, At, B0); PG8_MMA(0, 1, At, B1); PG8_BAR; PG8_SCHED;
            PG8_LDA(At, 1, 1); PG8_STAGE(PG8_SB(1, 0), b3, voffB); PG8_STAGE(PG8_SB(1, 1), b3 + hstepB, voffB); PG8_STAGE_A(PG8_SA(1, 0), a3, 0, last);
            PG8_WAIT_V(8); PG8_WAIT_L(0); PG8_BAR; PG8_MMA(1, 0, At, B0); PG8_MMA(1, 1, At, B1); PG8_BAR; PG8_SCHED;
        }
        if (cur.epi) {
            if (wr == 0) PG8_BAR;
            const int el = otid() & 63; const int efr = el & 15, efq = el >> 4;
            const bool z = E(acc, cur, wr, wc, efr, efq);
            if (z) {
#pragma unroll
                for (int a = 0; a < 2; ++a)
#pragma unroll
                    for (int b = 0; b < 2; ++b)
#pragma unroll
                        for (int m = 0; m < 4; ++m)
#pragma unroll
                            for (int n = 0; n < 2; ++n) acc[a][b][m][n] = (f32x4){0.f, 0.f, 0.f, 0.f};
            }
            if (!has_next) break;
            if (wr == 1) PG8_BAR;
        } else if (!has_next) { if (wr == 0) PG8_BAR; break; }
        cur = nxt; cA = nA; cB = nB; ++ui;
        if constexpr (GATHER) { gst[0] = gst[2]; gst[1] = gst[3]; }
    }
    PG8_WAIT_V(0);
    PG8_BAR;
#undef PG8_SA
#undef PG8_SB
#undef PG8_STAGE
#undef PG8_STAGE_A
#undef PG8_GV
#undef PG8_LDA
#undef PG8_LDB
#undef PG8_MMA
#undef PG8_WAIT_V
#undef PG8_WAIT_L
#undef PG8_BAR
#undef PG8_SCHED
}
}
namespace fk {
struct In { const float *x, *c, *ctx, *c_ctx, *w_mod, *b_mod, *w_in, *lam_q1, *lam_k1, *lam_q2, *lam_k2, *subln_g, *a_re, *a_im, *log_dt, *b_re, *b_im, *c_re, *c_im, *ssm_d,
  *w_glu, *b_glu, *w_pa, *w_ps, *w_o, *ln1_g, *ln1_b, *rg_w, *rg_b, *re_w, *re_b, *w1, *w3, *w2, *ln2_g, *ln2_b; };
struct WSet { bf16_t *Win, *Wglu, *Wpa, *Wps, *Wo, *W13, *W2; };
struct SSet { bf16_t *Smat, *TO; float *SAL, *WR; };
struct Params {
  In in; float* out;
  unsigned* bar;
  unsigned* ctl;
  float* MOD;
  float* ROPE;
  float* XL;
  bf16_t* Hb;
  bf16_t* Kc; bf16_t* Vc;
  bf16_t* Qb;
  bf16_t* Ug;
  bf16_t* RG; bf16_t* GSb;
  bf16_t* ATTb;
  float* SST;
  bf16_t* YG;
  bf16_t* S2;
  bf16_t* Mb;
  bf16_t* H2b;
  int* ROUTE;
  float* RW;
  int* TOK;
  bf16_t* Hm;
  bf16_t* Yo;
  SSet s[4];
  WSet w[2];
  int ph_lo, ph_hi;
  int pad0, pad1;
};
typedef const __attribute__((address_space(4))) Params& KP; typedef const __attribute__((address_space(4))) WSet& KW; typedef const __attribute__((address_space(4))) SSet& KS;
constexpr int CTL_CNT = 0;
constexpr int CTL_WORDS = 64 * 32 + 64;

__device__ __forceinline__ int modrow_of_tile(int pm) { return pm < 64 ? (pm >> 3) : 8; }
__device__ __forceinline__ int kvrow0_of_tile(int pm) { return pm < 64 ? (pm >> 3) * KVB + CTX + (pm & 7) * 256 : (pm - 64) * KVB; }

struct SchedPlain {
  const char* A; const char* B; int lda, ldb, nM, nN, nt, G, c, nunits; int epi; int atile;
  __device__ __forceinline__ bool next(int i, Seg& s) const {
    const int L = i * G + c; if (L >= nunits) return false;
    int pm, pn; tile_order(L, nM, nN, pm, pn);
    s.A = A + (size_t)pm * atile; s.B = B + (size_t)pn * 256 * ldb; s.nt = nt; s.epi = epi; s.pm = pm; s.pn = pn; s.aux = 0; s.aux2 = 0; return true; }
};
struct SchedMerge {
  const char* A1; const char* B1; const char* A2; const char* B2; int nM, nN, G, c, nunits;
  __device__ __forceinline__ bool next(int i, Seg& s) const {
    const int L = (i >> 1) * G + c; if (L >= nunits) return false;
    int pm, pn; tile_order(L, nM, nN, pm, pn); s.pm = pm; s.pn = pn; s.aux = 0; s.aux2 = 0;
    if ((i & 1) == 0) { s.A = A1 + (size_t)pm * 256 * 2048; s.B = B1 + (size_t)pn * 256 * 2048; s.nt = 16; s.epi = 2; }
    else { s.A = A2 + (size_t)pm * 256 * 2048; s.B = B2 + (size_t)pn * 256 * 2048; s.nt = 8; s.epi = 1; }
    return true; }
};
struct SchedSsm1 {
  const char* Ug; const char* Smat; int G, c;
  __device__ __forceinline__ bool next(int i, Seg& s) const {
    const int L = i * G + c; if (L >= NG * 3) return false;
    const int g = L / 3, pm = L % 3;
    s.A = Ug + (size_t)g * NCHP * 1536 + (size_t)pm * 256 * 1536; s.B = Smat + (size_t)g * 256 * 1536; s.nt = 8; s.epi = 1; s.pm = pm; s.pn = 0; s.aux = g; s.aux2 = 0; return true; }
};
struct SchedSsm3 {
  const char* Ug; const char* TO; int G, c;
  __device__ __forceinline__ bool next(int i, Seg& s) const {
    const int L = i * G + c; if (L >= NG * 6) return false;
    const int g = L / 6, r = L % 6, pm = r >> 1, pn = r & 1; s.pm = pm; s.pn = pn; s.aux = g; s.aux2 = 0;
    s.A = Ug + (size_t)g * NCHP * 1536 + (size_t)pm * 256 * 1536; s.B = TO + (size_t)g * 512 * 1536 + (size_t)pn * 256 * 1536; s.nt = 12; s.epi = 1; return true; }
};
struct MoeTab { int ntiles; int tileE[176]; int tileR0[176]; int cnt[32]; int tbase[33]; };
struct SchedMoe {
  const char* A; const char* B; int lda, ldb; size_t estride; const LAS MoeTab* tab; const int* TOK; int nN, nt, G, c; bool gather;
  __device__ __forceinline__ bool next(int i, Seg& s) const {
    const int L = i * G + c; if (L >= __builtin_amdgcn_readfirstlane(tab->ntiles) * nN) return false;
    const int t = L / nN, pn = L % nN; const int e = __builtin_amdgcn_readfirstlane(tab->tileE[t]);
    s.A = gather ? A : A + (size_t)t * 256 * lda; s.B = B + (size_t)e * estride + (size_t)pn * 256 * ldb; s.nt = nt; s.epi = 1; s.pm = t; s.pn = pn; s.aux = e; s.aux2 = __builtin_amdgcn_readfirstlane(tab->tileR0[t]); return true; }
  __device__ __forceinline__ unsigned grow(const Seg& s, int R) const { const int r = s.aux2 + R; return (unsigned)(r < tab->cnt[s.aux] ? TOK[(size_t)s.aux * NR + r] : 0); }
};
struct SchedG1 {
  const char* A; const char* B; int G, c, u0, u1; bool last;
  __device__ __forceinline__ bool next(int i, Seg& s) const {
    const int L = u0 + i * G + c; if (L >= u1) return false; int pm, pn;
    if (!last) { if (L < 144) { pm = L >> 1; pn = 8 + (L & 1); } else { int q; tile_order(L - 144, NR / 256, 20, pm, q); pn = q < 8 ? q : q + 2; } }
    else { if (L < 1408) tile_order(L, NLAT / 256, 22, pm, pn); else { const int L2 = L - 1408; pm = 64 + L2 / 10; pn = L2 % 10; } }
    s.A = A + (size_t)pm * 256 * 2048; s.B = B + (size_t)pn * 256 * 2048; s.nt = 16; s.epi = 1; s.pm = pm; s.pn = pn; s.aux = 0; s.aux2 = 0; return true; }
};
#define EPI_LOOP_AM for (int ai = 0; ai < 2; ++ai) _Pragma("unroll") for (int m = 0; m < 4; ++m)
struct EpiIn {
  const float* ROPE; bf16_t* Kc; bf16_t* Vc; bf16_t* Ug; bf16_t* Qb; bf16_t* RG; bf16_t* GSb;
  __device__ __forceinline__ bool operator()(f32x4 (&acc)[2][2][4][2], const Seg& s, int wr, int wc, int fr, int fq) const {
    const int pm = s.pm, pn = s.pn; const int rin0 = wr * 64 + fr;
    if (pn < 4 || (pn >= 10 && pn < 14)) {
      const bool isq = pn >= 10; const int pt = isq ? pn - 10 : pn; const int axis = wc & 1;
      bf16_t* dst = isq ? Qb : Kc; const int drow0 = isq ? pm * 256 : kvrow0_of_tile(pm); const bool lat = pm < 64;
#pragma unroll
      EPI_LOOP_AM { const int rin = ai * 128 + m * 16 + rin0; const int t = (pm * 256 + rin) & (SEQ - 1); const float* rp = ROPE + ((size_t)t * 2 + axis) * 32 + fq * 4;
        f32x4 cs, sn; if (lat) { cs = *(const f32x4*)rp; sn = *(const f32x4*)(rp + 16); }
#pragma unroll
        for (int bj = 0; bj < 2; ++bj) { f32x4 o1 = acc[ai][bj][m][0], o2 = acc[ai][bj][m][1]; if (lat) { const f32x4 t1 = o1, t2 = o2; o1 = t1 * cs - t2 * sn; o2 = t1 * sn + t2 * cs; }
          if (isq) { o1 *= 0.18033688011112042f; o2 *= 0.18033688011112042f; }
          *(u32x4*)(dst + (size_t)(drow0 + rin) * 1024 + (2 * pt + bj) * 128 + wc * 32 + fq * 8) = pack8(o1, o2); } }
    } else if (pn < 8) {
      const int drow0 = kvrow0_of_tile(pm);
#pragma unroll
      EPI_LOOP_AM { const int rin = ai * 128 + m * 16 + rin0;
#pragma unroll
        for (int bj = 0; bj < 2; ++bj) *(u32x4*)(Vc + (size_t)(drow0 + rin) * 1024 + (pn - 4) * 256 + bj * 128 + wc * 32 + fq * 8) = pack8(acc[ai][bj][m][0], acc[ai][bj][m][1]); }
    } else if (pn < 10) {
#pragma unroll
      EPI_LOOP_AM { const int rin = ai * 128 + m * 16 + rin0;
#pragma unroll
        for (int bj = 0; bj < 2; ++bj) { const int c0 = (pn - 8) * 256 + bj * 128 + wc * 32 + fq * 8; const int g = c0 >> 4, co = c0 & 15;
          const int R = pm * 256 + rin; *(u32x4*)(Ug + ((size_t)g * NCHP + (R >> 5)) * 768 + (R & 31) * 16 + co) = pack8(acc[ai][bj][m][0], acc[ai][bj][m][1]); } }
    } else {
      const int c0 = (pn - 14) * 128 + wc * 32 + fq * 8;
#pragma unroll
      EPI_LOOP_AM { const int rin = ai * 128 + m * 16 + rin0; f32x4 r[2], g[2];
#pragma unroll
        for (int n = 0; n < 2; ++n)
#pragma unroll
          for (int j = 0; j < 4; ++j) { const float ea = __builtin_amdgcn_exp2f(-1.4426950408889634f * acc[ai][0][m][n][j]); const float es = __builtin_amdgcn_exp2f(-1.4426950408889634f * fmaxf(acc[ai][1][m][n][j], -60.f));
            g[n][j] = __builtin_amdgcn_rcpf(1.f + es); r[n][j] = (1.f + es) * __builtin_amdgcn_rcpf(1.f + ea); }
        *(u32x4*)(RG + (size_t)(pm * 256 + rin) * 1024 + c0) = pack8(r[0], r[1]); *(u32x4*)(GSb + (size_t)(pm * 256 + rin) * 1024 + c0) = pack8(g[0], g[1]); }
    }
    return true;
  }
};
struct EpiState {
  float* SST;
  __device__ __forceinline__ bool operator()(f32x4 (&acc)[2][2][4][2], const Seg& s, int wr, int wc, int fr, int fq) const {
    const int g = s.aux;
#pragma unroll
    EPI_LOOP_AM { const int row = s.pm * 256 + ai * 128 + m * 16 + wr * 64 + fr;
      if (row < NCHR) {
#pragma unroll
        for (int bj = 0; bj < 2; ++bj) { float* p = SST + ((size_t)g * NCHP + row) * 256 + bj * 128 + wc * 32 + fq * 8; *(f32x4*)p = acc[ai][bj][m][0]; *(f32x4*)(p + 4) = acc[ai][bj][m][1]; } } }
    return true;
  }
};
struct EpiSsmOut {
  bf16_t* YG;
  __device__ __forceinline__ bool operator()(f32x4 (&acc)[2][2][4][2], const Seg& s, int wr, int wc, int fr, int fq) const {
    const int g = s.aux;
#pragma unroll
    EPI_LOOP_AM { const int row = s.pm * 256 + ai * 128 + m * 16 + wr * 64 + fr;
      if (row < NCHR) {
#pragma unroll
        for (int bj = 0; bj < 2; ++bj) { const int c0 = s.pn * 256 + bj * 128 + wc * 32 + fq * 8; const int t = c0 >> 4, co = c0 & 15; f32x4 a = acc[ai][bj][m][0], b = acc[ai][bj][m][1];
#pragma unroll
          for (int j = 0; j < 4; ++j) { a[j] = gelu_tanh_f(a[j]); b[j] = gelu_tanh_f(b[j]); }
          *(u32x4*)(YG + ((size_t)g * NR + (size_t)row * CHUNK + t) * 16 + co) = pack8(a, b); } } }
    return true;
  }
};
struct EpiGlu {
  const bf16_t* YG; bf16_t* S2; const float* bias;
  __device__ __forceinline__ bool operator()(f32x4 (&acc)[2][2][4][2], const Seg& s, int wr, int wc, int fr, int fq) const {
#pragma unroll
    for (int bj = 0; bj < 2; ++bj) { const int c0 = s.pn * 256 + bj * 128 + wc * 32 + fq * 8; const f32x4 b0 = *(const f32x4*)(bias + c0), b1 = *(const f32x4*)(bias + c0 + 4);
#pragma unroll
      EPI_LOOP_AM { const int row = s.pm * 256 + ai * 128 + m * 16 + wr * 64 + fr; const u32x4 yw = *(const u32x4*)(YG + ((size_t)(c0 >> 4) * NR + row) * 16 + (c0 & 15)); f32x4 y0, y1; unpack8(yw, y0, y1);
        f32x4 z0 = acc[ai][bj][m][0] + b0, z1 = acc[ai][bj][m][1] + b1;
#pragma unroll
        for (int j = 0; j < 4; ++j) { z0[j] = y0[j] * fast_sigmoid(z0[j]); z1[j] = y1[j] * fast_sigmoid(z1[j]); }
        *(u32x4*)(S2 + (size_t)row * 1024 + c0) = pack8(z0, z1); } }
    return true;
  }
};
struct EpiMerge {
  const bf16_t* RG; const bf16_t* GSb; bf16_t* Mb;
  __device__ __forceinline__ bool operator()(f32x4 (&acc)[2][2][4][2], const Seg& s, int wr, int wc, int fr, int fq) const {
    const bool mid = s.epi == 2; const bf16_t* src = mid ? RG : GSb;
#pragma unroll
    EPI_LOOP_AM { const int row = s.pm * 256 + ai * 128 + m * 16 + wr * 64 + fr;
#pragma unroll
      for (int bj = 0; bj < 2; ++bj) { const int c0 = s.pn * 256 + bj * 128 + wc * 32 + fq * 8; const u32x4 w = *(const u32x4*)(src + (size_t)row * 1024 + c0); f32x4 g0, g1; unpack8(w, g0, g1);
        acc[ai][bj][m][0] *= g0; acc[ai][bj][m][1] *= g1;
        if (!mid) *(u32x4*)(Mb + (size_t)row * 1024 + c0) = pack8(acc[ai][bj][m][0], acc[ai][bj][m][1]); } }
    return !mid;
  }
};
struct EpiWo {
  const float* xin_lat; const float* xin_ctx; float* XL; const float* MODl;
  __device__ __forceinline__ bool operator()(f32x4 (&acc)[2][2][4][2], const Seg& s, int wr, int wc, int fr, int fq) const {
    const int pm = s.pm; const float* gate = MODl + (size_t)modrow_of_tile(pm) * 6144 + 2 * 1024;
    const float* xin = pm < 64 ? xin_lat + (size_t)pm * 256 * 1024 : xin_ctx + (size_t)(pm - 64) * 256 * 1024;
#pragma unroll
    for (int bj = 0; bj < 2; ++bj) { const int c0 = s.pn * 256 + bj * 128 + wc * 32 + fq * 8; const f32x4 g0 = *(const f32x4*)(gate + c0), g1 = *(const f32x4*)(gate + c0 + 4);
#pragma unroll
      EPI_LOOP_AM { const int rin = ai * 128 + m * 16 + wr * 64 + fr; const float* xp = xin + (size_t)rin * 1024 + c0; float* op = XL + (size_t)(pm * 256 + rin) * 1024 + c0;
        const f32x4 x0 = *(const f32x4*)xp, x1 = *(const f32x4*)(xp + 4);
        *(f32x4*)op = x0 * ALPHA + g0 * acc[ai][bj][m][0]; *(f32x4*)(op + 4) = x1 * ALPHA + g1 * acc[ai][bj][m][1]; } }
    return true;
  }
};
struct EpiMoe1 {
  bf16_t* Hm;
  __device__ __forceinline__ bool operator()(f32x4 (&acc)[2][2][4][2], const Seg& s, int wr, int wc, int fr, int fq) const {
    const int c0 = s.pn * 128 + wc * 32 + fq * 8;
#pragma unroll
    EPI_LOOP_AM { const int row = s.pm * 256 + ai * 128 + m * 16 + wr * 64 + fr; f32x4 h0, h1;
#pragma unroll
      for (int j = 0; j < 4; ++j) { h0[j] = fast_silu(acc[ai][0][m][0][j]) * acc[ai][1][m][0][j]; h1[j] = fast_silu(acc[ai][0][m][1][j]) * acc[ai][1][m][1][j]; }
      *(u32x4*)(Hm + (size_t)row * EH + c0) = pack8(h0, h1); }
    return true;
  }
};
struct EpiMoe2 {
  bf16_t* Yo;
  __device__ __forceinline__ bool operator()(f32x4 (&acc)[2][2][4][2], const Seg& s, int wr, int wc, int fr, int fq) const {
#pragma unroll
    EPI_LOOP_AM { const int row = s.pm * 256 + ai * 128 + m * 16 + wr * 64 + fr;
#pragma unroll
      for (int bj = 0; bj < 2; ++bj) *(u32x4*)(Yo + (size_t)row * 1024 + s.pn * 256 + bj * 128 + wc * 32 + fq * 8) = pack8(acc[ai][bj][m][0], acc[ai][bj][m][1]); }
    return true;
  }
};
}
namespace fk {
constexpr int ATT_SHM_V = 64 * 128 * 2, ATT_SHM_K = 64 * 128 * 2;
constexpr int ATT_LDS = 3 * ATT_SHM_V + 3 * ATT_SHM_K + 8 * 256;
#define KSWZ(row, colB) ((row) * 256 + ((colB) ^ (((row) & 7) << 4)))
#define SBAR() __builtin_amdgcn_sched_barrier(0)
__device__ __forceinline__ int crow(int r, int hi) { return (r & 3) + 8 * (r >> 2) + 4 * hi; }
constexpr float ATT_THR2 = 11.5f;
__device__ __forceinline__ void partialSM(f32x16& p0, f32x16& p1, float& m_reg, float& alpha) {
  float pmax = p0[0];
#pragma unroll
  for (int r = 1; r < 16; ++r) pmax = fmaxf(pmax, p0[r]);
#pragma unroll
  for (int r = 0; r < 16; ++r) pmax = fmaxf(pmax, p1[r]);
  { auto rr = __builtin_amdgcn_permlane32_swap(__float_as_uint(pmax), __float_as_uint(pmax), false, false);
    pmax = fmaxf(__uint_as_float(rr[0]), __uint_as_float(rr[1])); }
  if (__builtin_expect(__all(pmax <= ATT_THR2 && pmax >= -2.f * ATT_THR2), 1)) { alpha = 1.f; }
  else { const float d = pmax; alpha = __builtin_amdgcn_exp2f(-d); m_reg += d;
#pragma unroll
    for (int r = 0; r < 16; ++r) { p0[r] -= d; p1[r] -= d; } }
#pragma unroll
  for (int r = 0; r < 16; ++r) p0[r] = __builtin_amdgcn_exp2f(p0[r]);
}
__device__ __forceinline__ void finishSM(f32x16& p0, f32x16& p1, float alpha, float& l_reg, bf16x8& pa0, bf16x8& pa1, bf16x8& pa2, bf16x8& pa3) {
#pragma unroll
  for (int r = 0; r < 16; ++r) p1[r] = __builtin_amdgcn_exp2f(p1[r]);
  float ps = 0;
#pragma unroll
  for (int r = 0; r < 16; ++r) ps += p0[r];
#pragma unroll
  for (int r = 0; r < 16; ++r) ps += p1[r];
  { auto rr = __builtin_amdgcn_permlane32_swap(__float_as_uint(ps), __float_as_uint(ps), false, false);
    ps = __uint_as_float(rr[0]) + __uint_as_float(rr[1]); }
  l_reg = l_reg * alpha + ps;
#define PK4(P, BASE, OUT) do { unsigned a0 = cvt_pk_bf16(P[BASE + 0], P[BASE + 1]), a1 = cvt_pk_bf16(P[BASE + 2], P[BASE + 3]);   \
    unsigned b0 = cvt_pk_bf16(P[BASE + 4], P[BASE + 5]), b1 = cvt_pk_bf16(P[BASE + 6], P[BASE + 7]);                              \
    auto r0 = __builtin_amdgcn_permlane32_swap(a0, b0, false, false); auto r1 = __builtin_amdgcn_permlane32_swap(a1, b1, false, false); \
    u32x4 w = {r0[0], r1[0], r0[1], r1[1]}; OUT = *reinterpret_cast<bf16x8*>(&w); } while (0)
  PK4(p0, 0, pa0); PK4(p0, 8, pa1); PK4(p1, 0, pa2); PK4(p1, 8, pa3);
#undef PK4
}
__device__ __forceinline__ void qkt(f32x16& p0, f32x16& p1, const LAS char* Ks, const bf16x8* qr, int mapcolB, int r32, int hi, float negm) {
#pragma unroll
  for (int r = 0; r < 16; ++r) { p0[r] = negm; p1[r] = negm; }
#pragma unroll
  for (int d0 = 0; d0 < 4; ++d0) { const int cb = mapcolB + (d0 * 16 + hi * 8) * 2;
    const bf16x8 b0 = *(const LAS bf16x8*)(Ks + KSWZ(r32, cb));
    const bf16x8 b1 = *(const LAS bf16x8*)(Ks + KSWZ(32 + r32, cb));
    p0 = __builtin_amdgcn_mfma_f32_32x32x16_bf16(b0, qr[d0], p0, 0, 0, 0);
    p1 = __builtin_amdgcn_mfma_f32_32x32x16_bf16(b1, qr[d0], p1, 0, 0, 0); }
}
__device__ __forceinline__ int v_st(int k, int c) { const int kk = (k & ~0xC) | ((k & 4) << 1) | ((k & 8) >> 1); return ((kk >> 3) * 4 + (c >> 5)) * 512 + ((kk & 7) * 32 + (c & 31)) * 2; }
__device__ __forceinline__ int v_rd_base(int lane) { return ((lane & 3) << 3) | (((lane >> 2) & 3) << 6) | (((lane >> 4) & 1) << 5) | (((lane >> 5) & 1) << 8); }
constexpr int v_rd_off(int d0, int ks, int half) { return d0 * 512 + ks * 4096 + half * 2048; }
template <int OFF> __device__ __forceinline__ s16x4 tr_read(int vb) {
  s16x4 r; asm volatile("ds_read_b64_tr_b16 %0, %1 offset:%2" : "=&v"(r) : "v"(vb), "i"(OFF) : "memory"); return r;
}
template <int D0> __device__ __forceinline__ void pv_one(f32x16& od, int vb, bf16x8 pa0, bf16x8 pa1, bf16x8 pa2, bf16x8 pa3) {
  const s16x4 l0 = tr_read<v_rd_off(D0, 0, 0)>(vb), h0 = tr_read<v_rd_off(D0, 0, 1)>(vb), l1 = tr_read<v_rd_off(D0, 1, 0)>(vb), h1 = tr_read<v_rd_off(D0, 1, 1)>(vb);
  const s16x4 l2 = tr_read<v_rd_off(D0, 2, 0)>(vb), h2 = tr_read<v_rd_off(D0, 2, 1)>(vb), l3 = tr_read<v_rd_off(D0, 3, 0)>(vb), h3 = tr_read<v_rd_off(D0, 3, 1)>(vb);
  asm volatile("s_waitcnt lgkmcnt(0)" ::: "memory"); SBAR();
#define PK(L, H) (bf16x8){L[0], L[1], L[2], L[3], H[0], H[1], H[2], H[3]}
  od = __builtin_amdgcn_mfma_f32_32x32x16_bf16(pa0, PK(l0, h0), od, 0, 0, 0);
  od = __builtin_amdgcn_mfma_f32_32x32x16_bf16(pa1, PK(l1, h1), od, 0, 0, 0);
  od = __builtin_amdgcn_mfma_f32_32x32x16_bf16(pa2, PK(l2, h2), od, 0, 0, 0);
  od = __builtin_amdgcn_mfma_f32_32x32x16_bf16(pa3, PK(l3, h3), od, 0, 0, 0);
#undef PK
}
__device__ __forceinline__ void pv_d0(f32x16* o, int vb, bf16x8 pa0, bf16x8 pa1, bf16x8 pa2, bf16x8 pa3) {
  pv_one<0>(o[0], vb, pa0, pa1, pa2, pa3); pv_one<1>(o[1], vb, pa0, pa1, pa2, pa3); pv_one<2>(o[2], vb, pa0, pa1, pa2, pa3); pv_one<3>(o[3], vb, pa0, pa1, pa2, pa3);
}
__device__ __forceinline__ void attn_unit(const bf16_t* __restrict__ Qg, const bf16_t* __restrict__ Kg, const bf16_t* __restrict__ Vg, bf16_t* __restrict__ Og,
                                          int qrow0, int kv0, int nkeys, int h, float lam, float lam_init, const float* __restrict__ subg, LAS char* lds, const int g_wv) {
  const int tid = otid(), wid = tid >> 6, lane = tid & 63, r32 = lane & 31, hi = lane >> 5, map = wid >> 2, wq = wid & 3;
  LAS char* V_lds = lds; LAS char* K_lds = lds + 3 * ATT_SHM_V;
  LAS float* wsf = (LAS float*)(lds + 3 * ATT_SHM_V + 3 * ATT_SHM_K) + wid * 64; LAS float* li_l = wsf; LAS float* al_l = wsf + 32;
  float m_reg = 0.f, l_reg = 0; f32x16 o[4] = {}; bf16x8 qr[4];
  const bf16_t* Qw = Qg + (size_t)(qrow0 + wq * 32 + r32) * 1024 + h * 128 + map * 64 + hi * 8;
#pragma unroll
  for (int d0 = 0; d0 < 4; ++d0) qr[d0] = *(const bf16x8*)(Qw + d0 * 16);
  const bf16_t* Kh = Kg + (size_t)kv0 * 1024 + h * 128; const bf16_t* Vh = Vg + (size_t)kv0 * 1024 + h * 128;
  const int sr = tid >> 4, sc = (tid & 15) * 8, vst0 = v_st(sr, sc), vst1 = v_st(32 + sr, sc);
  const int vb0 = (int)(uintptr_t)V_lds + v_rd_base(lane);
  const int mapcolB = map * 128;
  struct { bf16x8 vs0, vs1, ks0, ks1; } sr_;
#define SLOAD(k0) do { sr_.vs0 = *(const bf16x8*)(&Vh[(size_t)((k0) + sr) * 1024 + sc]); sr_.vs1 = *(const bf16x8*)(&Vh[(size_t)((k0) + 32 + sr) * 1024 + sc]); \
    sr_.ks0 = *(const bf16x8*)(&Kh[(size_t)((k0) + sr) * 1024 + sc]); sr_.ks1 = *(const bf16x8*)(&Kh[(size_t)((k0) + 32 + sr) * 1024 + sc]); } while (0)
#define SWRITE(bo) do { *(LAS bf16x8*)(V_lds + (bo) + vst0) = sr_.vs0;          \
    *(LAS bf16x8*)(V_lds + (bo) + vst1) = sr_.vs1; const int kc = sc * 2;               \
    *(LAS bf16x8*)(K_lds + (bo) + KSWZ(sr, kc)) = sr_.ks0;                       \
    *(LAS bf16x8*)(K_lds + (bo) + KSWZ(32 + sr, kc)) = sr_.ks1; } while (0)
#define SWAIT() asm volatile("s_waitcnt vmcnt(0)" ::: "memory")
#define RESC(a) do { if (__any((a) != 1.f)) { if (hi == 0) al_l[r32] = (a); asm volatile("s_waitcnt lgkmcnt(0)" ::: "memory"); \
    _Pragma("unroll") for (int d = 0; d < 4; ++d) _Pragma("unroll") for (int r = 0; r < 16; ++r) o[d][r] *= al_l[crow(r, hi)]; } } while (0)
  f32x16 pA0, pA1, pB0, pB1; float alA, alB; bf16x8 pa0, pa1, pa2, pa3; const int NT = nkeys / 64;
  int bprev = 0, bcur = ATT_SHM_V, bnext = 2 * ATT_SHM_V;
  SLOAD(0); asm volatile("s_waitcnt vmcnt(0)" ::: "memory"); SWRITE(0); __syncthreads();
  qkt(pA0, pA1, K_lds, qr, mapcolB, r32, hi, -m_reg); partialSM(pA0, pA1, m_reg, alA);
  SLOAD(64);
  SWAIT(); SWRITE(bcur); __syncthreads();
  for (int j = 1; j + 1 < NT; j += 2) {
    SBAR(); qkt(pB0, pB1, K_lds + bcur, qr, mapcolB, r32, hi, -m_reg);
    finishSM(pA0, pA1, alA, l_reg, pa0, pa1, pa2, pa3); SBAR();
    SLOAD((j + 1) * 64); SBAR();
    pv_d0(o, vb0 + bprev, pa0, pa1, pa2, pa3); partialSM(pB0, pB1, m_reg, alB);
    SWAIT(); SWRITE(bnext);
    RESC(alB); __syncthreads();
    { const int t_ = bprev; bprev = bcur; bcur = bnext; bnext = t_; }
    SBAR(); qkt(pA0, pA1, K_lds + bcur, qr, mapcolB, r32, hi, -m_reg);
    finishSM(pB0, pB1, alB, l_reg, pa0, pa1, pa2, pa3); SBAR();
    SLOAD((j + 2) * 64); SBAR();
    pv_d0(o, vb0 + bprev, pa0, pa1, pa2, pa3); partialSM(pA0, pA1, m_reg, alA);
    SWAIT(); SWRITE(bnext);
    RESC(alA); __syncthreads();
    { const int t_ = bprev; bprev = bcur; bcur = bnext; bnext = t_; }
  }
  SBAR(); qkt(pB0, pB1, K_lds + bcur, qr, mapcolB, r32, hi, -m_reg);
  finishSM(pA0, pA1, alA, l_reg, pa0, pa1, pa2, pa3); SBAR();
  pv_d0(o, vb0 + bprev, pa0, pa1, pa2, pa3); partialSM(pB0, pB1, m_reg, alB);
  RESC(alB);
  finishSM(pB0, pB1, alB, l_reg, pa0, pa1, pa2, pa3); SBAR();
  pv_d0(o, vb0 + bcur, pa0, pa1, pa2, pa3);
  if (hi == 0) li_l[r32] = l_reg; asm volatile("s_waitcnt lgkmcnt(0)" ::: "memory");
  float rli[16]; const float fac = map ? lam : 1.f;
#pragma unroll
  for (int r = 0; r < 16; ++r) rli[r] = fac * __builtin_amdgcn_rcpf(li_l[crow(r, hi)]);
  __syncthreads();
  LAS float* stg = (LAS float*)lds + wid * (32 * 128);
#pragma unroll
  for (int r = 0; r < 16; ++r)
#pragma unroll
    for (int d0 = 0; d0 < 4; ++d0) stg[crow(r, hi) * 128 + d0 * 32 + r32] = o[d0][r] * rli[r];
  __syncthreads();
  {
    const int qi = 16 * map + (lane >> 2), qt = lane & 3;
    const LAS float* pa = (const LAS float*)lds + wq * (32 * 128) + qi * 128 + qt * 32;
    const LAS float* pb = (const LAS float*)lds + (4 + wq) * (32 * 128) + qi * 128 + qt * 32;
    float v[32]; float ss = 0.f;
#pragma unroll
    for (int k = 0; k < 8; ++k) { const f32x4 a = *(const LAS f32x4*)(pa + 4 * k), b = *(const LAS f32x4*)(pb + 4 * k);
#pragma unroll
      for (int j = 0; j < 4; ++j) { const float x = a[j] - b[j]; v[4 * k + j] = x; ss += x * x; } }
    ss += dpp_f<0xB1, 0xF>(ss); ss += dpp_f<0x4E, 0xF>(ss);
    const float rn = __builtin_amdgcn_rsqf(ss * (1.f / 128.f) + 1e-5f) * (1.f - lam_init);
    bf16_t* op = Og + (size_t)(qrow0 + wq * 32 + qi) * 1024 + h * 128 + qt * 32; const float* gp = subg + qt * 32;
#pragma unroll
    for (int k = 0; k < 4; ++k) { f32x4 a, b;
#pragma unroll
      for (int j = 0; j < 4; ++j) { a[j] = v[8 * k + j] * rn * gp[8 * k + j]; b[j] = v[8 * k + 4 + j] * rn * gp[8 * k + 4 + j]; }
      *(u32x4*)(op + 8 * k) = pack8(a, b); }
  }
  __syncthreads();
#undef SLOAD
#undef SWRITE
#undef SWAIT
#undef RESC
}
__device__ __forceinline__ void attn_phase(KP p, int l, LAS char* lds, const int g_wv) {
  const int tid = otid(), lane = tid & 63; const bool last = (l == DEPTH - 1);
  float s1 = p.in.lam_q1[l * 64 + lane] * p.in.lam_k1[l * 64 + lane], s2 = p.in.lam_q2[l * 64 + lane] * p.in.lam_k2[l * 64 + lane];
  s1 = wave_sum_u(s1); s2 = wave_sum_u(s2);
  const float lam_init = 0.8f - 0.6f * expf(-0.3f * (float)l); const float lam = expf(s1) - expf(s2) + lam_init;
  const int c = obid(), x = c & 7, jl = c >> 3, per = ogd() >> 3;
  const int nloc = last ? 128 : 144;
  for (int q = jl; q < nloc; q += per) {
    int qrow0, nkeys, h;
    if (q < 128) { h = q >> 4; qrow0 = x * SEQ + (q & 15) * 128; nkeys = KVB; }
    else { const int qq = q - 128; h = qq >> 1; qrow0 = NLAT + x * CTX + (qq & 1) * 128; nkeys = CTX; }
    attn_unit(p.Qb, p.Kc, p.Vc, p.ATTb, qrow0, x * KVB, nkeys, h, lam, lam_init, p.in.subln_g + l * 128, lds, g_wv);
  }
}

__device__ __forceinline__ float wave_sum(float v) { return wave_sum_u(v); }
__device__ __forceinline__ void row_ld(const float* p, int lane, f32x4 (&v)[4]) {
#pragma unroll
  for (int i = 0; i < 4; ++i) v[i] = *(const f32x4*)(p + 4 * lane + 256 * i); }
__device__ __forceinline__ void row_st(float* p, int lane, const f32x4 (&v)[4]) {
#pragma unroll
  for (int i = 0; i < 4; ++i) *(f32x4*)(p + 4 * lane + 256 * i) = v[i]; }
__device__ __forceinline__ void row_st_bf16(bf16_t* p, int lane, const f32x4 (&v)[4]) {
#pragma unroll
  for (int i = 0; i < 4; ++i) { u32x2 w; w.x = cvt_pk_bf16(v[i][0], v[i][1]); w.y = cvt_pk_bf16(v[i][2], v[i][3]); *(u32x2*)(p + 4 * lane + 256 * i) = w; } }
__device__ __forceinline__ void row_ld_bf16(const bf16_t* p, int lane, f32x4 (&v)[4]) {
#pragma unroll
  for (int i = 0; i < 4; ++i) { const u32x2 w = *(const u32x2*)(p + 4 * lane + 256 * i); v[i] = (f32x4){bflo(w.x), bfhi(w.x), bflo(w.y), bfhi(w.y)}; } }
__device__ __forceinline__ void row_ln(f32x4 (&v)[4], const float* g, const float* b, int lane) {
  float s = 0.f;
#pragma unroll
  for (int i = 0; i < 4; ++i) s += (v[i][0] + v[i][1]) + (v[i][2] + v[i][3]);
  const float mean = wave_sum(s) * (1.f / 1024.f); float q = 0.f;
#pragma unroll
  for (int i = 0; i < 4; ++i) { v[i] -= mean; q += (v[i][0] * v[i][0] + v[i][1] * v[i][1]) + (v[i][2] * v[i][2] + v[i][3] * v[i][3]); }
  const float rs = __builtin_amdgcn_rsqf(wave_sum(q) * (1.f / 1024.f) + 1e-5f);
#pragma unroll
  for (int i = 0; i < 4; ++i) { const f32x4 gg = *(const f32x4*)(g + 4 * lane + 256 * i), bb = *(const f32x4*)(b + 4 * lane + 256 * i); v[i] = v[i] * rs * gg + bb; }
}
__device__ __forceinline__ void row_ln_r(f32x4 (&v)[4], const f32x4 (&gg)[4], const f32x4 (&bb)[4]) {
  float s = 0.f;
#pragma unroll
  for (int i = 0; i < 4; ++i) s += (v[i][0] + v[i][1]) + (v[i][2] + v[i][3]);
  const float mean = wave_sum(s) * (1.f / 1024.f); float q = 0.f;
#pragma unroll
  for (int i = 0; i < 4; ++i) { v[i] -= mean; q += (v[i][0] * v[i][0] + v[i][1] * v[i][1]) + (v[i][2] * v[i][2] + v[i][3] * v[i][3]); }
  const float rs = __builtin_amdgcn_rsqf(wave_sum(q) * (1.f / 1024.f) + 1e-5f);
#pragma unroll
  for (int i = 0; i < 4; ++i) v[i] = v[i] * rs * gg[i] + bb[i];
}
__device__ __forceinline__ void row_mod(f32x4 (&h)[4], const f32x4 (&v)[4], const float* modrow, int shift_idx, int scale_idx, int lane) {
#pragma unroll
  for (int i = 0; i < 4; ++i) { const f32x4 sc = *(const f32x4*)(modrow + scale_idx * 1024 + 4 * lane + 256 * i), sh = *(const f32x4*)(modrow + shift_idx * 1024 + 4 * lane + 256 * i); h[i] = v[i] * (1.f + sc) + sh; }
}
__device__ __forceinline__ int modrow_of_row(int r) { return r < NLAT ? (r >> 11) : 8; }

__device__ __forceinline__ void h0_phase(KP p, const int g_wv) {
  const int tid = otid(); const int lane = tid & 63, gw = obid() * 8 + (tid >> 6), nw = ogd() * 8;
  for (int r = gw; r < NR; r += nw) {
    const float* src = r < NLAT ? p.in.x + (size_t)r * D : p.in.ctx + (size_t)(r - NLAT) * D;
    f32x4 v[4], h[4]; row_ld(src, lane, v); row_mod(h, v, p.MOD + (size_t)modrow_of_row(r) * 6144, 0, 1, lane); row_st_bf16(p.Hb + (size_t)r * D, lane, h); }
}
constexpr int LN1_RS = 1032, LN1_HXB = 32 * LN1_RS * 2, LN1_OFF_SUM = 2 * LN1_HXB, LN1_OFF_LCNT = LN1_OFF_SUM + 64 * 32 * 4, LN1_OFF_LBASE = LN1_OFF_LCNT + 128, LN1_OFF_ENT = LN1_OFF_LBASE + 128, LN1_END = LN1_OFF_ENT + 72 * 16;
__device__ __forceinline__ void ln1_phase(KP p, int l, LAS char* lds, const int g_wv) {
  const int tid = otid(), lane = tid & 63, wid = tid >> 6, gw = obid() * 8 + wid; const bool last = (l == DEPTH - 1);
  LAS bf16_t* HXhi = (LAS bf16_t*)lds; LAS bf16_t* HXlo = (LAS bf16_t*)(lds + LN1_HXB); LAS float* RED = (LAS float*)lds;
  LAS int* lcnt = (LAS int*)(lds + LN1_OFF_LCNT); LAS int* lbase = (LAS int*)(lds + LN1_OFF_LBASE); LAS int* ent = (LAS int*)(lds + LN1_OFF_ENT);
  if (tid < 32) lcnt[tid] = 0;
  const float* MODl = p.MOD + (size_t)l * 9 * 6144; const bf16_t* WRh = (const bf16_t*)p.s[l].WR; const bf16_t* WRl = WRh + 64 * 1024;
  const int nrow = last ? NLAT : NR, ni = nrow / 2048; const int c32 = lane & 31, hh = lane >> 5;
  f32x4 gg[4], bb[4];
#pragma unroll
  for (int q = 0; q < 4; ++q) { gg[q] = *(const f32x4*)(p.in.ln1_g + l * D + 4 * lane + 256 * q); bb[q] = *(const f32x4*)(p.in.ln1_b + l * D + 4 * lane + 256 * q); }
  f32x4 vn[3][4];
#pragma unroll
  for (int j = 0; j < 3; ++j) if (j < ni) row_ld(p.XL + (size_t)(gw + 2048 * j) * D, lane, vn[j]);
#pragma unroll 1
  for (int i0 = 0; i0 < ni; i0 += 3) {
#pragma unroll
    for (int j = 0; j < 3; ++j) { const int r = gw + 2048 * (i0 + j); const int slot = wid * 3 + j;
      if (i0 + j < ni) { f32x4 v[4], h[4];
#pragma unroll
        for (int q = 0; q < 4; ++q) v[q] = vn[j][q];
        if (i0 + 3 + j < ni) row_ld(p.XL + (size_t)(r + 3 * 2048) * D, lane, vn[j]);
        row_ln_r(v, gg, bb); row_st(p.XL + (size_t)r * D, lane, v);
        row_mod(h, v, MODl + (size_t)modrow_of_row(r) * 6144, 3, 4, lane);
#pragma unroll
        for (int q = 0; q < 4; ++q) { u32x2 wh; wh.x = cvt_pk_bf16(h[q][0], h[q][1]); wh.y = cvt_pk_bf16(h[q][2], h[q][3]); *(u32x2*)(p.H2b + (size_t)r * D + 4 * lane + 256 * q) = wh;
          u32x2 wl; wl.x = cvt_pk_bf16(h[q][0] - bflo(wh.x), h[q][1] - bfhi(wh.x)); wl.y = cvt_pk_bf16(h[q][2] - bflo(wh.y), h[q][3] - bfhi(wh.y));
          *(LAS u32x2*)(HXhi + slot * LN1_RS + 4 * lane + 256 * q) = wh; *(LAS u32x2*)(HXlo + slot * LN1_RS + 4 * lane + 256 * q) = wl; } }
      else {
#pragma unroll
        for (int q = 0; q < 4; ++q) { *(LAS u32x2*)(HXhi + slot * LN1_RS + 4 * lane + 256 * q) = (u32x2){0u, 0u}; *(LAS u32x2*)(HXlo + slot * LN1_RS + 4 * lane + 256 * q) = (u32x2){0u, 0u}; } } }
    __syncthreads();
    f32x16 acc0 = {}, acc1 = {};
#pragma unroll 2
    for (int s8 = 0; s8 < 8; ++s8) { const int ko = (wid * 8 + s8) * 16 + hh * 8;
      const bf16x8 bh = *(const LAS bf16x8*)(HXhi + c32 * LN1_RS + ko), bl = *(const LAS bf16x8*)(HXlo + c32 * LN1_RS + ko);
      const bf16x8 ah0 = *(const bf16x8*)(WRh + (size_t)c32 * 1024 + ko), al0 = *(const bf16x8*)(WRl + (size_t)c32 * 1024 + ko);
      const bf16x8 ah1 = *(const bf16x8*)(WRh + (size_t)(32 + c32) * 1024 + ko), al1 = *(const bf16x8*)(WRl + (size_t)(32 + c32) * 1024 + ko);
      acc0 = __builtin_amdgcn_mfma_f32_32x32x16_bf16(ah0, bh, acc0, 0, 0, 0); acc0 = __builtin_amdgcn_mfma_f32_32x32x16_bf16(ah0, bl, acc0, 0, 0, 0); acc0 = __builtin_amdgcn_mfma_f32_32x32x16_bf16(al0, bh, acc0, 0, 0, 0);
      acc1 = __builtin_amdgcn_mfma_f32_32x32x16_bf16(ah1, bh, acc1, 0, 0, 0); acc1 = __builtin_amdgcn_mfma_f32_32x32x16_bf16(ah1, bl, acc1, 0, 0, 0); acc1 = __builtin_amdgcn_mfma_f32_32x32x16_bf16(al1, bh, acc1, 0, 0, 0); }
    __syncthreads();
#pragma unroll
    for (int r = 0; r < 16; ++r) { RED[(wid * 64 + crow(r, hh)) * 32 + c32] = acc0[r]; RED[(wid * 64 + 32 + crow(r, hh)) * 32 + c32] = acc1[r]; }
    __syncthreads();
    { LAS float* SUM = (LAS float*)(lds + LN1_OFF_SUM);
#pragma unroll
      for (int k = 0; k < 4; ++k) { const int idx = tid + 512 * k; float sacc = 0.f;
#pragma unroll
        for (int w = 0; w < 8; ++w) sacc += RED[w * 2048 + idx];
        SUM[idx] = sacc; } }
    __syncthreads();
    if (wid == 0 && lane < 24) { const int ws = lane / 3, j = lane - 3 * ws;
      if (i0 + j < ni) { const int r = obid() * 8 + ws + 2048 * (i0 + j); float lg[36]; const LAS float* SUM = (const LAS float*)(lds + LN1_OFF_SUM);
#pragma unroll
        for (int e = 0; e < 36; ++e) lg[e] = SUM[e * 32 + lane] + (e < 4 ? p.in.rg_b[l * 4 + e] : p.in.re_b[l * 32 + e - 4]);
        int gi = 0; float gm = lg[0];
#pragma unroll
        for (int q = 1; q < 4; ++q) if (lg[q] > gm) { gm = lg[q]; gi = q; }
        float gs = 0.f;
#pragma unroll
        for (int q = 0; q < 4; ++q) gs += expf(lg[q] - gm);
        const float gtop = 1.f / gs; float el[8];
#pragma unroll
        for (int q = 0; q < 8; ++q) el[q] = gi == 0 ? lg[4 + q] : gi == 1 ? lg[12 + q] : gi == 2 ? lg[20 + q] : lg[28 + q];
        int i0e = 0; float v0 = el[0];
#pragma unroll
        for (int q = 1; q < 8; ++q) if (el[q] > v0) { v0 = el[q]; i0e = q; }
        int i1e = -1; float v1 = -3.0e38f;
#pragma unroll
        for (int q = 0; q < 8; ++q) if (q != i0e && el[q] > v1) { v1 = el[q]; i1e = q; }
        const float e1 = expf(v1 - v0); const float w0 = gtop / (1.f + e1), w1 = gtop * e1 / (1.f + e1);
        const int e0i = gi * 8 + i0e, e1i = gi * 8 + i1e;
        const int lr0 = __hip_atomic_fetch_add(&lcnt[e0i], 1, __ATOMIC_RELAXED, __HIP_MEMORY_SCOPE_WORKGROUP); const int lr1 = __hip_atomic_fetch_add(&lcnt[e1i], 1, __ATOMIC_RELAXED, __HIP_MEMORY_SCOPE_WORKGROUP);
        { LAS int* ep = ent + ((i0 + j) * 8 + ws) * 4; ep[0] = e0i; ep[1] = e1i; ep[2] = lr0; ep[3] = lr1; } *(float2*)(p.RW + (size_t)r * 2) = make_float2(w0, w1); } }
  }
  __syncthreads();
  if (tid < 32) lbase[tid] = (int)atomicAdd(p.ctl + l * CTL_WORDS + CTL_CNT + 64 * tid, (unsigned)lcnt[tid]);
  __syncthreads();
  if (tid < ni * 8) { const int i = tid >> 3, w = tid & 7; const int r = obid() * 8 + w + 2048 * i; const LAS int* ep = ent + tid * 4; const int4 en = make_int4(ep[0], ep[1], ep[2], ep[3]); const int g0 = lbase[en.x] + en.z, g1 = lbase[en.y] + en.w;
    p.TOK[(size_t)en.x * NR + g0] = r; p.TOK[(size_t)en.y * NR + g1] = r; *(int4*)(p.ROUTE + (size_t)r * 4) = make_int4(en.x, en.y, g0, g1); }
}
__device__ __forceinline__ void moe_table(KP p, int l, LAS MoeTab* tab, const int g_wv) {
  const int tid = otid();
  if (tid < 32) tab->cnt[tid] = (int)__hip_atomic_load(p.ctl + l * CTL_WORDS + CTL_CNT + 64 * tid, __ATOMIC_RELAXED, __HIP_MEMORY_SCOPE_AGENT);
  __syncthreads();
  if (tid == 0) { int t = 0; for (int e = 0; e < 32; ++e) { const int c = tab->cnt[e]; tab->tbase[e] = t; const int n = (c + 255) >> 8; for (int i = 0; i < n; ++i) { tab->tileE[t] = e; tab->tileR0[t] = i * 256; ++t; } } tab->tbase[32] = t; tab->ntiles = t; }
  __syncthreads();
}
__device__ __forceinline__ void ln2_phase(KP p, int l, LAS char* lds, const int g_wv) {
  const int tid = otid(), lane = tid & 63, wid = tid >> 6, gw = obid() * 8 + wid; const bool last = (l == DEPTH - 1);
  LAS MoeTab* tab = (LAS MoeTab*)lds; moe_table(p, l, tab, g_wv);
  const float* MODl = p.MOD + (size_t)l * 9 * 6144; const int ni = last ? NLAT / 2048 : NR / 2048;
  int4 rt[9]; float2 rw[9]; f32x4 gg[4], bb[4];
#pragma unroll
  for (int q = 0; q < 4; ++q) { gg[q] = *(const f32x4*)(p.in.ln2_g + l * D + 4 * lane + 256 * q); bb[q] = *(const f32x4*)(p.in.ln2_b + l * D + 4 * lane + 256 * q); }
#pragma unroll
  for (int i = 0; i < 9; ++i) if (i < ni) { const int r = gw + 2048 * i; rt[i] = *(const int4*)(p.ROUTE + (size_t)r * 4); rw[i] = *(const float2*)(p.RW + (size_t)r * 2); }
  f32x4 v[4]; u32x2 ya[4], yb[4];
#define LN2_LOAD(i) do { const int r_ = gw + 2048 * (i); const int p0_ = (tab->tbase[rt[i].x] + (rt[i].z >> 8)) * 256 + (rt[i].z & 255), p1_ = (tab->tbase[rt[i].y] + (rt[i].w >> 8)) * 256 + (rt[i].w & 255); \
    row_ld(p.XL + (size_t)r_ * D, lane, v); _Pragma("unroll") for (int q_ = 0; q_ < 4; ++q_) { ya[q_] = *(const u32x2*)(p.Yo + (size_t)p0_ * D + 4 * lane + 256 * q_); yb[q_] = *(const u32x2*)(p.Yo + (size_t)p1_ * D + 4 * lane + 256 * q_); } } while (0)
  LN2_LOAD(0);
#pragma unroll
  for (int i = 0; i < 9; ++i) if (i < ni) { const int r = gw + 2048 * i; const float2 w = rw[i]; f32x4 x[4];
    const float* mr = MODl + (size_t)modrow_of_row(r) * 6144;
#pragma unroll
    for (int q = 0; q < 4; ++q) { const f32x4 g2 = *(const f32x4*)(mr + 5 * 1024 + 4 * lane + 256 * q); const f32x4 y0 = (f32x4){bflo(ya[q].x), bfhi(ya[q].x), bflo(ya[q].y), bfhi(ya[q].y)}, y1 = (f32x4){bflo(yb[q].x), bfhi(yb[q].x), bflo(yb[q].y), bfhi(yb[q].y)};
      x[q] = v[q] * ALPHA + g2 * (y0 * w.x + y1 * w.y); }
    if (i + 1 < ni) LN2_LOAD(i + 1);
    row_ln_r(x, gg, bb);
    if (!last) { row_st(p.XL + (size_t)r * D, lane, x); f32x4 h[4]; row_mod(h, x, p.MOD + ((size_t)(l + 1) * 9 + modrow_of_row(r)) * 6144, 0, 1, lane); row_st_bf16(p.Hb + (size_t)r * D, lane, h); }
    else row_st(p.out + (size_t)r * D, lane, x); }
#undef LN2_LOAD
}
__device__ __forceinline__ void s2_phase(KP p, int l, const int g_wv) {
  const int tid = otid(); if (tid >= 128) return;
  const int g = obid() >> 3, b = obid() & 7, dir = tid >> 6, pp = tid & 63;
  const f32x2 aL = *(const f32x2*)(p.s[l].SAL + ((size_t)(g * 2 + dir) * 64 + pp) * 2);
  const float* S = p.SST + (size_t)g * NCHP * 256 + dir * 128 + 2 * pp; bf16_t* A = p.Ug + (size_t)g * NCHP * 768 + 512 + dir * 128 + 2 * pp;
  float hr = 0.f, hi = 0.f;
#pragma unroll 1
  for (int s0 = 0; s0 < 72; s0 += 24) {
    f32x2 sv[24];
#pragma unroll
    for (int k = 0; k < 24; ++k) { const int s = s0 + k; int row; if (dir == 0) row = s < 8 ? 512 + b * 8 + s : b * 64 + (s - 8); else row = s < 8 ? 512 + b * 8 + (7 - s) : b * 64 + (63 - (s - 8));
      sv[k] = *(const f32x2*)(S + (size_t)row * 256); }
#pragma unroll
    for (int k = 0; k < 24; ++k) { const int s = s0 + k; int row; if (dir == 0) row = s < 8 ? 512 + b * 8 + s : b * 64 + (s - 8); else row = s < 8 ? 512 + b * 8 + (7 - s) : b * 64 + (63 - (s - 8));
      *(unsigned*)(A + (size_t)row * 768) = cvt_pk_bf16(hr, hi);
      const float nr = aL.x * hr - aL.y * hi + sv[k].x, ni = aL.x * hi + aL.y * hr + sv[k].y; hr = nr; hi = ni; }
  }
}

struct ConvJob { const float* src; const float* src2; bf16_t* dst; int ldd, lds_, kind, nK; };
__device__ __forceinline__ void conv_step(const ConvJob& j, int nt, int kt, int lane) {
  const int q = lane & 15, kq = lane >> 4; const int n = nt * 64 + 4 * q, k0 = kt * 64 + kq * 8; const float* s = j.src; int col;
  if (j.kind == 0) col = (n & ~31) + perm32(n & 31);
  else if (j.kind == 1) { const int pn = n >> 8; if (pn < 4 || (pn >= 10 && pn < 14)) col = n; else if (pn < 10) col = (n & ~31) + perm32(n & 31);
    else { const int bj = (n >> 7) & 1, w = n & 127; col = (bj ? 4608 : 3584) + (pn - 14) * 128 + (w & ~31) + perm32(w & 31); } }
  else { const int bj = (n >> 7) & 1, w = n & 127; col = (n >> 8) * 128 + (w & ~31) + perm32(w & 31); if (bj) s = j.src2; }
  const float* sp = s + (size_t)k0 * j.lds_ + col; f32x4 v[16];
#pragma unroll
  for (int i = 0; i < 8; ++i) { v[i] = *(const f32x4*)(sp + (size_t)i * j.lds_); v[8 + i] = *(const f32x4*)(sp + (size_t)(32 + i) * j.lds_); }
  bf16_t* dp = j.dst + (size_t)n * j.ldd + k0;
#pragma unroll
  for (int r = 0; r < 4; ++r) {
    *(u32x4*)(dp + (size_t)r * j.ldd) = pack8((f32x4){v[0][r], v[1][r], v[2][r], v[3][r]}, (f32x4){v[4][r], v[5][r], v[6][r], v[7][r]});
    *(u32x4*)(dp + (size_t)r * j.ldd + 32) = pack8((f32x4){v[8][r], v[9][r], v[10][r], v[11][r]}, (f32x4){v[12][r], v[13][r], v[14][r], v[15][r]}); }
}
__device__ __forceinline__ void ssm_mats(KP p, KS W, int l, int g, int hf, LAS char* lds, const int g_wv) {
  const int tid = otid();
  LAS f32x2* AP = (LAS f32x2*)lds;
  LAS f32x2* BB = AP + 2 * 64 * 34;
  LAS f32x2* CC = BB + 2 * 64 * 16;
  LAS float* KT = (LAS float*)(CC + 2 * 16 * 64);
  const size_t so = (size_t)l * 2 * NG * NP;
  if (tid < 128) { const int dir = tid >> 6, pp = tid & 63; const size_t gp = so + ((size_t)dir * NG + g) * NP + pp;
    const float dtf = expf(p.in.log_dt[(size_t)l * 2 * NG + dir * NG + g]); const double are = p.in.a_re[gp], aim = p.in.a_im[gp], dt = (double)dtf;
    double ang = aim * dt; ang -= 6.283185307179586476925 * (double)(long long)(ang * 0.15915494309189533577 + (ang >= 0 ? 0.5 : -0.5));
    const float e1f = expf((float)(are * dt)), angf = (float)ang; const double c1r = (double)(e1f * cosf(angf)), c1i = (double)(e1f * sinf(angf));
    { float onef = 1.f; asm volatile("" : "+v"(onef)); double cr = (double)onef, ci = 0.0;
      for (int t = 0; t < 34; ++t) { AP[(dir * 64 + pp) * 34 + t] = (f32x2){(float)cr, (float)ci}; if (t == 32 && hf == 0) *(f32x2*)(W.SAL + ((size_t)(g * 2 + dir) * 64 + pp) * 2) = (f32x2){(float)cr, (float)ci}; const double nr2 = cr * c1r - ci * c1i, ni2 = cr * c1i + ci * c1r; cr = nr2; ci = ni2; } }
    const float sh = sinf(0.5f * angf); const double nr = (double)(expm1f((float)(are * dt)) * cosf(angf) - 2.f * sh * sh), ni = c1i, den = are * are + aim * aim; const double fr = (nr * are + ni * aim) / den, fi = (ni * are - nr * aim) / den;
    for (int c = 0; c < 16; ++c) { const double br = p.in.b_re[gp * 16 + c], bi = p.in.b_im[gp * 16 + c]; BB[(dir * 64 + pp) * 16 + c] = (f32x2){(float)(fr * br - fi * bi), (float)(fr * bi + fi * br)}; }
  }
  for (int i = tid; i < 2 * 16 * 64; i += 512) { const int dir = i >> 10, c = (i >> 6) & 15, pp = i & 63; const size_t ci = (so + ((size_t)dir * NG + g) * NP) * 16 + (size_t)c * NP + pp; CC[i] = (f32x2){p.in.c_re[ci], p.in.c_im[ci]}; }
  __syncthreads();
  LAS float* K0o = KT + 32 * 260;
  { const int own = tid < 256, dir = own ? hf : 1 - hf, co = (tid >> 4) & 15, ci = tid & 15; float acc[32];
#pragma unroll
    for (int t = 0; t < 32; ++t) acc[t] = 0.f;
    if (own) {
      for (int pp = 0; pp < 64; ++pp) { const f32x2 c = CC[(dir * 16 + co) * 64 + pp], bq = BB[(dir * 64 + pp) * 16 + ci]; const float cbr = c.x * bq.x - c.y * bq.y, cbi = c.x * bq.y + c.y * bq.x;
        const LAS f32x4* ap = (const LAS f32x4*)(AP + (dir * 64 + pp) * 34);
#pragma unroll
        for (int t2 = 0; t2 < 16; ++t2) { const f32x4 a = ap[t2]; acc[2 * t2] += cbr * a[0] - cbi * a[1]; acc[2 * t2 + 1] += cbr * a[2] - cbi * a[3]; } }
#pragma unroll
      for (int t = 0; t < 32; ++t) KT[t * 260 + co * 16 + ci] = acc[t];
    } else { float s0 = 0.f;
      for (int pp = 0; pp < 64; ++pp) { const f32x2 c = CC[(dir * 16 + co) * 64 + pp], bq = BB[(dir * 64 + pp) * 16 + ci]; s0 += c.x * bq.x - c.y * bq.y; }
      K0o[co * 16 + ci] = s0; } }
  __syncthreads();
  bf16_t* Sm = W.Smat + (size_t)g * 256 * 768;
  for (int i = tid; i < 128 * 64; i += 512) { const int n = hf * 128 + (i >> 6), k8 = (i & 63) * 8; const int Lc = (n & ~31) + perm32(n & 31); const int dir = Lc >> 7, pp = (Lc & 127) >> 1, ri = Lc & 1; const int t = k8 >> 4, c0 = k8 & 15;
    const f32x2 a = AP[(dir * 64 + pp) * 34 + (dir == 0 ? 31 - t : t)]; float v[8];
#pragma unroll
    for (int q = 0; q < 8; ++q) { const f32x2 bq = BB[(dir * 64 + pp) * 16 + c0 + q]; v[q] = ri == 0 ? a.x * bq.x - a.y * bq.y : a.x * bq.y + a.y * bq.x; }
    *(u32x4*)(Sm + (size_t)n * 768 + k8) = pack8((f32x4){v[0], v[1], v[2], v[3]}, (f32x4){v[4], v[5], v[6], v[7]}); }
  bf16_t* To = W.TO + (size_t)g * 512 * 768; const float* dsk = p.in.ssm_d + l * SSMW + g * 16;
  for (int i = tid; i < 512 * 96; i += 512) { const int n = i / 96, k8 = (i % 96) * 8; const int Lc = (n & ~31) + perm32(n & 31); const int t = Lc >> 4, co = Lc & 15; f32x4 v0, v1;
    if (k8 < 512) { const int s = k8 >> 4, c0 = k8 & 15; if (hf == 0 ? s > t : s <= t) continue;
      const int tau = hf == 0 ? t - s : s - t; const LAS f32x4* kk = (const LAS f32x4*)(KT + tau * 260 + co * 16 + c0); v0 = kk[0]; v1 = kk[1];
      if (s == t) { const LAS f32x4* ko = (const LAS f32x4*)(K0o + co * 16 + c0); v0 += ko[0]; v1 += ko[1]; const float dv = dsk[co]; const int qd = co - c0;
#pragma unroll
        for (int q = 0; q < 4; ++q) { if (qd == q) v0[q] += dv; if (qd == 4 + q) v1[q] += dv; } } }
    else { const int hc0 = k8 - 512; const int dir = hc0 >> 7, pp0 = (hc0 & 127) >> 1; if (dir != hf) continue; float v[8];
#pragma unroll
      for (int q = 0; q < 4; ++q) { const f32x2 a = AP[(dir * 64 + pp0 + q) * 34 + (dir == 0 ? t + 1 : 32 - t)], c = CC[(dir * 16 + co) * 64 + pp0 + q];
        v[2 * q] = c.x * a.x - c.y * a.y; v[2 * q + 1] = -(c.x * a.y + c.y * a.x); }
      v0 = (f32x4){v[0], v[1], v[2], v[3]}; v1 = (f32x4){v[4], v[5], v[6], v[7]}; }
    *(u32x4*)(To + (size_t)n * 768 + k8) = pack8(v0, v1); }
  __syncthreads();
}
__device__ __forceinline__ void mod_item(KP p, int l, int j0, LAS char* lds, const int g_wv) {
  const int tid = otid(); LAS float* sl = (LAS float*)lds;
  LAS float* part = sl + 9 * 1024;
  for (int i = tid; i < 9 * 1024; i += 512) { const int r = i >> 10, k = i & 1023; const float v = r < 8 ? p.in.c[r * 1024 + k] : p.in.c_ctx[k]; sl[i] = v / (1.f + expf(-v)); }
  __syncthreads();
  const int jj = tid & 63, ks = tid >> 6; float acc[9];
#pragma unroll
  for (int r = 0; r < 9; ++r) acc[r] = 0.f;
  const float* w = p.in.w_mod + (size_t)l * 1024 * 6144 + j0 + jj;
  for (int k = ks * 128; k < ks * 128 + 128; ++k) { const float wv = w[(size_t)k * 6144];
#pragma unroll
    for (int r = 0; r < 9; ++r) acc[r] += sl[r * 1024 + k] * wv; }
#pragma unroll
  for (int r = 0; r < 9; ++r) part[(ks * 9 + r) * 64 + jj] = acc[r];
  __syncthreads();
  for (int i = tid; i < 9 * 64; i += 512) { const int r = i >> 6, j = i & 63; float s = 0.f;
#pragma unroll
    for (int k = 0; k < 8; ++k) s += part[(k * 9 + r) * 64 + j];
    p.MOD[((size_t)l * 9 + r) * 6144 + j0 + j] = s + p.in.b_mod[l * 6144 + j0 + j]; }
  __syncthreads();
}
__device__ __forceinline__ void conv_steps(KP p, KW W, int l, int s0, int s1, int gw, int nw, int lane) {
  for (int t0 = s0 + gw; t0 < s1; t0 += nw) { int t = t0; ConvJob j; int nK;
    if (t < 1408) { j.src = p.in.w_in + (size_t)l * 1024 * INW; j.src2 = nullptr; j.dst = W.Win; j.ldd = 1024; j.lds_ = INW; j.kind = 1; nK = 16; }
    else if ((t -= 1408) < 64) { j.src = p.in.w_glu + (size_t)l * 512 * 512; j.src2 = nullptr; j.dst = W.Wglu; j.ldd = 512; j.lds_ = 512; j.kind = 0; nK = 8; }
    else if ((t -= 64) < 256) { j.src = p.in.w_pa + (size_t)l * 1024 * 1024; j.src2 = nullptr; j.dst = W.Wpa; j.ldd = 1024; j.lds_ = 1024; j.kind = 0; nK = 16; }
    else if ((t -= 256) < 128) { j.src = p.in.w_ps + (size_t)l * 512 * 1024; j.src2 = nullptr; j.dst = W.Wps; j.ldd = 1024; j.lds_ = 1024; j.kind = 0; nK = 8; }
    else if ((t -= 128) < 256) { j.src = p.in.w_o + (size_t)l * 1024 * 1024; j.src2 = nullptr; j.dst = W.Wo; j.ldd = 1024; j.lds_ = 1024; j.kind = 0; nK = 16; }
    else if ((t -= 256) < 8192) { const int e = t >> 8; t &= 255; j.src = p.in.w1 + ((size_t)l * NE + e) * 1024 * 512; j.src2 = p.in.w3 + ((size_t)l * NE + e) * 1024 * 512; j.dst = W.W13 + (size_t)e * 1024 * 1024; j.ldd = 1024; j.lds_ = 512; j.kind = 2; nK = 16; }
    else { t -= 8192; const int e = t >> 7; t &= 127; j.src = p.in.w2 + ((size_t)l * NE + e) * 512 * 1024; j.src2 = nullptr; j.dst = W.W2 + (size_t)e * 1024 * 512; j.ldd = 512; j.lds_ = 1024; j.kind = 0; nK = 8; }
    conv_step(j, t / nK, t % nK, lane); }
}
__device__ __forceinline__ void router_tab(KP p, KS W, int l, int tid) {
  bf16_t* Wh = (bf16_t*)W.WR; bf16_t* Wl = Wh + 64 * 1024;
  for (int q = tid; q < 64 * 1024; q += 512) { const int e = q >> 10, k = q & 1023; const float w = e < 4 ? p.in.rg_w[((size_t)l * 1024 + k) * 4 + e] : e < 36 ? p.in.re_w[((size_t)l * 1024 + k) * 32 + (e - 4)] : 0.f;
    const unsigned hi = cvt_pk_bf16(w, 0.f) & 0xffffu; const unsigned lo = cvt_pk_bf16(w - bflo(hi), 0.f) & 0xffffu; Wh[q] = (bf16_t)hi; Wl[q] = (bf16_t)lo; }
}
constexpr int CONV_STEPS = 14400, CONV_S1 = 2350, CONV_S2 = 9550;
__device__ __forceinline__ void conv_phase(KP p, int l, LAS char* lds, const int g_wv) {
  const int tid = otid(); const int b = obid(); const int nb = ogd();
  if (b & 1) { for (int it = b; it < DEPTH * 2 * NG; it += nb) { const int ls = it >> 6, r = it & 63; ssm_mats(p, p.s[ls], ls, r >> 1, r & 1, lds, g_wv); } }
  else conv_steps(p, p.w[0], 0, 0, CONV_STEPS, (b >> 1) * 8 + (tid >> 6), (nb >> 1) * 8 * 2, tid & 63);
  if (b < DEPTH) router_tab(p, p.s[b], b, tid);
  if (b == 4) { for (int q = tid; q < 2048 * 32; q += 512) { const int t = q >> 5, axis = (q >> 4) & 1, f = q & 15; const float pos = axis == 0 ? (float)(t >> 6) : (float)(t & 63);
      const float inv = 1.0f / powf(10000.0f, (float)(2 * f) / 32.0f); const float ang = pos * inv; p.ROPE[((size_t)t * 2 + axis) * 32 + f] = cosf(ang); p.ROPE[((size_t)t * 2 + axis) * 32 + 16 + f] = sinf(ang); } }
  for (int it = b; it < 4 * 96; it += nb) mod_item(p, it / 96, (it % 96) * 64, lds, g_wv);
  if (b & 1) conv_steps(p, p.w[0], 0, 0, CONV_STEPS, ((nb >> 1) + (b >> 1)) * 8 + (tid >> 6), (nb >> 1) * 8 * 2, tid & 63);
  else { for (int it = b; it < DEPTH * 2 * NG; it += nb) { const int ls = it >> 6, r = it & 63; ssm_mats(p, p.s[ls], ls, r >> 1, r & 1, lds, g_wv); } }
}
__device__ __forceinline__ void conv_tail(KP p, int l, int part, const int g_wv) {
  const int b = obid(); if (l >= DEPTH - 1) return;
  const int tid = otid(); const int ln = l + 1; KW W = p.w[ln & 1];
  if (part == 2) { if (b >= 144) conv_steps(p, W, ln, 0, CONV_S1, (b - 144) * 8 + (tid >> 6), (ogd() - 144) * 8, tid & 63); return; }
  if (b < 32) return;
  if (part == 0) conv_steps(p, W, ln, CONV_S1, CONV_S2, (b - 32) * 8 + (tid >> 6), (ogd() - 32) * 8, tid & 63);
  else conv_steps(p, W, ln, CONV_S2, CONV_STEPS, (b - 32) * 8 + (tid >> 6), (ogd() - 32) * 8, tid & 63);
}
}
namespace fk {
constexpr int LDS_BYTES = 149504;
#ifndef PROBE_MASK
#define PROBE_MASK 0
#endif
constexpr int NPH = 14;
enum { PH_CONV = 0, PH_H0, PH_GEMM1, PH_S1, PH_S2, PH_S3, PH_ATT, PH_GLU, PH_MERGE, PH_WO, PH_LN1, PH_MOE1, PH_MOE2, PH_LN2 };

__device__ __forceinline__ void run_phase(KP p, int l, int ph, LAS unsigned char* lds, const int g_wv) {
  const int G = ogd(), c = obid(); const bool last = (l == DEPTH - 1);
  const float* MODl = p.MOD + (size_t)l * 9 * 6144; KW W = p.w[l & 1]; KS SS = p.s[l];
  switch (ph) {
    case PH_CONV: if (l == 0) conv_phase(p, l, (LAS char*)lds, g_wv); break;
    case PH_H0: if (l == 0) h0_phase(p, g_wv); break;
    case PH_GEMM1: { SchedG1 S{(const char*)p.Hb, (const char*)W.Win, G, c, 0, last ? 1488 : 1536, last};
      EpiIn E{p.ROPE, p.Kc, p.Vc, p.Ug, p.Qb, p.RG, p.GSb}; gemm_stream(lds, 2048, 2048, S, E, g_wv); } break;
    case PH_S1: if (c < 96) { SchedSsm1 S{(const char*)p.Ug, (const char*)SS.Smat, 96, c}; EpiState E{p.SST}; gemm_stream(lds, 1536, 1536, S, E, g_wv); }
      else if (!last && c < 144) { SchedG1 S{(const char*)p.Hb, (const char*)W.Win, 48, c - 96, 1536, 1584, false}; EpiIn E{p.ROPE, p.Kc, p.Vc, p.Ug, p.Qb, p.RG, p.GSb}; gemm_stream(lds, 2048, 2048, S, E, g_wv); }
      else conv_tail(p, l, 2, g_wv);
      break;
    case PH_S2: s2_phase(p, l, g_wv); break;
    case PH_S3: { SchedSsm3 S{(const char*)p.Ug, (const char*)SS.TO, G, c}; EpiSsmOut E{p.YG}; gemm_stream(lds, 1536, 1536, S, E, g_wv); } break;
    case PH_ATT: attn_phase(p, l, (LAS char*)lds, g_wv); break;
    case PH_GLU: { SchedPlain S; S.A = (const char*)p.YG; S.B = (const char*)W.Wglu; S.lda = NR * 32; S.ldb = 1024; S.nM = last ? NLAT / 256 : NR / 256; S.nN = 2; S.nt = 8; S.G = G; S.c = c; S.nunits = S.nM * 2; S.epi = 1; S.atile = 256 * 32;
      EpiGlu E{p.YG, p.S2, p.in.b_glu + l * SSMW}; gemm_stream<EpiGlu, SchedPlain, false, 1>(lds, NR * 32, 1024, S, E, g_wv); } break;
    case PH_MERGE: { SchedMerge S{(const char*)p.ATTb, (const char*)W.Wpa, (const char*)p.S2, (const char*)W.Wps, last ? NLAT / 256 : NR / 256, 4, G, c, (last ? NLAT / 256 : NR / 256) * 4};
      EpiMerge E{p.RG, p.GSb, p.Mb}; gemm_stream(lds, 2048, 2048, S, E, g_wv); } conv_tail(p, l, 0, g_wv); break;
    case PH_WO: { SchedPlain S; S.A = (const char*)p.Mb; S.B = (const char*)W.Wo; S.lda = 2048; S.ldb = 2048; S.nM = last ? NLAT / 256 : NR / 256; S.nN = 4; S.nt = 16; S.G = G; S.c = c; S.nunits = S.nM * 4; S.epi = 1; S.atile = 256 * 2048;
      EpiWo E{l == 0 ? p.in.x : p.XL, l == 0 ? p.in.ctx : p.XL + (size_t)NLAT * D, p.XL, MODl}; gemm_stream(lds, 2048, 2048, S, E, g_wv); } conv_tail(p, l, 1, g_wv); break;
    case PH_LN1: ln1_phase(p, l, (LAS char*)lds, g_wv); break;
    case PH_MOE1: { LAS MoeTab* tab = (LAS MoeTab*)(lds + STAGE_BYTES); moe_table(p, l, tab, g_wv);
      SchedMoe S{(const char*)p.H2b, (const char*)W.W13, 2048, 2048, (size_t)1024 * 2048, tab, p.TOK, 4, 16, G, c, true}; EpiMoe1 E{p.Hm}; gemm_stream<EpiMoe1, SchedMoe, true>(lds, 2048, 2048, S, E, g_wv); } break;
    case PH_MOE2: { LAS MoeTab* tab = (LAS MoeTab*)(lds + STAGE_BYTES); moe_table(p, l, tab, g_wv);
      SchedMoe S{(const char*)p.Hm, (const char*)W.W2, 1024, 1024, (size_t)1024 * 1024, tab, p.TOK, 4, 8, G, c, false}; EpiMoe2 E{p.Yo}; gemm_stream(lds, 1024, 1024, S, E, g_wv); } break;
    case PH_LN2: ln2_phase(p, l, (LAS char*)lds, g_wv); break;
  }
}

__global__ void __launch_bounds__(512, 2) mega(Params p) {
  extern __shared__ __attribute__((aligned(16))) unsigned char smem[];
  LAS unsigned char* lds = (LAS unsigned char*)smem;
  LAS unsigned* xbw = (LAS unsigned*)(lds + LDS_BYTES - 16);
  if (threadIdx.x == 0) { xbw[0] = 0u; xbw[1] = 0u; xbw[2] = 0u; xbw[3] = 0u; }
  __syncthreads();
  XcdBarrier bar = xcd_barrier_post(p.bar, (volatile LAS unsigned*)xbw);
  const int ph_lo = p.ph_lo, ph_hi = p.ph_hi; const int g_wv = __builtin_amdgcn_readfirstlane((int)threadIdx.x >> 6);
  for (int l = 0; l < DEPTH; ++l) {
#define PHASE(ID) do { const int gph = l * NPH + (ID); if (gph >= ph_lo && gph < ph_hi && !(((ID) == PH_H0 || (ID) == PH_CONV) && l > 0)) { \
      const __attribute__((address_space(4))) Params* kp = (const __attribute__((address_space(4))) Params*)__builtin_amdgcn_kernarg_segment_ptr(); int lv = l; int wvp = g_wv; \
      asm volatile("" : "+s"(kp), "+s"(lv), "+s"(wvp));     \
      run_phase(*kp, lv, (ID), lds, wvp); if (gph + 1 < ph_hi) xcd_barrier(bar); } } while (0)
    PHASE(PH_CONV); PHASE(PH_H0); PHASE(PH_GEMM1); PHASE(PH_S1); PHASE(PH_S2); PHASE(PH_S3); PHASE(PH_ATT); PHASE(PH_GLU); PHASE(PH_MERGE); PHASE(PH_WO);
    PHASE(PH_LN1); PHASE(PH_MOE1); PHASE(PH_MOE2); PHASE(PH_LN2);
#undef PHASE
  }
}

struct Host { Params p; size_t ws_used; };
inline size_t al256(size_t x) { return (x + 255) & ~(size_t)255; }
inline Host make_params(void* const* d_in, void* d_out, void* d_ws) {
  Host H; memset(&H, 0, sizeof(H)); Params& p = H.p;
  const float** ip = (const float**)&p.in; for (int i = 0; i < 36; ++i) ip[i] = (const float*)d_in[i];
  p.out = (float*)d_out;
  char* base = (char*)d_ws; size_t off = 0;
  auto take = [&](size_t bytes) { char* r = base + off; off = al256(off + bytes); return r; };
  p.bar = (unsigned*)take(XCD_BAR_WORDS * 4); p.ctl = (unsigned*)take((size_t)DEPTH * CTL_WORDS * 4);
  p.MOD = (float*)take((size_t)DEPTH * 9 * 6144 * 4); p.ROPE = (float*)take((size_t)2048 * 64 * 4);
  p.ROUTE = (int*)take((size_t)NR * 4 * 4); p.RW = (float*)take((size_t)NR * 2 * 4); p.TOK = (int*)take((size_t)NE * NR * 4);
  p.XL = (float*)take((size_t)NR * D * 4); p.Hb = (bf16_t*)take((size_t)NR * D * 2); p.H2b = (bf16_t*)take((size_t)NR * D * 2); p.Mb = (bf16_t*)take((size_t)NR * D * 2);
  for (int k = 0; k < 4; ++k) { SSet& w = p.s[k]; w.SAL = (float*)take((size_t)NG * 2 * 64 * 2 * 4); w.WR = (float*)take((size_t)2 * 64 * 1024 * 2);
    w.Smat = (bf16_t*)take((size_t)NG * 256 * 768 * 2); w.TO = (bf16_t*)take((size_t)NG * 512 * 768 * 2); }
  for (int k = 0; k < 2; ++k) { WSet& w = p.w[k];
    w.Win = (bf16_t*)take((size_t)INW * 1024 * 2); w.Wglu = (bf16_t*)take((size_t)512 * 512 * 2); w.Wpa = (bf16_t*)take((size_t)1024 * 1024 * 2); w.Wps = (bf16_t*)take((size_t)1024 * 1024 * 2);
    w.Wo = (bf16_t*)take((size_t)1024 * 1024 * 2); w.W13 = (bf16_t*)take((size_t)NE * 1024 * 1024 * 2); w.W2 = (bf16_t*)take((size_t)NE * 1024 * 512 * 2); }
  const size_t mix0 = off;
  p.Kc = (bf16_t*)take((size_t)NB * KVB * D * 2); p.Vc = (bf16_t*)take((size_t)NB * KVB * D * 2); p.Qb = (bf16_t*)take((size_t)NR * D * 2);
  p.Ug = (bf16_t*)take((size_t)NG * NCHP * 768 * 2 + 4096); p.RG = (bf16_t*)take((size_t)NR * D * 2); p.GSb = (bf16_t*)take((size_t)NR * D * 2); p.ATTb = (bf16_t*)take((size_t)NR * D * 2);
  p.SST = (float*)take((size_t)NG * NCHP * 256 * 4); p.YG = (bf16_t*)take((size_t)NR * SSMW * 2); p.S2 = (bf16_t*)take((size_t)NR * D * 2);
  const size_t mix1 = off; off = mix0;
  p.Hm = (bf16_t*)take((size_t)MOE_ROWS * EH * 2); p.Yo = (bf16_t*)take((size_t)MOE_ROWS * D * 2);
  if (off < mix1) off = mix1;
  H.ws_used = off; p.ph_lo = 0; p.ph_hi = DEPTH * NPH;
  return H;
}
inline int grid_size() {
  static int grid = 0;
  if (!grid) { hipFuncSetAttribute((const void*)mega, hipFuncAttributeMaxDynamicSharedMemorySize, LDS_BYTES);
    int dev = 0, cus = 0, per_cu = 0; hipGetDevice(&dev); hipDeviceGetAttribute(&cus, hipDeviceAttributeMultiprocessorCount, dev);
    hipOccupancyMaxActiveBlocksPerMultiprocessor(&per_cu, mega, 512, LDS_BYTES);
    grid = (per_cu >= 1 && cus >= 256) ? 256 : 0;
    if (!grid) fprintf(stderr, "mega: cannot be resident (cus %d per_cu %d)\n", cus, per_cu); }
  return grid;
}
inline void launch_range(Host& H, int lo, int hi, hipStream_t st) {
  const int grid = grid_size(); if (!grid) return;
  H.p.ph_lo = lo; H.p.ph_hi = hi;
  hipLaunchKernelGGL(mega, dim3(grid), dim3(512), LDS_BYTES, st, H.p);
}
}
#ifndef PROBE_K
#define PROBE_K 8
#endif
extern "C" void kernel_launch(void* const* d_in, const int* in_sizes, int n_in, void* d_out, int out_size, void* d_ws, size_t ws_size, hipStream_t stream) {
  fk::Host H = fk::make_params(d_in, d_out, d_ws);
  if (H.ws_used > ws_size) { fprintf(stderr, "ws too small: need %zu have %zu\n", H.ws_used, ws_size); return; }
  hipMemsetAsync(H.p.bar, 0, (size_t)((char*)H.p.MOD - (char*)H.p.bar), stream);
  fk::launch_range(H, 0, fk::DEPTH * fk::NPH, stream);
#if PROBE_MASK
  for (int id = 0; id < fk::NPH; ++id) if ((PROBE_MASK >> id) & 1) { const int g = fk::NPH + id;
    for (int k = 0; k < PROBE_K; ++k) { hipMemsetAsync(H.p.bar, 0, XCD_BAR_WORDS * 4, stream); fk::launch_range(H, g, g + 1, stream); } }
#endif
}
```

```cpp
#include <hip/hip_runtime.h>
#include <cstdio>
#include <cstdint>
#include <cstring>
#include <cmath>
namespace fk {
#define LAS __attribute__((address_space(3)))
typedef unsigned short bf16_t;
typedef short bf16x8 __attribute__((ext_vector_type(8)));
typedef short s16x4 __attribute__((ext_vector_type(4)));
typedef float f32x4 __attribute__((ext_vector_type(4)));
typedef float f32x2 __attribute__((ext_vector_type(2)));
typedef float f32x16 __attribute__((ext_vector_type(16)));
typedef unsigned u32x4 __attribute__((ext_vector_type(4)));
typedef unsigned u32x2 __attribute__((ext_vector_type(2)));

constexpr int D = 1024, SEQ = 2048, CTX = 256, NB = 8, NLAT = NB * SEQ, NCTX = NB * CTX, NR = NLAT + NCTX, KVB = SEQ + CTX;
constexpr int INW = 5632, NHEAD = 8, SSMW = 512, NG = 32, NP = 64, NE = 32, EH = 512, DEPTH = 4;
constexpr int CHUNK = 32, NCHR = NR / CHUNK  , NCHP = 768  ;
constexpr int MOE_ROWS = 2 * NR + NE * 256;
constexpr float ALPHA = 1.681792830507429f;

__device__ __forceinline__ unsigned cvt_pk_bf16(float lo, float hi) { unsigned r; asm volatile("v_cvt_pk_bf16_f32 %0, %1, %2" : "=v"(r) : "v"(lo), "v"(hi)); return r; }
__device__ __forceinline__ float bf2f(unsigned short b) { return __uint_as_float(((unsigned)b) << 16); }
__device__ __forceinline__ float bflo(unsigned w) { return __uint_as_float(w << 16); }
__device__ __forceinline__ float bfhi(unsigned w) { return __uint_as_float(w & 0xffff0000u); }
typedef _Float16 h16x2 __attribute__((ext_vector_type(2)));
__device__ __forceinline__ unsigned pk_h16(float lo, float hi) { h16x2 h; h[0] = (_Float16)lo; h[1] = (_Float16)hi; return __builtin_bit_cast(unsigned, h); }
__device__ __forceinline__ float h16lo(unsigned w) { return (float)__builtin_bit_cast(h16x2, w)[0]; }
__device__ __forceinline__ float h16hi(unsigned w) { return (float)__builtin_bit_cast(h16x2, w)[1]; }
__device__ __forceinline__ u32x4 pack8(const f32x4& a, const f32x4& b) { u32x4 w; w.x = cvt_pk_bf16(a[0], a[1]); w.y = cvt_pk_bf16(a[2], a[3]); w.z = cvt_pk_bf16(b[0], b[1]); w.w = cvt_pk_bf16(b[2], b[3]); return w; }
__device__ __forceinline__ void unpack8(const u32x4& w, f32x4& a, f32x4& b) { a = (f32x4){bflo(w.x), bfhi(w.x), bflo(w.y), bfhi(w.y)}; b = (f32x4){bflo(w.z), bfhi(w.z), bflo(w.w), bfhi(w.w)}; }
__device__ __forceinline__ float fast_sigmoid(float x) { return __builtin_amdgcn_rcpf(1.f + __builtin_amdgcn_exp2f(-1.4426950408889634f * x)); }
__device__ __forceinline__ float fast_silu(float x) { return x * fast_sigmoid(x); }
__device__ __forceinline__ float gelu_tanh_f(float x) { const float z = 0.7978845608028654f * (x + 0.044715f * x * x * x); return x * fast_sigmoid(2.f * z); }
__device__ __forceinline__ int otid_w(int wv) { int t; asm volatile("v_mbcnt_lo_u32_b32 %0, -1, 0\n\tv_mbcnt_hi_u32_b32 %0, -1, %0\n\tv_lshl_add_u32 %0, %1, 6, %0" : "=&v"(t) : "s"(wv)); return t; }
__device__ __forceinline__ float ozero() { float z = 0.f; asm volatile("" : "+v"(z)); return z; }
__device__ __forceinline__ void stagger_wait(int ticks) { if (ticks > 0) { const unsigned long long t0 = __builtin_amdgcn_s_memrealtime(); while ((long long)(__builtin_amdgcn_s_memrealtime() - t0) < (long long)ticks) __builtin_amdgcn_s_sleep(8); } }
__device__ __forceinline__ int obid() { int b = blockIdx.x; asm volatile("" : "+s"(b)); return b; }
__device__ __forceinline__ int ogd() { int g = gridDim.x; asm volatile("" : "+s"(g)); return g; }
#define otid() otid_w(g_wv)
template <int CTRL, int RM> __device__ __forceinline__ float dpp_f(float v) { return __builtin_bit_cast(float, __builtin_amdgcn_update_dpp(0, __builtin_bit_cast(int, v), CTRL, RM, 0xF, false)); }
__device__ __forceinline__ float wave_sum_u(float v) {
  v += dpp_f<0xB1, 0xF>(v); v += dpp_f<0x4E, 0xF>(v); v += dpp_f<0x141, 0xF>(v); v += dpp_f<0x140, 0xF>(v); v += dpp_f<0x142, 0xA>(v); v += dpp_f<0x143, 0xC>(v);
  return __builtin_bit_cast(float, __builtin_amdgcn_readlane(__builtin_bit_cast(int, v), 63)); }
__host__ __device__ __forceinline__ int perm32(int rho) { const int n = rho >> 4, i = rho & 15; return 8 * (i >> 2) + 4 * n + (i & 3); }

#define XB_TMO      128
#define XB_XCNT(j)  (256  + 64 * (j))
#define XB_XSUB(j)  (1280 + 64 * (j))
#define XB_XGEN(j)  (2304 + 64 * (j))
#define XB_TOP      3328
#define XB_TOPGEN   3392
#define XCD_BAR_WORDS 3456
#define XB_SPIN_CAP (1u << 22)
__device__ __forceinline__ unsigned xb_ld(unsigned* p)              { return __hip_atomic_load(p, __ATOMIC_RELAXED, __HIP_MEMORY_SCOPE_AGENT); }
__device__ __forceinline__ unsigned xb_add(unsigned* p, unsigned v) { return __hip_atomic_fetch_add(p, v, __ATOMIC_RELAXED, __HIP_MEMORY_SCOPE_AGENT); }
__device__ __forceinline__ unsigned xb_xcc_id() { return (unsigned)__builtin_amdgcn_s_getreg((3 << 11) | 20) & 0xFu; }
#define XB_SPIN(cond, bar) do { unsigned _sp = 0; while (cond) { __builtin_amdgcn_s_sleep(1); \
    if ((++_sp & 255u) == 0u) { if (xb_ld(&(bar)[XB_TMO])) break; if (_sp > XB_SPIN_CAP) { atomicAdd(&(bar)[XB_TMO], 1u); break; } } } } while (0)
struct XcdBarrier { unsigned* bar; unsigned x; volatile LAS unsigned* st; };
__device__ __forceinline__ XcdBarrier xcd_barrier_post(unsigned* bar, volatile LAS unsigned* st) {
    XcdBarrier b; b.bar = bar; b.x = xb_xcc_id(); b.st = st;
    if (threadIdx.x == 0) (void)xb_add(&bar[XB_XCNT(b.x)], 1u);
    return b;
}
__device__ __forceinline__ void xcd_barrier_complete(unsigned* bar, unsigned x, unsigned& nloc, unsigned& nx) {
    const unsigned G = gridDim.x * gridDim.y * gridDim.z;
    unsigned sum, cnt, mine, sp = 0u;
    for (;;) {
        sum = 0u; cnt = 0u; mine = 0u;
#pragma unroll
        for (unsigned j = 0; j < 16; ++j) { const unsigned c = xb_ld(&bar[XB_XCNT(j)]); sum += c; cnt += (c > 0u) ? 1u : 0u; mine = (j == x) ? c : mine; }
        if (sum == G) break;
        __builtin_amdgcn_s_sleep(1);
        if ((++sp & 255u) == 0u) { if (xb_ld(&bar[XB_TMO])) break; if (sp > XB_SPIN_CAP) { atomicAdd(&bar[XB_TMO], 1u); break; } }
    }
    nloc = mine > 0u ? mine : 1u; nx = cnt > 0u ? cnt : 1u;
}
__device__ __forceinline__ void xcd_barrier(const XcdBarrier& b) {
    asm volatile("s_waitcnt vmcnt(0)" ::: "memory");
    __syncthreads();
    if (threadIdx.x == 0) {
        unsigned* bar = b.bar;
        __builtin_amdgcn_s_waitcnt(0);
        unsigned nloc = b.st[0], nx = b.st[1];
        if (nloc == 0u) { xcd_barrier_complete(bar, b.x, nloc, nx); b.st[0] = nloc; b.st[1] = nx; }
        const unsigned old = xb_add(&bar[XB_XSUB(b.x)], 1u);
        const unsigned gen = old / nloc;
        if (old + 1u == (gen + 1u) * nloc) {
            __builtin_amdgcn_fence(__ATOMIC_RELEASE, "agent");
            asm volatile("s_waitcnt vmcnt(0)" ::: "memory");
            const unsigned og = xb_add(&bar[XB_TOP], 1u);
            const unsigned tg = og / nx;
            if (og + 1u == (tg + 1u) * nx) xb_add(&bar[XB_TOPGEN], 1u);
            else XB_SPIN(xb_ld(&bar[XB_TOPGEN]) == tg, bar);
            __builtin_amdgcn_fence(__ATOMIC_ACQUIRE, "agent");
            asm volatile("s_waitcnt vmcnt(0)" ::: "memory");
        } else {
            XB_SPIN(xb_ld(&bar[XB_TOPGEN]) == gen, bar);
            __builtin_amdgcn_fence(__ATOMIC_ACQUIRE, "agent");
            asm volatile("s_waitcnt vmcnt(0)" ::: "memory");
        }
    }
    __syncthreads();
}

__device__ __forceinline__ void tile_signal(unsigned* cnt) {
    asm volatile("s_waitcnt vmcnt(0)" ::: "memory");
    __syncthreads();
    if (threadIdx.x == 0) { __builtin_amdgcn_fence(__ATOMIC_RELEASE, "agent"); asm volatile("s_waitcnt vmcnt(0)" ::: "memory"); (void)xb_add(cnt, 1u); }
}
__device__ __forceinline__ void tile_wait(unsigned* cnt, unsigned target, unsigned* bar) {
#ifdef NO_ACQ
    if (threadIdx.x == 0) { XB_SPIN(xb_ld(cnt) < target, bar); asm volatile("s_waitcnt vmcnt(0)" ::: "memory"); }
#else
    if (threadIdx.x == 0) { XB_SPIN(xb_ld(cnt) < target, bar); __builtin_amdgcn_fence(__ATOMIC_ACQUIRE, "agent"); asm volatile("s_waitcnt vmcnt(0)" ::: "memory"); }
#endif
    __syncthreads();
}

__device__ __forceinline__ void split_arrive(unsigned* bar, volatile LAS unsigned* st, unsigned* xc, unsigned* done) {
    asm volatile("s_waitcnt vmcnt(0)" ::: "memory");
    __syncthreads();
    if (threadIdx.x == 0) {
        const unsigned x = xb_xcc_id(); unsigned nloc = st[0], nx = st[1];
        if (nloc == 0u) { xcd_barrier_complete(bar, x, nloc, nx); st[0] = nloc; st[1] = nx; }
        const unsigned old = xb_add(&xc[x * 16], 1u);
        if (old + 1u == nloc) { __builtin_amdgcn_fence(__ATOMIC_RELEASE, "agent"); asm volatile("s_waitcnt vmcnt(0)" ::: "memory"); (void)xb_add(done, 1u); }
    }
}
__device__ __forceinline__ void split_wait(unsigned* bar, volatile LAS unsigned* st, unsigned* done) {
    if (threadIdx.x == 0) { const unsigned nx = st[1]; XB_SPIN(xb_ld(done) < nx, bar); __builtin_amdgcn_fence(__ATOMIC_ACQUIRE, "agent"); asm volatile("s_waitcnt vmcnt(0)" ::: "memory"); }
    __syncthreads();
}

constexpr int BM = 256, BK = 64, HALF = 128, HTB = HALF * BK * 2, STAGE_BYTES = 8 * HTB;
__host__ __device__ __forceinline__ int lds_byte(int r, int c) { const int st = (r >> 4) * 2 + (c >> 5), rr = r & 15, cc = c & 31, ob = rr * 64 + cc * 2; return st * 1024 + (ob ^ (((ob >> 9) & 1) << 5)); }
__host__ __device__ __forceinline__ void stage_rc(int b, int& R, int& C) { const int st = b / 1024, sb = b % 1024, swz = sb ^ (((sb >> 9) & 1) << 5); R = (st >> 1) * 16 + swz / 64; C = (st & 1) * 32 + (swz % 64) / 2; }
struct Seg { const char* A; const char* B; int nt; int epi; int pm; int pn; int aux; int aux2; };
__device__ __forceinline__ void tile_order(int L, int nM, int nN, int& pm, int& pn) {
    const int nwg = nM * nN; int wgid = L; { const int q = nwg / 8, r = nwg % 8, xcd = wgid % 8, off = wgid / 8; wgid = (xcd < r ? xcd * (q + 1) : r * (q + 1) + (xcd - r) * q) + off; }
    const int nig = 8 * nN, gid = wgid / nig, fm = gid * 8, gsz = (nM - fm) < 8 ? (nM - fm) : 8;
    pm = fm + ((wgid % nig) % gsz); pn = (wgid % nig) / gsz;
}
#ifndef GEMM_8PH
#define GEMM_8PH 0
#endif
template <class Epi, class Sched, bool GATHER = false, int AMODE = 0>
__device__ __forceinline__ void gemm_stream(LAS unsigned char* lds, const int lda, const int ldb, const Sched& S, const Epi& E, const int g_wv) {
    const int tid = otid(), wid = __builtin_amdgcn_readfirstlane(tid >> 6), lane = tid & 63, wr = wid >> 2, wc = wid & 3, fr = lane & 15, fq = lane >> 4;
    unsigned voffA[2], voffB[2];
#pragma unroll
    for (int i = 0; i < 2; ++i) { int R, C; stage_rc(tid * 16 + i * 8192, R, C); voffA[i] = AMODE == 1 ? (unsigned)((C >> 4) * lda + R * 32 + (C & 15) * 2) : (unsigned)(R * lda + C * 2); voffB[i] = (unsigned)(R * ldb + C * 2); }
    LAS unsigned* gst = (LAS unsigned*)(lds + STAGE_BYTES + 8192) + tid * 4;
    unsigned gCb = 0; if constexpr (GATHER) { int R_, C_; stage_rc(tid * 16, R_, C_); gCb = (unsigned)(C_ * 2); }
#define PG8_GV(slot, seg) do { int _R, _C; stage_rc(otid() * 16, _R, _C); _Pragma("unroll") for (int _h = 0; _h < 2; ++_h) gst[(slot) * 2 + _h] = S.grow(seg, _h * HALF + _R) | (S.grow(seg, _h * HALF + _R + 64) << 16); } while (0)
    const size_t kstep = (size_t)(BK * 2), kstepA = AMODE == 1 ? (size_t)4 * lda : kstep;
    const size_t hstepA = AMODE == 1 ? (size_t)HALF * 32 : (size_t)HALF * lda, hstepB = (size_t)HALF * ldb;
    const unsigned ldsw = (unsigned)wid * 1024u;
    const int aoff = lds_byte(wr * 64 + fr, fq * 8), boff = lds_byte(wc * 32 + fr, fq * 8);
#define PG8_SA(b, h) (((b) * 2 + (h)) * HTB)
#define PG8_SB(b, h) ((4 + (b) * 2 + (h)) * HTB)
#define PG8_STAGE(bufoff, gbase, voff) do { _Pragma("unroll") for (int _i = 0; _i < 2; ++_i) \
        __builtin_amdgcn_global_load_lds((const unsigned*)((const char*)(gbase) + (voff)[_i]), (LAS unsigned*)(lds + (bufoff) + ldsw + _i * 8192), 16, 0, 0); } while (0)
#define PG8_LDA(dst, b, h) do { _Pragma("unroll") for (int m = 0; m < 4; ++m) _Pragma("unroll") for (int k = 0; k < 2; ++k) dst[m][k] = *(const LAS bf16x8*)(lds + PG8_SA(b, h) + aoff + m * 2048 + k * 1024); } while (0)
#define PG8_LDB(dst, b, h) do { _Pragma("unroll") for (int n = 0; n < 2; ++n) _Pragma("unroll") for (int k = 0; k < 2; ++k) dst[n][k] = *(const LAS bf16x8*)(lds + PG8_SB(b, h) + boff + n * 2048 + k * 1024); } while (0)
#define PG8_MMA(ai, bj, At, Bt) do { __builtin_amdgcn_s_setprio(1); _Pragma("unroll") for (int m = 0; m < 4; ++m) _Pragma("unroll") for (int n = 0; n < 2; ++n) _Pragma("unroll") for (int k = 0; k < 2; ++k) \
        acc[ai][bj][m][n] = __builtin_amdgcn_mfma_f32_16x16x32_bf16(Bt[n][k], At[m][k], acc[ai][bj][m][n], 0, 0, 0); __builtin_amdgcn_s_setprio(0); } while (0)
#define PG8_WAIT_V(n) asm volatile("s_waitcnt vmcnt(" #n ")" ::: "memory")
#define PG8_WAIT_L(n) asm volatile("s_waitcnt lgkmcnt(" #n ")" ::: "memory")
#define PG8_BAR __builtin_amdgcn_s_barrier()
#define PG8_SCHED __builtin_amdgcn_sched_barrier(0)
    Seg cur, nxt; int ui = 0;
    if (!S.next(0, cur)) return;
    f32x4 acc[2][2][4][2];
#pragma unroll
    for (int a = 0; a < 2; ++a)
#pragma unroll
        for (int b = 0; b < 2; ++b)
#pragma unroll
            for (int m = 0; m < 4; ++m)
#pragma unroll
                for (int n = 0; n < 2; ++n) acc[a][b][m][n] = (f32x4){0.f, 0.f, 0.f, 0.f};
    bf16x8 At[4][2], B0[2][2], B1[2][2];
    const char* cA = cur.A; const char* cB = cur.B;
    if constexpr (GATHER) { PG8_GV(0, cur); gst[2] = gst[0]; gst[3] = gst[1]; }
#define PG8_STAGE_A(bufoff, kbase, h, usenext) do { if constexpr (GATHER) { const unsigned _p = gst[((usenext) ? 2 : 0) + (h)]; unsigned _v[2] = {(_p & 0xffffu) * (unsigned)lda + gCb, (_p >> 16) * (unsigned)lda + gCb}; PG8_STAGE(bufoff, kbase, _v); } \
        else { PG8_STAGE(bufoff, (kbase) + (h) * hstepA, voffA); } } while (0)
#if GEMM_8PH
    PG8_STAGE(PG8_SB(0, 0), cB, voffB); PG8_STAGE_A(PG8_SA(0, 0), cA, 0, false); PG8_STAGE(PG8_SB(0, 1), cB + hstepB, voffB); PG8_STAGE_A(PG8_SA(0, 1), cA, 1, false);
    if (wr == 1) PG8_BAR;
    PG8_WAIT_V(4); PG8_BAR;
    PG8_STAGE(PG8_SB(1, 0), cB + kstep, voffB); PG8_STAGE_A(PG8_SA(1, 0), cA + kstepA, 0, false); PG8_STAGE(PG8_SB(1, 1), cB + hstepB + kstep, voffB);
    PG8_WAIT_V(6); PG8_BAR;
#else
    PG8_STAGE(PG8_SB(0, 0), cB, voffB); PG8_STAGE(PG8_SB(0, 1), cB + hstepB, voffB); PG8_STAGE_A(PG8_SA(0, 0), cA, 0, false); PG8_STAGE_A(PG8_SA(0, 1), cA, 1, false);
    if (wr == 1) PG8_BAR;
    PG8_WAIT_V(2); PG8_BAR;
    PG8_STAGE(PG8_SB(1, 0), cB + kstep, voffB); PG8_STAGE_A(PG8_SA(1, 0), cA + kstepA, 0, false); PG8_STAGE(PG8_SB(1, 1), cB + hstepB + kstep, voffB);
    PG8_WAIT_V(6); PG8_BAR;
#endif
    for (;;) {
        const bool has_next = S.next(ui + 1, nxt);
        const char* nA = has_next ? nxt.A : cA; const char* nB = has_next ? nxt.B : cB;
        const int nt = cur.nt;
        for (int t = 0; t < nt; t += 2) {
            const bool last = (t == nt - 2);
            if constexpr (GATHER) { if (last) { if (has_next) { PG8_GV(1, nxt); } else { gst[2] = gst[0]; gst[3] = gst[1]; } } }
            const char* a1 = cA + (size_t)(t + 1) * kstepA;
            const char* a2 = last ? nA : cA + (size_t)(t + 2) * kstepA; const char* b2 = last ? nB : cB + (size_t)(t + 2) * kstep;
            const char* a3 = a2 + kstepA; const char* b3 = b2 + kstep;
#if GEMM_8PH
            PG8_LDB(B0, 0, 0); PG8_SCHED; PG8_LDA(At, 0, 0); PG8_STAGE_A(PG8_SA(1, 1), a1, 1, false);
            PG8_WAIT_L(8); PG8_BAR; PG8_WAIT_L(0); PG8_MMA(0, 0, At, B0); PG8_BAR; PG8_SCHED;
            PG8_LDB(B1, 0, 1); PG8_STAGE(PG8_SB(0, 0), b2, voffB);
            PG8_BAR; PG8_WAIT_L(0); PG8_MMA(0, 1, At, B1); PG8_BAR;
            PG8_LDA(At, 0, 1); PG8_STAGE_A(PG8_SA(0, 0), a2, 0, last);
            PG8_BAR; PG8_WAIT_L(0); PG8_MMA(1, 0, At, B0); PG8_BAR; PG8_SCHED;
            PG8_STAGE(PG8_SB(0, 1), b2 + hstepB, voffB);
            PG8_WAIT_V(6); PG8_BAR; PG8_MMA(1, 1, At, B1); PG8_BAR;
            PG8_LDB(B0, 1, 0); PG8_SCHED; PG8_LDA(At, 1, 0); PG8_STAGE_A(PG8_SA(0, 1), a2, 1, last);
            PG8_WAIT_L(8); PG8_BAR; PG8_WAIT_L(0); PG8_MMA(0, 0, At, B0); PG8_BAR; PG8_SCHED;
            PG8_LDB(B1, 1, 1); PG8_STAGE(PG8_SB(1, 0), b3, voffB);
            PG8_BAR; PG8_WAIT_L(0); PG8_MMA(0, 1, At, B1); PG8_BAR;
            PG8_LDA(At, 1, 1); PG8_STAGE_A(PG8_SA(1, 0), a3, 0, last);
            PG8_BAR; PG8_WAIT_L(0); PG8_MMA(1, 0, At, B0); PG8_BAR; PG8_SCHED;
            PG8_STAGE(PG8_SB(1, 1), b3 + hstepB, voffB);
            PG8_WAIT_V(6); PG8_BAR; PG8_MMA(1, 1, At, B1); PG8_BAR;
#else
            PG8_LDB(B0, 0, 0); PG8_LDB(B1, 0, 1); PG8_SCHED; PG8_LDA(At, 0, 0); PG8_STAGE_A(PG8_SA(1, 1), a1, 1, false);
            PG8_WAIT_V(8); PG8_WAIT_L(0); PG8_BAR; PG8_MMA(0, 0, At, B0); PG8_MMA(0, 1, At, B1); PG8_BAR; PG8_SCHED;
            PG8_LDA(At, 0, 1); PG8_STAGE(PG8_SB(0, 0), b2, voffB); PG8_STAGE(PG8_SB(0, 1), b2 + hstepB, voffB); PG8_STAGE_A(PG8_SA(0, 0), a2, 0, last);
            PG8_WAIT_V(8); PG8_WAIT_L(0); PG8_BAR; PG8_MMA(1, 0, At, B0); PG8_MMA(1, 1, At, B1); PG8_BAR; PG8_SCHED;
            PG8_LDB(B0, 1, 0); PG8_LDB(B1, 1, 1); PG8_SCHED; PG8_LDA(At, 1, 0); PG8_STAGE_A(PG8_SA(0, 1), a2, 1, last);
            PG8_WAIT_V(8); PG8_WAIT_L(0); PG8_BAR; PG8_MMA(0, 0, At, B0); PG8_MMA(0, 1, At, B1); PG8_BAR; PG8_SCHED;
            PG8_LDA(At, 1, 1); PG8_STAGE(PG8_SB(1, 0), b3, voffB); PG8_STAGE(PG8_SB(1, 1), b3 + hstepB, voffB); PG8_STAGE_A(PG8_SA(1, 0), a3, 0, last);
            PG8_WAIT_V(8); PG8_WAIT_L(0); PG8_BAR; PG8_MMA(1, 0, At, B0); PG8_MMA(1, 1, At, B1); PG8_BAR; PG8_SCHED;
#endif
        }
        if (cur.epi) {
            if (wr == 0) PG8_BAR;
            const int el = otid() & 63; const int efr = el & 15, efq = el >> 4;
            const bool z = E(acc, cur, wr, wc, efr, efq);
            if (z) {
#pragma unroll
                for (int a = 0; a < 2; ++a)
#pragma unroll
                    for (int b = 0; b < 2; ++b)
#pragma unroll
                        for (int m = 0; m < 4; ++m)
#pragma unroll
                            for (int n = 0; n < 2; ++n) acc[a][b][m][n] = (f32x4){0.f, 0.f, 0.f, 0.f};
            }
            if (!has_next) break;
            if (wr == 1) PG8_BAR;
        } else if (!has_next) { if (wr == 0) PG8_BAR; break; }
        cur = nxt; cA = nA; cB = nB; ++ui;
        if constexpr (GATHER) { gst[0] = gst[2]; gst[1] = gst[3]; }
    }
    PG8_WAIT_V(0);
    PG8_BAR;
#undef PG8_SA
#undef PG8_SB
#undef PG8_STAGE
#undef PG8_STAGE_A
#undef PG8_GV
#undef PG8_LDA
#undef PG8_LDB
#undef PG8_MMA
#undef PG8_WAIT_V
#undef PG8_WAIT_L
#undef PG8_BAR
#undef PG8_SCHED
}
}
namespace fk {
struct In { const float *x, *c, *ctx, *c_ctx, *w_mod, *b_mod, *w_in, *lam_q1, *lam_k1, *lam_q2, *lam_k2, *subln_g, *a_re, *a_im, *log_dt, *b_re, *b_im, *c_re, *c_im, *ssm_d,
  *w_glu, *b_glu, *w_pa, *w_ps, *w_o, *ln1_g, *ln1_b, *rg_w, *rg_b, *re_w, *re_b, *w1, *w3, *w2, *ln2_g, *ln2_b; };
struct WSet { bf16_t *Win, *Wglu, *Wpa, *Wps, *Wo, *W13, *W2; };
struct SSet { bf16_t *Smat, *TO; float *SAL, *WR; };
struct Params {
  In in; float* out;
  unsigned* bar;
  unsigned* ctl;
  float* MOD;
  float* ROPE;
  float* XL;
  bf16_t* X1b;
  bf16_t* Hb;
  bf16_t* Kc; bf16_t* Vc;
  bf16_t* Qb;
  bf16_t* Ug;
  bf16_t* RG; bf16_t* GSb;
  bf16_t* ATTb;
  float* SST;
  bf16_t* YG;
  bf16_t* S2;
  bf16_t* Mb;
  bf16_t* H2b;
  int* ROUTE;
  float* RW;
  int* TOK;
  bf16_t* Hm;
  bf16_t* Yo;
  SSet s[4];
  WSet w[2];
  int ph_lo, ph_hi;
  int pad0, pad1;
};
typedef const __attribute__((address_space(4))) Params& KP; typedef const __attribute__((address_space(4))) WSet& KW; typedef const __attribute__((address_space(4))) SSet& KS;
constexpr int CTL_CNT = 0;
constexpr int CTL_TILE = 64 * 32 + 64;
constexpr int CTL_XC = CTL_TILE + 72 * 16;
constexpr int CTL_DONE = CTL_XC + 16 * 16;
constexpr int CTL_WORDS = CTL_XC + 4 * 272;

__device__ __forceinline__ int modrow_of_tile(int pm) { return pm < 64 ? (pm >> 3) : 8; }
__device__ __forceinline__ int kvrow0_of_tile(int pm) { return pm < 64 ? (pm >> 3) * KVB + CTX + (pm & 7) * 256 : (pm - 64) * KVB; }

struct SchedPlain {
  const char* A; const char* B; int lda, ldb, nM, nN, nt, G, c, nunits; int epi; int atile;
  __device__ __forceinline__ bool next(int i, Seg& s) const {
    const int L = i * G + c; if (L >= nunits) return false;
    int pm, pn; tile_order(L, nM, nN, pm, pn);
    s.A = A + (size_t)pm * atile; s.B = B + (size_t)pn * 256 * ldb; s.nt = nt; s.epi = epi; s.pm = pm; s.pn = pn; s.aux = 0; s.aux2 = 0; return true; }
};
struct SchedMerge {
  const char* A1; const char* B1; const char* A2; const char* B2; int nM, nN, G, c, nunits;
  __device__ __forceinline__ bool next(int i, Seg& s) const {
    const int L = (i >> 1) * G + c; if (L >= nunits) return false;
    int pm, pn; tile_order(L, nM, nN, pm, pn); s.pm = pm; s.pn = pn; s.aux = 0; s.aux2 = 0;
    if ((i & 1) == 0) { s.A = A1 + (size_t)pm * 256 * 2048; s.B = B1 + (size_t)pn * 256 * 2048; s.nt = 16; s.epi = 2; }
    else { s.A = A2 + (size_t)pm * 256 * 2048; s.B = B2 + (size_t)pn * 256 * 2048; s.nt = 8; s.epi = 1; }
    return true; }
};
struct SchedMergeOne {
  const char* A1; const char* B1; const char* A2; const char* B2; int pm, pn;
  __device__ __forceinline__ bool next(int i, Seg& s) const {
    if (i >= 2) return false; s.pm = pm; s.pn = pn; s.aux = 0; s.aux2 = 0;
    if (i == 0) { s.A = A1 + (size_t)pm * 256 * 2048; s.B = B1 + (size_t)pn * 256 * 2048; s.nt = 16; s.epi = 2; }
    else { s.A = A2 + (size_t)pm * 256 * 2048; s.B = B2 + (size_t)pn * 256 * 2048; s.nt = 8; s.epi = 1; }
    return true; }
};
struct SchedPlainOne {
  const char* A; const char* B; int nt, pm, pn;
  __device__ __forceinline__ bool next(int i, Seg& s) const {
    if (i >= 1) return false; s.A = A + (size_t)pm * 256 * 2048; s.B = B + (size_t)pn * 256 * 2048; s.nt = nt; s.epi = 1; s.pm = pm; s.pn = pn; s.aux = 0; s.aux2 = 0; return true; }
};
struct SchedSsm1 {
  const char* Ug; const char* Smat; int G, c;
  __device__ __forceinline__ bool next(int i, Seg& s) const {
    const int L = i * G + c; if (L >= NG * 3) return false;
    const int g = L / 3, pm = L % 3;
    s.A = Ug + (size_t)g * NCHP * 1536 + (size_t)pm * 256 * 1536; s.B = Smat + (size_t)g * 256 * 1536; s.nt = 8; s.epi = 1; s.pm = pm; s.pn = 0; s.aux = g; s.aux2 = 0; return true; }
};
struct SchedSsm3 {
  const char* Ug; const char* TO; int G, c;
  __device__ __forceinline__ bool next(int i, Seg& s) const {
    const int L = i * G + c; if (L >= NG * 6) return false;
    const int g = L / 6, r = L % 6, pm = r >> 1, pn = r & 1; s.pm = pm; s.pn = pn; s.aux = g; s.aux2 = 0;
    s.A = Ug + (size_t)g * NCHP * 1536 + (size_t)pm * 256 * 1536; s.B = TO + (size_t)g * 512 * 1536 + (size_t)pn * 256 * 1536; s.nt = 12; s.epi = 1; return true; }
};
struct MoeTab { int ntiles; int tileE[176]; int tileR0[176]; int cnt[32]; int tbase[33]; };
struct SchedMoe {
  const char* A; const char* B; int lda, ldb; size_t estride; const LAS MoeTab* tab; const int* TOK; int nN, nt, G, c; bool gather; int i0, i1;
  __device__ __forceinline__ bool next(int i, Seg& s) const {
    if (i0 + i >= i1) return false;
    const int L = (i0 + i) * G + c; if (L >= __builtin_amdgcn_readfirstlane(tab->ntiles) * nN) return false;
    const int t = L / nN, pn = L % nN; const int e = __builtin_amdgcn_readfirstlane(tab->tileE[t]);
    s.A = gather ? A : A + (size_t)t * 256 * lda; s.B = B + (size_t)e * estride + (size_t)pn * 256 * ldb; s.nt = nt; s.epi = 1; s.pm = t; s.pn = pn; s.aux = e; s.aux2 = __builtin_amdgcn_readfirstlane(tab->tileR0[t]); return true; }
  __device__ __forceinline__ unsigned grow(const Seg& s, int R) const { const int r = s.aux2 + R; return (unsigned)(r < tab->cnt[s.aux] ? TOK[(size_t)s.aux * NR + r] : 0); }
};
struct SchedG1 {
  const char* A; const char* B; int G, c, u0, u1; bool last;
  __device__ __forceinline__ bool next(int i, Seg& s) const {
    const int L = u0 + i * G + c; if (L >= u1) return false; int pm, pn;
    if (!last) { if (L < 144) { pm = L >> 1; pn = 8 + (L & 1); } else { int q; tile_order(L - 144, NR / 256, 20, pm, q); pn = q < 8 ? q : q + 2; } }
    else { if (L < 1408) tile_order(L, NLAT / 256, 22, pm, pn); else { const int L2 = L - 1408; pm = 64 + L2 / 10; pn = L2 % 10; } }
    s.A = A + (size_t)pm * 256 * 2048; s.B = B + (size_t)pn * 256 * 2048; s.nt = 16; s.epi = 1; s.pm = pm; s.pn = pn; s.aux = 0; s.aux2 = 0; return true; }
};
#define EPI_LOOP_AM for (int ai = 0; ai < 2; ++ai) _Pragma("unroll") for (int m = 0; m < 4; ++m)
struct EpiIn {
  const float* ROPE; bf16_t* Kc; bf16_t* Vc; bf16_t* Ug; bf16_t* Qb; bf16_t* RG; bf16_t* GSb; int rowmask;
  __device__ __forceinline__ bool operator()(f32x4 (&acc)[2][2][4][2], const Seg& s, int wr, int wc, int fr, int fq) const {
    const int pm = s.pm, pn = s.pn; const int rin0 = (wr * 64 + fr) & rowmask;
    if (pn < 4 || (pn >= 10 && pn < 14)) {
      const bool isq = pn >= 10; const int pt = isq ? pn - 10 : pn; const int axis = wc & 1;
      bf16_t* dst = isq ? Qb : Kc; const int drow0 = isq ? pm * 256 : kvrow0_of_tile(pm); const bool lat = pm < 64;
#pragma unroll
      EPI_LOOP_AM { const int rin = ((ai * 128 + m * 16) & rowmask) + rin0; const int t = (pm * 256 + rin) & (SEQ - 1); const float* rp = ROPE + ((size_t)t * 2 + axis) * 32 + fq * 4;
        f32x4 cs, sn; if (lat) { cs = *(const f32x4*)rp; sn = *(const f32x4*)(rp + 16); }
#pragma unroll
        for (int bj = 0; bj < 2; ++bj) { f32x4 o1 = acc[ai][bj][m][0], o2 = acc[ai][bj][m][1]; if (lat) { const f32x4 t1 = o1, t2 = o2; o1 = t1 * cs - t2 * sn; o2 = t1 * sn + t2 * cs; }
          if (isq) { o1 *= 0.18033688011112042f; o2 *= 0.18033688011112042f; }
          *(u32x4*)(dst + (size_t)(drow0 + rin) * 1024 + (2 * pt + bj) * 128 + wc * 32 + fq * 8) = pack8(o1, o2); } }
    } else if (pn < 8) {
      const int drow0 = kvrow0_of_tile(pm);
#pragma unroll
      EPI_LOOP_AM { const int rin = ((ai * 128 + m * 16) & rowmask) + rin0;
#pragma unroll
        for (int bj = 0; bj < 2; ++bj) *(u32x4*)(Vc + (size_t)(drow0 + rin) * 1024 + (pn - 4) * 256 + bj * 128 + wc * 32 + fq * 8) = pack8(acc[ai][bj][m][0], acc[ai][bj][m][1]); }
    } else if (pn < 10) {
#pragma unroll
      EPI_LOOP_AM { const int rin = ((ai * 128 + m * 16) & rowmask) + rin0;
#pragma unroll
        for (int bj = 0; bj < 2; ++bj) { const int c0 = (pn - 8) * 256 + bj * 128 + wc * 32 + fq * 8; const int g = c0 >> 4, co = c0 & 15;
          const int R = pm * 256 + rin; *(u32x4*)(Ug + ((size_t)g * NCHP + (R >> 5)) * 768 + (R & 31) * 16 + co) = pack8(acc[ai][bj][m][0], acc[ai][bj][m][1]); } }
    } else {
      const int c0 = (pn - 14) * 128 + wc * 32 + fq * 8;
#pragma unroll
      EPI_LOOP_AM { const int rin = ((ai * 128 + m * 16) & rowmask) + rin0; f32x4 r[2], g[2];
#pragma unroll
        for (int n = 0; n < 2; ++n)
#pragma unroll
          for (int j = 0; j < 4; ++j) { const float ea = __builtin_amdgcn_exp2f(-1.4426950408889634f * acc[ai][0][m][n][j]); const float es = __builtin_amdgcn_exp2f(-1.4426950408889634f * fmaxf(acc[ai][1][m][n][j], -60.f));
            g[n][j] = __builtin_amdgcn_rcpf(1.f + es); r[n][j] = (1.f + es) * __builtin_amdgcn_rcpf(1.f + ea); }
        *(u32x4*)(RG + (size_t)(pm * 256 + rin) * 1024 + c0) = pack8(r[0], r[1]); *(u32x4*)(GSb + (size_t)(pm * 256 + rin) * 1024 + c0) = pack8(g[0], g[1]); }
    }
    return true;
  }
};
struct EpiNone { __device__ __forceinline__ bool operator()(f32x4 (&acc)[2][2][4][2], const Seg& s, int wr, int wc, int fr, int fq) const { asm volatile("" :: "v"(acc[0][0][0][0][0]), "v"(acc[1][1][3][1][3])); return true; } };
template <int NST> struct EpiLinT {
  bf16_t* Yo;
  __device__ __forceinline__ bool operator()(f32x4 (&acc)[2][2][4][2], const Seg& s, int wr, int wc, int fr, int fq) const {
    const int lane = fr + 16 * fq; const int w = wr * 4 + wc; int k = 0;
#pragma unroll
    EPI_LOOP_AM {
#pragma unroll
      for (int bj = 0; bj < 2; ++bj) { if (k < NST) *(u32x4*)(Yo + ((size_t)s.pm * 256 * 1024) + (size_t)(s.pn & 3) * 65536 + ((w * 16 + k) * 64 + lane) * 8) = pack8(acc[ai][bj][m][0], acc[ai][bj][m][1]); else asm volatile("" :: "v"(acc[ai][bj][m][0][0]), "v"(acc[ai][bj][m][1][3])); ++k; } }
    return true;
  }
};
struct EpiLin {
  bf16_t* Yo;
  __device__ __forceinline__ bool operator()(f32x4 (&acc)[2][2][4][2], const Seg& s, int wr, int wc, int fr, int fq) const {
    const int lane = fr + 16 * fq; const int w = wr * 4 + wc; int k = 0;
#pragma unroll
    EPI_LOOP_AM {
#pragma unroll
      for (int bj = 0; bj < 2; ++bj) { *(u32x4*)(Yo + ((size_t)s.pm * 256 * 1024) + (size_t)(s.pn & 3) * 65536 + ((w * 16 + k) * 64 + lane) * 8) = pack8(acc[ai][bj][m][0], acc[ai][bj][m][1]); ++k; } }
    return true;
  }
};
struct EpiState {
  float* SST;
  __device__ __forceinline__ bool operator()(f32x4 (&acc)[2][2][4][2], const Seg& s, int wr, int wc, int fr, int fq) const {
    const int g = s.aux;
#pragma unroll
    EPI_LOOP_AM { const int row = s.pm * 256 + ai * 128 + m * 16 + wr * 64 + fr;
      if (row < NCHR) {
#pragma unroll
        for (int bj = 0; bj < 2; ++bj) { float* p = SST + ((size_t)g * NCHP + row) * 256 + bj * 128 + wc * 32 + fq * 8; *(f32x4*)p = acc[ai][bj][m][0]; *(f32x4*)(p + 4) = acc[ai][bj][m][1]; } } }
    return true;
  }
};
struct EpiSsmOut {
  bf16_t* YG;
  __device__ __forceinline__ bool operator()(f32x4 (&acc)[2][2][4][2], const Seg& s, int wr, int wc, int fr, int fq) const {
    const int g = s.aux;
#pragma unroll
    EPI_LOOP_AM { const int row = s.pm * 256 + ai * 128 + m * 16 + wr * 64 + fr;
      if (row < NCHR) {
#pragma unroll
        for (int bj = 0; bj < 2; ++bj) { const int c0 = s.pn * 256 + bj * 128 + wc * 32 + fq * 8; const int t = c0 >> 4, co = c0 & 15; f32x4 a = acc[ai][bj][m][0], b = acc[ai][bj][m][1];
#pragma unroll
          for (int j = 0; j < 4; ++j) { a[j] = gelu_tanh_f(a[j]); b[j] = gelu_tanh_f(b[j]); }
          *(u32x4*)(YG + ((size_t)g * NR + (size_t)row * CHUNK + t) * 16 + co) = pack8(a, b); } } }
    return true;
  }
};
struct EpiGlu {
  const bf16_t* YG; bf16_t* S2; const float* bias;
  __device__ __forceinline__ bool operator()(f32x4 (&acc)[2][2][4][2], const Seg& s, int wr, int wc, int fr, int fq) const {
#pragma unroll
    for (int bj = 0; bj < 2; ++bj) { const int c0 = s.pn * 256 + bj * 128 + wc * 32 + fq * 8; const f32x4 b0 = *(const f32x4*)(bias + c0), b1 = *(const f32x4*)(bias + c0 + 4);
#pragma unroll
      EPI_LOOP_AM { const int row = s.pm * 256 + ai * 128 + m * 16 + wr * 64 + fr; const u32x4 yw = *(const u32x4*)(YG + ((size_t)(c0 >> 4) * NR + row) * 16 + (c0 & 15)); f32x4 y0, y1; unpack8(yw, y0, y1);
        f32x4 z0 = acc[ai][bj][m][0] + b0, z1 = acc[ai][bj][m][1] + b1;
#pragma unroll
        for (int j = 0; j < 4; ++j) { z0[j] = y0[j] * fast_sigmoid(z0[j]); z1[j] = y1[j] * fast_sigmoid(z1[j]); }
        *(u32x4*)(S2 + (size_t)row * 1024 + c0) = pack8(z0, z1); } }
    return true;
  }
};
struct EpiMerge {
  const bf16_t* RG; const bf16_t* GSb; bf16_t* Mb;
  __device__ __forceinline__ bool operator()(f32x4 (&acc)[2][2][4][2], const Seg& s, int wr, int wc, int fr, int fq) const {
    const bool mid = s.epi == 2; const bf16_t* src = mid ? RG : GSb;
#pragma unroll
    EPI_LOOP_AM { const int row = s.pm * 256 + ai * 128 + m * 16 + wr * 64 + fr;
#pragma unroll
      for (int bj = 0; bj < 2; ++bj) { const int c0 = s.pn * 256 + bj * 128 + wc * 32 + fq * 8; const u32x4 w = *(const u32x4*)(src + (size_t)row * 1024 + c0); f32x4 g0, g1; unpack8(w, g0, g1);
        acc[ai][bj][m][0] *= g0; acc[ai][bj][m][1] *= g1;
        if (!mid) *(u32x4*)(Mb + (size_t)row * 1024 + c0) = pack8(acc[ai][bj][m][0], acc[ai][bj][m][1]); } }
    return !mid;
  }
};
struct EpiWo {
  bf16_t* D1; const float* MODl;
  __device__ __forceinline__ bool operator()(f32x4 (&acc)[2][2][4][2], const Seg& s, int wr, int wc, int fr, int fq) const {
    const int pm = s.pm; const float* gate = MODl + (size_t)modrow_of_tile(pm) * 6144 + 2 * 1024;
#pragma unroll
    for (int bj = 0; bj < 2; ++bj) { const int c0 = s.pn * 256 + bj * 128 + wc * 32 + fq * 8; const f32x4 g0 = *(const f32x4*)(gate + c0), g1 = *(const f32x4*)(gate + c0 + 4);
#pragma unroll
      EPI_LOOP_AM { const int rin = ai * 128 + m * 16 + wr * 64 + fr;
        *(u32x4*)(D1 + (size_t)(pm * 256 + rin) * 1024 + c0) = pack8(g0 * acc[ai][bj][m][0], g1 * acc[ai][bj][m][1]); } }
    return true;
  }
};
struct EpiMoe1 {
  bf16_t* Hm;
  __device__ __forceinline__ bool operator()(f32x4 (&acc)[2][2][4][2], const Seg& s, int wr, int wc, int fr, int fq) const {
    const int c0 = s.pn * 128 + wc * 32 + fq * 8;
#pragma unroll
    EPI_LOOP_AM { const int row = s.pm * 256 + ai * 128 + m * 16 + wr * 64 + fr; f32x4 h0, h1;
#pragma unroll
      for (int j = 0; j < 4; ++j) { h0[j] = fast_silu(acc[ai][0][m][0][j]) * acc[ai][1][m][0][j]; h1[j] = fast_silu(acc[ai][0][m][1][j]) * acc[ai][1][m][1][j]; }
      *(u32x4*)(Hm + (size_t)row * EH + c0) = pack8(h0, h1); }
    return true;
  }
};
struct EpiMoe2 {
  bf16_t* Yo;
  __device__ __forceinline__ bool operator()(f32x4 (&acc)[2][2][4][2], const Seg& s, int wr, int wc, int fr, int fq) const {
#pragma unroll
    EPI_LOOP_AM { const int row = s.pm * 256 + ai * 128 + m * 16 + wr * 64 + fr;
#pragma unroll
      for (int bj = 0; bj < 2; ++bj) *(u32x4*)(Yo + (size_t)row * 1024 + s.pn * 256 + bj * 128 + wc * 32 + fq * 8) = pack8(acc[ai][bj][m][0], acc[ai][bj][m][1]); }
    return true;
  }
};
}
namespace fk {
constexpr int ATT_SHM_V = 64 * 128 * 2, ATT_SHM_K = 64 * 128 * 2;
constexpr int ATT_LDS = 4 * ATT_SHM_V + 4 * ATT_SHM_K + 8 * 256;
#define KSWZ(row, colB) ((row) * 256 + ((colB) ^ (((row) & 15) << 4)))
#define SBAR() __builtin_amdgcn_sched_barrier(0)
__device__ __forceinline__ int crow(int r, int hi) { return (r & 3) + 8 * (r >> 2) + 4 * hi; }
constexpr float ATT_THR2 = 11.5f;
template <int VAR = 0> __device__ __forceinline__ void partialSM(f32x16& p0, f32x16& p1, float& m_reg, float& alpha) {
  if (VAR == 1) { alpha = 1.f; return; }
  float pmax = p0[0];
#pragma unroll
  for (int r = 1; r < 16; ++r) pmax = fmaxf(pmax, p0[r]);
#pragma unroll
  for (int r = 0; r < 16; ++r) pmax = fmaxf(pmax, p1[r]);
  { auto rr = __builtin_amdgcn_permlane32_swap(__float_as_uint(pmax), __float_as_uint(pmax), false, false);
    pmax = fmaxf(__uint_as_float(rr[0]), __uint_as_float(rr[1])); }
  if (__builtin_expect(__all(pmax <= ATT_THR2 && pmax >= -2.f * ATT_THR2), 1)) { alpha = 1.f; }
  else { const float d = pmax; alpha = __builtin_amdgcn_exp2f(-d); m_reg += d;
#pragma unroll
    for (int r = 0; r < 16; ++r) { p0[r] -= d; p1[r] -= d; } }
#pragma unroll
  for (int r = 0; r < 16; ++r) p0[r] = __builtin_amdgcn_exp2f(p0[r]);
}
template <int VAR = 0> __device__ __forceinline__ void finishSM(f32x16& p0, f32x16& p1, float alpha, float& l_reg, bf16x8& pa0, bf16x8& pa1, bf16x8& pa2, bf16x8& pa3) {
  if (VAR != 1) {
#pragma unroll
  for (int r = 0; r < 16; ++r) p1[r] = __builtin_amdgcn_exp2f(p1[r]);
  float ps = 0;
#pragma unroll
  for (int r = 0; r < 16; ++r) ps += p0[r];
#pragma unroll
  for (int r = 0; r < 16; ++r) ps += p1[r];
  { auto rr = __builtin_amdgcn_permlane32_swap(__float_as_uint(ps), __float_as_uint(ps), false, false);
    ps = __uint_as_float(rr[0]) + __uint_as_float(rr[1]); }
  l_reg = l_reg * alpha + ps; } else l_reg += 1.f;
#define PK4(P, BASE, OUT) do { unsigned a0 = cvt_pk_bf16(P[BASE + 0], P[BASE + 1]), a1 = cvt_pk_bf16(P[BASE + 2], P[BASE + 3]);   \
    unsigned b0 = cvt_pk_bf16(P[BASE + 4], P[BASE + 5]), b1 = cvt_pk_bf16(P[BASE + 6], P[BASE + 7]);                              \
    auto r0 = __builtin_amdgcn_permlane32_swap(a0, b0, false, false); auto r1 = __builtin_amdgcn_permlane32_swap(a1, b1, false, false); \
    u32x4 w = {r0[0], r1[0], r0[1], r1[1]}; OUT = *reinterpret_cast<bf16x8*>(&w); } while (0)
  PK4(p0, 0, pa0); PK4(p0, 8, pa1); PK4(p1, 0, pa2); PK4(p1, 8, pa3);
#undef PK4
}
template <int VAR = 0> __device__ __forceinline__ void qkt(f32x16& p0, f32x16& p1, const LAS char* Ks, const bf16x8* qr, int mapcolB, int r32, int hi, float negm) {
#pragma unroll
  for (int r = 0; r < 16; ++r) { p0[r] = negm; p1[r] = negm; }
  if (VAR == 3) return;
#pragma unroll
  for (int d0 = 0; d0 < 4; ++d0) { const int cb = mapcolB + (d0 * 16 + hi * 8) * 2;
    const bf16x8 b0 = *(const LAS bf16x8*)(Ks + KSWZ(r32, cb));
    const bf16x8 b1 = *(const LAS bf16x8*)(Ks + KSWZ(32 + r32, cb));
    p0 = __builtin_amdgcn_mfma_f32_32x32x16_bf16(b0, qr[d0], p0, 0, 0, 0);
    p1 = __builtin_amdgcn_mfma_f32_32x32x16_bf16(b1, qr[d0], p1, 0, 0, 0); }
}
__device__ __forceinline__ int v_st(int k, int c) { const int kk = (k & ~0xC) | ((k & 4) << 1) | ((k & 8) >> 1); return ((kk >> 3) * 4 + (c >> 5)) * 512 + ((kk & 7) * 32 + (c & 31)) * 2; }
__device__ __forceinline__ int v_rd_base(int lane) { return ((lane & 3) << 3) | (((lane >> 2) & 3) << 6) | (((lane >> 4) & 1) << 5) | (((lane >> 5) & 1) << 8); }
constexpr int v_rd_off(int d0, int ks, int half) { return d0 * 512 + ks * 4096 + half * 2048; }
template <int OFF> __device__ __forceinline__ s16x4 tr_read(int vb) {
  s16x4 r; asm volatile("ds_read_b64_tr_b16 %0, %1 offset:%2" : "=&v"(r) : "v"(vb), "i"(OFF) : "memory"); return r;
}
struct VFrag { s16x4 l0, h0, l1, h1, l2, h2, l3, h3; };
template <int D0> __device__ __forceinline__ void v_issue(VFrag& f, int vb) {
  f.l0 = tr_read<v_rd_off(D0, 0, 0)>(vb); f.h0 = tr_read<v_rd_off(D0, 0, 1)>(vb); f.l1 = tr_read<v_rd_off(D0, 1, 0)>(vb); f.h1 = tr_read<v_rd_off(D0, 1, 1)>(vb);
  f.l2 = tr_read<v_rd_off(D0, 2, 0)>(vb); f.h2 = tr_read<v_rd_off(D0, 2, 1)>(vb); f.l3 = tr_read<v_rd_off(D0, 3, 0)>(vb); f.h3 = tr_read<v_rd_off(D0, 3, 1)>(vb);
}
__device__ __forceinline__ void v_mma(f32x16& od, const VFrag& f, bf16x8 pa0, bf16x8 pa1, bf16x8 pa2, bf16x8 pa3) {
#define PK(L, H) (bf16x8){L[0], L[1], L[2], L[3], H[0], H[1], H[2], H[3]}
  od = __builtin_amdgcn_mfma_f32_32x32x16_bf16(pa0, PK(f.l0, f.h0), od, 0, 0, 0);
  od = __builtin_amdgcn_mfma_f32_32x32x16_bf16(pa1, PK(f.l1, f.h1), od, 0, 0, 0);
  od = __builtin_amdgcn_mfma_f32_32x32x16_bf16(pa2, PK(f.l2, f.h2), od, 0, 0, 0);
  od = __builtin_amdgcn_mfma_f32_32x32x16_bf16(pa3, PK(f.l3, f.h3), od, 0, 0, 0);
#undef PK
}
template <int VAR = 0> __device__ __forceinline__ void pv_d0(f32x16* o, int vb, bf16x8 pa0, bf16x8 pa1, bf16x8 pa2, bf16x8 pa3) {
  if (VAR == 2) { asm volatile("" :: "v"(pa0), "v"(pa1), "v"(pa2), "v"(pa3)); return; }
  VFrag fa, fb;
  v_issue<0>(fa, vb); v_issue<1>(fb, vb);
  asm volatile("s_waitcnt lgkmcnt(8)" ::: "memory"); SBAR(); v_mma(o[0], fa, pa0, pa1, pa2, pa3);
  v_issue<2>(fa, vb);
  asm volatile("s_waitcnt lgkmcnt(8)" ::: "memory"); SBAR(); v_mma(o[1], fb, pa0, pa1, pa2, pa3);
  v_issue<3>(fb, vb);
  asm volatile("s_waitcnt lgkmcnt(8)" ::: "memory"); SBAR(); v_mma(o[2], fa, pa0, pa1, pa2, pa3);
  asm volatile("s_waitcnt lgkmcnt(0)" ::: "memory"); SBAR(); v_mma(o[3], fb, pa0, pa1, pa2, pa3);
}
template <int VAR = 0> __device__ __forceinline__ void attn_unit(const bf16_t* __restrict__ Qg, const bf16_t* __restrict__ Kg, const bf16_t* __restrict__ Vg, bf16_t* __restrict__ Og,
                                          int qrow0, int kv0, int nkeys, int h, float lam, float lam_init, const float* __restrict__ subg, LAS char* lds, const int g_wv) {
  const int tid = otid(), wid = g_wv, lane = tid & 63, r32 = lane & 31, hi = lane >> 5, map = wid >> 2, wq = wid & 3;
  LAS char* V_lds = lds; LAS char* K_lds = lds + 4 * ATT_SHM_V;
  LAS float* wsf = (LAS float*)(lds + 4 * ATT_SHM_V + 4 * ATT_SHM_K) + wid * 64; LAS float* li_l = wsf; LAS float* al_l = wsf + 32;
  float m_reg = 0.f, l_reg = 0; f32x16 o[4] = {}; bf16x8 qr[4];
  const bf16_t* Qw = Qg + (size_t)(qrow0 + wq * 32 + r32) * 1024 + h * 128 + map * 64 + hi * 8;
#pragma unroll
  for (int d0 = 0; d0 < 4; ++d0) qr[d0] = *(const bf16x8*)(Qw + d0 * 16);
  const bf16_t* Kh = Kg + (size_t)kv0 * 1024 + h * 128; const bf16_t* Vh = Vg + (size_t)kv0 * 1024 + h * 128;
  const int vb0 = (int)(uintptr_t)V_lds + v_rd_base(lane);
  const int mapcolB = map * 128;
  unsigned offK0, offK1, offV0, offV1;
  { const int kr0 = 4 * wid + (lane >> 4), kr1 = 32 + kr0, kp = (lane & 15) * 16;
    offK0 = (unsigned)(kr0 * 2048 + (kp ^ ((kr0 & 15) << 4))); offK1 = (unsigned)(kr1 * 2048 + (kp ^ ((kr1 & 15) << 4)));
#pragma unroll
    for (int u = 0; u < 2; ++u) { const int B = 2 * (8 * u + wid) + (lane >> 5); const int kk = (B >> 2) * 8 + ((lane & 31) >> 2); const int k = (kk & ~0xC) | ((kk & 4) << 1) | ((kk & 8) >> 1); const int c = (B & 3) * 32 + (lane & 3) * 8;
      const unsigned o = (unsigned)(k * 2048 + c * 2); if (u == 0) offV0 = o; else offV1 = o; } }
#define SLOT(t) (((t) & 3) * ATT_SHM_V)
#define SLOAD(k0, bo) do { const char* kb_ = (const char*)Kh + (size_t)(k0) * 2048; const char* vb_ = (const char*)Vh + (size_t)(k0) * 2048; \
    __builtin_amdgcn_global_load_lds((const unsigned*)(vb_ + offV0), (LAS unsigned*)(V_lds + (bo) + wid * 1024), 16, 0, 0); \
    __builtin_amdgcn_global_load_lds((const unsigned*)(vb_ + offV1), (LAS unsigned*)(V_lds + (bo) + (8 + wid) * 1024), 16, 0, 0); \
    __builtin_amdgcn_global_load_lds((const unsigned*)(kb_ + offK0), (LAS unsigned*)(K_lds + (bo) + wid * 1024), 16, 0, 0); \
    __builtin_amdgcn_global_load_lds((const unsigned*)(kb_ + offK1), (LAS unsigned*)(K_lds + (bo) + (8 + wid) * 1024), 16, 0, 0); } while (0)
#define SWRITE(bo) do { } while (0)
#define SWAIT() asm volatile("s_waitcnt vmcnt(0)" ::: "memory")
#define RESC(a) do { if (__any((a) != 1.f)) { if (hi == 0) al_l[r32] = (a); asm volatile("s_waitcnt lgkmcnt(0)" ::: "memory"); \
    _Pragma("unroll") for (int d = 0; d < 4; ++d) _Pragma("unroll") for (int r = 0; r < 16; ++r) o[d][r] *= al_l[crow(r, hi)]; } } while (0)
  f32x16 pA0, pA1, pB0, pB1; float alA, alB; bf16x8 pa0, pa1, pa2, pa3; const int NT = nkeys / 64;
  SLOAD(0, SLOT(0)); SLOAD(64, SLOT(1)); asm volatile("s_waitcnt vmcnt(0)" ::: "memory"); __syncthreads();
  if (g_wv < 4) {
    qkt<VAR>(pA0, pA1, K_lds, qr, mapcolB, r32, hi, -m_reg); partialSM<VAR>(pA0, pA1, m_reg, alA);
    __syncthreads();
    for (int j = 1; j + 1 < NT; j += 2) {
      SBAR(); { qkt<VAR>(pB0, pB1, K_lds + SLOT(j), qr, mapcolB, r32, hi, -m_reg);
      finishSM<VAR>(pA0, pA1, alA, l_reg, pa0, pa1, pa2, pa3); } SBAR();
      SLOAD((j + 1) * 64, SLOT(j + 1)); SBAR();
      pv_d0<VAR>(o, vb0 + SLOT(j - 1), pa0, pa1, pa2, pa3); partialSM<VAR>(pB0, pB1, m_reg, alB);
      SWAIT(); SWRITE(SLOT(j + 1));
      RESC(alB); __syncthreads();
      SBAR(); { qkt<VAR>(pA0, pA1, K_lds + SLOT(j + 1), qr, mapcolB, r32, hi, -m_reg);
      finishSM<VAR>(pB0, pB1, alB, l_reg, pa0, pa1, pa2, pa3); } SBAR();
      SLOAD((j + 2) * 64, SLOT(j + 2)); SBAR();
      pv_d0<VAR>(o, vb0 + SLOT(j), pa0, pa1, pa2, pa3); partialSM<VAR>(pA0, pA1, m_reg, alA);
      SWAIT(); SWRITE(SLOT(j + 2));
      RESC(alA); __syncthreads();
    }
    SBAR(); { qkt<VAR>(pB0, pB1, K_lds + SLOT(NT - 1), qr, mapcolB, r32, hi, -m_reg);
    finishSM<VAR>(pA0, pA1, alA, l_reg, pa0, pa1, pa2, pa3); } SBAR();
    pv_d0<VAR>(o, vb0 + SLOT(NT - 2), pa0, pa1, pa2, pa3); partialSM<VAR>(pB0, pB1, m_reg, alB);
    RESC(alB);
    finishSM<VAR>(pB0, pB1, alB, l_reg, pa0, pa1, pa2, pa3); SBAR();
    pv_d0<VAR>(o, vb0 + SLOT(NT - 1), pa0, pa1, pa2, pa3);
  } else {
    qkt<VAR>(pA0, pA1, K_lds, qr, mapcolB, r32, hi, -m_reg);
    __syncthreads();
    for (int k = 1; k + 1 < NT; k += 2) {
      SLOAD((k + 1) * 64, SLOT(k + 1)); SBAR();
      if (k >= 2) pv_d0<VAR>(o, vb0 + SLOT(k - 2), pa0, pa1, pa2, pa3);
      partialSM<VAR>(pA0, pA1, m_reg, alA); RESC(alA);
      SBAR(); { qkt<VAR>(pB0, pB1, K_lds + SLOT(k), qr, mapcolB, r32, hi, -m_reg);
      finishSM<VAR>(pA0, pA1, alA, l_reg, pa0, pa1, pa2, pa3); } SBAR();
      SWAIT(); SWRITE(SLOT(k + 1)); __syncthreads();
      SLOAD((k + 2) * 64, SLOT(k + 2)); SBAR();
      pv_d0<VAR>(o, vb0 + SLOT(k - 1), pa0, pa1, pa2, pa3); partialSM<VAR>(pB0, pB1, m_reg, alB); RESC(alB);
      SBAR(); { qkt<VAR>(pA0, pA1, K_lds + SLOT(k + 1), qr, mapcolB, r32, hi, -m_reg);
      finishSM<VAR>(pB0, pB1, alB, l_reg, pa0, pa1, pa2, pa3); } SBAR();
      SWAIT(); SWRITE(SLOT(k + 2)); __syncthreads();
    }
    pv_d0<VAR>(o, vb0 + SLOT(NT - 3), pa0, pa1, pa2, pa3); partialSM<VAR>(pA0, pA1, m_reg, alA); RESC(alA);
    SBAR(); { qkt<VAR>(pB0, pB1, K_lds + SLOT(NT - 1), qr, mapcolB, r32, hi, -m_reg);
    finishSM<VAR>(pA0, pA1, alA, l_reg, pa0, pa1, pa2, pa3); } SBAR();
    pv_d0<VAR>(o, vb0 + SLOT(NT - 2), pa0, pa1, pa2, pa3); partialSM<VAR>(pB0, pB1, m_reg, alB); RESC(alB);
    finishSM<VAR>(pB0, pB1, alB, l_reg, pa0, pa1, pa2, pa3); SBAR();
    pv_d0<VAR>(o, vb0 + SLOT(NT - 1), pa0, pa1, pa2, pa3);
  }
  if (hi == 0) li_l[r32] = l_reg; asm volatile("s_waitcnt lgkmcnt(0)" ::: "memory");
  float rli[16]; const float fac = map ? lam : 1.f;
#pragma unroll
  for (int r = 0; r < 16; ++r) rli[r] = fac * __builtin_amdgcn_rcpf(li_l[crow(r, hi)]);
  __syncthreads();
  LAS float* stg = (LAS float*)lds + wid * (32 * 128);
#pragma unroll
  for (int r = 0; r < 16; ++r)
#pragma unroll
    for (int d0 = 0; d0 < 4; ++d0) stg[crow(r, hi) * 128 + d0 * 32 + r32] = o[d0][r] * rli[r];
  __syncthreads();
  {
    const int qi = 16 * map + (lane >> 2), qt = lane & 3;
    const LAS float* pa = (const LAS float*)lds + wq * (32 * 128) + qi * 128 + qt * 32;
    const LAS float* pb = (const LAS float*)lds + (4 + wq) * (32 * 128) + qi * 128 + qt * 32;
    float v[32]; float ss = 0.f;
#pragma unroll
    for (int k = 0; k < 8; ++k) { const f32x4 a = *(const LAS f32x4*)(pa + 4 * k), b = *(const LAS f32x4*)(pb + 4 * k);
#pragma unroll
      for (int j = 0; j < 4; ++j) { const float x = a[j] - b[j]; v[4 * k + j] = x; ss += x * x; } }
    ss += dpp_f<0xB1, 0xF>(ss); ss += dpp_f<0x4E, 0xF>(ss);
    float li_ = lam_init; asm volatile("" : "+s"(li_));
    const float rn = __builtin_amdgcn_rsqf(ss * (1.f / 128.f) + 1e-5f) * (1.f - li_);
    bf16_t* op = Og + (size_t)(qrow0 + wq * 32 + qi) * 1024 + h * 128 + qt * 32; const float* gp = subg + qt * 32;
#pragma unroll
    for (int k = 0; k < 4; ++k) { f32x4 a, b;
#pragma unroll
      for (int j = 0; j < 4; ++j) { a[j] = v[8 * k + j] * rn * gp[8 * k + j]; b[j] = v[8 * k + 4 + j] * rn * gp[8 * k + 4 + j]; }
      *(u32x4*)(op + 8 * k) = pack8(a, b); }
  }
  __syncthreads();
#undef SLOT
#undef SLOAD
#undef SWRITE
#undef SWAIT
#undef RESC
}
template <int VAR = 0> __device__ __forceinline__ void attn_phase(KP p, int l, LAS char* lds, const int g_wv) {
  const int tid = otid(), lane = tid & 63; const bool last = (l == DEPTH - 1);
  float s1 = p.in.lam_q1[l * 64 + lane] * p.in.lam_k1[l * 64 + lane], s2 = p.in.lam_q2[l * 64 + lane] * p.in.lam_k2[l * 64 + lane];
  s1 = wave_sum_u(s1); s2 = wave_sum_u(s2);
  const float lam_init_v = 0.8f - 0.6f * expf(-0.3f * (float)l); const float lam_v = expf(s1) - expf(s2) + lam_init_v;
  const float lam_init = __builtin_bit_cast(float, __builtin_amdgcn_readfirstlane(__builtin_bit_cast(int, lam_init_v))), lam = __builtin_bit_cast(float, __builtin_amdgcn_readfirstlane(__builtin_bit_cast(int, lam_v)));
  const int c = obid(), x = c & 7, jl = c >> 3, per = ogd() >> 3;
  const int nu = (!last && jl >= 24) ? 6 : 4;
  for (int u = 0; u < nu; ++u) { const int q = u < 4 ? jl + per * u : 128 + (jl - 24) * 2 + (u - 4);
    int qrow0, nkeys, h;
    if (q < 128) { h = q >> 4; qrow0 = x * SEQ + (q & 15) * 128; nkeys = KVB; }
    else { const int qq = q - 128; h = qq >> 1; qrow0 = NLAT + x * CTX + (qq & 1) * 128; nkeys = CTX; }
    attn_unit<VAR>(p.Qb, p.Kc, p.Vc, p.ATTb, qrow0, x * KVB, nkeys, h, lam, lam_init, p.in.subln_g + l * 128, lds, g_wv);
  }
}

__device__ __forceinline__ float wave_sum(float v) { return wave_sum_u(v); }
__device__ __forceinline__ void row_ld(const float* p, int lane, f32x4 (&v)[4]) {
#pragma unroll
  for (int i = 0; i < 4; ++i) v[i] = *(const f32x4*)(p + 4 * lane + 256 * i); }
__device__ __forceinline__ void row_st(float* p, int lane, const f32x4 (&v)[4]) {
#pragma unroll
  for (int i = 0; i < 4; ++i) *(f32x4*)(p + 4 * lane + 256 * i) = v[i]; }
__device__ __forceinline__ void row_st_bf16(bf16_t* p, int lane, const f32x4 (&v)[4]) {
#pragma unroll
  for (int i = 0; i < 4; ++i) { u32x2 w; w.x = cvt_pk_bf16(v[i][0], v[i][1]); w.y = cvt_pk_bf16(v[i][2], v[i][3]); *(u32x2*)(p + 4 * lane + 256 * i) = w; } }
__device__ __forceinline__ void row_st_h16(bf16_t* p, int lane, const f32x4 (&v)[4]) {
#pragma unroll
  for (int i = 0; i < 4; ++i) { u32x2 w; w.x = pk_h16(v[i][0], v[i][1]); w.y = pk_h16(v[i][2], v[i][3]); *(u32x2*)(p + 4 * lane + 256 * i) = w; } }
__device__ __forceinline__ void row_ld_bf16(const bf16_t* p, int lane, f32x4 (&v)[4]) {
#pragma unroll
  for (int i = 0; i < 4; ++i) { const u32x2 w = *(const u32x2*)(p + 4 * lane + 256 * i); v[i] = (f32x4){bflo(w.x), bfhi(w.x), bflo(w.y), bfhi(w.y)}; } }
__device__ __forceinline__ void row_ln(f32x4 (&v)[4], const float* g, const float* b, int lane) {
  float s = 0.f;
#pragma unroll
  for (int i = 0; i < 4; ++i) s += (v[i][0] + v[i][1]) + (v[i][2] + v[i][3]);
  const float mean = wave_sum(s) * (1.f / 1024.f); float q = 0.f;
#pragma unroll
  for (int i = 0; i < 4; ++i) { v[i] -= mean; q += (v[i][0] * v[i][0] + v[i][1] * v[i][1]) + (v[i][2] * v[i][2] + v[i][3] * v[i][3]); }
  const float rs = __builtin_amdgcn_rsqf(wave_sum(q) * (1.f / 1024.f) + 1e-5f);
#pragma unroll
  for (int i = 0; i < 4; ++i) { const f32x4 gg = *(const f32x4*)(g + 4 * lane + 256 * i), bb = *(const f32x4*)(b + 4 * lane + 256 * i); v[i] = v[i] * rs * gg + bb; }
}
__device__ __forceinline__ void row_ln_r(f32x4 (&v)[4], const f32x4 (&gg)[4], const f32x4 (&bb)[4]) {
  float s = 0.f;
#pragma unroll
  for (int i = 0; i < 4; ++i) s += (v[i][0] + v[i][1]) + (v[i][2] + v[i][3]);
  const float mean = wave_sum(s) * (1.f / 1024.f); float q = 0.f;
#pragma unroll
  for (int i = 0; i < 4; ++i) { v[i] -= mean; q += (v[i][0] * v[i][0] + v[i][1] * v[i][1]) + (v[i][2] * v[i][2] + v[i][3] * v[i][3]); }
  const float rs = __builtin_amdgcn_rsqf(wave_sum(q) * (1.f / 1024.f) + 1e-5f);
#pragma unroll
  for (int i = 0; i < 4; ++i) v[i] = v[i] * rs * gg[i] + bb[i];
}
__device__ __forceinline__ void row_mod(f32x4 (&h)[4], const f32x4 (&v)[4], const float* modrow, int shift_idx, int scale_idx, int lane) {
#pragma unroll
  for (int i = 0; i < 4; ++i) { const f32x4 sc = *(const f32x4*)(modrow + scale_idx * 1024 + 4 * lane + 256 * i), sh = *(const f32x4*)(modrow + shift_idx * 1024 + 4 * lane + 256 * i); h[i] = v[i] * (1.f + sc) + sh; }
}
__device__ __forceinline__ int modrow_of_row(int r) { return r < NLAT ? (r >> 11) : 8; }

__device__ __forceinline__ void h0_phase(KP p, const int g_wv) {
  const int tid = otid(); const int lane = tid & 63, gw = obid() * 8 + (tid >> 6), nw = ogd() * 8;
  const int per = (NR + nw - 1) / nw;
  for (int r = gw * per; r < NR && r < (gw + 1) * per; ++r) {
    const float* src = r < NLAT ? p.in.x + (size_t)r * D : p.in.ctx + (size_t)(r - NLAT) * D;
    f32x4 v[4], h[4]; row_ld(src, lane, v); row_mod(h, v, p.MOD + (size_t)modrow_of_row(r) * 6144, 0, 1, lane); row_st_bf16(p.Hb + (size_t)r * D, lane, h); }
}
constexpr int LN1_RS = 1032, LN1_HXB = 32 * LN1_RS * 2, LN1_OFF_SUM = 2 * LN1_HXB, LN1_OFF_LCNT = LN1_OFF_SUM + 64 * 32 * 4, LN1_OFF_LBASE = LN1_OFF_LCNT + 128, LN1_OFF_ENT = LN1_OFF_LBASE + 128, LN1_END = LN1_OFF_ENT + 72 * 16;
__device__ __forceinline__ void ln1_phase(KP p, int l, LAS char* lds, const int g_wv) {
  const int tid = otid(), lane = tid & 63, wid = tid >> 6, gw = obid() * 8 + wid; const bool last = (l == DEPTH - 1);
  LAS bf16_t* HXhi = (LAS bf16_t*)lds; LAS bf16_t* HXlo = (LAS bf16_t*)(lds + LN1_HXB); LAS float* RED = (LAS float*)lds;
  LAS int* lcnt = (LAS int*)(lds + LN1_OFF_LCNT); LAS int* lbase = (LAS int*)(lds + LN1_OFF_LBASE); LAS int* ent = (LAS int*)(lds + LN1_OFF_ENT);
  if (tid < 32) lcnt[tid] = 0;
  const float* MODl = p.MOD + (size_t)l * 9 * 6144; const bf16_t* WRh = (const bf16_t*)p.s[l].WR; const bf16_t* WRl = WRh + 64 * 1024;
  const int nrow = last ? NLAT : NR, ni = nrow / 2048; const int c32 = lane & 31, hh = lane >> 5;
  u32x4 vn[3][4];
#define LN1_XROW(r) ((r) < NLAT ? p.in.x + (size_t)(r) * D : p.in.ctx + (size_t)((r) - NLAT) * D)
#define LN1_LD(j, r) do { if (l == 0) { const float* s_ = LN1_XROW(r); _Pragma("unroll") for (int q_ = 0; q_ < 4; ++q_) vn[j][q_] = *(const u32x4*)(s_ + 4 * lane + 256 * q_); } \
    else { _Pragma("unroll") for (int q_ = 0; q_ < 4; ++q_) { const u32x2 t_ = *(const u32x2*)((const bf16_t*)p.XL + (size_t)(r) * D + 4 * lane + 256 * q_); vn[j][q_].x = t_.x; vn[j][q_].y = t_.y; } } } while (0)
#define LN1_LDD(r) do { _Pragma("unroll") for (int q_ = 0; q_ < 4; ++q_) dq[q_] = *(const u32x2*)(p.ATTb + (size_t)(r) * D + 4 * lane + 256 * q_); } while (0)
#pragma unroll
  for (int j = 0; j < 3; ++j) if (j < ni) LN1_LD(j, gw * ni + j);
  u32x2 dq[4];
  LN1_LDD(gw * ni);
#pragma unroll 1
  for (int i0 = 0; i0 < ni; i0 += 3) {
#pragma unroll
    for (int j = 0; j < 3; ++j) { const int r = gw * ni + (i0 + j); const int slot = wid * 3 + j;
      if (i0 + j < ni) { f32x4 v[4], h[4];
#pragma unroll
        for (int q = 0; q < 4; ++q) { const f32x4 xi = l == 0 ? __builtin_bit_cast(f32x4, vn[j][q]) : (f32x4){h16lo(vn[j][q].x), h16hi(vn[j][q].x), h16lo(vn[j][q].y), h16hi(vn[j][q].y)};
          v[q] = xi * ALPHA + (f32x4){bflo(dq[q].x), bfhi(dq[q].x), bflo(dq[q].y), bfhi(dq[q].y)}; }
        if (i0 + j + 1 < ni) LN1_LDD(r + 1);
        if (i0 + 3 + j < ni) LN1_LD(j, r + 3);
        row_ln(v, p.in.ln1_g + l * D, p.in.ln1_b + l * D, lane); row_st_h16(p.X1b + (size_t)r * D, lane, v);
        row_mod(h, v, MODl + (size_t)modrow_of_row(r) * 6144, 3, 4, lane);
#pragma unroll
        for (int q = 0; q < 4; ++q) { u32x2 wh; wh.x = cvt_pk_bf16(h[q][0], h[q][1]); wh.y = cvt_pk_bf16(h[q][2], h[q][3]); *(u32x2*)(p.H2b + (size_t)r * D + 4 * lane + 256 * q) = wh;
          u32x2 wl; wl.x = cvt_pk_bf16(h[q][0] - bflo(wh.x), h[q][1] - bfhi(wh.x)); wl.y = cvt_pk_bf16(h[q][2] - bflo(wh.y), h[q][3] - bfhi(wh.y));
          *(LAS u32x2*)(HXhi + slot * LN1_RS + 4 * lane + 256 * q) = wh; *(LAS u32x2*)(HXlo + slot * LN1_RS + 4 * lane + 256 * q) = wl; } }
      else {
#pragma unroll
        for (int q = 0; q < 4; ++q) { *(LAS u32x2*)(HXhi + slot * LN1_RS + 4 * lane + 256 * q) = (u32x2){0u, 0u}; *(LAS u32x2*)(HXlo + slot * LN1_RS + 4 * lane + 256 * q) = (u32x2){0u, 0u}; } } }
    __syncthreads();
#ifdef PROBE_G0
    if (p.pad0 & 1) continue;
#endif
    f32x16 acc0 = {}, acc1 = {};
#pragma unroll 2
    for (int s8 = 0; s8 < 8; ++s8) { const int ko = (wid * 8 + s8) * 16 + hh * 8;
      const bf16x8 bh = *(const LAS bf16x8*)(HXhi + c32 * LN1_RS + ko), bl = *(const LAS bf16x8*)(HXlo + c32 * LN1_RS + ko);
      const bf16x8 ah0 = *(const bf16x8*)(WRh + (size_t)c32 * 1024 + ko), al0 = *(const bf16x8*)(WRl + (size_t)c32 * 1024 + ko);
      const bf16x8 ah1 = *(const bf16x8*)(WRh + (size_t)(32 + c32) * 1024 + ko), al1 = *(const bf16x8*)(WRl + (size_t)(32 + c32) * 1024 + ko);
      acc0 = __builtin_amdgcn_mfma_f32_32x32x16_bf16(ah0, bh, acc0, 0, 0, 0); acc0 = __builtin_amdgcn_mfma_f32_32x32x16_bf16(ah0, bl, acc0, 0, 0, 0); acc0 = __builtin_amdgcn_mfma_f32_32x32x16_bf16(al0, bh, acc0, 0, 0, 0);
      acc1 = __builtin_amdgcn_mfma_f32_32x32x16_bf16(ah1, bh, acc1, 0, 0, 0); acc1 = __builtin_amdgcn_mfma_f32_32x32x16_bf16(ah1, bl, acc1, 0, 0, 0); acc1 = __builtin_amdgcn_mfma_f32_32x32x16_bf16(al1, bh, acc1, 0, 0, 0); }
    __syncthreads();
#pragma unroll
    for (int r = 0; r < 16; ++r) { RED[(wid * 64 + crow(r, hh)) * 32 + c32] = acc0[r]; RED[(wid * 64 + 32 + crow(r, hh)) * 32 + c32] = acc1[r]; }
    __syncthreads();
    { LAS float* SUM = (LAS float*)(lds + LN1_OFF_SUM);
#pragma unroll
      for (int k = 0; k < 4; ++k) { const int idx = tid + 512 * k; float sacc = 0.f;
#pragma unroll
        for (int w = 0; w < 8; ++w) sacc += RED[w * 2048 + idx];
        SUM[idx] = sacc; } }
    __syncthreads();
    if (wid == 0 && lane < 24) { const int ws = lane / 3, j = lane - 3 * ws;
      if (i0 + j < ni) { const int r = (obid() * 8 + ws) * ni + (i0 + j); float lg[36]; const LAS float* SUM = (const LAS float*)(lds + LN1_OFF_SUM);
#pragma unroll
        for (int e = 0; e < 36; ++e) lg[e] = SUM[e * 32 + lane] + (e < 4 ? p.in.rg_b[l * 4 + e] : p.in.re_b[l * 32 + e - 4]);
        int gi = 0; float gm = lg[0];
#pragma unroll
        for (int q = 1; q < 4; ++q) if (lg[q] > gm) { gm = lg[q]; gi = q; }
        float gs = 0.f;
#pragma unroll
        for (int q = 0; q < 4; ++q) gs += expf(lg[q] - gm);
        const float gtop = 1.f / gs; float el[8];
#pragma unroll
        for (int q = 0; q < 8; ++q) el[q] = gi == 0 ? lg[4 + q] : gi == 1 ? lg[12 + q] : gi == 2 ? lg[20 + q] : lg[28 + q];
        int i0e = 0; float v0 = el[0];
#pragma unroll
        for (int q = 1; q < 8; ++q) if (el[q] > v0) { v0 = el[q]; i0e = q; }
        int i1e = -1; float v1 = -3.0e38f;
#pragma unroll
        for (int q = 0; q < 8; ++q) if (q != i0e && el[q] > v1) { v1 = el[q]; i1e = q; }
        const float e1 = expf(v1 - v0); const float w0 = gtop / (1.f + e1), w1 = gtop * e1 / (1.f + e1);
        const int e0i = gi * 8 + i0e, e1i = gi * 8 + i1e;
        const int lr0 = __hip_atomic_fetch_add(&lcnt[e0i], 1, __ATOMIC_RELAXED, __HIP_MEMORY_SCOPE_WORKGROUP); const int lr1 = __hip_atomic_fetch_add(&lcnt[e1i], 1, __ATOMIC_RELAXED, __HIP_MEMORY_SCOPE_WORKGROUP);
        { LAS int* ep = ent + ((i0 + j) * 8 + ws) * 4; ep[0] = e0i; ep[1] = e1i; ep[2] = lr0; ep[3] = lr1; } *(float2*)(p.RW + (size_t)r * 2) = make_float2(w0, w1); } }
  }
  __syncthreads();
#ifdef PROBE_G0
  if (p.pad0 & 1) return;
#endif
  if (tid < 32) lbase[tid] = (int)atomicAdd(p.ctl + l * CTL_WORDS + CTL_CNT + 64 * tid, (unsigned)lcnt[tid]);
  __syncthreads();
  if (tid < ni * 8) { const int i = tid >> 3, w = tid & 7; const int r = (obid() * 8 + w) * ni + i; const LAS int* ep = ent + tid * 4; const int4 en = make_int4(ep[0], ep[1], ep[2], ep[3]); const int g0 = lbase[en.x] + en.z, g1 = lbase[en.y] + en.w;
    p.TOK[(size_t)en.x * NR + g0] = r; p.TOK[(size_t)en.y * NR + g1] = r; *(int4*)(p.ROUTE + (size_t)r * 4) = make_int4(en.x, en.y, g0, g1); }
}
__device__ __forceinline__ void moe_table(KP p, int l, LAS MoeTab* tab, const int g_wv) {
  const int tid = otid();
  if (tid < 32) tab->cnt[tid] = (int)__hip_atomic_load(p.ctl + l * CTL_WORDS + CTL_CNT + 64 * tid, __ATOMIC_RELAXED, __HIP_MEMORY_SCOPE_AGENT);
  __syncthreads();
  if (tid < 32) {
    const int n = (tab->cnt[tid] + 255) >> 8; int t0 = 0, tot = 0;
#pragma unroll
    for (int e = 0; e < 32; ++e) { const int ne = (tab->cnt[e] + 255) >> 8; if (e < tid) t0 += ne; tot += ne; }
    tab->tbase[tid] = t0; for (int i = 0; i < n; ++i) { tab->tileE[t0 + i] = tid; tab->tileR0[t0 + i] = i * 256; }
    if (tid == 0) { tab->tbase[32] = tot; tab->ntiles = tot; } }
  __syncthreads();
}
__device__ __forceinline__ void ln2_phase(KP p, int l, LAS char* lds, const int g_wv) {
  const int tid = otid(), lane = tid & 63, wid = tid >> 6, gw = obid() * 8 + wid; const bool last = (l == DEPTH - 1);
  LAS MoeTab* tab = (LAS MoeTab*)lds; moe_table(p, l, tab, g_wv);
  const float* MODl = p.MOD + (size_t)l * 9 * 6144; const int ni = last ? NLAT / 2048 : NR / 2048;
  int4 rt[9]; float2 rw[9]; f32x4 gg[4], bb[4];
#pragma unroll
  for (int q = 0; q < 4; ++q) { gg[q] = *(const f32x4*)(p.in.ln2_g + l * D + 4 * lane + 256 * q); bb[q] = *(const f32x4*)(p.in.ln2_b + l * D + 4 * lane + 256 * q); }
#pragma unroll
  for (int i = 0; i < 9; ++i) if (i < ni) { const int r = gw * ni + i; rt[i] = *(const int4*)(p.ROUTE + (size_t)r * 4); rw[i] = *(const float2*)(p.RW + (size_t)r * 2); }
  u32x2 xb[4], ya[4], yb[4];
#define LN2_LOAD(i) do { const int r_ = gw * ni + (i); const int p0_ = (tab->tbase[rt[i].x] + (rt[i].z >> 8)) * 256 + (rt[i].z & 255), p1_ = (tab->tbase[rt[i].y] + (rt[i].w >> 8)) * 256 + (rt[i].w & 255); \
    _Pragma("unroll") for (int q_ = 0; q_ < 4; ++q_) { xb[q_] = *(const u32x2*)(p.X1b + (size_t)r_ * D + 4 * lane + 256 * q_); ya[q_] = *(const u32x2*)(p.Yo + (size_t)p0_ * D + 4 * lane + 256 * q_); yb[q_] = *(const u32x2*)(p.Yo + (size_t)p1_ * D + 4 * lane + 256 * q_); } } while (0)
  LN2_LOAD(0);
#pragma unroll
  for (int i = 0; i < 9; ++i) if (i < ni) { const int r = gw * ni + i; const float2 w = rw[i]; f32x4 x[4];
    const float* mr = MODl + (size_t)modrow_of_row(r) * 6144;
#pragma unroll
    for (int q = 0; q < 4; ++q) { const f32x4 g2 = *(const f32x4*)(mr + 5 * 1024 + 4 * lane + 256 * q); const f32x4 y0 = (f32x4){bflo(ya[q].x), bfhi(ya[q].x), bflo(ya[q].y), bfhi(ya[q].y)}, y1 = (f32x4){bflo(yb[q].x), bfhi(yb[q].x), bflo(yb[q].y), bfhi(yb[q].y)};
      x[q] = (f32x4){h16lo(xb[q].x), h16hi(xb[q].x), h16lo(xb[q].y), h16hi(xb[q].y)} * ALPHA + g2 * (y0 * w.x + y1 * w.y); }
    if (i + 1 < ni) LN2_LOAD(i + 1);
    row_ln_r(x, gg, bb);
    if (!last) { row_st_h16((bf16_t*)p.XL + (size_t)r * D, lane, x); f32x4 h[4]; row_mod(h, x, p.MOD + ((size_t)(l + 1) * 9 + modrow_of_row(r)) * 6144, 0, 1, lane); row_st_bf16(p.Hb + (size_t)r * D, lane, h); }
    else row_st(p.out + (size_t)r * D, lane, x); }
#undef LN2_LOAD
}
__device__ __forceinline__ void s2_phase(KP p, int l, const int g_wv) {
  const int tid = otid(); const int it = (tid >> 7) * 96 + obid(); if (it >= NG * 8) return;
  const int g = it >> 3, b = it & 7, dir = (tid >> 6) & 1, pp = tid & 63;
  const f32x2 aL = *(const f32x2*)(p.s[l].SAL + ((size_t)(g * 2 + dir) * 64 + pp) * 2);
  const float* S = p.SST + (size_t)g * NCHP * 256 + dir * 128 + 2 * pp; bf16_t* A = p.Ug + (size_t)g * NCHP * 768 + 512 + dir * 128 + 2 * pp;
  float hr = 0.f, hi = 0.f;
#pragma unroll 1
  for (int s0 = 0; s0 < 72; s0 += 24) {
    f32x2 sv[24];
#pragma unroll
    for (int k = 0; k < 24; ++k) { const int s = s0 + k; int row; if (dir == 0) row = s < 8 ? 512 + b * 8 + s : b * 64 + (s - 8); else row = s < 8 ? 512 + b * 8 + (7 - s) : b * 64 + (63 - (s - 8));
      sv[k] = *(const f32x2*)(S + (size_t)row * 256); }
#pragma unroll
    for (int k = 0; k < 24; ++k) { const int s = s0 + k; int row; if (dir == 0) row = s < 8 ? 512 + b * 8 + s : b * 64 + (s - 8); else row = s < 8 ? 512 + b * 8 + (7 - s) : b * 64 + (63 - (s - 8));
      *(unsigned*)(A + (size_t)row * 768) = cvt_pk_bf16(hr, hi);
      const float nr = aL.x * hr - aL.y * hi + sv[k].x, ni = aL.x * hi + aL.y * hr + sv[k].y; hr = nr; hi = ni; }
  }
}

struct ConvJob { const float* src; const float* src2; bf16_t* dst; int ldd, lds_, kind, nK; };
__device__ __forceinline__ void conv_step(const ConvJob& j, int nt, int kt, int lane) {
  const int q = lane & 15, kq = lane >> 4; const int n = nt * 64 + 4 * q, k0 = kt * 64 + kq * 8; const float* s = j.src; int col;
  if (j.kind == 0) col = (n & ~31) + perm32(n & 31);
  else if (j.kind == 1) { const int pn = n >> 8; if (pn < 4 || (pn >= 10 && pn < 14)) col = n; else if (pn < 10) col = (n & ~31) + perm32(n & 31);
    else { const int bj = (n >> 7) & 1, w = n & 127; col = (bj ? 4608 : 3584) + (pn - 14) * 128 + (w & ~31) + perm32(w & 31); } }
  else { const int bj = (n >> 7) & 1, w = n & 127; col = (n >> 8) * 128 + (w & ~31) + perm32(w & 31); if (bj) s = j.src2; }
  const float* sp = s + (size_t)k0 * j.lds_ + col; f32x4 v[16];
#pragma unroll
  for (int i = 0; i < 8; ++i) { v[i] = __builtin_nontemporal_load((const f32x4*)(sp + (size_t)i * j.lds_)); v[8 + i] = __builtin_nontemporal_load((const f32x4*)(sp + (size_t)(32 + i) * j.lds_)); }
  bf16_t* dp = j.dst + (size_t)n * j.ldd + k0;
#pragma unroll
  for (int r = 0; r < 4; ++r) {
    *(u32x4*)(dp + (size_t)r * j.ldd) = pack8((f32x4){v[0][r], v[1][r], v[2][r], v[3][r]}, (f32x4){v[4][r], v[5][r], v[6][r], v[7][r]});
    *(u32x4*)(dp + (size_t)r * j.ldd + 32) = pack8((f32x4){v[8][r], v[9][r], v[10][r], v[11][r]}, (f32x4){v[12][r], v[13][r], v[14][r], v[15][r]}); }
}
__device__ __forceinline__ void ssm_mats(KP p, KS W, int l, int g, int hf, LAS char* lds, const int g_wv) {
  const int tid = otid();
  LAS f32x2* AP = (LAS f32x2*)lds;
  LAS f32x2* BB = AP + 2 * 64 * 34;
  LAS f32x2* CC = BB + 2 * 64 * 16;
  LAS float* KT = (LAS float*)(CC + 2 * 16 * 64);
  LAS float* DS = KT + 32 * 260 + 256;
  const size_t so = (size_t)l * 2 * NG * NP;
  if (tid < 128) { const int dir = tid >> 6, pp = tid & 63; const size_t gp = so + ((size_t)dir * NG + g) * NP + pp;
    const float dtf = expf(p.in.log_dt[(size_t)l * 2 * NG + dir * NG + g]); const double are = p.in.a_re[gp], aim = p.in.a_im[gp], dt = (double)dtf;
    double ang = aim * dt; ang -= 6.283185307179586476925 * (double)(long long)(ang * 0.15915494309189533577 + (ang >= 0 ? 0.5 : -0.5));
    const float e1f = expf((float)(are * dt)), angf = (float)ang; const double c1r = (double)(e1f * cosf(angf)), c1i = (double)(e1f * sinf(angf));
    { float onef = 1.f; asm volatile("" : "+v"(onef)); double cr = (double)onef, ci = 0.0;
      for (int t = 0; t < 34; ++t) { AP[(dir * 64 + pp) * 34 + t] = (f32x2){(float)cr, (float)ci}; if (t == 32 && hf == 0) *(f32x2*)(W.SAL + ((size_t)(g * 2 + dir) * 64 + pp) * 2) = (f32x2){(float)cr, (float)ci}; const double nr2 = cr * c1r - ci * c1i, ni2 = cr * c1i + ci * c1r; cr = nr2; ci = ni2; } }
    const float sh = sinf(0.5f * angf); const double nr = (double)(expm1f((float)(are * dt)) * cosf(angf) - 2.f * sh * sh), ni = c1i, den = are * are + aim * aim; const double fr = (nr * are + ni * aim) / den, fi = (ni * are - nr * aim) / den;
    f32x4 brv[4], biv[4];
#pragma unroll
    for (int c = 0; c < 4; ++c) { brv[c] = *(const f32x4*)(p.in.b_re + gp * 16 + 4 * c); biv[c] = *(const f32x4*)(p.in.b_im + gp * 16 + 4 * c); }
#pragma unroll
    for (int c = 0; c < 16; ++c) { const double br = brv[c >> 2][c & 3], bi = biv[c >> 2][c & 3]; BB[(dir * 64 + pp) * 16 + c] = (f32x2){(float)(fr * br - fi * bi), (float)(fr * bi + fi * br)}; }
  }
  if (tid >= 496) DS[tid - 496] = p.in.ssm_d[l * SSMW + g * 16 + (tid - 496)];
  for (int i = tid; i < 2 * 16 * 64; i += 512) { const int dir = i >> 10, c = (i >> 6) & 15, pp = i & 63; const size_t ci = (so + ((size_t)dir * NG + g) * NP) * 16 + (size_t)c * NP + pp; CC[i] = (f32x2){p.in.c_re[ci], p.in.c_im[ci]}; }
  __syncthreads();
  LAS float* K0o = KT + 32 * 260;
  { const int own = tid < 256, dir = own ? hf : 1 - hf, co = (tid >> 4) & 15, ci = tid & 15; float acc[32];
#pragma unroll
    for (int t = 0; t < 32; ++t) acc[t] = 0.f;
    if (own) {
      for (int pp = 0; pp < 64; ++pp) { const f32x2 c = CC[(dir * 16 + co) * 64 + pp], bq = BB[(dir * 64 + pp) * 16 + ci]; const float cbr = c.x * bq.x - c.y * bq.y, cbi = c.x * bq.y + c.y * bq.x;
        const LAS f32x4* ap = (const LAS f32x4*)(AP + (dir * 64 + pp) * 34);
#pragma unroll
        for (int t2 = 0; t2 < 16; ++t2) { const f32x4 a = ap[t2]; acc[2 * t2] += cbr * a[0] - cbi * a[1]; acc[2 * t2 + 1] += cbr * a[2] - cbi * a[3]; } }
#pragma unroll
      for (int t = 0; t < 32; ++t) KT[t * 260 + co * 16 + ci] = acc[t];
    } else { float s0 = 0.f;
      for (int pp = 0; pp < 64; ++pp) { const f32x2 c = CC[(dir * 16 + co) * 64 + pp], bq = BB[(dir * 64 + pp) * 16 + ci]; s0 += c.x * bq.x - c.y * bq.y; }
      K0o[co * 16 + ci] = s0; } }
  __syncthreads();
  bf16_t* Sm = W.Smat + (size_t)g * 256 * 768;
  for (int i = tid; i < 128 * 64; i += 512) { const int n = hf * 128 + (i >> 6), k8 = (i & 63) * 8; const int Lc = (n & ~31) + perm32(n & 31); const int dir = Lc >> 7, pp = (Lc & 127) >> 1, ri = Lc & 1; const int t = k8 >> 4, c0 = k8 & 15;
    const f32x2 a = AP[(dir * 64 + pp) * 34 + (dir == 0 ? 31 - t : t)]; float v[8];
#pragma unroll
    for (int q = 0; q < 8; ++q) { const f32x2 bq = BB[(dir * 64 + pp) * 16 + c0 + q]; v[q] = ri == 0 ? a.x * bq.x - a.y * bq.y : a.x * bq.y + a.y * bq.x; }
    *(u32x4*)(Sm + (size_t)n * 768 + k8) = pack8((f32x4){v[0], v[1], v[2], v[3]}, (f32x4){v[4], v[5], v[6], v[7]}); }
  bf16_t* To = W.TO + (size_t)g * 512 * 768;
#ifdef PROBE_G0
  if (p.pad0 & 16) { __syncthreads(); return; }
#endif
  for (int i = tid; i < 512 * 64; i += 512) { const int n = i >> 6, k8 = (i & 63) * 8; const int Lc = (n & ~31) + perm32(n & 31); const int t = Lc >> 4, co = Lc & 15; const int s = k8 >> 4, c0 = k8 & 15;
    if (hf == 0 ? s > t : s <= t) continue;
    const int tau = hf == 0 ? t - s : s - t; const LAS f32x4* kk = (const LAS f32x4*)(KT + tau * 260 + co * 16 + c0); f32x4 v0 = kk[0], v1 = kk[1];
    if (s == t) { const LAS f32x4* ko = (const LAS f32x4*)(K0o + co * 16 + c0); v0 += ko[0]; v1 += ko[1]; const float dv = DS[co]; const int qd = co - c0;
#pragma unroll
      for (int q = 0; q < 4; ++q) { if (qd == q) v0[q] += dv; if (qd == 4 + q) v1[q] += dv; } }
    *(u32x4*)(To + (size_t)n * 768 + k8) = pack8(v0, v1); }
  for (int i = tid; i < 512 * 16; i += 512) { const int n = i >> 4, k8 = 512 + hf * 128 + (i & 15) * 8; const int Lc = (n & ~31) + perm32(n & 31); const int t = Lc >> 4, co = Lc & 15;
    const int dir = hf, pp0 = (i & 15) * 4; float v[8];
#pragma unroll
    for (int q = 0; q < 4; ++q) { const f32x2 a = AP[(dir * 64 + pp0 + q) * 34 + (dir == 0 ? t + 1 : 32 - t)], c = CC[(dir * 16 + co) * 64 + pp0 + q];
      v[2 * q] = c.x * a.x - c.y * a.y; v[2 * q + 1] = -(c.x * a.y + c.y * a.x); }
    *(u32x4*)(To + (size_t)n * 768 + k8) = pack8((f32x4){v[0], v[1], v[2], v[3]}, (f32x4){v[4], v[5], v[6], v[7]}); }
  __syncthreads();
}
__device__ __forceinline__ void mod_item(KP p, int l, int j0, LAS char* lds, const int g_wv) {
  const int tid = otid(); LAS float* sl = (LAS float*)lds;
  LAS float* part = sl + 9 * 1024;
  for (int i = tid; i < 9 * 1024; i += 512) { const int r = i >> 10, k = i & 1023; const float v = r < 8 ? p.in.c[r * 1024 + k] : p.in.c_ctx[k]; sl[i] = v / (1.f + expf(-v)); }
  __syncthreads();
  const int jj = tid & 63, ks = tid >> 6; float acc[9];
#pragma unroll
  for (int r = 0; r < 9; ++r) acc[r] = 0.f;
  const float* w = p.in.w_mod + (size_t)l * 1024 * 6144 + j0 + jj;
  for (int k = ks * 128; k < ks * 128 + 128; ++k) { const float wv = w[(size_t)k * 6144];
#pragma unroll
    for (int r = 0; r < 9; ++r) acc[r] += sl[r * 1024 + k] * wv; }
#pragma unroll
  for (int r = 0; r < 9; ++r) part[(ks * 9 + r) * 64 + jj] = acc[r];
  __syncthreads();
  for (int i = tid; i < 9 * 64; i += 512) { const int r = i >> 6, j = i & 63; float s = 0.f;
#pragma unroll
    for (int k = 0; k < 8; ++k) s += part[(k * 9 + r) * 64 + j];
    p.MOD[((size_t)l * 9 + r) * 6144 + j0 + j] = s + p.in.b_mod[l * 6144 + j0 + j]; }
  __syncthreads();
}
constexpr int CONV_NONMOE = 2112;
__device__ __forceinline__ void conv_steps(KP p, int lc, int s0, int s1, int gw, int nw, int lane) {
  for (int t0 = s0 + gw; t0 < s1; t0 += nw) { int t = t0; ConvJob j; int nK;
    const int l = lc + 1; if (l >= DEPTH) continue;
    KW W = p.w[l & 1];
    if (t < 1408) { j.src = p.in.w_in + (size_t)l * 1024 * INW; j.src2 = nullptr; j.dst = W.Win; j.ldd = 1024; j.lds_ = INW; j.kind = 1; nK = 16; }
    else if ((t -= 1408) < 64) { j.src = p.in.w_glu + (size_t)l * 512 * 512; j.src2 = nullptr; j.dst = W.Wglu; j.ldd = 512; j.lds_ = 512; j.kind = 0; nK = 8; }
    else if ((t -= 64) < 256) { j.src = p.in.w_pa + (size_t)l * 1024 * 1024; j.src2 = nullptr; j.dst = W.Wpa; j.ldd = 1024; j.lds_ = 1024; j.kind = 0; nK = 16; }
    else if ((t -= 256) < 128) { j.src = p.in.w_ps + (size_t)l * 512 * 1024; j.src2 = nullptr; j.dst = W.Wps; j.ldd = 1024; j.lds_ = 1024; j.kind = 0; nK = 8; }
    else if ((t -= 128) < 256) { j.src = p.in.w_o + (size_t)l * 1024 * 1024; j.src2 = nullptr; j.dst = W.Wo; j.ldd = 1024; j.lds_ = 1024; j.kind = 0; nK = 16; }
    else if ((t -= 256) < 8192) { const int e = t >> 8; t &= 255; j.src = p.in.w1 + ((size_t)l * NE + e) * 1024 * 512; j.src2 = p.in.w3 + ((size_t)l * NE + e) * 1024 * 512; j.dst = W.W13 + (size_t)e * 1024 * 1024; j.ldd = 1024; j.lds_ = 512; j.kind = 2; nK = 16; }
    else { t -= 8192; const int e = t >> 7; t &= 127; j.src = p.in.w2 + ((size_t)l * NE + e) * 512 * 1024; j.src2 = nullptr; j.dst = W.W2 + (size_t)e * 1024 * 512; j.ldd = 512; j.lds_ = 1024; j.kind = 0; nK = 8; }
    conv_step(j, t / nK, t % nK, lane); }
}
__device__ __forceinline__ void router_tab(KP p, KS W, int l, int tid) {
  bf16_t* Wh = (bf16_t*)W.WR; bf16_t* Wl = Wh + 64 * 1024;
  for (int q = tid; q < 64 * 1024; q += 512) { const int e = q >> 10, k = q & 1023; const float w = e < 4 ? p.in.rg_w[((size_t)l * 1024 + k) * 4 + e] : e < 36 ? p.in.re_w[((size_t)l * 1024 + k) * 32 + (e - 4)] : 0.f;
    const unsigned hi = cvt_pk_bf16(w, 0.f) & 0xffffu; const unsigned lo = cvt_pk_bf16(w - bflo(hi), 0.f) & 0xffffu; Wh[q] = (bf16_t)hi; Wl[q] = (bf16_t)lo; }
}
constexpr int CONV_STEPS = 14400, CONV_S1 = 2350, CONV_S2 = 2350, CONV_S3 = 2350, CONV_S4 = 3694;
__device__ __forceinline__ void conv_phase(KP p, int l, LAS char* lds, const int g_wv) {
  const int tid = otid(); const int b = obid(); const int nb = ogd();
#ifdef PROBE_G0
  const int pf = p.pad0;
  if (pf) { if (!(pf & 2)) { for (int it = b; it < ((pf & 8) ? 2 : 1) * DEPTH * 2 * NG; it += nb) { const int ls = (it >> 6) & 3, r = it & 63; ssm_mats(p, p.s[ls], ls, r >> 1, r & 1, lds, g_wv); } }
    if (!(pf & 4)) { for (int it = b; it < 4 * 96; it += nb) mod_item(p, it / 96, (it % 96) * 64, lds, g_wv); }
    if (!(pf & 1)) conv_steps(p, -1, 0, CONV_STEPS, b * 8 + (tid >> 6), nb * 8, tid & 63);
    return; }
#endif
  if (b & 1) { for (int it = b; it < DEPTH * 2 * NG; it += nb) { const int ls = it >> 6, r = it & 63; ssm_mats(p, p.s[ls], ls, r >> 1, r & 1, lds, g_wv); } }
  else conv_steps(p, -1, 0, CONV_STEPS, (b >> 1) * 8 + (tid >> 6), (nb >> 1) * 8 * 2, tid & 63);
  if (b < DEPTH) router_tab(p, p.s[b], b, tid);
  if (b == 4) { for (int q = tid; q < 2048 * 32; q += 512) { const int t = q >> 5, axis = (q >> 4) & 1, f = q & 15; const float pos = axis == 0 ? (float)(t >> 6) : (float)(t & 63);
      const float inv = 1.0f / powf(10000.0f, (float)(2 * f) / 32.0f); const float ang = pos * inv; p.ROPE[((size_t)t * 2 + axis) * 32 + f] = cosf(ang); p.ROPE[((size_t)t * 2 + axis) * 32 + 16 + f] = sinf(ang); } }
  for (int it = b; it < 4 * 96; it += nb) mod_item(p, it / 96, (it % 96) * 64, lds, g_wv);
  if (b & 1) conv_steps(p, -1, 0, CONV_STEPS, ((nb >> 1) + (b >> 1)) * 8 + (tid >> 6), (nb >> 1) * 8 * 2, tid & 63);
  else { for (int it = b; it < DEPTH * 2 * NG; it += nb) { const int ls = it >> 6, r = it & 63; ssm_mats(p, p.s[ls], ls, r >> 1, r & 1, lds, g_wv); } }
}
__device__ __forceinline__ void conv_tail(KP p, int l, int part, const int g_wv) {
  const int b = obid(); const int tid = otid();
  if (part == 2) { if (b >= 144) conv_steps(p, l, 0, CONV_S1, (b - 144) * 8 + (tid >> 6), (ogd() - 144) * 8, tid & 63); return; }
  if (part == 3) { if (b >= 192) conv_steps(p, l, CONV_S2, CONV_S3, (b - 192) * 8 + (tid >> 6), (ogd() - 192) * 8, tid & 63); return; }
  if (part == 4) { if (b >= 144) conv_steps(p, l, CONV_S3, CONV_S4, (b - 144) * 8 + (tid >> 6), (ogd() - 144) * 8, tid & 63); return; }
  if (b < 64) return;
  conv_steps(p, l, CONV_S4, CONV_STEPS, (b - 64) * 8 + (tid >> 6), (ogd() - 64) * 8, tid & 63);
}
}
namespace fk {
constexpr int LDS_BYTES = 149504;
#ifndef STAG_G1
#define STAG_G1 450
#endif
#ifndef PROBE_MASK
#define PROBE_MASK 0
#endif
constexpr int NPH = 14;
enum { PH_CONV = 0, PH_H0, PH_GEMM1, PH_S1, PH_S2, PH_S3, PH_ATT, PH_GLU, PH_MERGE, PH_WO, PH_LN1, PH_MOE1, PH_MOE2, PH_LN2 };

__device__ __forceinline__ void run_phase(KP p, int l, int ph, LAS unsigned char* lds, const int g_wv) {
  const int G = ogd(), c = obid(); const bool last = (l == DEPTH - 1);
  const float* MODl = p.MOD + (size_t)l * 9 * 6144; KW W = p.w[l & 1]; KS SS = p.s[l];
  switch (ph) {
    case PH_CONV: if (l == 0) conv_phase(p, l, (LAS char*)lds, g_wv); break;
    case PH_H0: if (l == 0) h0_phase(p, g_wv); break;
    case PH_GEMM1: { SchedG1 S{(const char*)p.Hb, (const char*)W.Win, G, c, 0, last ? 1488 : 1536, last};
      EpiIn E{p.ROPE, p.Kc, p.Vc, p.Ug, p.Qb, p.RG, p.GSb, ~0}; gemm_stream(lds, 2048, 2048, S, E, g_wv); } break;
    case PH_S1: { unsigned* sp = p.ctl + l * CTL_WORDS + CTL_XC + 3 * 272; volatile LAS unsigned* xst = (volatile LAS unsigned*)(lds + LDS_BYTES - 16);
      if (c < 96) { SchedSsm1 S{(const char*)p.Ug, (const char*)SS.Smat, 96, c}; EpiState E{p.SST}; gemm_stream(lds, 1536, 1536, S, E, g_wv); }
      split_arrive(p.bar, xst, sp, sp + 256);
      if (c < 96) { split_wait(p.bar, xst, sp + 256); s2_phase(p, l, g_wv); } }
      if (c < 96) { }
      else if (!last && c < 144) { SchedG1 S{(const char*)p.Hb, (const char*)W.Win, 48, c - 96, 1536, 1584, false}; EpiIn E{p.ROPE, p.Kc, p.Vc, p.Ug, p.Qb, p.RG, p.GSb, ~0}; gemm_stream(lds, 2048, 2048, S, E, g_wv); }
      else conv_tail(p, l, 2, g_wv);
      break;
    case PH_S2: break;
    case PH_S3: break;
    case PH_ATT: {
      if ((c >> 3) < 24) { SchedSsm3 S{(const char*)p.Ug, (const char*)SS.TO, 256, (c & 7) * 24 + (c >> 3)}; EpiSsmOut E{p.YG}; gemm_stream(lds, 1536, 1536, S, E, g_wv); __syncthreads(); }
      attn_phase(p, l, (LAS char*)lds, g_wv); } break;
    case PH_GLU: { SchedPlain S; S.A = (const char*)p.YG; S.B = (const char*)W.Wglu; S.lda = NR * 32; S.ldb = 1024; S.nM = last ? NLAT / 256 : NR / 256; S.nN = 2; S.nt = 8; S.G = G; S.c = c; S.nunits = S.nM * 2; S.epi = 1; S.atile = 256 * 32;
      EpiGlu E{p.YG, p.S2, p.in.b_glu + l * SSMW}; gemm_stream<EpiGlu, SchedPlain, false, 1>(lds, NR * 32, 1024, S, E, g_wv); } conv_tail(p, l, 4, g_wv); break;
    case PH_MERGE: {
      unsigned* tc = p.ctl + l * CTL_WORDS + CTL_TILE; volatile LAS unsigned* xst = (volatile LAS unsigned*)(lds + LDS_BYTES - 16);
#ifdef PROBE_G0
      const int pf = p.pad0;
      const int nmu = (pf & 4) ? 0 : ((!last && c < 32 && !(pf & 8)) ? 2 : 1);
#define PF_SKIP(b) (pf & (b))
#else
#define PF_SKIP(b) false
      const int nmu = (!last && c < 32) ? 2 : 1;
#endif
      for (int k = 0; k < nmu; ++k) { int pm, pn; if (k == 0) tile_order(c, 64, 4, pm, pn); else { pm = 64 + (c & 7); pn = c >> 3; }
        pm = __builtin_amdgcn_readfirstlane(pm); pn = __builtin_amdgcn_readfirstlane(pn);
        SchedMergeOne S{(const char*)p.ATTb, (const char*)W.Wpa, (const char*)p.S2, (const char*)W.Wps, pm, pn}; EpiMerge E{p.RG, p.GSb, p.Mb}; gemm_stream(lds, 2048, 2048, S, E, g_wv);
        if (k == 0) split_arrive(p.bar, xst, p.ctl + l * CTL_WORDS + CTL_XC, p.ctl + l * CTL_WORDS + CTL_DONE); else tile_signal(tc + pm * 16); }
      const bool cf = (c & 1);
      if (cf && !PF_SKIP(1)) conv_tail(p, l, 1, g_wv);
      const int nwu = PF_SKIP(2) ? 0 : ((!last && c >= 32 && c < 64 && !PF_SKIP(16)) ? 2 : 1);
      for (int k = 0; k < nwu; ++k) { int pm, pn;
        if (last) tile_order(c, 64, 4, pm, pn); else if (c < 32) { pm = 64 + (c & 7); pn = c >> 3; } else tile_order(k == 0 ? c - 32 : 192 + c, 64, 4, pm, pn);
        pm = __builtin_amdgcn_readfirstlane(pm); pn = __builtin_amdgcn_readfirstlane(pn);
        if (pm >= 64) tile_wait(tc + pm * 16, 4u, p.bar); else if (k == 0) split_wait(p.bar, xst, p.ctl + l * CTL_WORDS + CTL_DONE);
        SchedPlainOne S{(const char*)p.Mb, (const char*)W.Wo, 16, pm, pn};
        EpiWo E{p.ATTb, MODl}; gemm_stream(lds, 2048, 2048, S, E, g_wv); }
      if (!cf && !PF_SKIP(1)) conv_tail(p, l, 1, g_wv); } break;
#undef PF_SKIP
    case PH_WO: break;
    case PH_LN1: ln1_phase(p, l, (LAS char*)lds, g_wv); break;
    case PH_MOE1: {
      LAS MoeTab* tab = (LAS MoeTab*)(lds + STAGE_BYTES); moe_table(p, l, tab, g_wv);
      const int nU = __builtin_amdgcn_readfirstlane(tab->ntiles) * 4, R = nU >> 8, rem = nU & 255;
      const int cc = ((c & 7) << 5) | (c >> 3);
      const int r2 = cc >= rem ? cc - rem : cc + 256 - rem;
      unsigned* sp = p.ctl + l * CTL_WORDS + CTL_XC + 272; volatile LAS unsigned* xst = (volatile LAS unsigned*)(lds + LDS_BYTES - 16);
      for (int st = 0; st < 2; ++st) {
        { SchedMoe S{(const char*)p.H2b, (const char*)W.W13, 2048, 2048, (size_t)1024 * 2048, tab, p.TOK, 4, 16, G, cc, true, st ? R : 0, st ? R + 1 : R}; EpiMoe1 E{p.Hm}; gemm_stream<EpiMoe1, SchedMoe, true>(lds, 2048, 2048, S, E, g_wv); }
        split_arrive(p.bar, xst, sp + st * 272, sp + st * 272 + 256); }
      for (int st = 0; st < 2; ++st) { if (st && r2 >= rem) break;
        split_wait(p.bar, xst, sp + st * 272 + 256);
        SchedMoe S{(const char*)p.Hm, (const char*)W.W2, 1024, 1024, (size_t)1024 * 1024, tab, p.TOK, 4, 8, G, r2, false, st ? R : 0, st ? R + 1 : R}; EpiMoe2 E{p.Yo}; gemm_stream(lds, 1024, 1024, S, E, g_wv); } } break;
    case PH_MOE2: break;
    case PH_LN2: ln2_phase(p, l, (LAS char*)lds, g_wv); break;
#if PROBE_MASK
    case 15: { SchedG1 S{(const char*)p.Hb, (const char*)W.Win, G, c, 0, 1536, false}; EpiIn E{p.ROPE, p.Kc, p.Vc, p.Ug, p.Qb, p.RG, p.GSb, 0}; gemm_stream(lds, 2048, 2048, S, E, g_wv); } break;
    case 16: { SchedG1 S{(const char*)p.Hb, (const char*)W.Win, G, c, 0, 1536, false}; EpiMoe2 E{p.Yo}; gemm_stream(lds, 2048, 2048, S, E, g_wv); } break;
    case 17: { SchedG1 S{(const char*)p.Hb, (const char*)W.Win, G, c, 0, 1536, false}; EpiLin E{p.Yo}; gemm_stream(lds, 2048, 2048, S, E, g_wv); } break;
    case 18: { SchedG1 S{(const char*)p.Hb, (const char*)W.Win, G, c, 0, 1536, false}; EpiLinT<8> E{p.Yo}; gemm_stream(lds, 2048, 2048, S, E, g_wv); } break;
    case 19: { SchedG1 S{(const char*)p.Hb, (const char*)W.Win, G, c, 0, 1536, false}; EpiLinT<2> E{p.Yo}; gemm_stream(lds, 2048, 2048, S, E, g_wv); } break;
    case 20: attn_phase<1>(p, l, (LAS char*)lds, g_wv); break;
    case 21: attn_phase<2>(p, l, (LAS char*)lds, g_wv); break;
    case 22: attn_phase<3>(p, l, (LAS char*)lds, g_wv); break;
    case 14: { SchedG1 S{(const char*)p.Hb, (const char*)W.Win, G, c, 0, 1536, false}; EpiNone E; gemm_stream(lds, 2048, 2048, S, E, g_wv); } break;
#endif
  }
}

__global__ void __launch_bounds__(512, 2) mega(Params p) {
  extern __shared__ __attribute__((aligned(16))) unsigned char smem[];
  LAS unsigned char* lds = (LAS unsigned char*)smem;
  LAS unsigned* xbw = (LAS unsigned*)(lds + LDS_BYTES - 16);
  if (threadIdx.x == 0) { xbw[0] = 0u; xbw[1] = 0u; xbw[2] = 0u; xbw[3] = 0u; }
  __syncthreads();
  XcdBarrier bar = xcd_barrier_post(p.bar, (volatile LAS unsigned*)xbw);
  const int ph_lo = p.ph_lo, ph_hi = p.ph_hi; const int g_wv = __builtin_amdgcn_readfirstlane((int)threadIdx.x >> 6);
#if PROBE_MASK
  if (ph_lo >= 1000) { run_phase(*(const __attribute__((address_space(4))) Params*)__builtin_amdgcn_kernarg_segment_ptr(), 1, ph_lo - 1000, lds, g_wv); return; }
#endif
  for (int l = 0; l < DEPTH; ++l) {
#define PHASE(ID) do { const int gph = l * NPH + (ID); if (gph >= ph_lo && gph < ph_hi && !(((ID) == PH_H0 || (ID) == PH_CONV) && l > 0)) { \
      const __attribute__((address_space(4))) Params* kp = (const __attribute__((address_space(4))) Params*)__builtin_amdgcn_kernarg_segment_ptr(); int lv = l; int wvp = g_wv; \
      asm volatile("" : "+s"(kp), "+s"(lv), "+s"(wvp));     \
      run_phase(*kp, lv, (ID), lds, wvp); if (gph + 1 < ph_hi) xcd_barrier(bar); } } while (0)
    PHASE(PH_CONV); PHASE(PH_H0); PHASE(PH_GEMM1); PHASE(PH_S1); PHASE(PH_ATT); PHASE(PH_GLU); PHASE(PH_MERGE);
    PHASE(PH_LN1); PHASE(PH_MOE1); PHASE(PH_LN2);
#undef PHASE
  }
}

struct Host { Params p; size_t ws_used; };
inline size_t al256(size_t x) { return (x + 255) & ~(size_t)255; }
inline Host make_params(void* const* d_in, void* d_out, void* d_ws) {
  Host H; memset(&H, 0, sizeof(H)); Params& p = H.p;
  const float** ip = (const float**)&p.in; for (int i = 0; i < 36; ++i) ip[i] = (const float*)d_in[i];
  p.out = (float*)d_out;
  char* base = (char*)d_ws; size_t off = 0;
  auto take = [&](size_t bytes) { char* r = base + off; off = al256(off + bytes); return r; };
  p.bar = (unsigned*)take(XCD_BAR_WORDS * 4); p.ctl = (unsigned*)take((size_t)DEPTH * CTL_WORDS * 4);
  p.MOD = (float*)take((size_t)DEPTH * 9 * 6144 * 4); p.ROPE = (float*)take((size_t)2048 * 64 * 4);
  p.ROUTE = (int*)take((size_t)NR * 4 * 4); p.RW = (float*)take((size_t)NR * 2 * 4); p.TOK = (int*)take((size_t)NE * NR * 4);
  p.XL = (float*)take((size_t)NR * D * 4); p.X1b = (bf16_t*)take((size_t)NR * D * 2); p.Hb = (bf16_t*)take((size_t)NR * D * 2); p.H2b = (bf16_t*)take((size_t)NR * D * 2); p.Mb = (bf16_t*)take((size_t)NR * D * 2);
  for (int k = 0; k < 4; ++k) { SSet& w = p.s[k]; w.SAL = (float*)take((size_t)NG * 2 * 64 * 2 * 4); w.WR = (float*)take((size_t)2 * 64 * 1024 * 2);
    w.Smat = (bf16_t*)take((size_t)NG * 256 * 768 * 2); w.TO = (bf16_t*)take((size_t)NG * 512 * 768 * 2); }
  for (int k = 0; k < 2; ++k) { WSet& w = p.w[k];
    w.Win = (bf16_t*)take((size_t)INW * 1024 * 2); w.Wglu = (bf16_t*)take((size_t)512 * 512 * 2); w.Wpa = (bf16_t*)take((size_t)1024 * 1024 * 2); w.Wps = (bf16_t*)take((size_t)1024 * 1024 * 2);
    w.Wo = (bf16_t*)take((size_t)1024 * 1024 * 2); w.W13 = (bf16_t*)take((size_t)NE * 1024 * 1024 * 2); w.W2 = (bf16_t*)take((size_t)NE * 1024 * 512 * 2); }
  const size_t mix0 = off;
  p.Kc = (bf16_t*)take((size_t)NB * KVB * D * 2); p.Vc = (bf16_t*)take((size_t)NB * KVB * D * 2); p.Qb = (bf16_t*)take((size_t)NR * D * 2);
  p.Ug = (bf16_t*)take((size_t)NG * NCHP * 768 * 2 + 4096); p.RG = (bf16_t*)take((size_t)NR * D * 2); p.GSb = (bf16_t*)take((size_t)NR * D * 2); p.ATTb = (bf16_t*)take((size_t)NR * D * 2);
  p.SST = (float*)take((size_t)NG * NCHP * 256 * 4); p.YG = (bf16_t*)take((size_t)NR * SSMW * 2); p.S2 = (bf16_t*)take((size_t)NR * D * 2);
  const size_t mix1 = off; off = mix0;
  p.Hm = (bf16_t*)take((size_t)MOE_ROWS * EH * 2); p.Yo = (bf16_t*)take((size_t)MOE_ROWS * D * 2);
  if (off < mix1) off = mix1;
  H.ws_used = off; p.ph_lo = 0; p.ph_hi = DEPTH * NPH; p.pad0 = 0; p.pad1 = 0;
  return H;
}
inline int grid_size() {
  static int grid = 0;
  if (!grid) { hipFuncSetAttribute((const void*)mega, hipFuncAttributeMaxDynamicSharedMemorySize, LDS_BYTES);
    int dev = 0, cus = 0, per_cu = 0; hipGetDevice(&dev); hipDeviceGetAttribute(&cus, hipDeviceAttributeMultiprocessorCount, dev);
    hipOccupancyMaxActiveBlocksPerMultiprocessor(&per_cu, mega, 512, LDS_BYTES);
    grid = (per_cu >= 1 && cus >= 256) ? 256 : 0;
    if (!grid) fprintf(stderr, "mega: cannot be resident (cus %d per_cu %d)\n", cus, per_cu); }
  return grid;
}
inline void launch_range(Host& H, int lo, int hi, hipStream_t st) {
  const int grid = grid_size(); if (!grid) return;
  H.p.ph_lo = lo; H.p.ph_hi = hi;
  hipLaunchKernelGGL(mega, dim3(grid), dim3(512), LDS_BYTES, st, H.p);
}
}
#ifndef PROBE_K
#define PROBE_K 8
#endif
extern "C" void kernel_launch(void* const* d_in, const int* in_sizes, int n_in, void* d_out, int out_size, void* d_ws, size_t ws_size, hipStream_t stream) {
  fk::Host H = fk::make_params(d_in, d_out, d_ws);
  if (H.ws_used > ws_size) { fprintf(stderr, "ws too small: need %zu have %zu\n", H.ws_used, ws_size); return; }
  hipMemsetAsync(H.p.bar, 0, (size_t)((char*)H.p.MOD - (char*)H.p.bar), stream);
  fk::launch_range(H, 0, fk::DEPTH * fk::NPH, stream);
#if PROBE_MASK
  for (int id = 0; id < 24; ++id) if ((PROBE_MASK >> id) & 1) { const int g = id >= fk::NPH ? 1000 + id : fk::NPH + id;
    for (int k = 0; k < PROBE_K; ++k) { hipMemsetAsync(H.p.bar, 0, XCD_BAR_WORDS * 4, stream); fk::launch_range(H, g, g + 1, stream); } }
#endif
#ifdef PROBE_G0
#ifdef PROBE_PF
  H.p.pad0 = PROBE_PF;
#endif
  for (int k = 0; k < PROBE_K; ++k) { hipMemsetAsync(H.p.bar, 0, XCD_BAR_WORDS * 4, stream); fk::launch_range(H, PROBE_G0, PROBE_G0 + 1, stream); }
#endif
}
```

```cpp
#include <hip/hip_runtime.h>
#include <cstdio>
#include <cstdint>
#include <cstring>
#include <cmath>
namespace fk {
#define LAS __attribute__((address_space(3)))
typedef unsigned short bf16_t;
typedef short bf16x8 __attribute__((ext_vector_type(8)));
typedef short s16x4 __attribute__((ext_vector_type(4)));
typedef float f32x4 __attribute__((ext_vector_type(4)));
typedef float f32x2 __attribute__((ext_vector_type(2)));
typedef float f32x16 __attribute__((ext_vector_type(16)));
typedef unsigned u32x4 __attribute__((ext_vector_type(4)));
typedef unsigned u32x2 __attribute__((ext_vector_type(2)));

constexpr int D = 1024, SEQ = 2048, CTX = 256, NB = 8, NLAT = NB * SEQ, NCTX = NB * CTX, NR = NLAT + NCTX, KVB = SEQ + CTX;
constexpr int INW = 5632, NHEAD = 8, SSMW = 512, NG = 32, NP = 64, NE = 32, EH = 512, DEPTH = 4;
constexpr int CHUNK = 32, NCHR = NR / CHUNK  , NCHP = 768  ;
constexpr int MOE_ROWS = 2 * NR + NE * 256;
constexpr float ALPHA = 1.681792830507429f;

__device__ __forceinline__ unsigned cvt_pk_bf16(float lo, float hi) { unsigned r; asm volatile("v_cvt_pk_bf16_f32 %0, %1, %2" : "=v"(r) : "v"(lo), "v"(hi)); return r; }
__device__ __forceinline__ float bf2f(unsigned short b) { return __uint_as_float(((unsigned)b) << 16); }
__device__ __forceinline__ float bflo(unsigned w) { return __uint_as_float(w << 16); }
__device__ __forceinline__ float bfhi(unsigned w) { return __uint_as_float(w & 0xffff0000u); }
typedef _Float16 h16x2 __attribute__((ext_vector_type(2)));
__device__ __forceinline__ unsigned pk_h16(float lo, float hi) { h16x2 h; h[0] = (_Float16)lo; h[1] = (_Float16)hi; return __builtin_bit_cast(unsigned, h); }
__device__ __forceinline__ float h16lo(unsigned w) { return (float)__builtin_bit_cast(h16x2, w)[0]; }
__device__ __forceinline__ float h16hi(unsigned w) { return (float)__builtin_bit_cast(h16x2, w)[1]; }
__device__ __forceinline__ u32x4 pack8(const f32x4& a, const f32x4& b) { u32x4 w; w.x = cvt_pk_bf16(a[0], a[1]); w.y = cvt_pk_bf16(a[2], a[3]); w.z = cvt_pk_bf16(b[0], b[1]); w.w = cvt_pk_bf16(b[2], b[3]); return w; }
__device__ __forceinline__ void unpack8(const u32x4& w, f32x4& a, f32x4& b) { a = (f32x4){bflo(w.x), bfhi(w.x), bflo(w.y), bfhi(w.y)}; b = (f32x4){bflo(w.z), bfhi(w.z), bflo(w.w), bfhi(w.w)}; }
__device__ __forceinline__ float fast_sigmoid(float x) { return __builtin_amdgcn_rcpf(1.f + __builtin_amdgcn_exp2f(-1.4426950408889634f * x)); }
__device__ __forceinline__ float fast_silu(float x) { return x * fast_sigmoid(x); }
__device__ __forceinline__ float gelu_tanh_f(float x) { const float z = 0.7978845608028654f * (x + 0.044715f * x * x * x); return x * fast_sigmoid(2.f * z); }
__device__ __forceinline__ int otid_w(int wv) { int t; asm volatile("v_mbcnt_lo_u32_b32 %0, -1, 0\n\tv_mbcnt_hi_u32_b32 %0, -1, %0\n\tv_lshl_add_u32 %0, %1, 6, %0" : "=&v"(t) : "s"(wv)); return t; }
__device__ __forceinline__ float ozero() { float z = 0.f; asm volatile("" : "+v"(z)); return z; }
__device__ __forceinline__ void stagger_wait(int ticks) { if (ticks > 0) { const unsigned long long t0 = __builtin_amdgcn_s_memrealtime(); while ((long long)(__builtin_amdgcn_s_memrealtime() - t0) < (long long)ticks) __builtin_amdgcn_s_sleep(8); } }
__device__ __forceinline__ int obid() { int b = blockIdx.x; asm volatile("" : "+s"(b)); return b; }
__device__ __forceinline__ int ogd() { int g = gridDim.x; asm volatile("" : "+s"(g)); return g; }
#define otid() otid_w(g_wv)
template <int CTRL, int RM> __device__ __forceinline__ float dpp_f(float v) { return __builtin_bit_cast(float, __builtin_amdgcn_update_dpp(0, __builtin_bit_cast(int, v), CTRL, RM, 0xF, false)); }
__device__ __forceinline__ float wave_sum_u(float v) {
  v += dpp_f<0xB1, 0xF>(v); v += dpp_f<0x4E, 0xF>(v); v += dpp_f<0x141, 0xF>(v); v += dpp_f<0x140, 0xF>(v); v += dpp_f<0x142, 0xA>(v); v += dpp_f<0x143, 0xC>(v);
  return __builtin_bit_cast(float, __builtin_amdgcn_readlane(__builtin_bit_cast(int, v), 63)); }
__host__ __device__ __forceinline__ int perm32(int rho) { const int n = rho >> 4, i = rho & 15; return 8 * (i >> 2) + 4 * n + (i & 3); }

#define XB_TMO      128
#define XB_XCNT(j)  (256  + 64 * (j))
#define XB_XSUB(j)  (1280 + 64 * (j))
#define XB_XGEN(j)  (2304 + 64 * (j))
#define XB_TOP      3328
#define XB_TOPGEN   3392
#define XCD_BAR_WORDS 3456
#define XB_SPIN_CAP (1u << 22)
__device__ __forceinline__ unsigned xb_ld(unsigned* p)              { return __hip_atomic_load(p, __ATOMIC_RELAXED, __HIP_MEMORY_SCOPE_AGENT); }
__device__ __forceinline__ unsigned xb_add(unsigned* p, unsigned v) { return __hip_atomic_fetch_add(p, v, __ATOMIC_RELAXED, __HIP_MEMORY_SCOPE_AGENT); }
__device__ __forceinline__ unsigned xb_xcc_id() { return (unsigned)__builtin_amdgcn_s_getreg((3 << 11) | 20) & 0xFu; }
#define XB_SPIN(cond, bar) do { unsigned _sp = 0; while (cond) { __builtin_amdgcn_s_sleep(1); \
    if ((++_sp & 255u) == 0u) { if (xb_ld(&(bar)[XB_TMO])) break; if (_sp > XB_SPIN_CAP) { atomicAdd(&(bar)[XB_TMO], 1u); break; } } } } while (0)
struct XcdBarrier { unsigned* bar; unsigned x; volatile LAS unsigned* st; };
__device__ __forceinline__ XcdBarrier xcd_barrier_post(unsigned* bar, volatile LAS unsigned* st) {
    XcdBarrier b; b.bar = bar; b.x = xb_xcc_id(); b.st = st;
    if (threadIdx.x == 0) (void)xb_add(&bar[XB_XCNT(b.x)], 1u);
    return b;
}
__device__ __forceinline__ void xcd_barrier_complete(unsigned* bar, unsigned x, unsigned& nloc, unsigned& nx) {
    const unsigned G = gridDim.x * gridDim.y * gridDim.z;
    unsigned sum, cnt, mine, sp = 0u;
    for (;;) {
        sum = 0u; cnt = 0u; mine = 0u;
#pragma unroll
        for (unsigned j = 0; j < 16; ++j) { const unsigned c = xb_ld(&bar[XB_XCNT(j)]); sum += c; cnt += (c > 0u) ? 1u : 0u; mine = (j == x) ? c : mine; }
        if (sum == G) break;
        __builtin_amdgcn_s_sleep(1);
        if ((++sp & 255u) == 0u) { if (xb_ld(&bar[XB_TMO])) break; if (sp > XB_SPIN_CAP) { atomicAdd(&bar[XB_TMO], 1u); break; } }
    }
    nloc = mine > 0u ? mine : 1u; nx = cnt > 0u ? cnt : 1u;
}
__device__ __forceinline__ void xcd_barrier(const XcdBarrier& b) {
    asm volatile("s_waitcnt vmcnt(0)" ::: "memory");
    __syncthreads();
    if (threadIdx.x == 0) {
        unsigned* bar = b.bar;
        __builtin_amdgcn_s_waitcnt(0);
        unsigned nloc = b.st[0], nx = b.st[1];
        if (nloc == 0u) { xcd_barrier_complete(bar, b.x, nloc, nx); b.st[0] = nloc; b.st[1] = nx; }
        const unsigned old = xb_add(&bar[XB_XSUB(b.x)], 1u);
        const unsigned gen = old / nloc;
        if (old + 1u == (gen + 1u) * nloc) {
            __builtin_amdgcn_fence(__ATOMIC_RELEASE, "agent");
            asm volatile("s_waitcnt vmcnt(0)" ::: "memory");
            const unsigned og = xb_add(&bar[XB_TOP], 1u);
            const unsigned tg = og / nx;
            if (og + 1u == (tg + 1u) * nx) xb_add(&bar[XB_TOPGEN], 1u);
            else XB_SPIN(xb_ld(&bar[XB_TOPGEN]) == tg, bar);
            __builtin_amdgcn_fence(__ATOMIC_ACQUIRE, "agent");
            asm volatile("s_waitcnt vmcnt(0)" ::: "memory");
        } else {
            XB_SPIN(xb_ld(&bar[XB_TOPGEN]) == gen, bar);
            __builtin_amdgcn_fence(__ATOMIC_ACQUIRE, "agent");
            asm volatile("s_waitcnt vmcnt(0)" ::: "memory");
        }
    }
    __syncthreads();
}

__device__ __forceinline__ void tile_signal(unsigned* cnt) {
    asm volatile("s_waitcnt vmcnt(0)" ::: "memory");
    __syncthreads();
    if (threadIdx.x == 0) { __builtin_amdgcn_fence(__ATOMIC_RELEASE, "agent"); asm volatile("s_waitcnt vmcnt(0)" ::: "memory"); (void)xb_add(cnt, 1u); }
}
__device__ __forceinline__ void tile_wait(unsigned* cnt, unsigned target, unsigned* bar) {
#ifdef NO_ACQ
    if (threadIdx.x == 0) { XB_SPIN(xb_ld(cnt) < target, bar); asm volatile("s_waitcnt vmcnt(0)" ::: "memory"); }
#else
    if (threadIdx.x == 0) { XB_SPIN(xb_ld(cnt) < target, bar); __builtin_amdgcn_fence(__ATOMIC_ACQUIRE, "agent"); asm volatile("s_waitcnt vmcnt(0)" ::: "memory"); }
#endif
    __syncthreads();
}

__device__ __forceinline__ void split_arrive(unsigned* bar, volatile LAS unsigned* st, unsigned* xc, unsigned* done) {
    asm volatile("s_waitcnt vmcnt(0)" ::: "memory");
    __syncthreads();
    if (threadIdx.x == 0) {
        const unsigned x = xb_xcc_id(); unsigned nloc = st[0], nx = st[1];
        if (nloc == 0u) { xcd_barrier_complete(bar, x, nloc, nx); st[0] = nloc; st[1] = nx; }
        const unsigned old = xb_add(&xc[x * 16], 1u);
        if (old + 1u == nloc) { __builtin_amdgcn_fence(__ATOMIC_RELEASE, "agent"); asm volatile("s_waitcnt vmcnt(0)" ::: "memory"); (void)xb_add(done, 1u); }
    }
}
__device__ __forceinline__ void split_wait(unsigned* bar, volatile LAS unsigned* st, unsigned* done) {
    if (threadIdx.x == 0) { const unsigned nx = st[1]; XB_SPIN(xb_ld(done) < nx, bar); __builtin_amdgcn_fence(__ATOMIC_ACQUIRE, "agent"); asm volatile("s_waitcnt vmcnt(0)" ::: "memory"); }
    __syncthreads();
}

constexpr int BM = 256, BK = 64, HALF = 128, HTB = HALF * BK * 2, STAGE_BYTES = 8 * HTB;
__host__ __device__ __forceinline__ int lds_byte(int r, int c) { const int st = (r >> 4) * 2 + (c >> 5), rr = r & 15, cc = c & 31, ob = rr * 64 + cc * 2; return st * 1024 + (ob ^ (((ob >> 9) & 1) << 5)); }
__host__ __device__ __forceinline__ void stage_rc(int b, int& R, int& C) { const int st = b / 1024, sb = b % 1024, swz = sb ^ (((sb >> 9) & 1) << 5); R = (st >> 1) * 16 + swz / 64; C = (st & 1) * 32 + (swz % 64) / 2; }
struct Seg { const char* A; const char* B; int nt; int epi; int pm; int pn; int aux; int aux2; };
__device__ __forceinline__ void tile_order(int L, int nM, int nN, int& pm, int& pn) {
    const int nwg = nM * nN; int wgid = L; { const int q = nwg / 8, r = nwg % 8, xcd = wgid % 8, off = wgid / 8; wgid = (xcd < r ? xcd * (q + 1) : r * (q + 1) + (xcd - r) * q) + off; }
    const int nig = 8 * nN, gid = wgid / nig, fm = gid * 8, gsz = (nM - fm) < 8 ? (nM - fm) : 8;
    pm = fm + ((wgid % nig) % gsz); pn = (wgid % nig) / gsz;
}
#ifndef GEMM_8PH
#define GEMM_8PH 0
#endif
template <class Epi, class Sched, bool GATHER = false, int AMODE = 0>
__device__ __forceinline__ void gemm_stream(LAS unsigned char* lds, const int lda, const int ldb, const Sched& S, const Epi& E, const int g_wv) {
    const int tid = otid(), wid = __builtin_amdgcn_readfirstlane(tid >> 6), lane = tid & 63, wr = wid >> 2, wc = wid & 3, fr = lane & 15, fq = lane >> 4;
    unsigned voffA[2], voffB[2];
#pragma unroll
    for (int i = 0; i < 2; ++i) { int R, C; stage_rc(tid * 16 + i * 8192, R, C); voffA[i] = AMODE == 1 ? (unsigned)((C >> 4) * lda + R * 32 + (C & 15) * 2) : (unsigned)(R * lda + C * 2); voffB[i] = (unsigned)(R * ldb + C * 2); }
    LAS unsigned* gst = (LAS unsigned*)(lds + STAGE_BYTES + 8192) + tid * 4;
    unsigned gCb = 0; if constexpr (GATHER) { int R_, C_; stage_rc(tid * 16, R_, C_); gCb = (unsigned)(C_ * 2); }
#define PG8_GV(slot, seg) do { int _R, _C; stage_rc(otid() * 16, _R, _C); _Pragma("unroll") for (int _h = 0; _h < 2; ++_h) gst[(slot) * 2 + _h] = S.grow(seg, _h * HALF + _R) | (S.grow(seg, _h * HALF + _R + 64) << 16); } while (0)
    const size_t kstep = (size_t)(BK * 2), kstepA = AMODE == 1 ? (size_t)4 * lda : kstep;
    const size_t hstepA = AMODE == 1 ? (size_t)HALF * 32 : (size_t)HALF * lda, hstepB = (size_t)HALF * ldb;
    const unsigned ldsw = (unsigned)wid * 1024u;
    const int aoff = lds_byte(wr * 64 + fr, fq * 8), boff = lds_byte(wc * 32 + fr, fq * 8);
#define PG8_SA(b, h) (((b) * 2 + (h)) * HTB)
#define PG8_SB(b, h) ((4 + (b) * 2 + (h)) * HTB)
#define PG8_STAGE(bufoff, gbase, voff) do { _Pragma("unroll") for (int _i = 0; _i < 2; ++_i) \
        __builtin_amdgcn_global_load_lds((const unsigned*)((const char*)(gbase) + (voff)[_i]), (LAS unsigned*)(lds + (bufoff) + ldsw + _i * 8192), 16, 0, 0); } while (0)
#define PG8_LDA(dst, b, h) do { _Pragma("unroll") for (int m = 0; m < 4; ++m) _Pragma("unroll") for (int k = 0; k < 2; ++k) dst[m][k] = *(const LAS bf16x8*)(lds + PG8_SA(b, h) + aoff + m * 2048 + k * 1024); } while (0)
#define PG8_LDB(dst, b, h) do { _Pragma("unroll") for (int n = 0; n < 2; ++n) _Pragma("unroll") for (int k = 0; k < 2; ++k) dst[n][k] = *(const LAS bf16x8*)(lds + PG8_SB(b, h) + boff + n * 2048 + k * 1024); } while (0)
#define PG8_MMA(ai, bj, At, Bt) do { __builtin_amdgcn_s_setprio(1); _Pragma("unroll") for (int m = 0; m < 4; ++m) _Pragma("unroll") for (int n = 0; n < 2; ++n) _Pragma("unroll") for (int k = 0; k < 2; ++k) \
        acc[ai][bj][m][n] = __builtin_amdgcn_mfma_f32_16x16x32_bf16(Bt[n][k], At[m][k], acc[ai][bj][m][n], 0, 0, 0); __builtin_amdgcn_s_setprio(0); } while (0)
#define PG8_WAIT_V(n) asm volatile("s_waitcnt vmcnt(" #n ")" ::: "memory")
#define PG8_WAIT_L(n) asm volatile("s_waitcnt lgkmcnt(" #n ")" ::: "memory")
#define PG8_BAR __builtin_amdgcn_s_barrier()
#define PG8_SCHED __builtin_amdgcn_sched_barrier(0)
    Seg cur, nxt; int ui = 0;
    if (!S.next(0, cur)) return;
    f32x4 acc[2][2][4][2];
#pragma unroll
    for (int a = 0; a < 2; ++a)
#pragma unroll
        for (int b = 0; b < 2; ++b)
#pragma unroll
            for (int m = 0; m < 4; ++m)
#pragma unroll
                for (int n = 0; n < 2; ++n) acc[a][b][m][n] = (f32x4){0.f, 0.f, 0.f, 0.f};
    bf16x8 At[4][2], B0[2][2], B1[2][2];
    const char* cA = cur.A; const char* cB = cur.B;
    if constexpr (GATHER) { PG8_GV(0, cur); gst[2] = gst[0]; gst[3] = gst[1]; }
#define PG8_STAGE_A(bufoff, kbase, h, usenext) do { if constexpr (GATHER) { const unsigned _p = gst[((usenext) ? 2 : 0) + (h)]; unsigned _v[2] = {(_p & 0xffffu) * (unsigned)lda + gCb, (_p >> 16) * (unsigned)lda + gCb}; PG8_STAGE(bufoff, kbase, _v); } \
        else { PG8_STAGE(bufoff, (kbase) + (h) * hstepA, voffA); } } while (0)
#if GEMM_8PH
    PG8_STAGE(PG8_SB(0, 0), cB, voffB); PG8_STAGE_A(PG8_SA(0, 0), cA, 0, false); PG8_STAGE(PG8_SB(0, 1), cB + hstepB, voffB); PG8_STAGE_A(PG8_SA(0, 1), cA, 1, false);
    if (wr == 1) PG8_BAR;
    PG8_WAIT_V(4); PG8_BAR;
    PG8_STAGE(PG8_SB(1, 0), cB + kstep, voffB); PG8_STAGE_A(PG8_SA(1, 0), cA + kstepA, 0, false); PG8_STAGE(PG8_SB(1, 1), cB + hstepB + kstep, voffB);
    PG8_WAIT_V(6); PG8_BAR;
#else
    PG8_STAGE(PG8_SB(0, 0), cB, voffB); PG8_STAGE(PG8_SB(0, 1), cB + hstepB, voffB); PG8_STAGE_A(PG8_SA(0, 0), cA, 0, false); PG8_STAGE_A(PG8_SA(0, 1), cA, 1, false);
    if (wr == 1) PG8_BAR;
    PG8_WAIT_V(2); PG8_BAR;
    PG8_STAGE(PG8_SB(1, 0), cB + kstep, voffB); PG8_STAGE_A(PG8_SA(1, 0), cA + kstepA, 0, false); PG8_STAGE(PG8_SB(1, 1), cB + hstepB + kstep, voffB);
    PG8_WAIT_V(6); PG8_BAR;
#endif
    for (;;) {
        const bool has_next = S.next(ui + 1, nxt);
        const char* nA = has_next ? nxt.A : cA; const char* nB = has_next ? nxt.B : cB;
        const int nt = cur.nt;
        for (int t = 0; t < nt; t += 2) {
            const bool last = (t == nt - 2);
            if constexpr (GATHER) { if (last) { if (has_next) { PG8_GV(1, nxt); } else { gst[2] = gst[0]; gst[3] = gst[1]; } } }
            const char* a1 = cA + (size_t)(t + 1) * kstepA;
            const char* a2 = last ? nA : cA + (size_t)(t + 2) * kstepA; const char* b2 = last ? nB : cB + (size_t)(t + 2) * kstep;
            const char* a3 = a2 + kstepA; const char* b3 = b2 + kstep;
#if GEMM_8PH
            PG8_LDB(B0, 0, 0); PG8_SCHED; PG8_LDA(At, 0, 0); PG8_STAGE_A(PG8_SA(1, 1), a1, 1, false);
            PG8_WAIT_L(8); PG8_BAR; PG8_WAIT_L(0); PG8_MMA(0, 0, At, B0); PG8_BAR; PG8_SCHED;
            PG8_LDB(B1, 0, 1); PG8_STAGE(PG8_SB(0, 0), b2, voffB);
            PG8_BAR; PG8_WAIT_L(0); PG8_MMA(0, 1, At, B1); PG8_BAR;
            PG8_LDA(At, 0, 1); PG8_STAGE_A(PG8_SA(0, 0), a2, 0, last);
            PG8_BAR; PG8_WAIT_L(0); PG8_MMA(1, 0, At, B0); PG8_BAR; PG8_SCHED;
            PG8_STAGE(PG8_SB(0, 1), b2 + hstepB, voffB);
            PG8_WAIT_V(6); PG8_BAR; PG8_MMA(1, 1, At, B1); PG8_BAR;
            PG8_LDB(B0, 1, 0); PG8_SCHED; PG8_LDA(At, 1, 0); PG8_STAGE_A(PG8_SA(0, 1), a2, 1, last);
            PG8_WAIT_L(8); PG8_BAR; PG8_WAIT_L(0); PG8_MMA(0, 0, At, B0); PG8_BAR; PG8_SCHED;
            PG8_LDB(B1, 1, 1); PG8_STAGE(PG8_SB(1, 0), b3, voffB);
            PG8_BAR; PG8_WAIT_L(0); PG8_MMA(0, 1, At, B1); PG8_BAR;
            PG8_LDA(At, 1, 1); PG8_STAGE_A(PG8_SA(1, 0), a3, 0, last);
            PG8_BAR; PG8_WAIT_L(0); PG8_MMA(1, 0, At, B0); PG8_BAR; PG8_SCHED;
            PG8_STAGE(PG8_SB(1, 1), b3 + hstepB, voffB);
            PG8_WAIT_V(6); PG8_BAR; PG8_MMA(1, 1, At, B1); PG8_BAR;
#else
            PG8_LDB(B0, 0, 0); PG8_LDB(B1, 0, 1); PG8_SCHED; PG8_LDA(At, 0, 0); PG8_STAGE_A(PG8_SA(1, 1), a1, 1, false);
            PG8_WAIT_V(8); PG8_WAIT_L(0); PG8_BAR; PG8_MMA(0, 0, At, B0); PG8_MMA(0, 1, At, B1); PG8_BAR; PG8_SCHED;
            PG8_LDA(At, 0, 1); PG8_STAGE(PG8_SB(0, 0), b2, voffB); PG8_STAGE(PG8_SB(0, 1), b2 + hstepB, voffB); PG8_STAGE_A(PG8_SA(0, 0), a2, 0, last);
            PG8_WAIT_V(8); PG8_WAIT_L(0); PG8_BAR; PG8_MMA(1, 0, At, B0); PG8_MMA(1, 1, At, B1); PG8_BAR; PG8_SCHED;
            PG8_LDB(B0, 1, 0); PG8_LDB(B1, 1, 1); PG8_SCHED; PG8_LDA(At, 1, 0); PG8_STAGE_A(PG8_SA(0, 1), a2, 1, last);
            PG8_WAIT_V(8); PG8_WAIT_L(0); PG8_BAR; PG8_MMA(0, 0, At, B0); PG8_MMA(0, 1, At, B1); PG8_BAR; PG8_SCHED;
            PG8_LDA(At, 1, 1); PG8_STAGE(PG8_SB(1, 0), b3, voffB); PG8_STAGE(PG8_SB(1, 1), b3 + hstepB, voffB); PG8_STAGE_A(PG8_SA(1, 0), a3, 0, last);
            PG8_WAIT_V(8); PG8_WAIT_L(0); PG8_BAR; PG8_MMA(1, 0, At, B0); PG8_MMA(1, 1, At, B1); PG8_BAR; PG8_SCHED;
#endif
        }
        if (cur.epi) {
            if (wr == 0) PG8_BAR;
            const int el = otid() & 63; const int efr = el & 15, efq = el >> 4;
            const bool z = E(acc, cur, wr, wc, efr, efq);
            if (z) {
#pragma unroll
                for (int a = 0; a < 2; ++a)
#pragma unroll
                    for (int b = 0; b < 2; ++b)
#pragma unroll
                        for (int m = 0; m < 4; ++m)
#pragma unroll
                            for (int n = 0; n < 2; ++n) acc[a][b][m][n] = (f32x4){0.f, 0.f, 0.f, 0.f};
            }
            if (!has_next) break;
            if (wr == 1) PG8_BAR;
        } else if (!has_next) { if (wr == 0) PG8_BAR; break; }
        cur = nxt; cA = nA; cB = nB; ++ui;
        if constexpr (GATHER) { gst[0] = gst[2]; gst[1] = gst[3]; }
    }
    PG8_WAIT_V(0);
    PG8_BAR;
#undef PG8_SA
#undef PG8_SB
#undef PG8_STAGE
#undef PG8_STAGE_A
#undef PG8_GV
#undef PG8_LDA
#undef PG8_LDB
#undef PG8_MMA
#undef PG8_WAIT_V
#undef PG8_WAIT_L
#undef PG8_BAR
#undef PG8_SCHED
}
}
namespace fk {
struct In { const float *x, *c, *ctx, *c_ctx, *w_mod, *b_mod, *w_in, *lam_q1, *lam_k1, *lam_q2, *lam_k2, *subln_g, *a_re, *a_im, *log_dt, *b_re, *b_im, *c_re, *c_im, *ssm_d,
  *w_glu, *b_glu, *w_pa, *w_ps, *w_o, *ln1_g, *ln1_b, *rg_w, *rg_b, *re_w, *re_b, *w1, *w3, *w2, *ln2_g, *ln2_b; };
struct WSet { bf16_t *Win, *Wglu, *Wpa, *Wps, *Wo, *W13, *W2; };
struct SSet { bf16_t *Smat, *TO; float *SAL, *WR; };
struct Params {
  In in; float* out;
  unsigned* bar;
  unsigned* ctl;
  float* MOD;
  float* ROPE;
  float* XL;
  bf16_t* X1b;
  bf16_t* Hb;
  bf16_t* Kc; bf16_t* Vc;
  bf16_t* Qb;
  bf16_t* Ug;
  bf16_t* RG; bf16_t* GSb;
  bf16_t* ATTb;
  float* SST;
  bf16_t* YG;
  bf16_t* S2;
  bf16_t* Mb;
  bf16_t* H2b;
  int* ROUTE;
  float* RW;
  int* TOK;
  bf16_t* Hm;
  bf16_t* Yo;
  SSet s[4];
  WSet w[2];
  int ph_lo, ph_hi;
  int pad0, pad1;
};
typedef const __attribute__((address_space(4))) Params& KP; typedef const __attribute__((address_space(4))) WSet& KW; typedef const __attribute__((address_space(4))) SSet& KS;
constexpr int CTL_CNT = 0;
constexpr int CTL_TILE = 64 * 32 + 64;
constexpr int CTL_XC = CTL_TILE + 72 * 16;
constexpr int CTL_DONE = CTL_XC + 16 * 16;
constexpr int CTL_WORDS = CTL_XC + 4 * 272;

__device__ __forceinline__ int modrow_of_tile(int pm) { return pm < 64 ? (pm >> 3) : 8; }
__device__ __forceinline__ int kvrow0_of_tile(int pm) { return pm < 64 ? (pm >> 3) * KVB + CTX + (pm & 7) * 256 : (pm - 64) * KVB; }

struct SchedPlain {
  const char* A; const char* B; int lda, ldb, nM, nN, nt, G, c, nunits; int epi; int atile;
  __device__ __forceinline__ bool next(int i, Seg& s) const {
    const int L = i * G + c; if (L >= nunits) return false;
    int pm, pn; tile_order(L, nM, nN, pm, pn);
    s.A = A + (size_t)pm * atile; s.B = B + (size_t)pn * 256 * ldb; s.nt = nt; s.epi = epi; s.pm = pm; s.pn = pn; s.aux = 0; s.aux2 = 0; return true; }
};
struct SchedMerge {
  const char* A1; const char* B1; const char* A2; const char* B2; int nM, nN, G, c, nunits;
  __device__ __forceinline__ bool next(int i, Seg& s) const {
    const int L = (i >> 1) * G + c; if (L >= nunits) return false;
    int pm, pn; tile_order(L, nM, nN, pm, pn); s.pm = pm; s.pn = pn; s.aux = 0; s.aux2 = 0;
    if ((i & 1) == 0) { s.A = A1 + (size_t)pm * 256 * 2048; s.B = B1 + (size_t)pn * 256 * 2048; s.nt = 16; s.epi = 2; }
    else { s.A = A2 + (size_t)pm * 256 * 2048; s.B = B2 + (size_t)pn * 256 * 2048; s.nt = 8; s.epi = 1; }
    return true; }
};
struct SchedMergeOne {
  const char* A1; const char* B1; const char* A2; const char* B2; int pm, pn;
  __device__ __forceinline__ bool next(int i, Seg& s) const {
    if (i >= 2) return false; s.pm = pm; s.pn = pn; s.aux = 0; s.aux2 = 0;
    if (i == 0) { s.A = A1 + (size_t)pm * 256 * 2048; s.B = B1 + (size_t)pn * 256 * 2048; s.nt = 16; s.epi = 2; }
    else { s.A = A2 + (size_t)pm * 256 * 2048; s.B = B2 + (size_t)pn * 256 * 2048; s.nt = 8; s.epi = 1; }
    return true; }
};
struct SchedPlainOne {
  const char* A; const char* B; int nt, pm, pn;
  __device__ __forceinline__ bool next(int i, Seg& s) const {
    if (i >= 1) return false; s.A = A + (size_t)pm * 256 * 2048; s.B = B + (size_t)pn * 256 * 2048; s.nt = nt; s.epi = 1; s.pm = pm; s.pn = pn; s.aux = 0; s.aux2 = 0; return true; }
};
struct SchedSsm1 {
  const char* Ug; const char* Smat; int G, c;
  __device__ __forceinline__ bool next(int i, Seg& s) const {
    const int L = i * G + c; if (L >= NG * 3) return false;
    const int g = L / 3, pm = L % 3;
    s.A = Ug + (size_t)g * NCHP * 1536 + (size_t)pm * 256 * 1536; s.B = Smat + (size_t)g * 256 * 1536; s.nt = 8; s.epi = 1; s.pm = pm; s.pn = 0; s.aux = g; s.aux2 = 0; return true; }
};
struct SchedSsm3 {
  const char* Ug; const char* TO; int G, c;
  __device__ __forceinline__ bool next(int i, Seg& s) const {
    const int L = i * G + c; if (L >= NG * 6) return false;
    const int g = L / 6, r = L % 6, pm = r >> 1, pn = r & 1; s.pm = pm; s.pn = pn; s.aux = g; s.aux2 = 0;
    s.A = Ug + (size_t)g * NCHP * 1536 + (size_t)pm * 256 * 1536; s.B = TO + (size_t)g * 512 * 1536 + (size_t)pn * 256 * 1536; s.nt = 12; s.epi = 1; return true; }
};
struct MoeTab { int ntiles; int tileE[176]; int tileR0[176]; int cnt[32]; int tbase[33]; };
struct SchedMoe {
  const char* A; const char* B; int lda, ldb; size_t estride; const LAS MoeTab* tab; const int* TOK; int nN, nt, G, c; bool gather; int i0, i1;
  __device__ __forceinline__ bool next(int i, Seg& s) const {
    if (i0 + i >= i1) return false;
    const int L = (i0 + i) * G + c; if (L >= __builtin_amdgcn_readfirstlane(tab->ntiles) * nN) return false;
    const int t = L / nN, pn = L % nN; const int e = __builtin_amdgcn_readfirstlane(tab->tileE[t]);
    s.A = gather ? A : A + (size_t)t * 256 * lda; s.B = B + (size_t)e * estride + (size_t)pn * 256 * ldb; s.nt = nt; s.epi = 1; s.pm = t; s.pn = pn; s.aux = e; s.aux2 = __builtin_amdgcn_readfirstlane(tab->tileR0[t]); return true; }
  __device__ __forceinline__ unsigned grow(const Seg& s, int R) const { const int r = s.aux2 + R; return (unsigned)(r < tab->cnt[s.aux] ? TOK[(size_t)s.aux * NR + r] : 0); }
};
struct SchedG1 {
  const char* A; const char* B; int G, c, u0, u1; bool last;
  __device__ __forceinline__ bool next(int i, Seg& s) const {
    const int L = u0 + i * G + c; if (L >= u1) return false; int pm, pn;
    if (!last) { if (L < 144) { pm = L >> 1; pn = 8 + (L & 1); } else { int q; tile_order(L - 144, NR / 256, 20, pm, q); pn = q < 8 ? q : q + 2; } }
    else { if (L < 1408) tile_order(L, NLAT / 256, 22, pm, pn); else { const int L2 = L - 1408; pm = 64 + L2 / 10; pn = L2 % 10; } }
    s.A = A + (size_t)pm * 256 * 2048; s.B = B + (size_t)pn * 256 * 2048; s.nt = 16; s.epi = 1; s.pm = pm; s.pn = pn; s.aux = 0; s.aux2 = 0; return true; }
};
#define EPI_LOOP_AM for (int ai = 0; ai < 2; ++ai) _Pragma("unroll") for (int m = 0; m < 4; ++m)
struct EpiIn {
  const float* ROPE; bf16_t* Kc; bf16_t* Vc; bf16_t* Ug; bf16_t* Qb; bf16_t* RG; bf16_t* GSb; int rowmask;
  __device__ __forceinline__ bool operator()(f32x4 (&acc)[2][2][4][2], const Seg& s, int wr, int wc, int fr, int fq) const {
    const int pm = s.pm, pn = s.pn; const int rin0 = (wr * 64 + fr) & rowmask;
    if (pn < 4 || (pn >= 10 && pn < 14)) {
      const bool isq = pn >= 10; const int pt = isq ? pn - 10 : pn; const int axis = wc & 1;
      bf16_t* dst = isq ? Qb : Kc; const int drow0 = isq ? pm * 256 : kvrow0_of_tile(pm); const bool lat = pm < 64;
#pragma unroll
      EPI_LOOP_AM { const int rin = ((ai * 128 + m * 16) & rowmask) + rin0; const int t = (pm * 256 + rin) & (SEQ - 1); const float* rp = ROPE + ((size_t)t * 2 + axis) * 32 + fq * 4;
        f32x4 cs, sn; if (lat) { cs = *(const f32x4*)rp; sn = *(const f32x4*)(rp + 16); }
#pragma unroll
        for (int bj = 0; bj < 2; ++bj) { f32x4 o1 = acc[ai][bj][m][0], o2 = acc[ai][bj][m][1]; if (lat) { const f32x4 t1 = o1, t2 = o2; o1 = t1 * cs - t2 * sn; o2 = t1 * sn + t2 * cs; }
          if (isq) { o1 *= 0.18033688011112042f; o2 *= 0.18033688011112042f; }
          *(u32x4*)(dst + (size_t)(drow0 + rin) * 1024 + (2 * pt + bj) * 128 + wc * 32 + fq * 8) = pack8(o1, o2); } }
    } else if (pn < 8) {
      const int drow0 = kvrow0_of_tile(pm);
#pragma unroll
      EPI_LOOP_AM { const int rin = ((ai * 128 + m * 16) & rowmask) + rin0;
#pragma unroll
        for (int bj = 0; bj < 2; ++bj) *(u32x4*)(Vc + (size_t)(drow0 + rin) * 1024 + (pn - 4) * 256 + bj * 128 + wc * 32 + fq * 8) = pack8(acc[ai][bj][m][0], acc[ai][bj][m][1]); }
    } else if (pn < 10) {
#pragma unroll
      EPI_LOOP_AM { const int rin = ((ai * 128 + m * 16) & rowmask) + rin0;
#pragma unroll
        for (int bj = 0; bj < 2; ++bj) { const int c0 = (pn - 8) * 256 + bj * 128 + wc * 32 + fq * 8; const int g = c0 >> 4, co = c0 & 15;
          const int R = pm * 256 + rin; *(u32x4*)(Ug + ((size_t)g * NCHP + (R >> 5)) * 768 + (R & 31) * 16 + co) = pack8(acc[ai][bj][m][0], acc[ai][bj][m][1]); } }
    } else {
      const int c0 = (pn - 14) * 128 + wc * 32 + fq * 8;
#pragma unroll
      EPI_LOOP_AM { const int rin = ((ai * 128 + m * 16) & rowmask) + rin0; f32x4 r[2], g[2];
#pragma unroll
        for (int n = 0; n < 2; ++n)
#pragma unroll
          for (int j = 0; j < 4; ++j) { const float ea = __builtin_amdgcn_exp2f(-1.4426950408889634f * acc[ai][0][m][n][j]); const float es = __builtin_amdgcn_exp2f(-1.4426950408889634f * fmaxf(acc[ai][1][m][n][j], -60.f));
            g[n][j] = __builtin_amdgcn_rcpf(1.f + es); r[n][j] = (1.f + es) * __builtin_amdgcn_rcpf(1.f + ea); }
        *(u32x4*)(RG + (size_t)(pm * 256 + rin) * 1024 + c0) = pack8(r[0], r[1]); *(u32x4*)(GSb + (size_t)(pm * 256 + rin) * 1024 + c0) = pack8(g[0], g[1]); }
    }
    return true;
  }
};
struct EpiNone { __device__ __forceinline__ bool operator()(f32x4 (&acc)[2][2][4][2], const Seg& s, int wr, int wc, int fr, int fq) const { asm volatile("" :: "v"(acc[0][0][0][0][0]), "v"(acc[1][1][3][1][3])); return true; } };
template <int NST> struct EpiLinT {
  bf16_t* Yo;
  __device__ __forceinline__ bool operator()(f32x4 (&acc)[2][2][4][2], const Seg& s, int wr, int wc, int fr, int fq) const {
    const int lane = fr + 16 * fq; const int w = wr * 4 + wc; int k = 0;
#pragma unroll
    EPI_LOOP_AM {
#pragma unroll
      for (int bj = 0; bj < 2; ++bj) { if (k < NST) *(u32x4*)(Yo + ((size_t)s.pm * 256 * 1024) + (size_t)(s.pn & 3) * 65536 + ((w * 16 + k) * 64 + lane) * 8) = pack8(acc[ai][bj][m][0], acc[ai][bj][m][1]); else asm volatile("" :: "v"(acc[ai][bj][m][0][0]), "v"(acc[ai][bj][m][1][3])); ++k; } }
    return true;
  }
};
struct EpiLin {
  bf16_t* Yo;
  __device__ __forceinline__ bool operator()(f32x4 (&acc)[2][2][4][2], const Seg& s, int wr, int wc, int fr, int fq) const {
    const int lane = fr + 16 * fq; const int w = wr * 4 + wc; int k = 0;
#pragma unroll
    EPI_LOOP_AM {
#pragma unroll
      for (int bj = 0; bj < 2; ++bj) { *(u32x4*)(Yo + ((size_t)s.pm * 256 * 1024) + (size_t)(s.pn & 3) * 65536 + ((w * 16 + k) * 64 + lane) * 8) = pack8(acc[ai][bj][m][0], acc[ai][bj][m][1]); ++k; } }
    return true;
  }
};
struct EpiState {
  float* SST;
  __device__ __forceinline__ bool operator()(f32x4 (&acc)[2][2][4][2], const Seg& s, int wr, int wc, int fr, int fq) const {
    const int g = s.aux;
#pragma unroll
    EPI_LOOP_AM { const int row = s.pm * 256 + ai * 128 + m * 16 + wr * 64 + fr;
      if (row < NCHR) {
#pragma unroll
        for (int bj = 0; bj < 2; ++bj) { float* p = SST + ((size_t)g * NCHP + row) * 256 + bj * 128 + wc * 32 + fq * 8; *(f32x4*)p = acc[ai][bj][m][0]; *(f32x4*)(p + 4) = acc[ai][bj][m][1]; } } }
    return true;
  }
};
struct EpiSsmOut {
  bf16_t* YG;
  __device__ __forceinline__ bool operator()(f32x4 (&acc)[2][2][4][2], const Seg& s, int wr, int wc, int fr, int fq) const {
    const int g = s.aux;
#pragma unroll
    EPI_LOOP_AM { const int row = s.pm * 256 + ai * 128 + m * 16 + wr * 64 + fr;
      if (row < NCHR) {
#pragma unroll
        for (int bj = 0; bj < 2; ++bj) { const int c0 = s.pn * 256 + bj * 128 + wc * 32 + fq * 8; const int t = c0 >> 4, co = c0 & 15; f32x4 a = acc[ai][bj][m][0], b = acc[ai][bj][m][1];
#pragma unroll
          for (int j = 0; j < 4; ++j) { a[j] = gelu_tanh_f(a[j]); b[j] = gelu_tanh_f(b[j]); }
          *(u32x4*)(YG + ((size_t)g * NR + (size_t)row * CHUNK + t) * 16 + co) = pack8(a, b); } } }
    return true;
  }
};
struct EpiGlu {
  const bf16_t* YG; bf16_t* S2; const float* bias;
  __device__ __forceinline__ bool operator()(f32x4 (&acc)[2][2][4][2], const Seg& s, int wr, int wc, int fr, int fq) const {
#pragma unroll
    for (int bj = 0; bj < 2; ++bj) { const int c0 = s.pn * 256 + bj * 128 + wc * 32 + fq * 8; const f32x4 b0 = *(const f32x4*)(bias + c0), b1 = *(const f32x4*)(bias + c0 + 4);
#pragma unroll
      EPI_LOOP_AM { const int row = s.pm * 256 + ai * 128 + m * 16 + wr * 64 + fr; const u32x4 yw = *(const u32x4*)(YG + ((size_t)(c0 >> 4) * NR + row) * 16 + (c0 & 15)); f32x4 y0, y1; unpack8(yw, y0, y1);
        f32x4 z0 = acc[ai][bj][m][0] + b0, z1 = acc[ai][bj][m][1] + b1;
#pragma unroll
        for (int j = 0; j < 4; ++j) { z0[j] = y0[j] * fast_sigmoid(z0[j]); z1[j] = y1[j] * fast_sigmoid(z1[j]); }
        *(u32x4*)(S2 + (size_t)row * 1024 + c0) = pack8(z0, z1); } }
    return true;
  }
};
struct EpiMerge {
  const bf16_t* RG; const bf16_t* GSb; bf16_t* Mb;
  __device__ __forceinline__ bool operator()(f32x4 (&acc)[2][2][4][2], const Seg& s, int wr, int wc, int fr, int fq) const {
    const bool mid = s.epi == 2; const bf16_t* src = mid ? RG : GSb;
#pragma unroll
    EPI_LOOP_AM { const int row = s.pm * 256 + ai * 128 + m * 16 + wr * 64 + fr;
#pragma unroll
      for (int bj = 0; bj < 2; ++bj) { const int c0 = s.pn * 256 + bj * 128 + wc * 32 + fq * 8; const u32x4 w = *(const u32x4*)(src + (size_t)row * 1024 + c0); f32x4 g0, g1; unpack8(w, g0, g1);
        acc[ai][bj][m][0] *= g0; acc[ai][bj][m][1] *= g1;
        if (!mid) *(u32x4*)(Mb + (size_t)row * 1024 + c0) = pack8(acc[ai][bj][m][0], acc[ai][bj][m][1]); } }
    return !mid;
  }
};
struct EpiWo {
  bf16_t* D1; const float* MODl;
  __device__ __forceinline__ bool operator()(f32x4 (&acc)[2][2][4][2], const Seg& s, int wr, int wc, int fr, int fq) const {
    const int pm = s.pm; const float* gate = MODl + (size_t)modrow_of_tile(pm) * 6144 + 2 * 1024;
#pragma unroll
    for (int bj = 0; bj < 2; ++bj) { const int c0 = s.pn * 256 + bj * 128 + wc * 32 + fq * 8; const f32x4 g0 = *(const f32x4*)(gate + c0), g1 = *(const f32x4*)(gate + c0 + 4);
#pragma unroll
      EPI_LOOP_AM { const int rin = ai * 128 + m * 16 + wr * 64 + fr;
        *(u32x4*)(D1 + (size_t)(pm * 256 + rin) * 1024 + c0) = pack8(g0 * acc[ai][bj][m][0], g1 * acc[ai][bj][m][1]); } }
    return true;
  }
};
struct EpiMoe1 {
  bf16_t* Hm;
  __device__ __forceinline__ bool operator()(f32x4 (&acc)[2][2][4][2], const Seg& s, int wr, int wc, int fr, int fq) const {
    const int c0 = s.pn * 128 + wc * 32 + fq * 8;
#pragma unroll
    EPI_LOOP_AM { const int row = s.pm * 256 + ai * 128 + m * 16 + wr * 64 + fr; f32x4 h0, h1;
#pragma unroll
      for (int j = 0; j < 4; ++j) { h0[j] = fast_silu(acc[ai][0][m][0][j]) * acc[ai][1][m][0][j]; h1[j] = fast_silu(acc[ai][0][m][1][j]) * acc[ai][1][m][1][j]; }
      *(u32x4*)(Hm + (size_t)row * EH + c0) = pack8(h0, h1); }
    return true;
  }
};
struct EpiMoe2 {
  bf16_t* Yo;
  __device__ __forceinline__ bool operator()(f32x4 (&acc)[2][2][4][2], const Seg& s, int wr, int wc, int fr, int fq) const {
#pragma unroll
    EPI_LOOP_AM { const int row = s.pm * 256 + ai * 128 + m * 16 + wr * 64 + fr;
#pragma unroll
      for (int bj = 0; bj < 2; ++bj) *(u32x4*)(Yo + (size_t)row * 1024 + s.pn * 256 + bj * 128 + wc * 32 + fq * 8) = pack8(acc[ai][bj][m][0], acc[ai][bj][m][1]); }
    return true;
  }
};
}
namespace fk {
constexpr int ATT_SHM_V = 64 * 128 * 2, ATT_SHM_K = 64 * 128 * 2;
constexpr int ATT_LDS = 4 * ATT_SHM_V + 4 * ATT_SHM_K + 8 * 256;
#define KSWZ(row, colB) ((row) * 256 + ((colB) ^ (((row) & 15) << 4)))
#define SBAR() __builtin_amdgcn_sched_barrier(0)
__device__ __forceinline__ int crow(int r, int hi) { return (r & 3) + 8 * (r >> 2) + 4 * hi; }
constexpr float ATT_THR2 = 11.5f;
template <int VAR = 0> __device__ __forceinline__ void partialSM(f32x16& p0, f32x16& p1, float& m_reg, float& alpha) {
  if (VAR == 1) { alpha = 1.f; return; }
  float pmax = p0[0];
#pragma unroll
  for (int r = 1; r < 16; ++r) pmax = fmaxf(pmax, p0[r]);
#pragma unroll
  for (int r = 0; r < 16; ++r) pmax = fmaxf(pmax, p1[r]);
  { auto rr = __builtin_amdgcn_permlane32_swap(__float_as_uint(pmax), __float_as_uint(pmax), false, false);
    pmax = fmaxf(__uint_as_float(rr[0]), __uint_as_float(rr[1])); }
  if (__builtin_expect(__all(pmax <= ATT_THR2 && pmax >= -2.f * ATT_THR2), 1)) { alpha = 1.f; }
  else { const float d = pmax; alpha = __builtin_amdgcn_exp2f(-d); m_reg += d;
#pragma unroll
    for (int r = 0; r < 16; ++r) { p0[r] -= d; p1[r] -= d; } }
#pragma unroll
  for (int r = 0; r < 16; ++r) p0[r] = __builtin_amdgcn_exp2f(p0[r]);
}
template <int VAR = 0> __device__ __forceinline__ void finishSM(f32x16& p0, f32x16& p1, float alpha, float& l_reg, bf16x8& pa0, bf16x8& pa1, bf16x8& pa2, bf16x8& pa3) {
  if (VAR != 1) {
#pragma unroll
  for (int r = 0; r < 16; ++r) p1[r] = __builtin_amdgcn_exp2f(p1[r]);
  float ps = 0;
#pragma unroll
  for (int r = 0; r < 16; ++r) ps += p0[r];
#pragma unroll
  for (int r = 0; r < 16; ++r) ps += p1[r];
  { auto rr = __builtin_amdgcn_permlane32_swap(__float_as_uint(ps), __float_as_uint(ps), false, false);
    ps = __uint_as_float(rr[0]) + __uint_as_float(rr[1]); }
  l_reg = l_reg * alpha + ps; } else l_reg += 1.f;
#define PK4(P, BASE, OUT) do { unsigned a0 = cvt_pk_bf16(P[BASE + 0], P[BASE + 1]), a1 = cvt_pk_bf16(P[BASE + 2], P[BASE + 3]);   \
    unsigned b0 = cvt_pk_bf16(P[BASE + 4], P[BASE + 5]), b1 = cvt_pk_bf16(P[BASE + 6], P[BASE + 7]);                              \
    auto r0 = __builtin_amdgcn_permlane32_swap(a0, b0, false, false); auto r1 = __builtin_amdgcn_permlane32_swap(a1, b1, false, false); \
    u32x4 w = {r0[0], r1[0], r0[1], r1[1]}; OUT = *reinterpret_cast<bf16x8*>(&w); } while (0)
  PK4(p0, 0, pa0); PK4(p0, 8, pa1); PK4(p1, 0, pa2); PK4(p1, 8, pa3);
#undef PK4
}
template <int VAR = 0> __device__ __forceinline__ void qkt(f32x16& p0, f32x16& p1, const LAS char* Ks, const bf16x8* qr, int mapcolB, int r32, int hi, float negm) {
#pragma unroll
  for (int r = 0; r < 16; ++r) { p0[r] = negm; p1[r] = negm; }
  if (VAR == 3) return;
#pragma unroll
  for (int d0 = 0; d0 < 4; ++d0) { const int cb = mapcolB + (d0 * 16 + hi * 8) * 2;
    const bf16x8 b0 = *(const LAS bf16x8*)(Ks + KSWZ(r32, cb));
    const bf16x8 b1 = *(const LAS bf16x8*)(Ks + KSWZ(32 + r32, cb));
    p0 = __builtin_amdgcn_mfma_f32_32x32x16_bf16(b0, qr[d0], p0, 0, 0, 0);
    p1 = __builtin_amdgcn_mfma_f32_32x32x16_bf16(b1, qr[d0], p1, 0, 0, 0); }
}
__device__ __forceinline__ int v_st(int k, int c) { const int kk = (k & ~0xC) | ((k & 4) << 1) | ((k & 8) >> 1); return ((kk >> 3) * 4 + (c >> 5)) * 512 + ((kk & 7) * 32 + (c & 31)) * 2; }
__device__ __forceinline__ int v_rd_base(int lane) { return ((lane & 3) << 3) | (((lane >> 2) & 3) << 6) | (((lane >> 4) & 1) << 5) | (((lane >> 5) & 1) << 8); }
constexpr int v_rd_off(int d0, int ks, int half) { return d0 * 512 + ks * 4096 + half * 2048; }
template <int OFF> __device__ __forceinline__ s16x4 tr_read(int vb) {
  s16x4 r; asm volatile("ds_read_b64_tr_b16 %0, %1 offset:%2" : "=&v"(r) : "v"(vb), "i"(OFF) : "memory"); return r;
}
struct VFrag { s16x4 l0, h0, l1, h1, l2, h2, l3, h3; };
template <int D0> __device__ __forceinline__ void v_issue(VFrag& f, int vb) {
  f.l0 = tr_read<v_rd_off(D0, 0, 0)>(vb); f.h0 = tr_read<v_rd_off(D0, 0, 1)>(vb); f.l1 = tr_read<v_rd_off(D0, 1, 0)>(vb); f.h1 = tr_read<v_rd_off(D0, 1, 1)>(vb);
  f.l2 = tr_read<v_rd_off(D0, 2, 0)>(vb); f.h2 = tr_read<v_rd_off(D0, 2, 1)>(vb); f.l3 = tr_read<v_rd_off(D0, 3, 0)>(vb); f.h3 = tr_read<v_rd_off(D0, 3, 1)>(vb);
}
__device__ __forceinline__ void v_mma(f32x16& od, const VFrag& f, bf16x8 pa0, bf16x8 pa1, bf16x8 pa2, bf16x8 pa3) {
#define PK(L, H) (bf16x8){L[0], L[1], L[2], L[3], H[0], H[1], H[2], H[3]}
  od = __builtin_amdgcn_mfma_f32_32x32x16_bf16(pa0, PK(f.l0, f.h0), od, 0, 0, 0);
  od = __builtin_amdgcn_mfma_f32_32x32x16_bf16(pa1, PK(f.l1, f.h1), od, 0, 0, 0);
  od = __builtin_amdgcn_mfma_f32_32x32x16_bf16(pa2, PK(f.l2, f.h2), od, 0, 0, 0);
  od = __builtin_amdgcn_mfma_f32_32x32x16_bf16(pa3, PK(f.l3, f.h3), od, 0, 0, 0);
#undef PK
}
template <int VAR = 0> __device__ __forceinline__ void pv_d0(f32x16* o, int vb, bf16x8 pa0, bf16x8 pa1, bf16x8 pa2, bf16x8 pa3) {
  if (VAR == 2) { asm volatile("" :: "v"(pa0), "v"(pa1), "v"(pa2), "v"(pa3)); return; }
  VFrag fa, fb;
  v_issue<0>(fa, vb); v_issue<1>(fb, vb);
  asm volatile("s_waitcnt lgkmcnt(8)" ::: "memory"); SBAR(); v_mma(o[0], fa, pa0, pa1, pa2, pa3);
  v_issue<2>(fa, vb);
  asm volatile("s_waitcnt lgkmcnt(8)" ::: "memory"); SBAR(); v_mma(o[1], fb, pa0, pa1, pa2, pa3);
  v_issue<3>(fb, vb);
  asm volatile("s_waitcnt lgkmcnt(8)" ::: "memory"); SBAR(); v_mma(o[2], fa, pa0, pa1, pa2, pa3);
  asm volatile("s_waitcnt lgkmcnt(0)" ::: "memory"); SBAR(); v_mma(o[3], fb, pa0, pa1, pa2, pa3);
}
template <int VAR = 0> __device__ __forceinline__ void attn_unit(const bf16_t* __restrict__ Qg, const bf16_t* __restrict__ Kg, const bf16_t* __restrict__ Vg, bf16_t* __restrict__ Og,
                                          int qrow0, int kv0, int nkeys, int h, float lam, float lam_init, const float* __restrict__ subg, LAS char* lds, const int g_wv) {
  const int tid = otid(), wid = g_wv, lane = tid & 63, r32 = lane & 31, hi = lane >> 5, map = wid >> 2, wq = wid & 3;
  LAS char* V_lds = lds; LAS char* K_lds = lds + 4 * ATT_SHM_V;
  LAS float* wsf = (LAS float*)(lds + 4 * ATT_SHM_V + 4 * ATT_SHM_K) + wid * 64; LAS float* li_l = wsf; LAS float* al_l = wsf + 32;
  float m_reg = 0.f, l_reg = 0; f32x16 o[4] = {}; bf16x8 qr[4];
  const bf16_t* Qw = Qg + (size_t)(qrow0 + wq * 32 + r32) * 1024 + h * 128 + map * 64 + hi * 8;
#pragma unroll
  for (int d0 = 0; d0 < 4; ++d0) qr[d0] = *(const bf16x8*)(Qw + d0 * 16);
  const bf16_t* Kh = Kg + (size_t)kv0 * 1024 + h * 128; const bf16_t* Vh = Vg + (size_t)kv0 * 1024 + h * 128;
  const int vb0 = (int)(uintptr_t)V_lds + v_rd_base(lane);
  const int mapcolB = map * 128;
  unsigned offK0, offK1, offV0, offV1;
  { const int kr0 = 4 * wid + (lane >> 4), kr1 = 32 + kr0, kp = (lane & 15) * 16;
    offK0 = (unsigned)(kr0 * 2048 + (kp ^ ((kr0 & 15) << 4))); offK1 = (unsigned)(kr1 * 2048 + (kp ^ ((kr1 & 15) << 4)));
#pragma unroll
    for (int u = 0; u < 2; ++u) { const int B = 2 * (8 * u + wid) + (lane >> 5); const int kk = (B >> 2) * 8 + ((lane & 31) >> 2); const int k = (kk & ~0xC) | ((kk & 4) << 1) | ((kk & 8) >> 1); const int c = (B & 3) * 32 + (lane & 3) * 8;
      const unsigned o = (unsigned)(k * 2048 + c * 2); if (u == 0) offV0 = o; else offV1 = o; } }
#define SLOT(t) (((t) & 3) * ATT_SHM_V)
#define SLOAD(k0, bo) do { const char* kb_ = (const char*)Kh + (size_t)(k0) * 2048; const char* vb_ = (const char*)Vh + (size_t)(k0) * 2048; \
    __builtin_amdgcn_global_load_lds((const unsigned*)(vb_ + offV0), (LAS unsigned*)(V_lds + (bo) + wid * 1024), 16, 0, 0); \
    __builtin_amdgcn_global_load_lds((const unsigned*)(vb_ + offV1), (LAS unsigned*)(V_lds + (bo) + (8 + wid) * 1024), 16, 0, 0); \
    __builtin_amdgcn_global_load_lds((const unsigned*)(kb_ + offK0), (LAS unsigned*)(K_lds + (bo) + wid * 1024), 16, 0, 0); \
    __builtin_amdgcn_global_load_lds((const unsigned*)(kb_ + offK1), (LAS unsigned*)(K_lds + (bo) + (8 + wid) * 1024), 16, 0, 0); } while (0)
#define SWRITE(bo) do { } while (0)
#define SWAIT() asm volatile("s_waitcnt vmcnt(0)" ::: "memory")
#define RESC(a) do { if (__any((a) != 1.f)) { if (hi == 0) al_l[r32] = (a); asm volatile("s_waitcnt lgkmcnt(0)" ::: "memory"); \
    _Pragma("unroll") for (int d = 0; d < 4; ++d) _Pragma("unroll") for (int r = 0; r < 16; ++r) o[d][r] *= al_l[crow(r, hi)]; } } while (0)
  f32x16 pA0, pA1, pB0, pB1; float alA, alB; bf16x8 pa0, pa1, pa2, pa3; const int NT = nkeys / 64;
  SLOAD(0, SLOT(0)); SLOAD(64, SLOT(1)); asm volatile("s_waitcnt vmcnt(0)" ::: "memory"); __syncthreads();
  if (g_wv < 4) {
    qkt<VAR>(pA0, pA1, K_lds, qr, mapcolB, r32, hi, -m_reg); partialSM<VAR>(pA0, pA1, m_reg, alA);
    __syncthreads();
    for (int j = 1; j + 1 < NT; j += 2) {
      SBAR(); { qkt<VAR>(pB0, pB1, K_lds + SLOT(j), qr, mapcolB, r32, hi, -m_reg);
      finishSM<VAR>(pA0, pA1, alA, l_reg, pa0, pa1, pa2, pa3); } SBAR();
      SLOAD((j + 1) * 64, SLOT(j + 1)); SBAR();
      pv_d0<VAR>(o, vb0 + SLOT(j - 1), pa0, pa1, pa2, pa3); partialSM<VAR>(pB0, pB1, m_reg, alB);
      SWAIT(); SWRITE(SLOT(j + 1));
      RESC(alB); __syncthreads();
      SBAR(); { qkt<VAR>(pA0, pA1, K_lds + SLOT(j + 1), qr, mapcolB, r32, hi, -m_reg);
      finishSM<VAR>(pB0, pB1, alB, l_reg, pa0, pa1, pa2, pa3); } SBAR();
      SLOAD((j + 2) * 64, SLOT(j + 2)); SBAR();
      pv_d0<VAR>(o, vb0 + SLOT(j), pa0, pa1, pa2, pa3); partialSM<VAR>(pA0, pA1, m_reg, alA);
      SWAIT(); SWRITE(SLOT(j + 2));
      RESC(alA); __syncthreads();
    }
    SBAR(); { qkt<VAR>(pB0, pB1, K_lds + SLOT(NT - 1), qr, mapcolB, r32, hi, -m_reg);
    finishSM<VAR>(pA0, pA1, alA, l_reg, pa0, pa1, pa2, pa3); } SBAR();
    pv_d0<VAR>(o, vb0 + SLOT(NT - 2), pa0, pa1, pa2, pa3); partialSM<VAR>(pB0, pB1, m_reg, alB);
    RESC(alB);
    finishSM<VAR>(pB0, pB1, alB, l_reg, pa0, pa1, pa2, pa3); SBAR();
    pv_d0<VAR>(o, vb0 + SLOT(NT - 1), pa0, pa1, pa2, pa3);
  } else {
    qkt<VAR>(pA0, pA1, K_lds, qr, mapcolB, r32, hi, -m_reg);
    __syncthreads();
    for (int k = 1; k + 1 < NT; k += 2) {
      SLOAD((k + 1) * 64, SLOT(k + 1)); SBAR();
      if (k >= 2) pv_d0<VAR>(o, vb0 + SLOT(k - 2), pa0, pa1, pa2, pa3);
      partialSM<VAR>(pA0, pA1, m_reg, alA); RESC(alA);
      SBAR(); { qkt<VAR>(pB0, pB1, K_lds + SLOT(k), qr, mapcolB, r32, hi, -m_reg);
      finishSM<VAR>(pA0, pA1, alA, l_reg, pa0, pa1, pa2, pa3); } SBAR();
      SWAIT(); SWRITE(SLOT(k + 1)); __syncthreads();
      SLOAD((k + 2) * 64, SLOT(k + 2)); SBAR();
      pv_d0<VAR>(o, vb0 + SLOT(k - 1), pa0, pa1, pa2, pa3); partialSM<VAR>(pB0, pB1, m_reg, alB); RESC(alB);
      SBAR(); { qkt<VAR>(pA0, pA1, K_lds + SLOT(k + 1), qr, mapcolB, r32, hi, -m_reg);
      finishSM<VAR>(pB0, pB1, alB, l_reg, pa0, pa1, pa2, pa3); } SBAR();
      SWAIT(); SWRITE(SLOT(k + 2)); __syncthreads();
    }
    pv_d0<VAR>(o, vb0 + SLOT(NT - 3), pa0, pa1, pa2, pa3); partialSM<VAR>(pA0, pA1, m_reg, alA); RESC(alA);
    SBAR(); { qkt<VAR>(pB0, pB1, K_lds + SLOT(NT - 1), qr, mapcolB, r32, hi, -m_reg);
    finishSM<VAR>(pA0, pA1, alA, l_reg, pa0, pa1, pa2, pa3); } SBAR();
    pv_d0<VAR>(o, vb0 + SLOT(NT - 2), pa0, pa1, pa2, pa3); partialSM<VAR>(pB0, pB1, m_reg, alB); RESC(alB);
    finishSM<VAR>(pB0, pB1, alB, l_reg, pa0, pa1, pa2, pa3); SBAR();
    pv_d0<VAR>(o, vb0 + SLOT(NT - 1), pa0, pa1, pa2, pa3);
  }
  if (hi == 0) li_l[r32] = l_reg; asm volatile("s_waitcnt lgkmcnt(0)" ::: "memory");
  float rli[16]; const float fac = map ? lam : 1.f;
#pragma unroll
  for (int r = 0; r < 16; ++r) rli[r] = fac * __builtin_amdgcn_rcpf(li_l[crow(r, hi)]);
  __syncthreads();
  LAS float* stg = (LAS float*)lds + wid * (32 * 128);
#pragma unroll
  for (int r = 0; r < 16; ++r)
#pragma unroll
    for (int d0 = 0; d0 < 4; ++d0) stg[crow(r, hi) * 128 + d0 * 32 + r32] = o[d0][r] * rli[r];
  __syncthreads();
  {
    const int qi = 16 * map + (lane >> 2), qt = lane & 3;
    const LAS float* pa = (const LAS float*)lds + wq * (32 * 128) + qi * 128 + qt * 32;
    const LAS float* pb = (const LAS float*)lds + (4 + wq) * (32 * 128) + qi * 128 + qt * 32;
    float v[32]; float ss = 0.f;
#pragma unroll
    for (int k = 0; k < 8; ++k) { const f32x4 a = *(const LAS f32x4*)(pa + 4 * k), b = *(const LAS f32x4*)(pb + 4 * k);
#pragma unroll
      for (int j = 0; j < 4; ++j) { const float x = a[j] - b[j]; v[4 * k + j] = x; ss += x * x; } }
    ss += dpp_f<0xB1, 0xF>(ss); ss += dpp_f<0x4E, 0xF>(ss);
    float li_ = lam_init; asm volatile("" : "+s"(li_));
    const float rn = __builtin_amdgcn_rsqf(ss * (1.f / 128.f) + 1e-5f) * (1.f - li_);
    bf16_t* op = Og + (size_t)(qrow0 + wq * 32 + qi) * 1024 + h * 128 + qt * 32; const float* gp = subg + qt * 32;
#pragma unroll
    for (int k = 0; k < 4; ++k) { f32x4 a, b;
#pragma unroll
      for (int j = 0; j < 4; ++j) { a[j] = v[8 * k + j] * rn * gp[8 * k + j]; b[j] = v[8 * k + 4 + j] * rn * gp[8 * k + 4 + j]; }
      *(u32x4*)(op + 8 * k) = pack8(a, b); }
  }
  __syncthreads();
#undef SLOT
#undef SLOAD
#undef SWRITE
#undef SWAIT
#undef RESC
}
template <int VAR = 0> __device__ __forceinline__ void attn_phase(KP p, int l, LAS char* lds, const int g_wv) {
  const int tid = otid(), lane = tid & 63; const bool last = (l == DEPTH - 1);
  float s1 = p.in.lam_q1[l * 64 + lane] * p.in.lam_k1[l * 64 + lane], s2 = p.in.lam_q2[l * 64 + lane] * p.in.lam_k2[l * 64 + lane];
  s1 = wave_sum_u(s1); s2 = wave_sum_u(s2);
  const float lam_init_v = 0.8f - 0.6f * expf(-0.3f * (float)l); const float lam_v = expf(s1) - expf(s2) + lam_init_v;
  const float lam_init = __builtin_bit_cast(float, __builtin_amdgcn_readfirstlane(__builtin_bit_cast(int, lam_init_v))), lam = __builtin_bit_cast(float, __builtin_amdgcn_readfirstlane(__builtin_bit_cast(int, lam_v)));
  const int c = obid(), x = c & 7, jl = c >> 3, per = ogd() >> 3;
  const int nu = (!last && jl >= 24) ? 6 : 4;
  for (int u = 0; u < nu; ++u) { const int q = u < 4 ? jl + per * u : 128 + (jl - 24) * 2 + (u - 4);
    int qrow0, nkeys, h;
    if (q < 128) { h = q >> 4; qrow0 = x * SEQ + (q & 15) * 128; nkeys = KVB; }
    else { const int qq = q - 128; h = qq >> 1; qrow0 = NLAT + x * CTX + (qq & 1) * 128; nkeys = CTX; }
    attn_unit<VAR>(p.Qb, p.Kc, p.Vc, p.ATTb, qrow0, x * KVB, nkeys, h, lam, lam_init, p.in.subln_g + l * 128, lds, g_wv);
  }
}

__device__ __forceinline__ float wave_sum(float v) { return wave_sum_u(v); }
__device__ __forceinline__ void row_ld(const float* p, int lane, f32x4 (&v)[4]) {
#pragma unroll
  for (int i = 0; i < 4; ++i) v[i] = *(const f32x4*)(p + 4 * lane + 256 * i); }
__device__ __forceinline__ void row_st(float* p, int lane, const f32x4 (&v)[4]) {
#pragma unroll
  for (int i = 0; i < 4; ++i) *(f32x4*)(p + 4 * lane + 256 * i) = v[i]; }
__device__ __forceinline__ void row_st_bf16(bf16_t* p, int lane, const f32x4 (&v)[4]) {
#pragma unroll
  for (int i = 0; i < 4; ++i) { u32x2 w; w.x = cvt_pk_bf16(v[i][0], v[i][1]); w.y = cvt_pk_bf16(v[i][2], v[i][3]); *(u32x2*)(p + 4 * lane + 256 * i) = w; } }
__device__ __forceinline__ void row_st_h16(bf16_t* p, int lane, const f32x4 (&v)[4]) {
#pragma unroll
  for (int i = 0; i < 4; ++i) { u32x2 w; w.x = pk_h16(v[i][0], v[i][1]); w.y = pk_h16(v[i][2], v[i][3]); *(u32x2*)(p + 4 * lane + 256 * i) = w; } }
__device__ __forceinline__ void row_ld_bf16(const bf16_t* p, int lane, f32x4 (&v)[4]) {
#pragma unroll
  for (int i = 0; i < 4; ++i) { const u32x2 w = *(const u32x2*)(p + 4 * lane + 256 * i); v[i] = (f32x4){bflo(w.x), bfhi(w.x), bflo(w.y), bfhi(w.y)}; } }
__device__ __forceinline__ void row_ln(f32x4 (&v)[4], const float* g, const float* b, int lane) {
  float s = 0.f;
#pragma unroll
  for (int i = 0; i < 4; ++i) s += (v[i][0] + v[i][1]) + (v[i][2] + v[i][3]);
  const float mean = wave_sum(s) * (1.f / 1024.f); float q = 0.f;
#pragma unroll
  for (int i = 0; i < 4; ++i) { v[i] -= mean; q += (v[i][0] * v[i][0] + v[i][1] * v[i][1]) + (v[i][2] * v[i][2] + v[i][3] * v[i][3]); }
  const float rs = __builtin_amdgcn_rsqf(wave_sum(q) * (1.f / 1024.f) + 1e-5f);
#pragma unroll
  for (int i = 0; i < 4; ++i) { const f32x4 gg = *(const f32x4*)(g + 4 * lane + 256 * i), bb = *(const f32x4*)(b + 4 * lane + 256 * i); v[i] = v[i] * rs * gg + bb; }
}
__device__ __forceinline__ void row_ln_r(f32x4 (&v)[4], const f32x4 (&gg)[4], const f32x4 (&bb)[4]) {
  float s = 0.f;
#pragma unroll
  for (int i = 0; i < 4; ++i) s += (v[i][0] + v[i][1]) + (v[i][2] + v[i][3]);
  const float mean = wave_sum(s) * (1.f / 1024.f); float q = 0.f;
#pragma unroll
  for (int i = 0; i < 4; ++i) { v[i] -= mean; q += (v[i][0] * v[i][0] + v[i][1] * v[i][1]) + (v[i][2] * v[i][2] + v[i][3] * v[i][3]); }
  const float rs = __builtin_amdgcn_rsqf(wave_sum(q) * (1.f / 1024.f) + 1e-5f);
#pragma unroll
  for (int i = 0; i < 4; ++i) v[i] = v[i] * rs * gg[i] + bb[i];
}
__device__ __forceinline__ void row_mod(f32x4 (&h)[4], const f32x4 (&v)[4], const float* modrow, int shift_idx, int scale_idx, int lane) {
#pragma unroll
  for (int i = 0; i < 4; ++i) { const f32x4 sc = *(const f32x4*)(modrow + scale_idx * 1024 + 4 * lane + 256 * i), sh = *(const f32x4*)(modrow + shift_idx * 1024 + 4 * lane + 256 * i); h[i] = v[i] * (1.f + sc) + sh; }
}
__device__ __forceinline__ int modrow_of_row(int r) { return r < NLAT ? (r >> 11) : 8; }

__device__ __forceinline__ void h0_phase(KP p, const int g_wv) {
  const int tid = otid(); const int lane = tid & 63, gw = obid() * 8 + (tid >> 6), nw = ogd() * 8;
  const int per = (NR + nw - 1) / nw;
  for (int r = gw * per; r < NR && r < (gw + 1) * per; ++r) {
    const float* src = r < NLAT ? p.in.x + (size_t)r * D : p.in.ctx + (size_t)(r - NLAT) * D;
    f32x4 v[4], h[4]; row_ld(src, lane, v); row_mod(h, v, p.MOD + (size_t)modrow_of_row(r) * 6144, 0, 1, lane); row_st_bf16(p.Hb + (size_t)r * D, lane, h); }
}
constexpr int LN1_RS = 1032, LN1_HXB = 32 * LN1_RS * 2, LN1_OFF_SUM = 2 * LN1_HXB, LN1_OFF_LCNT = LN1_OFF_SUM + 64 * 32 * 4, LN1_OFF_LBASE = LN1_OFF_LCNT + 128, LN1_OFF_ENT = LN1_OFF_LBASE + 128, LN1_END = LN1_OFF_ENT + 72 * 16;
__device__ __forceinline__ void ln1_phase(KP p, int l, LAS char* lds, const int g_wv) {
  const int tid = otid(), lane = tid & 63, wid = tid >> 6, gw = obid() * 8 + wid; const bool last = (l == DEPTH - 1);
  LAS bf16_t* HXhi = (LAS bf16_t*)lds; LAS bf16_t* HXlo = (LAS bf16_t*)(lds + LN1_HXB); LAS float* RED = (LAS float*)lds;
  LAS int* lcnt = (LAS int*)(lds + LN1_OFF_LCNT); LAS int* lbase = (LAS int*)(lds + LN1_OFF_LBASE); LAS int* ent = (LAS int*)(lds + LN1_OFF_ENT);
  if (tid < 32) lcnt[tid] = 0;
  const float* MODl = p.MOD + (size_t)l * 9 * 6144; const bf16_t* WRh = (const bf16_t*)p.s[l].WR; const bf16_t* WRl = WRh + 64 * 1024;
  const int nrow = last ? NLAT : NR, ni = nrow / 2048; const int c32 = lane & 31, hh = lane >> 5;
  u32x4 vn[3][4];
#define LN1_XROW(r) ((r) < NLAT ? p.in.x + (size_t)(r) * D : p.in.ctx + (size_t)((r) - NLAT) * D)
#define LN1_LD(j, r) do { if (l == 0) { const float* s_ = LN1_XROW(r); _Pragma("unroll") for (int q_ = 0; q_ < 4; ++q_) vn[j][q_] = *(const u32x4*)(s_ + 4 * lane + 256 * q_); } \
    else { _Pragma("unroll") for (int q_ = 0; q_ < 4; ++q_) { const u32x2 t_ = *(const u32x2*)((const bf16_t*)p.XL + (size_t)(r) * D + 4 * lane + 256 * q_); vn[j][q_].x = t_.x; vn[j][q_].y = t_.y; } } } while (0)
#define LN1_LDD(r) do { _Pragma("unroll") for (int q_ = 0; q_ < 4; ++q_) dq[q_] = *(const u32x2*)(p.ATTb + (size_t)(r) * D + 4 * lane + 256 * q_); } while (0)
#pragma unroll
  for (int j = 0; j < 3; ++j) if (j < ni) LN1_LD(j, gw * ni + j);
  u32x2 dq[4];
  LN1_LDD(gw * ni);
#pragma unroll 1
  for (int i0 = 0; i0 < ni; i0 += 3) {
#pragma unroll
    for (int j = 0; j < 3; ++j) { const int r = gw * ni + (i0 + j); const int slot = wid * 3 + j;
      if (i0 + j < ni) { f32x4 v[4], h[4];
#pragma unroll
        for (int q = 0; q < 4; ++q) { const f32x4 xi = l == 0 ? __builtin_bit_cast(f32x4, vn[j][q]) : (f32x4){h16lo(vn[j][q].x), h16hi(vn[j][q].x), h16lo(vn[j][q].y), h16hi(vn[j][q].y)};
          v[q] = xi * ALPHA + (f32x4){bflo(dq[q].x), bfhi(dq[q].x), bflo(dq[q].y), bfhi(dq[q].y)}; }
        if (i0 + j + 1 < ni) LN1_LDD(r + 1);
        if (i0 + 3 + j < ni) LN1_LD(j, r + 3);
        row_ln(v, p.in.ln1_g + l * D, p.in.ln1_b + l * D, lane); row_st_h16(p.X1b + (size_t)r * D, lane, v);
        row_mod(h, v, MODl + (size_t)modrow_of_row(r) * 6144, 3, 4, lane);
#pragma unroll
        for (int q = 0; q < 4; ++q) { u32x2 wh; wh.x = cvt_pk_bf16(h[q][0], h[q][1]); wh.y = cvt_pk_bf16(h[q][2], h[q][3]); *(u32x2*)(p.H2b + (size_t)r * D + 4 * lane + 256 * q) = wh;
          u32x2 wl; wl.x = cvt_pk_bf16(h[q][0] - bflo(wh.x), h[q][1] - bfhi(wh.x)); wl.y = cvt_pk_bf16(h[q][2] - bflo(wh.y), h[q][3] - bfhi(wh.y));
          *(LAS u32x2*)(HXhi + slot * LN1_RS + 4 * lane + 256 * q) = wh; *(LAS u32x2*)(HXlo + slot * LN1_RS + 4 * lane + 256 * q) = wl; } }
      else {
#pragma unroll
        for (int q = 0; q < 4; ++q) { *(LAS u32x2*)(HXhi + slot * LN1_RS + 4 * lane + 256 * q) = (u32x2){0u, 0u}; *(LAS u32x2*)(HXlo + slot * LN1_RS + 4 * lane + 256 * q) = (u32x2){0u, 0u}; } } }
    __syncthreads();
#ifdef PROBE_G0
    if (p.pad0 & 1) continue;
#endif
    f32x16 acc0 = {}, acc1 = {};
#pragma unroll 2
    for (int s8 = 0; s8 < 8; ++s8) { const int ko = (wid * 8 + s8) * 16 + hh * 8;
      const bf16x8 bh = *(const LAS bf16x8*)(HXhi + c32 * LN1_RS + ko), bl = *(const LAS bf16x8*)(HXlo + c32 * LN1_RS + ko);
      const bf16x8 ah0 = *(const bf16x8*)(WRh + (size_t)c32 * 1024 + ko), al0 = *(const bf16x8*)(WRl + (size_t)c32 * 1024 + ko);
      const bf16x8 ah1 = *(const bf16x8*)(WRh + (size_t)(32 + c32) * 1024 + ko), al1 = *(const bf16x8*)(WRl + (size_t)(32 + c32) * 1024 + ko);
      acc0 = __builtin_amdgcn_mfma_f32_32x32x16_bf16(ah0, bh, acc0, 0, 0, 0); acc0 = __builtin_amdgcn_mfma_f32_32x32x16_bf16(ah0, bl, acc0, 0, 0, 0); acc0 = __builtin_amdgcn_mfma_f32_32x32x16_bf16(al0, bh, acc0, 0, 0, 0);
      acc1 = __builtin_amdgcn_mfma_f32_32x32x16_bf16(ah1, bh, acc1, 0, 0, 0); acc1 = __builtin_amdgcn_mfma_f32_32x32x16_bf16(ah1, bl, acc1, 0, 0, 0); acc1 = __builtin_amdgcn_mfma_f32_32x32x16_bf16(al1, bh, acc1, 0, 0, 0); }
    __syncthreads();
#pragma unroll
    for (int r = 0; r < 16; ++r) { RED[(wid * 64 + crow(r, hh)) * 32 + c32] = acc0[r]; RED[(wid * 64 + 32 + crow(r, hh)) * 32 + c32] = acc1[r]; }
    __syncthreads();
    { LAS float* SUM = (LAS float*)(lds + LN1_OFF_SUM);
#pragma unroll
      for (int k = 0; k < 4; ++k) { const int idx = tid + 512 * k; float sacc = 0.f;
#pragma unroll
        for (int w = 0; w < 8; ++w) sacc += RED[w * 2048 + idx];
        SUM[idx] = sacc; } }
    __syncthreads();
    if (wid == 0 && lane < 24) { const int ws = lane / 3, j = lane - 3 * ws;
      if (i0 + j < ni) { const int r = (obid() * 8 + ws) * ni + (i0 + j); float lg[36]; const LAS float* SUM = (const LAS float*)(lds + LN1_OFF_SUM);
#pragma unroll
        for (int e = 0; e < 36; ++e) lg[e] = SUM[e * 32 + lane] + (e < 4 ? p.in.rg_b[l * 4 + e] : p.in.re_b[l * 32 + e - 4]);
        int gi = 0; float gm = lg[0];
#pragma unroll
        for (int q = 1; q < 4; ++q) if (lg[q] > gm) { gm = lg[q]; gi = q; }
        float gs = 0.f;
#pragma unroll
        for (int q = 0; q < 4; ++q) gs += expf(lg[q] - gm);
        const float gtop = 1.f / gs; float el[8];
#pragma unroll
        for (int q = 0; q < 8; ++q) el[q] = gi == 0 ? lg[4 + q] : gi == 1 ? lg[12 + q] : gi == 2 ? lg[20 + q] : lg[28 + q];
        int i0e = 0; float v0 = el[0];
#pragma unroll
        for (int q = 1; q < 8; ++q) if (el[q] > v0) { v0 = el[q]; i0e = q; }
        int i1e = -1; float v1 = -3.0e38f;
#pragma unroll
        for (int q = 0; q < 8; ++q) if (q != i0e && el[q] > v1) { v1 = el[q]; i1e = q; }
        const float e1 = expf(v1 - v0); const float w0 = gtop / (1.f + e1), w1 = gtop * e1 / (1.f + e1);
        const int e0i = gi * 8 + i0e, e1i = gi * 8 + i1e;
        const int lr0 = __hip_atomic_fetch_add(&lcnt[e0i], 1, __ATOMIC_RELAXED, __HIP_MEMORY_SCOPE_WORKGROUP); const int lr1 = __hip_atomic_fetch_add(&lcnt[e1i], 1, __ATOMIC_RELAXED, __HIP_MEMORY_SCOPE_WORKGROUP);
        { LAS int* ep = ent + ((i0 + j) * 8 + ws) * 4; ep[0] = e0i; ep[1] = e1i; ep[2] = lr0; ep[3] = lr1; } *(float2*)(p.RW + (size_t)r * 2) = make_float2(w0, w1); } }
  }
  __syncthreads();
#ifdef PROBE_G0
  if (p.pad0 & 1) return;
#endif
  if (tid < 32) lbase[tid] = (int)atomicAdd(p.ctl + l * CTL_WORDS + CTL_CNT + 64 * tid, (unsigned)lcnt[tid]);
  __syncthreads();
  if (tid < ni * 8) { const int i = tid >> 3, w = tid & 7; const int r = (obid() * 8 + w) * ni + i; const LAS int* ep = ent + tid * 4; const int4 en = make_int4(ep[0], ep[1], ep[2], ep[3]); const int g0 = lbase[en.x] + en.z, g1 = lbase[en.y] + en.w;
    p.TOK[(size_t)en.x * NR + g0] = r; p.TOK[(size_t)en.y * NR + g1] = r; *(int4*)(p.ROUTE + (size_t)r * 4) = make_int4(en.x, en.y, g0, g1); }
}
__device__ __forceinline__ void moe_table(KP p, int l, LAS MoeTab* tab, const int g_wv) {
  const int tid = otid();
  if (tid < 32) tab->cnt[tid] = (int)__hip_atomic_load(p.ctl + l * CTL_WORDS + CTL_CNT + 64 * tid, __ATOMIC_RELAXED, __HIP_MEMORY_SCOPE_AGENT);
  __syncthreads();
  if (tid < 32) {
    const int n = (tab->cnt[tid] + 255) >> 8; int t0 = 0, tot = 0;
#pragma unroll
    for (int e = 0; e < 32; ++e) { const int ne = (tab->cnt[e] + 255) >> 8; if (e < tid) t0 += ne; tot += ne; }
    tab->tbase[tid] = t0; for (int i = 0; i < n; ++i) { tab->tileE[t0 + i] = tid; tab->tileR0[t0 + i] = i * 256; }
    if (tid == 0) { tab->tbase[32] = tot; tab->ntiles = tot; } }
  __syncthreads();
}
__device__ __forceinline__ void ln2_phase(KP p, int l, LAS char* lds, const int g_wv) {
  const int tid = otid(), lane = tid & 63, wid = tid >> 6, gw = obid() * 8 + wid; const bool last = (l == DEPTH - 1);
  LAS MoeTab* tab = (LAS MoeTab*)lds; moe_table(p, l, tab, g_wv);
  const float* MODl = p.MOD + (size_t)l * 9 * 6144; const int ni = last ? NLAT / 2048 : NR / 2048;
  int4 rt[9]; float2 rw[9]; f32x4 gg[4], bb[4];
#pragma unroll
  for (int q = 0; q < 4; ++q) { gg[q] = *(const f32x4*)(p.in.ln2_g + l * D + 4 * lane + 256 * q); bb[q] = *(const f32x4*)(p.in.ln2_b + l * D + 4 * lane + 256 * q); }
#pragma unroll
  for (int i = 0; i < 9; ++i) if (i < ni) { const int r = gw * ni + i; rt[i] = *(const int4*)(p.ROUTE + (size_t)r * 4); rw[i] = *(const float2*)(p.RW + (size_t)r * 2); }
  u32x2 xb[4], ya[4], yb[4];
#define LN2_LOAD(i) do { const int r_ = gw * ni + (i); const int p0_ = (tab->tbase[rt[i].x] + (rt[i].z >> 8)) * 256 + (rt[i].z & 255), p1_ = (tab->tbase[rt[i].y] + (rt[i].w >> 8)) * 256 + (rt[i].w & 255); \
    _Pragma("unroll") for (int q_ = 0; q_ < 4; ++q_) { xb[q_] = *(const u32x2*)(p.X1b + (size_t)r_ * D + 4 * lane + 256 * q_); ya[q_] = *(const u32x2*)(p.Yo + (size_t)p0_ * D + 4 * lane + 256 * q_); yb[q_] = *(const u32x2*)(p.Yo + (size_t)p1_ * D + 4 * lane + 256 * q_); } } while (0)
  LN2_LOAD(0);
#pragma unroll
  for (int i = 0; i < 9; ++i) if (i < ni) { const int r = gw * ni + i; const float2 w = rw[i]; f32x4 x[4];
    const float* mr = MODl + (size_t)modrow_of_row(r) * 6144;
#pragma unroll
    for (int q = 0; q < 4; ++q) { const f32x4 g2 = *(const f32x4*)(mr + 5 * 1024 + 4 * lane + 256 * q); const f32x4 y0 = (f32x4){bflo(ya[q].x), bfhi(ya[q].x), bflo(ya[q].y), bfhi(ya[q].y)}, y1 = (f32x4){bflo(yb[q].x), bfhi(yb[q].x), bflo(yb[q].y), bfhi(yb[q].y)};
      x[q] = (f32x4){h16lo(xb[q].x), h16hi(xb[q].x), h16lo(xb[q].y), h16hi(xb[q].y)} * ALPHA + g2 * (y0 * w.x + y1 * w.y); }
    if (i + 1 < ni) LN2_LOAD(i + 1);
    row_ln_r(x, gg, bb);
    if (!last) { row_st_h16((bf16_t*)p.XL + (size_t)r * D, lane, x); f32x4 h[4]; row_mod(h, x, p.MOD + ((size_t)(l + 1) * 9 + modrow_of_row(r)) * 6144, 0, 1, lane); row_st_bf16(p.Hb + (size_t)r * D, lane, h); }
    else row_st(p.out + (size_t)r * D, lane, x); }
#undef LN2_LOAD
}
__device__ __forceinline__ void s2_phase(KP p, int l, const int g_wv) {
  const int tid = otid(); const int it = (tid >> 7) * 96 + obid(); if (it >= NG * 8) return;
  const int g = it >> 3, b = it & 7, dir = (tid >> 6) & 1, pp = tid & 63;
  const f32x2 aL = *(const f32x2*)(p.s[l].SAL + ((size_t)(g * 2 + dir) * 64 + pp) * 2);
  const float* S = p.SST + (size_t)g * NCHP * 256 + dir * 128 + 2 * pp; bf16_t* A = p.Ug + (size_t)g * NCHP * 768 + 512 + dir * 128 + 2 * pp;
  float hr = 0.f, hi = 0.f;
#pragma unroll 1
  for (int s0 = 0; s0 < 72; s0 += 24) {
    f32x2 sv[24];
#pragma unroll
    for (int k = 0; k < 24; ++k) { const int s = s0 + k; int row; if (dir == 0) row = s < 8 ? 512 + b * 8 + s : b * 64 + (s - 8); else row = s < 8 ? 512 + b * 8 + (7 - s) : b * 64 + (63 - (s - 8));
      sv[k] = *(const f32x2*)(S + (size_t)row * 256); }
#pragma unroll
    for (int k = 0; k < 24; ++k) { const int s = s0 + k; int row; if (dir == 0) row = s < 8 ? 512 + b * 8 + s : b * 64 + (s - 8); else row = s < 8 ? 512 + b * 8 + (7 - s) : b * 64 + (63 - (s - 8));
      *(unsigned*)(A + (size_t)row * 768) = cvt_pk_bf16(hr, hi);
      const float nr = aL.x * hr - aL.y * hi + sv[k].x, ni = aL.x * hi + aL.y * hr + sv[k].y; hr = nr; hi = ni; }
  }
}

struct ConvJob { const float* src; const float* src2; bf16_t* dst; int ldd, lds_, kind, nK; };
__device__ __forceinline__ void conv_step(const ConvJob& j, int nt, int kt, int lane) {
  const int q = lane & 15, kq = lane >> 4; const int n = nt * 64 + 4 * q, k0 = kt * 64 + kq * 8; const float* s = j.src; int col;
  if (j.kind == 0) col = (n & ~31) + perm32(n & 31);
  else if (j.kind == 1) { const int pn = n >> 8; if (pn < 4 || (pn >= 10 && pn < 14)) col = n; else if (pn < 10) col = (n & ~31) + perm32(n & 31);
    else { const int bj = (n >> 7) & 1, w = n & 127; col = (bj ? 4608 : 3584) + (pn - 14) * 128 + (w & ~31) + perm32(w & 31); } }
  else { const int bj = (n >> 7) & 1, w = n & 127; col = (n >> 8) * 128 + (w & ~31) + perm32(w & 31); if (bj) s = j.src2; }
  const float* sp = s + (size_t)k0 * j.lds_ + col; f32x4 v[16];
#pragma unroll
  for (int i = 0; i < 8; ++i) { v[i] = __builtin_nontemporal_load((const f32x4*)(sp + (size_t)i * j.lds_)); v[8 + i] = __builtin_nontemporal_load((const f32x4*)(sp + (size_t)(32 + i) * j.lds_)); }
  bf16_t* dp = j.dst + (size_t)n * j.ldd + k0;
#pragma unroll
  for (int r = 0; r < 4; ++r) {
    *(u32x4*)(dp + (size_t)r * j.ldd) = pack8((f32x4){v[0][r], v[1][r], v[2][r], v[3][r]}, (f32x4){v[4][r], v[5][r], v[6][r], v[7][r]});
    *(u32x4*)(dp + (size_t)r * j.ldd + 32) = pack8((f32x4){v[8][r], v[9][r], v[10][r], v[11][r]}, (f32x4){v[12][r], v[13][r], v[14][r], v[15][r]}); }
}
__device__ __forceinline__ void ssm_mats(KP p, KS W, int l, int g, int hf, LAS char* lds, const int g_wv) {
  const int tid = otid();
  LAS f32x2* AP = (LAS f32x2*)lds;
  LAS f32x2* BB = AP + 2 * 64 * 34;
  LAS f32x2* CC = BB + 2 * 64 * 16;
  LAS float* KT = (LAS float*)(CC + 2 * 16 * 64);
  LAS float* DS = KT + 32 * 260 + 256;
  const size_t so = (size_t)l * 2 * NG * NP;
  if (tid < 128) { const int dir = tid >> 6, pp = tid & 63; const size_t gp = so + ((size_t)dir * NG + g) * NP + pp;
    const float dtf = expf(p.in.log_dt[(size_t)l * 2 * NG + dir * NG + g]); const double are = p.in.a_re[gp], aim = p.in.a_im[gp], dt = (double)dtf;
    double ang = aim * dt; ang -= 6.283185307179586476925 * (double)(long long)(ang * 0.15915494309189533577 + (ang >= 0 ? 0.5 : -0.5));
    const float e1f = expf((float)(are * dt)), angf = (float)ang; const double c1r = (double)(e1f * cosf(angf)), c1i = (double)(e1f * sinf(angf));
    { float onef = 1.f; asm volatile("" : "+v"(onef)); double cr = (double)onef, ci = 0.0;
      for (int t = 0; t < 34; ++t) { AP[(dir * 64 + pp) * 34 + t] = (f32x2){(float)cr, (float)ci}; if (t == 32 && hf == 0) *(f32x2*)(W.SAL + ((size_t)(g * 2 + dir) * 64 + pp) * 2) = (f32x2){(float)cr, (float)ci}; const double nr2 = cr * c1r - ci * c1i, ni2 = cr * c1i + ci * c1r; cr = nr2; ci = ni2; } }
    const float sh = sinf(0.5f * angf); const double nr = (double)(expm1f((float)(are * dt)) * cosf(angf) - 2.f * sh * sh), ni = c1i, den = are * are + aim * aim; const double fr = (nr * are + ni * aim) / den, fi = (ni * are - nr * aim) / den;
    f32x4 brv[4], biv[4];
#pragma unroll
    for (int c = 0; c < 4; ++c) { brv[c] = *(const f32x4*)(p.in.b_re + gp * 16 + 4 * c); biv[c] = *(const f32x4*)(p.in.b_im + gp * 16 + 4 * c); }
#pragma unroll
    for (int c = 0; c < 16; ++c) { const double br = brv[c >> 2][c & 3], bi = biv[c >> 2][c & 3]; BB[(dir * 64 + pp) * 16 + c] = (f32x2){(float)(fr * br - fi * bi), (float)(fr * bi + fi * br)}; }
  }
  if (tid >= 496) DS[tid - 496] = p.in.ssm_d[l * SSMW + g * 16 + (tid - 496)];
  for (int i = tid; i < 2 * 16 * 64; i += 512) { const int dir = i >> 10, c = (i >> 6) & 15, pp = i & 63; const size_t ci = (so + ((size_t)dir * NG + g) * NP) * 16 + (size_t)c * NP + pp; CC[i] = (f32x2){p.in.c_re[ci], p.in.c_im[ci]}; }
  __syncthreads();
  LAS float* K0o = KT + 32 * 260;
  { const int half = tid >> 8, co = (tid >> 4) & 15, ci = tid & 15; float acc[16];
#pragma unroll
    for (int t = 0; t < 16; ++t) acc[t] = 0.f;
#pragma unroll 2
    for (int pp = 0; pp < 64; ++pp) { const f32x2 c = CC[(hf * 16 + co) * 64 + pp], bq = BB[(hf * 64 + pp) * 16 + ci];
      const LAS f32x4* ap = (const LAS f32x4*)(AP + (hf * 64 + pp) * 34) + half * 8; f32x4 a[8];
#pragma unroll
      for (int t2 = 0; t2 < 8; ++t2) a[t2] = ap[t2];
      __builtin_amdgcn_sched_barrier(0);
      const float cbr = c.x * bq.x - c.y * bq.y, cbi = c.x * bq.y + c.y * bq.x;
#pragma unroll
      for (int t2 = 0; t2 < 8; ++t2) { acc[2 * t2] += cbr * a[t2][0] - cbi * a[t2][1]; acc[2 * t2 + 1] += cbr * a[t2][2] - cbi * a[t2][3]; } }
#pragma unroll
    for (int t = 0; t < 16; ++t) KT[(half * 16 + t) * 260 + co * 16 + ci] = acc[t];
    if (tid < 256) { const int dir = 1 - hf; float s0 = 0.f;
      for (int pp = 0; pp < 64; ++pp) { const f32x2 c = CC[(dir * 16 + co) * 64 + pp], bq = BB[(dir * 64 + pp) * 16 + ci]; s0 += c.x * bq.x - c.y * bq.y; }
      K0o[co * 16 + ci] = s0; } }
  __syncthreads();
  bf16_t* Sm = W.Smat + (size_t)g * 256 * 768;
  for (int i = tid; i < 128 * 64; i += 512) { const int n = hf * 128 + (i >> 6), k8 = (i & 63) * 8; const int Lc = (n & ~31) + perm32(n & 31); const int dir = Lc >> 7, pp = (Lc & 127) >> 1, ri = Lc & 1; const int t = k8 >> 4, c0 = k8 & 15;
    const f32x2 a = AP[(dir * 64 + pp) * 34 + (dir == 0 ? 31 - t : t)]; float v[8];
#pragma unroll
    for (int q = 0; q < 8; ++q) { const f32x2 bq = BB[(dir * 64 + pp) * 16 + c0 + q]; v[q] = ri == 0 ? a.x * bq.x - a.y * bq.y : a.x * bq.y + a.y * bq.x; }
    *(u32x4*)(Sm + (size_t)n * 768 + k8) = pack8((f32x4){v[0], v[1], v[2], v[3]}, (f32x4){v[4], v[5], v[6], v[7]}); }
  bf16_t* To = W.TO + (size_t)g * 512 * 768;
#ifdef PROBE_G0
  if (p.pad0 & 16) { __syncthreads(); return; }
#endif
  for (int i = tid; i < 512 * 64; i += 512) { const int n = i >> 6, k8 = (i & 63) * 8; const int Lc = (n & ~31) + perm32(n & 31); const int t = Lc >> 4, co = Lc & 15; const int s = k8 >> 4, c0 = k8 & 15;
    if (hf == 0 ? s > t : s <= t) continue;
    const int tau = hf == 0 ? t - s : s - t; const LAS f32x4* kk = (const LAS f32x4*)(KT + tau * 260 + co * 16 + c0); f32x4 v0 = kk[0], v1 = kk[1];
    if (s == t) { const LAS f32x4* ko = (const LAS f32x4*)(K0o + co * 16 + c0); v0 += ko[0]; v1 += ko[1]; const float dv = DS[co]; const int qd = co - c0;
#pragma unroll
      for (int q = 0; q < 4; ++q) { if (qd == q) v0[q] += dv; if (qd == 4 + q) v1[q] += dv; } }
    *(u32x4*)(To + (size_t)n * 768 + k8) = pack8(v0, v1); }
  for (int i = tid; i < 512 * 16; i += 512) { const int n = i >> 4, k8 = 512 + hf * 128 + (i & 15) * 8; const int Lc = (n & ~31) + perm32(n & 31); const int t = Lc >> 4, co = Lc & 15;
    const int dir = hf, pp0 = (i & 15) * 4; float v[8];
#pragma unroll
    for (int q = 0; q < 4; ++q) { const f32x2 a = AP[(dir * 64 + pp0 + q) * 34 + (dir == 0 ? t + 1 : 32 - t)], c = CC[(dir * 16 + co) * 64 + pp0 + q];
      v[2 * q] = c.x * a.x - c.y * a.y; v[2 * q + 1] = -(c.x * a.y + c.y * a.x); }
    *(u32x4*)(To + (size_t)n * 768 + k8) = pack8((f32x4){v[0], v[1], v[2], v[3]}, (f32x4){v[4], v[5], v[6], v[7]}); }
  __syncthreads();
}
__device__ __forceinline__ void mod_item(KP p, int l, int j0, LAS char* lds, const int g_wv) {
  const int tid = otid(); LAS float* sl = (LAS float*)lds;
  LAS float* part = sl + 9 * 1024;
  for (int i = tid; i < 9 * 1024; i += 512) { const int r = i >> 10, k = i & 1023; const float v = r < 8 ? p.in.c[r * 1024 + k] : p.in.c_ctx[k]; sl[i] = v / (1.f + expf(-v)); }
  __syncthreads();
  const int jj = tid & 63, ks = tid >> 6; float acc[9];
#pragma unroll
  for (int r = 0; r < 9; ++r) acc[r] = 0.f;
  const float* w = p.in.w_mod + (size_t)l * 1024 * 6144 + j0 + jj;
  for (int k0 = ks * 128; k0 < ks * 128 + 128; k0 += 16) { float wv[16];
#pragma unroll
    for (int u = 0; u < 16; ++u) wv[u] = __builtin_nontemporal_load(w + (size_t)(k0 + u) * 6144);
    __builtin_amdgcn_sched_barrier(0);
#pragma unroll
    for (int r = 0; r < 9; ++r)
#pragma unroll
      for (int u4 = 0; u4 < 4; ++u4) { const f32x4 sv = *(const LAS f32x4*)(sl + r * 1024 + k0 + 4 * u4); acc[r] += sv[0] * wv[4 * u4] + sv[1] * wv[4 * u4 + 1] + sv[2] * wv[4 * u4 + 2] + sv[3] * wv[4 * u4 + 3]; } }
#pragma unroll
  for (int r = 0; r < 9; ++r) part[(ks * 9 + r) * 64 + jj] = acc[r];
  __syncthreads();
  for (int i = tid; i < 9 * 64; i += 512) { const int r = i >> 6, j = i & 63; float s = 0.f;
#pragma unroll
    for (int k = 0; k < 8; ++k) s += part[(k * 9 + r) * 64 + j];
    p.MOD[((size_t)l * 9 + r) * 6144 + j0 + j] = s + p.in.b_mod[l * 6144 + j0 + j]; }
  __syncthreads();
}
constexpr int CONV_NONMOE = 2112;
__device__ __forceinline__ void conv_steps(KP p, int lc, int s0, int s1, int gw, int nw, int lane) {
  for (int t0 = s0 + gw; t0 < s1; t0 += nw) { int t = t0; ConvJob j; int nK;
    const int l = lc + 1; if (l >= DEPTH) continue;
    KW W = p.w[l & 1];
    if (t < 1408) { j.src = p.in.w_in + (size_t)l * 1024 * INW; j.src2 = nullptr; j.dst = W.Win; j.ldd = 1024; j.lds_ = INW; j.kind = 1; nK = 16; }
    else if ((t -= 1408) < 64) { j.src = p.in.w_glu + (size_t)l * 512 * 512; j.src2 = nullptr; j.dst = W.Wglu; j.ldd = 512; j.lds_ = 512; j.kind = 0; nK = 8; }
    else if ((t -= 64) < 256) { j.src = p.in.w_pa + (size_t)l * 1024 * 1024; j.src2 = nullptr; j.dst = W.Wpa; j.ldd = 1024; j.lds_ = 1024; j.kind = 0; nK = 16; }
    else if ((t -= 256) < 128) { j.src = p.in.w_ps + (size_t)l * 512 * 1024; j.src2 = nullptr; j.dst = W.Wps; j.ldd = 1024; j.lds_ = 1024; j.kind = 0; nK = 8; }
    else if ((t -= 128) < 256) { j.src = p.in.w_o + (size_t)l * 1024 * 1024; j.src2 = nullptr; j.dst = W.Wo; j.ldd = 1024; j.lds_ = 1024; j.kind = 0; nK = 16; }
    else if ((t -= 256) < 8192) { const int e = t >> 8; t &= 255; j.src = p.in.w1 + ((size_t)l * NE + e) * 1024 * 512; j.src2 = p.in.w3 + ((size_t)l * NE + e) * 1024 * 512; j.dst = W.W13 + (size_t)e * 1024 * 1024; j.ldd = 1024; j.lds_ = 512; j.kind = 2; nK = 16; }
    else { t -= 8192; const int e = t >> 7; t &= 127; j.src = p.in.w2 + ((size_t)l * NE + e) * 512 * 1024; j.src2 = nullptr; j.dst = W.W2 + (size_t)e * 1024 * 512; j.ldd = 512; j.lds_ = 1024; j.kind = 0; nK = 8; }
    conv_step(j, t / nK, t % nK, lane); }
}
__device__ __forceinline__ void router_tab(KP p, KS W, int l, int tid) {
  bf16_t* Wh = (bf16_t*)W.WR; bf16_t* Wl = Wh + 64 * 1024;
  for (int q = tid; q < 64 * 1024; q += 512) { const int e = q >> 10, k = q & 1023; const float w = e < 4 ? p.in.rg_w[((size_t)l * 1024 + k) * 4 + e] : e < 36 ? p.in.re_w[((size_t)l * 1024 + k) * 32 + (e - 4)] : 0.f;
    const unsigned hi = cvt_pk_bf16(w, 0.f) & 0xffffu; const unsigned lo = cvt_pk_bf16(w - bflo(hi), 0.f) & 0xffffu; Wh[q] = (bf16_t)hi; Wl[q] = (bf16_t)lo; }
}
constexpr int CONV_STEPS = 14400, CONV_S1 = 2350, CONV_S2 = 2350, CONV_S3 = 2350, CONV_S4 = 3694;
__device__ __forceinline__ void conv_phase(KP p, int l, LAS char* lds, const int g_wv) {
  const int tid = otid(); const int b = obid(); const int nb = ogd();
#ifdef PROBE_G0
  const int pf = p.pad0;
  if (pf) { if (!(pf & 2)) { for (int it = b; it < ((pf & 8) ? 2 : 1) * DEPTH * 2 * NG; it += nb) { const int ls = (it >> 6) & 3, r = it & 63; ssm_mats(p, p.s[ls], ls, r >> 1, r & 1, lds, g_wv); } }
    if (!(pf & 4)) { for (int it = b; it < 4 * 96; it += nb) mod_item(p, it / 96, (it % 96) * 64, lds, g_wv); }
    if (!(pf & 1)) conv_steps(p, -1, 0, CONV_STEPS, b * 8 + (tid >> 6), nb * 8, tid & 63);
    return; }
#endif
  if (b & 1) { for (int it = b; it < DEPTH * 2 * NG; it += nb) { const int ls = it >> 6, r = it & 63; ssm_mats(p, p.s[ls], ls, r >> 1, r & 1, lds, g_wv); } }
  else conv_steps(p, -1, 0, CONV_STEPS, (b >> 1) * 8 + (tid >> 6), (nb >> 1) * 8 * 2, tid & 63);
  if (b < DEPTH) router_tab(p, p.s[b], b, tid);
  if (b == 4) { for (int q = tid; q < 2048 * 32; q += 512) { const int t = q >> 5, axis = (q >> 4) & 1, f = q & 15; const float pos = axis == 0 ? (float)(t >> 6) : (float)(t & 63);
      const float inv = 1.0f / powf(10000.0f, (float)(2 * f) / 32.0f); const float ang = pos * inv; p.ROPE[((size_t)t * 2 + axis) * 32 + f] = cosf(ang); p.ROPE[((size_t)t * 2 + axis) * 32 + 16 + f] = sinf(ang); } }
  for (int it = b; it < 4 * 96; it += nb) mod_item(p, it / 96, (it % 96) * 64, lds, g_wv);
  if (b & 1) conv_steps(p, -1, 0, CONV_STEPS, ((nb >> 1) + (b >> 1)) * 8 + (tid >> 6), (nb >> 1) * 8 * 2, tid & 63);
  else { for (int it = b; it < DEPTH * 2 * NG; it += nb) { const int ls = it >> 6, r = it & 63; ssm_mats(p, p.s[ls], ls, r >> 1, r & 1, lds, g_wv); } }
}
__device__ __forceinline__ void conv_tail(KP p, int l, int part, const int g_wv) {
  const int b = obid(); const int tid = otid();
  if (part == 2) { if (b >= 144) conv_steps(p, l, 0, CONV_S1, (b - 144) * 8 + (tid >> 6), (ogd() - 144) * 8, tid & 63); return; }
  if (part == 3) { if (b >= 192) conv_steps(p, l, CONV_S2, CONV_S3, (b - 192) * 8 + (tid >> 6), (ogd() - 192) * 8, tid & 63); return; }
  if (part == 4) { if (b >= 144) conv_steps(p, l, CONV_S3, CONV_S4, (b - 144) * 8 + (tid >> 6), (ogd() - 144) * 8, tid & 63); return; }
  if (b < 64) return;
  conv_steps(p, l, CONV_S4, CONV_STEPS, (b - 64) * 8 + (tid >> 6), (ogd() - 64) * 8, tid & 63);
}
}
namespace fk {
constexpr int LDS_BYTES = 149504;
#ifndef STAG_G1
#define STAG_G1 450
#endif
#ifndef PROBE_MASK
#define PROBE_MASK 0
#endif
constexpr int NPH = 14;
enum { PH_CONV = 0, PH_H0, PH_GEMM1, PH_S1, PH_S2, PH_S3, PH_ATT, PH_GLU, PH_MERGE, PH_WO, PH_LN1, PH_MOE1, PH_MOE2, PH_LN2 };

__device__ __forceinline__ void run_phase(KP p, int l, int ph, LAS unsigned char* lds, const int g_wv) {
  const int G = ogd(), c = obid(); const bool last = (l == DEPTH - 1);
  const float* MODl = p.MOD + (size_t)l * 9 * 6144; KW W = p.w[l & 1]; KS SS = p.s[l];
  switch (ph) {
    case PH_CONV: if (l == 0) conv_phase(p, l, (LAS char*)lds, g_wv); break;
    case PH_H0: if (l == 0) h0_phase(p, g_wv); break;
    case PH_GEMM1: { SchedG1 S{(const char*)p.Hb, (const char*)W.Win, G, c, 0, last ? 1488 : 1536, last};
      EpiIn E{p.ROPE, p.Kc, p.Vc, p.Ug, p.Qb, p.RG, p.GSb, ~0}; gemm_stream(lds, 2048, 2048, S, E, g_wv); } break;
    case PH_S1: { unsigned* sp = p.ctl + l * CTL_WORDS + CTL_XC + 3 * 272; volatile LAS unsigned* xst = (volatile LAS unsigned*)(lds + LDS_BYTES - 16);
      if (c < 96) { SchedSsm1 S{(const char*)p.Ug, (const char*)SS.Smat, 96, c}; EpiState E{p.SST}; gemm_stream(lds, 1536, 1536, S, E, g_wv); }
      split_arrive(p.bar, xst, sp, sp + 256);
      if (c < 96) { split_wait(p.bar, xst, sp + 256); s2_phase(p, l, g_wv); } }
      if (c < 96) { }
      else if (!last && c < 144) { SchedG1 S{(const char*)p.Hb, (const char*)W.Win, 48, c - 96, 1536, 1584, false}; EpiIn E{p.ROPE, p.Kc, p.Vc, p.Ug, p.Qb, p.RG, p.GSb, ~0}; gemm_stream(lds, 2048, 2048, S, E, g_wv); }
      else conv_tail(p, l, 2, g_wv);
      break;
    case PH_S2: break;
    case PH_S3: break;
    case PH_ATT: {
      if ((c >> 3) < 24) { SchedSsm3 S{(const char*)p.Ug, (const char*)SS.TO, 256, (c & 7) * 24 + (c >> 3)}; EpiSsmOut E{p.YG}; gemm_stream(lds, 1536, 1536, S, E, g_wv); __syncthreads(); }
      attn_phase(p, l, (LAS char*)lds, g_wv); } break;
    case PH_GLU: { SchedPlain S; S.A = (const char*)p.YG; S.B = (const char*)W.Wglu; S.lda = NR * 32; S.ldb = 1024; S.nM = last ? NLAT / 256 : NR / 256; S.nN = 2; S.nt = 8; S.G = G; S.c = c; S.nunits = S.nM * 2; S.epi = 1; S.atile = 256 * 32;
      EpiGlu E{p.YG, p.S2, p.in.b_glu + l * SSMW}; gemm_stream<EpiGlu, SchedPlain, false, 1>(lds, NR * 32, 1024, S, E, g_wv); } conv_tail(p, l, 4, g_wv); break;
    case PH_MERGE: {
      unsigned* tc = p.ctl + l * CTL_WORDS + CTL_TILE; volatile LAS unsigned* xst = (volatile LAS unsigned*)(lds + LDS_BYTES - 16);
#ifdef PROBE_G0
      const int pf = p.pad0;
      const int nmu = (pf & 4) ? 0 : ((!last && c < 32 && !(pf & 8)) ? 2 : 1);
#define PF_SKIP(b) (pf & (b))
#else
#define PF_SKIP(b) false
      const int nmu = (!last && c < 32) ? 2 : 1;
#endif
      for (int k = 0; k < nmu; ++k) { int pm, pn; if (k == 0) tile_order(c, 64, 4, pm, pn); else { pm = 64 + (c & 7); pn = c >> 3; }
        pm = __builtin_amdgcn_readfirstlane(pm); pn = __builtin_amdgcn_readfirstlane(pn);
        SchedMergeOne S{(const char*)p.ATTb, (const char*)W.Wpa, (const char*)p.S2, (const char*)W.Wps, pm, pn}; EpiMerge E{p.RG, p.GSb, p.Mb}; gemm_stream(lds, 2048, 2048, S, E, g_wv);
        if (k == 0) split_arrive(p.bar, xst, p.ctl + l * CTL_WORDS + CTL_XC, p.ctl + l * CTL_WORDS + CTL_DONE); else tile_signal(tc + pm * 16); }
      const bool cf = (c & 1);
      if (cf && !PF_SKIP(1)) conv_tail(p, l, 1, g_wv);
      const int nwu = PF_SKIP(2) ? 0 : ((!last && c >= 32 && c < 64 && !PF_SKIP(16)) ? 2 : 1);
      for (int k = 0; k < nwu; ++k) { int pm, pn;
        if (last) tile_order(c, 64, 4, pm, pn); else if (c < 32) { pm = 64 + (c & 7); pn = c >> 3; } else tile_order(k == 0 ? c - 32 : 192 + c, 64, 4, pm, pn);
        pm = __builtin_amdgcn_readfirstlane(pm); pn = __builtin_amdgcn_readfirstlane(pn);
        if (pm >= 64) tile_wait(tc + pm * 16, 4u, p.bar); else if (k == 0) split_wait(p.bar, xst, p.ctl + l * CTL_WORDS + CTL_DONE);
        SchedPlainOne S{(const char*)p.Mb, (const char*)W.Wo, 16, pm, pn};
        EpiWo E{p.ATTb, MODl}; gemm_stream(lds, 2048, 2048, S, E, g_wv); }
      if (!cf && !PF_SKIP(1)) conv_tail(p, l, 1, g_wv); } break;
#undef PF_SKIP
    case PH_WO: break;
    case PH_LN1: ln1_phase(p, l, (LAS char*)lds, g_wv); break;
    case PH_MOE1: {
      LAS MoeTab* tab = (LAS MoeTab*)(lds + STAGE_BYTES); moe_table(p, l, tab, g_wv);
      const int nU = __builtin_amdgcn_readfirstlane(tab->ntiles) * 4, R = nU >> 8, rem = nU & 255;
      const int cc = ((c & 7) << 5) | (c >> 3);
      const int r2 = cc >= rem ? cc - rem : cc + 256 - rem;
      unsigned* sp = p.ctl + l * CTL_WORDS + CTL_XC + 272; volatile LAS unsigned* xst = (volatile LAS unsigned*)(lds + LDS_BYTES - 16);
      for (int st = 0; st < 2; ++st) {
        { SchedMoe S{(const char*)p.H2b, (const char*)W.W13, 2048, 2048, (size_t)1024 * 2048, tab, p.TOK, 4, 16, G, cc, true, st ? R : 0, st ? R + 1 : R}; EpiMoe1 E{p.Hm}; gemm_stream<EpiMoe1, SchedMoe, true>(lds, 2048, 2048, S, E, g_wv); }
        split_arrive(p.bar, xst, sp + st * 272, sp + st * 272 + 256); }
      for (int st = 0; st < 2; ++st) { if (st && r2 >= rem) break;
        split_wait(p.bar, xst, sp + st * 272 + 256);
        SchedMoe S{(const char*)p.Hm, (const char*)W.W2, 1024, 1024, (size_t)1024 * 1024, tab, p.TOK, 4, 8, G, r2, false, st ? R : 0, st ? R + 1 : R}; EpiMoe2 E{p.Yo}; gemm_stream(lds, 1024, 1024, S, E, g_wv); } } break;
    case PH_MOE2: break;
    case PH_LN2: ln2_phase(p, l, (LAS char*)lds, g_wv); break;
#if PROBE_MASK
    case 15: { SchedG1 S{(const char*)p.Hb, (const char*)W.Win, G, c, 0, 1536, false}; EpiIn E{p.ROPE, p.Kc, p.Vc, p.Ug, p.Qb, p.RG, p.GSb, 0}; gemm_stream(lds, 2048, 2048, S, E, g_wv); } break;
    case 16: { SchedG1 S{(const char*)p.Hb, (const char*)W.Win, G, c, 0, 1536, false}; EpiMoe2 E{p.Yo}; gemm_stream(lds, 2048, 2048, S, E, g_wv); } break;
    case 17: { SchedG1 S{(const char*)p.Hb, (const char*)W.Win, G, c, 0, 1536, false}; EpiLin E{p.Yo}; gemm_stream(lds, 2048, 2048, S, E, g_wv); } break;
    case 18: { SchedG1 S{(const char*)p.Hb, (const char*)W.Win, G, c, 0, 1536, false}; EpiLinT<8> E{p.Yo}; gemm_stream(lds, 2048, 2048, S, E, g_wv); } break;
    case 19: { SchedG1 S{(const char*)p.Hb, (const char*)W.Win, G, c, 0, 1536, false}; EpiLinT<2> E{p.Yo}; gemm_stream(lds, 2048, 2048, S, E, g_wv); } break;
    case 20: attn_phase<1>(p, l, (LAS char*)lds, g_wv); break;
    case 21: attn_phase<2>(p, l, (LAS char*)lds, g_wv); break;
    case 22: attn_phase<3>(p, l, (LAS char*)lds, g_wv); break;
    case 14: { SchedG1 S{(const char*)p.Hb, (const char*)W.Win, G, c, 0, 1536, false}; EpiNone E; gemm_stream(lds, 2048, 2048, S, E, g_wv); } break;
#endif
  }
}

__global__ void __launch_bounds__(512, 2) mega(Params p) {
  extern __shared__ __attribute__((aligned(16))) unsigned char smem[];
  LAS unsigned char* lds = (LAS unsigned char*)smem;
  LAS unsigned* xbw = (LAS unsigned*)(lds + LDS_BYTES - 16);
  if (threadIdx.x == 0) { xbw[0] = 0u; xbw[1] = 0u; xbw[2] = 0u; xbw[3] = 0u; }
  __syncthreads();
  XcdBarrier bar = xcd_barrier_post(p.bar, (volatile LAS unsigned*)xbw);
  const int ph_lo = p.ph_lo, ph_hi = p.ph_hi; const int g_wv = __builtin_amdgcn_readfirstlane((int)threadIdx.x >> 6);
#if PROBE_MASK
  if (ph_lo >= 1000) { run_phase(*(const __attribute__((address_space(4))) Params*)__builtin_amdgcn_kernarg_segment_ptr(), 1, ph_lo - 1000, lds, g_wv); return; }
#endif
  for (int l = 0; l < DEPTH; ++l) {
#define PHASE(ID) do { const int gph = l * NPH + (ID); if (gph >= ph_lo && gph < ph_hi && !(((ID) == PH_H0 || (ID) == PH_CONV) && l > 0)) { \
      const __attribute__((address_space(4))) Params* kp = (const __attribute__((address_space(4))) Params*)__builtin_amdgcn_kernarg_segment_ptr(); int lv = l; int wvp = g_wv; \
      asm volatile("" : "+s"(kp), "+s"(lv), "+s"(wvp));     \
      run_phase(*kp, lv, (ID), lds, wvp); if (gph + 1 < ph_hi) xcd_barrier(bar); } } while (0)
    PHASE(PH_CONV); PHASE(PH_H0); PHASE(PH_GEMM1); PHASE(PH_S1); PHASE(PH_ATT); PHASE(PH_GLU); PHASE(PH_MERGE);
    PHASE(PH_LN1); PHASE(PH_MOE1); PHASE(PH_LN2);
#undef PHASE
  }
}

struct Host { Params p; size_t ws_used; };
inline size_t al256(size_t x) { return (x + 255) & ~(size_t)255; }
inline Host make_params(void* const* d_in, void* d_out, void* d_ws) {
  Host H; memset(&H, 0, sizeof(H)); Params& p = H.p;
  const float** ip = (const float**)&p.in; for (int i = 0; i < 36; ++i) ip[i] = (const float*)d_in[i];
  p.out = (float*)d_out;
  char* base = (char*)d_ws; size_t off = 0;
  auto take = [&](size_t bytes) { char* r = base + off; off = al256(off + bytes); return r; };
  p.bar = (unsigned*)take(XCD_BAR_WORDS * 4); p.ctl = (unsigned*)take((size_t)DEPTH * CTL_WORDS * 4);
  p.MOD = (float*)take((size_t)DEPTH * 9 * 6144 * 4); p.ROPE = (float*)take((size_t)2048 * 64 * 4);
  p.ROUTE = (int*)take((size_t)NR * 4 * 4); p.RW = (float*)take((size_t)NR * 2 * 4); p.TOK = (int*)take((size_t)NE * NR * 4);
  p.XL = (float*)take((size_t)NR * D * 4); p.X1b = (bf16_t*)take((size_t)NR * D * 2); p.Hb = (bf16_t*)take((size_t)NR * D * 2); p.H2b = (bf16_t*)take((size_t)NR * D * 2); p.Mb = (bf16_t*)take((size_t)NR * D * 2);
  for (int k = 0; k < 4; ++k) { SSet& w = p.s[k]; w.SAL = (float*)take((size_t)NG * 2 * 64 * 2 * 4); w.WR = (float*)take((size_t)2 * 64 * 1024 * 2);
    w.Smat = (bf16_t*)take((size_t)NG * 256 * 768 * 2); w.TO = (bf16_t*)take((size_t)NG * 512 * 768 * 2); }
  for (int k = 0; k < 2; ++k) { WSet& w = p.w[k];
    w.Win = (bf16_t*)take((size_t)INW * 1024 * 2); w.Wglu = (bf16_t*)take((size_t)512 * 512 * 2); w.Wpa = (bf16_t*)take((size_t)1024 * 1024 * 2); w.Wps = (bf16_t*)take((size_t)1024 * 1024 * 2);
    w.Wo = (bf16_t*)take((size_t)1024 * 1024 * 2); w.W13 = (bf16_t*)take((size_t)NE * 1024 * 1024 * 2); w.W2 = (bf16_t*)take((size_t)NE * 1024 * 512 * 2); }
  const size_t mix0 = off;
  p.Kc = (bf16_t*)take((size_t)NB * KVB * D * 2); p.Vc = (bf16_t*)take((size_t)NB * KVB * D * 2); p.Qb = (bf16_t*)take((size_t)NR * D * 2);
  p.Ug = (bf16_t*)take((size_t)NG * NCHP * 768 * 2 + 4096); p.RG = (bf16_t*)take((size_t)NR * D * 2); p.GSb = (bf16_t*)take((size_t)NR * D * 2); p.ATTb = (bf16_t*)take((size_t)NR * D * 2);
  p.SST = (float*)take((size_t)NG * NCHP * 256 * 4); p.YG = (bf16_t*)take((size_t)NR * SSMW * 2); p.S2 = (bf16_t*)take((size_t)NR * D * 2);
  const size_t mix1 = off; off = mix0;
  p.Hm = (bf16_t*)take((size_t)MOE_ROWS * EH * 2); p.Yo = (bf16_t*)take((size_t)MOE_ROWS * D * 2);
  if (off < mix1) off = mix1;
  H.ws_used = off; p.ph_lo = 0; p.ph_hi = DEPTH * NPH; p.pad0 = 0; p.pad1 = 0;
  return H;
}
inline int grid_size() {
  static int grid = 0;
  if (!grid) { hipFuncSetAttribute((const void*)mega, hipFuncAttributeMaxDynamicSharedMemorySize, LDS_BYTES);
    int dev = 0, cus = 0, per_cu = 0; hipGetDevice(&dev); hipDeviceGetAttribute(&cus, hipDeviceAttributeMultiprocessorCount, dev);
    hipOccupancyMaxActiveBlocksPerMultiprocessor(&per_cu, mega, 512, LDS_BYTES);
    grid = (per_cu >= 1 && cus >= 256) ? 256 : 0;
    if (!grid) fprintf(stderr, "mega: cannot be resident (cus %d per_cu %d)\n", cus, per_cu); }
  return grid;
}
inline void launch_range(Host& H, int lo, int hi, hipStream_t st) {
  const int grid = grid_size(); if (!grid) return;
  H.p.ph_lo = lo; H.p.ph_hi = hi;
  hipLaunchKernelGGL(mega, dim3(grid), dim3(512), LDS_BYTES, st, H.p);
}
}
#ifndef PROBE_K
#define PROBE_K 8
#endif
extern "C" void kernel_launch(void* const* d_in, const int* in_sizes, int n_in, void* d_out, int out_size, void* d_ws, size_t ws_size, hipStream_t stream) {
  fk::Host H = fk::make_params(d_in, d_out, d_ws);
  if (H.ws_used > ws_size) { fprintf(stderr, "ws too small: need %zu have %zu\n", H.ws_used, ws_size); return; }
  hipMemsetAsync(H.p.bar, 0, (size_t)((char*)H.p.MOD - (char*)H.p.bar), stream);
  fk::launch_range(H, 0, fk::DEPTH * fk::NPH, stream);
#if PROBE_MASK
  for (int id = 0; id < 24; ++id) if ((PROBE_MASK >> id) & 1) { const int g = id >= fk::NPH ? 1000 + id : fk::NPH + id;
    for (int k = 0; k < PROBE_K; ++k) { hipMemsetAsync(H.p.bar, 0, XCD_BAR_WORDS * 4, stream); fk::launch_range(H, g, g + 1, stream); } }
#endif
#ifdef PROBE_G0
#ifdef PROBE_PF
  H.p.pad0 = PROBE_PF;
#endif
  for (int k = 0; k < PROBE_K; ++k) { hipMemsetAsync(H.p.bar, 0, XCD_BAR_WORDS * 4, stream); fk::launch_range(H, PROBE_G0, PROBE_G0 + 1, stream); }
#endif
}
```

```cpp
#include <hip/hip_runtime.h>
#include <cstdio>
#include <cstdint>
#include <cstring>
#include <cmath>
namespace fk {
#define LAS __attribute__((address_space(3)))
typedef unsigned short bf16_t;
typedef short bf16x8 __attribute__((ext_vector_type(8)));
typedef short s16x4 __attribute__((ext_vector_type(4)));
typedef float f32x4 __attribute__((ext_vector_type(4)));
typedef float f32x2 __attribute__((ext_vector_type(2)));
typedef float f32x16 __attribute__((ext_vector_type(16)));
typedef unsigned u32x4 __attribute__((ext_vector_type(4)));
typedef unsigned u32x2 __attribute__((ext_vector_type(2)));

constexpr int D = 1024, SEQ = 2048, CTX = 256, NB = 8, NLAT = NB * SEQ, NCTX = NB * CTX, NR = NLAT + NCTX, KVB = SEQ + CTX;
constexpr int INW = 5632, NHEAD = 8, SSMW = 512, NG = 32, NP = 64, NE = 32, EH = 512, DEPTH = 4;
constexpr int CHUNK = 32, NCHR = NR / CHUNK  , NCHP = 768  ;
constexpr int MOE_ROWS = 2 * NR + NE * 256;
constexpr float ALPHA = 1.681792830507429f;

__device__ __forceinline__ unsigned cvt_pk_bf16(float lo, float hi) { unsigned r; asm volatile("v_cvt_pk_bf16_f32 %0, %1, %2" : "=v"(r) : "v"(lo), "v"(hi)); return r; }
__device__ __forceinline__ float bf2f(unsigned short b) { return __uint_as_float(((unsigned)b) << 16); }
__device__ __forceinline__ float bflo(unsigned w) { return __uint_as_float(w << 16); }
__device__ __forceinline__ float bfhi(unsigned w) { return __uint_as_float(w & 0xffff0000u); }
typedef _Float16 h16x2 __attribute__((ext_vector_type(2)));
__device__ __forceinline__ unsigned pk_h16(float lo, float hi) { h16x2 h; h[0] = (_Float16)lo; h[1] = (_Float16)hi; return __builtin_bit_cast(unsigned, h); }
__device__ __forceinline__ float h16lo(unsigned w) { return (float)__builtin_bit_cast(h16x2, w)[0]; }
__device__ __forceinline__ float h16hi(unsigned w) { return (float)__builtin_bit_cast(h16x2, w)[1]; }
__device__ __forceinline__ u32x4 pack8(const f32x4& a, const f32x4& b) { u32x4 w; w.x = cvt_pk_bf16(a[0], a[1]); w.y = cvt_pk_bf16(a[2], a[3]); w.z = cvt_pk_bf16(b[0], b[1]); w.w = cvt_pk_bf16(b[2], b[3]); return w; }
__device__ __forceinline__ void unpack8(const u32x4& w, f32x4& a, f32x4& b) { a = (f32x4){bflo(w.x), bfhi(w.x), bflo(w.y), bfhi(w.y)}; b = (f32x4){bflo(w.z), bfhi(w.z), bflo(w.w), bfhi(w.w)}; }
__device__ __forceinline__ float fast_sigmoid(float x) { return __builtin_amdgcn_rcpf(1.f + __builtin_amdgcn_exp2f(-1.4426950408889634f * x)); }
__device__ __forceinline__ float fast_silu(float x) { return x * fast_sigmoid(x); }
__device__ __forceinline__ float gelu_tanh_f(float x) { const float z = 0.7978845608028654f * (x + 0.044715f * x * x * x); return x * fast_sigmoid(2.f * z); }
__device__ __forceinline__ int otid_w(int wv) { int t; asm volatile("v_mbcnt_lo_u32_b32 %0, -1, 0\n\tv_mbcnt_hi_u32_b32 %0, -1, %0\n\tv_lshl_add_u32 %0, %1, 6, %0" : "=&v"(t) : "s"(wv)); return t; }
__device__ __forceinline__ float ozero() { float z = 0.f; asm volatile("" : "+v"(z)); return z; }
__device__ __forceinline__ void stagger_wait(int ticks) { if (ticks > 0) { const unsigned long long t0 = __builtin_amdgcn_s_memrealtime(); while ((long long)(__builtin_amdgcn_s_memrealtime() - t0) < (long long)ticks) __builtin_amdgcn_s_sleep(8); } }
__device__ __forceinline__ int obid() { int b = blockIdx.x; asm volatile("" : "+s"(b)); return b; }
__device__ __forceinline__ int ogd() { int g = gridDim.x; asm volatile("" : "+s"(g)); return g; }
#define otid() otid_w(g_wv)
template <int CTRL, int RM> __device__ __forceinline__ float dpp_f(float v) { return __builtin_bit_cast(float, __builtin_amdgcn_update_dpp(0, __builtin_bit_cast(int, v), CTRL, RM, 0xF, false)); }
__device__ __forceinline__ float wave_sum_u(float v) {
  v += dpp_f<0xB1, 0xF>(v); v += dpp_f<0x4E, 0xF>(v); v += dpp_f<0x141, 0xF>(v); v += dpp_f<0x140, 0xF>(v); v += dpp_f<0x142, 0xA>(v); v += dpp_f<0x143, 0xC>(v);
  return __builtin_bit_cast(float, __builtin_amdgcn_readlane(__builtin_bit_cast(int, v), 63)); }
__host__ __device__ __forceinline__ int perm32(int rho) { const int n = rho >> 4, i = rho & 15; return 8 * (i >> 2) + 4 * n + (i & 3); }

#define XB_TMO      128
#define XB_XCNT(j)  (256  + 64 * (j))
#define XB_XSUB(j)  (1280 + 64 * (j))
#define XB_XGEN(j)  (2304 + 64 * (j))
#define XB_TOP      3328
#define XB_TOPGEN   3392
#define XCD_BAR_WORDS 3456
#define XB_SPIN_CAP (1u << 22)
__device__ __forceinline__ unsigned xb_ld(unsigned* p)              { return __hip_atomic_load(p, __ATOMIC_RELAXED, __HIP_MEMORY_SCOPE_AGENT); }
__device__ __forceinline__ unsigned xb_add(unsigned* p, unsigned v) { return __hip_atomic_fetch_add(p, v, __ATOMIC_RELAXED, __HIP_MEMORY_SCOPE_AGENT); }
__device__ __forceinline__ unsigned xb_xcc_id() { return (unsigned)__builtin_amdgcn_s_getreg((3 << 11) | 20) & 0xFu; }
#define XB_SPIN(cond, bar) do { unsigned _sp = 0; while (cond) { __builtin_amdgcn_s_sleep(1); \
    if ((++_sp & 255u) == 0u) { if (xb_ld(&(bar)[XB_TMO])) break; if (_sp > XB_SPIN_CAP) { atomicAdd(&(bar)[XB_TMO], 1u); break; } } } } while (0)
struct XcdBarrier { unsigned* bar; unsigned x; volatile LAS unsigned* st; };
__device__ __forceinline__ XcdBarrier xcd_barrier_post(unsigned* bar, volatile LAS unsigned* st) {
    XcdBarrier b; b.bar = bar; b.x = xb_xcc_id(); b.st = st;
    if (threadIdx.x == 0) (void)xb_add(&bar[XB_XCNT(b.x)], 1u);
    return b;
}
__device__ __forceinline__ void xcd_barrier_complete(unsigned* bar, unsigned x, unsigned& nloc, unsigned& nx) {
    const unsigned G = gridDim.x * gridDim.y * gridDim.z;
    unsigned sum, cnt, mine, sp = 0u;
    for (;;) {
        sum = 0u; cnt = 0u; mine = 0u;
#pragma unroll
        for (unsigned j = 0; j < 16; ++j) { const unsigned c = xb_ld(&bar[XB_XCNT(j)]); sum += c; cnt += (c > 0u) ? 1u : 0u; mine = (j == x) ? c : mine; }
        if (sum == G) break;
        __builtin_amdgcn_s_sleep(1);
        if ((++sp & 255u) == 0u) { if (xb_ld(&bar[XB_TMO])) break; if (sp > XB_SPIN_CAP) { atomicAdd(&bar[XB_TMO], 1u); break; } }
    }
    nloc = mine > 0u ? mine : 1u; nx = cnt > 0u ? cnt : 1u;
}
__device__ __forceinline__ void xcd_barrier(const XcdBarrier& b) {
    asm volatile("s_waitcnt vmcnt(0)" ::: "memory");
    __syncthreads();
    if (threadIdx.x == 0) {
        unsigned* bar = b.bar;
        __builtin_amdgcn_s_waitcnt(0);
        unsigned nloc = b.st[0], nx = b.st[1];
        if (nloc == 0u) { xcd_barrier_complete(bar, b.x, nloc, nx); b.st[0] = nloc; b.st[1] = nx; }
        const unsigned old = xb_add(&bar[XB_XSUB(b.x)], 1u);
        const unsigned gen = old / nloc;
        if (old + 1u == (gen + 1u) * nloc) {
            __builtin_amdgcn_fence(__ATOMIC_RELEASE, "agent");
            asm volatile("s_waitcnt vmcnt(0)" ::: "memory");
            const unsigned og = xb_add(&bar[XB_TOP], 1u);
            const unsigned tg = og / nx;
            if (og + 1u == (tg + 1u) * nx) xb_add(&bar[XB_TOPGEN], 1u);
            else XB_SPIN(xb_ld(&bar[XB_TOPGEN]) == tg, bar);
            __builtin_amdgcn_fence(__ATOMIC_ACQUIRE, "agent");
            asm volatile("s_waitcnt vmcnt(0)" ::: "memory");
        } else {
            XB_SPIN(xb_ld(&bar[XB_TOPGEN]) == gen, bar);
            __builtin_amdgcn_fence(__ATOMIC_ACQUIRE, "agent");
            asm volatile("s_waitcnt vmcnt(0)" ::: "memory");
        }
    }
    __syncthreads();
}

__device__ __forceinline__ void tile_signal(unsigned* cnt) {
    asm volatile("s_waitcnt vmcnt(0)" ::: "memory");
    __syncthreads();
    if (threadIdx.x == 0) { __builtin_amdgcn_fence(__ATOMIC_RELEASE, "agent"); asm volatile("s_waitcnt vmcnt(0)" ::: "memory"); (void)xb_add(cnt, 1u); }
}
__device__ __forceinline__ void tile_wait(unsigned* cnt, unsigned target, unsigned* bar) {
#ifdef NO_ACQ
    if (threadIdx.x == 0) { XB_SPIN(xb_ld(cnt) < target, bar); asm volatile("s_waitcnt vmcnt(0)" ::: "memory"); }
#else
    if (threadIdx.x == 0) { XB_SPIN(xb_ld(cnt) < target, bar); __builtin_amdgcn_fence(__ATOMIC_ACQUIRE, "agent"); asm volatile("s_waitcnt vmcnt(0)" ::: "memory"); }
#endif
    __syncthreads();
}

__device__ __forceinline__ void split_arrive(unsigned* bar, volatile LAS unsigned* st, unsigned* xc, unsigned* done) {
    asm volatile("s_waitcnt vmcnt(0)" ::: "memory");
    __syncthreads();
    if (threadIdx.x == 0) {
        const unsigned x = xb_xcc_id(); unsigned nloc = st[0], nx = st[1];
        if (nloc == 0u) { xcd_barrier_complete(bar, x, nloc, nx); st[0] = nloc; st[1] = nx; }
        const unsigned old = xb_add(&xc[x * 16], 1u);
        if (old + 1u == nloc) { __builtin_amdgcn_fence(__ATOMIC_RELEASE, "agent"); asm volatile("s_waitcnt vmcnt(0)" ::: "memory"); (void)xb_add(done, 1u); }
    }
}
__device__ __forceinline__ void split_wait(unsigned* bar, volatile LAS unsigned* st, unsigned* done) {
    if (threadIdx.x == 0) { const unsigned nx = st[1]; XB_SPIN(xb_ld(done) < nx, bar); __builtin_amdgcn_fence(__ATOMIC_ACQUIRE, "agent"); asm volatile("s_waitcnt vmcnt(0)" ::: "memory"); }
    __syncthreads();
}

constexpr int BM = 256, BK = 64, HALF = 128, HTB = HALF * BK * 2, STAGE_BYTES = 8 * HTB;
__host__ __device__ __forceinline__ int lds_byte(int r, int c) { const int st = (r >> 4) * 2 + (c >> 5), rr = r & 15, cc = c & 31, ob = rr * 64 + cc * 2; return st * 1024 + (ob ^ (((ob >> 9) & 1) << 5)); }
__host__ __device__ __forceinline__ void stage_rc(int b, int& R, int& C) { const int st = b / 1024, sb = b % 1024, swz = sb ^ (((sb >> 9) & 1) << 5); R = (st >> 1) * 16 + swz / 64; C = (st & 1) * 32 + (swz % 64) / 2; }
struct Seg { const char* A; const char* B; int nt; int epi; int pm; int pn; int aux; int aux2; };
__device__ __forceinline__ void tile_order(int L, int nM, int nN, int& pm, int& pn) {
    const int nwg = nM * nN; int wgid = L; { const int q = nwg / 8, r = nwg % 8, xcd = wgid % 8, off = wgid / 8; wgid = (xcd < r ? xcd * (q + 1) : r * (q + 1) + (xcd - r) * q) + off; }
    const int nig = 8 * nN, gid = wgid / nig, fm = gid * 8, gsz = (nM - fm) < 8 ? (nM - fm) : 8;
    pm = fm + ((wgid % nig) % gsz); pn = (wgid % nig) / gsz;
}
#ifndef GEMM_8PH
#define GEMM_8PH 0
#endif
template <class Epi, class Sched, bool GATHER = false, int AMODE = 0>
__device__ __forceinline__ void gemm_stream(LAS unsigned char* lds, const int lda, const int ldb, const Sched& S, const Epi& E, const int g_wv) {
    const int tid = otid(), wid = __builtin_amdgcn_readfirstlane(tid >> 6), lane = tid & 63, wr = wid >> 2, wc = wid & 3, fr = lane & 15, fq = lane >> 4;
    unsigned voffA[2], voffB[2];
#pragma unroll
    for (int i = 0; i < 2; ++i) { int R, C; stage_rc(tid * 16 + i * 8192, R, C); voffA[i] = AMODE == 1 ? (unsigned)((C >> 4) * lda + R * 32 + (C & 15) * 2) : (unsigned)(R * lda + C * 2); voffB[i] = (unsigned)(R * ldb + C * 2); }
    LAS unsigned* gst = (LAS unsigned*)(lds + STAGE_BYTES + 8192) + tid * 4;
    unsigned gCb = 0; if constexpr (GATHER) { int R_, C_; stage_rc(tid * 16, R_, C_); gCb = (unsigned)(C_ * 2); }
#define PG8_GV(slot, seg) do { int _R, _C; stage_rc(otid() * 16, _R, _C); const unsigned _g0 = S.grow(seg, _R), _g1 = S.grow(seg, _R + 64), _g2 = S.grow(seg, HALF + _R), _g3 = S.grow(seg, HALF + _R + 64); \
        gst[(slot) * 2] = _g0 | (_g1 << 16); gst[(slot) * 2 + 1] = _g2 | (_g3 << 16); } while (0)
    const size_t kstep = (size_t)(BK * 2), kstepA = AMODE == 1 ? (size_t)4 * lda : kstep;
    const size_t hstepA = AMODE == 1 ? (size_t)HALF * 32 : (size_t)HALF * lda, hstepB = (size_t)HALF * ldb;
    const unsigned ldsw = (unsigned)wid * 1024u;
    const int aoff = lds_byte(wr * 64 + fr, fq * 8), boff = lds_byte(wc * 32 + fr, fq * 8);
#define PG8_SA(b, h) (((b) * 2 + (h)) * HTB)
#define PG8_SB(b, h) ((4 + (b) * 2 + (h)) * HTB)
#define PG8_STAGE(bufoff, gbase, voff) do { _Pragma("unroll") for (int _i = 0; _i < 2; ++_i) \
        __builtin_amdgcn_global_load_lds((const unsigned*)((const char*)(gbase) + (voff)[_i]), (LAS unsigned*)(lds + (bufoff) + ldsw + _i * 8192), 16, 0, 0); } while (0)
#define PG8_LDA(dst, b, h) do { _Pragma("unroll") for (int m = 0; m < 4; ++m) _Pragma("unroll") for (int k = 0; k < 2; ++k) dst[m][k] = *(const LAS bf16x8*)(lds + PG8_SA(b, h) + aoff + m * 2048 + k * 1024); } while (0)
#define PG8_LDB(dst, b, h) do { _Pragma("unroll") for (int n = 0; n < 2; ++n) _Pragma("unroll") for (int k = 0; k < 2; ++k) dst[n][k] = *(const LAS bf16x8*)(lds + PG8_SB(b, h) + boff + n * 2048 + k * 1024); } while (0)
#define PG8_MMA(ai, bj, At, Bt) do { __builtin_amdgcn_s_setprio(1); _Pragma("unroll") for (int m = 0; m < 4; ++m) _Pragma("unroll") for (int n = 0; n < 2; ++n) _Pragma("unroll") for (int k = 0; k < 2; ++k) \
        acc[ai][bj][m][n] = __builtin_amdgcn_mfma_f32_16x16x32_bf16(Bt[n][k], At[m][k], acc[ai][bj][m][n], 0, 0, 0); __builtin_amdgcn_s_setprio(0); } while (0)
#define PG8_WAIT_V(n) asm volatile("s_waitcnt vmcnt(" #n ")" ::: "memory")
#define PG8_WAIT_L(n) asm volatile("s_waitcnt lgkmcnt(" #n ")" ::: "memory")
#define PG8_BAR __builtin_amdgcn_s_barrier()
#define PG8_SCHED __builtin_amdgcn_sched_barrier(0)
    Seg cur, nxt; int ui = 0;
    if (!S.next(0, cur)) return;
    f32x4 acc[2][2][4][2];
#pragma unroll
    for (int a = 0; a < 2; ++a)
#pragma unroll
        for (int b = 0; b < 2; ++b)
#pragma unroll
            for (int m = 0; m < 4; ++m)
#pragma unroll
                for (int n = 0; n < 2; ++n) acc[a][b][m][n] = (f32x4){0.f, 0.f, 0.f, 0.f};
    bf16x8 At[4][2], B0[2][2], B1[2][2];
    const char* cA = cur.A; const char* cB = cur.B;
    if constexpr (GATHER) { PG8_GV(0, cur); gst[2] = gst[0]; gst[3] = gst[1]; }
#define PG8_STAGE_A(bufoff, kbase, h, usenext) do { if constexpr (GATHER) { const unsigned _p = gst[((usenext) ? 2 : 0) + (h)]; unsigned _v[2] = {(_p & 0xffffu) * (unsigned)lda + gCb, (_p >> 16) * (unsigned)lda + gCb}; PG8_STAGE(bufoff, kbase, _v); } \
        else { PG8_STAGE(bufoff, (kbase) + (h) * hstepA, voffA); } } while (0)
#if GEMM_8PH
    PG8_STAGE(PG8_SB(0, 0), cB, voffB); PG8_STAGE_A(PG8_SA(0, 0), cA, 0, false); PG8_STAGE(PG8_SB(0, 1), cB + hstepB, voffB); PG8_STAGE_A(PG8_SA(0, 1), cA, 1, false);
    if (wr == 1) PG8_BAR;
    PG8_WAIT_V(4); PG8_BAR;
    PG8_STAGE(PG8_SB(1, 0), cB + kstep, voffB); PG8_STAGE_A(PG8_SA(1, 0), cA + kstepA, 0, false); PG8_STAGE(PG8_SB(1, 1), cB + hstepB + kstep, voffB);
    PG8_WAIT_V(6); PG8_BAR;
#else
    PG8_STAGE(PG8_SB(0, 0), cB, voffB); PG8_STAGE(PG8_SB(0, 1), cB + hstepB, voffB); PG8_STAGE_A(PG8_SA(0, 0), cA, 0, false); PG8_STAGE_A(PG8_SA(0, 1), cA, 1, false);
    if (wr == 1) PG8_BAR;
    PG8_WAIT_V(2); PG8_BAR;
    PG8_STAGE(PG8_SB(1, 0), cB + kstep, voffB); PG8_STAGE_A(PG8_SA(1, 0), cA + kstepA, 0, false); PG8_STAGE(PG8_SB(1, 1), cB + hstepB + kstep, voffB);
    PG8_WAIT_V(6); PG8_BAR;
#endif
    for (;;) {
        const bool has_next = S.next(ui + 1, nxt);
        const char* nA = has_next ? nxt.A : cA; const char* nB = has_next ? nxt.B : cB;
        const int nt = cur.nt;
        for (int t = 0; t < nt; t += 2) {
            const bool last = (t == nt - 2);
            if constexpr (GATHER) { if (last) { if (has_next) { PG8_GV(1, nxt); } else { gst[2] = gst[0]; gst[3] = gst[1]; } } }
            const char* a1 = cA + (size_t)(t + 1) * kstepA;
            const char* a2 = last ? nA : cA + (size_t)(t + 2) * kstepA; const char* b2 = last ? nB : cB + (size_t)(t + 2) * kstep;
            const char* a3 = a2 + kstepA; const char* b3 = b2 + kstep;
#if GEMM_8PH
            PG8_LDB(B0, 0, 0); PG8_SCHED; PG8_LDA(At, 0, 0); PG8_STAGE_A(PG8_SA(1, 1), a1, 1, false);
            PG8_WAIT_L(8); PG8_BAR; PG8_WAIT_L(0); PG8_MMA(0, 0, At, B0); PG8_BAR; PG8_SCHED;
            PG8_LDB(B1, 0, 1); PG8_STAGE(PG8_SB(0, 0), b2, voffB);
            PG8_BAR; PG8_WAIT_L(0); PG8_MMA(0, 1, At, B1); PG8_BAR;
            PG8_LDA(At, 0, 1); PG8_STAGE_A(PG8_SA(0, 0), a2, 0, last);
            PG8_BAR; PG8_WAIT_L(0); PG8_MMA(1, 0, At, B0); PG8_BAR; PG8_SCHED;
            PG8_STAGE(PG8_SB(0, 1), b2 + hstepB, voffB);
            PG8_WAIT_V(6); PG8_BAR; PG8_MMA(1, 1, At, B1); PG8_BAR;
            PG8_LDB(B0, 1, 0); PG8_SCHED; PG8_LDA(At, 1, 0); PG8_STAGE_A(PG8_SA(0, 1), a2, 1, last);
            PG8_WAIT_L(8); PG8_BAR; PG8_WAIT_L(0); PG8_MMA(0, 0, At, B0); PG8_BAR; PG8_SCHED;
            PG8_LDB(B1, 1, 1); PG8_STAGE(PG8_SB(1, 0), b3, voffB);
            PG8_BAR; PG8_WAIT_L(0); PG8_MMA(0, 1, At, B1); PG8_BAR;
            PG8_LDA(At, 1, 1); PG8_STAGE_A(PG8_SA(1, 0), a3, 0, last);
            PG8_BAR; PG8_WAIT_L(0); PG8_MMA(1, 0, At, B0); PG8_BAR; PG8_SCHED;
            PG8_STAGE(PG8_SB(1, 1), b3 + hstepB, voffB);
            PG8_WAIT_V(6); PG8_BAR; PG8_MMA(1, 1, At, B1); PG8_BAR;
#else
            PG8_LDB(B0, 0, 0); PG8_LDB(B1, 0, 1); PG8_SCHED; PG8_LDA(At, 0, 0); PG8_STAGE_A(PG8_SA(1, 1), a1, 1, false);
            PG8_WAIT_V(8); PG8_WAIT_L(0); PG8_BAR; PG8_MMA(0, 0, At, B0); PG8_MMA(0, 1, At, B1); PG8_BAR; PG8_SCHED;
            PG8_LDA(At, 0, 1); PG8_STAGE(PG8_SB(0, 0), b2, voffB); PG8_STAGE(PG8_SB(0, 1), b2 + hstepB, voffB); PG8_STAGE_A(PG8_SA(0, 0), a2, 0, last);
            PG8_WAIT_V(8); PG8_WAIT_L(0); PG8_BAR; PG8_MMA(1, 0, At, B0); PG8_MMA(1, 1, At, B1); PG8_BAR; PG8_SCHED;
            PG8_LDB(B0, 1, 0); PG8_LDB(B1, 1, 1); PG8_SCHED; PG8_LDA(At, 1, 0); PG8_STAGE_A(PG8_SA(0, 1), a2, 1, last);
            PG8_WAIT_V(8); PG8_WAIT_L(0); PG8_BAR; PG8_MMA(0, 0, At, B0); PG8_MMA(0, 1, At, B1); PG8_BAR; PG8_SCHED;
            PG8_LDA(At, 1, 1); PG8_STAGE(PG8_SB(1, 0), b3, voffB); PG8_STAGE(PG8_SB(1, 1), b3 + hstepB, voffB); PG8_STAGE_A(PG8_SA(1, 0), a3, 0, last);
            PG8_WAIT_V(8); PG8_WAIT_L(0); PG8_BAR; PG8_MMA(1, 0, At, B0); PG8_MMA(1, 1, At, B1); PG8_BAR; PG8_SCHED;
#endif
        }
        if (cur.epi) {
            if (wr == 0) PG8_BAR;
            const int el = otid() & 63; const int efr = el & 15, efq = el >> 4;
            const bool z = E(acc, cur, wr, wc, efr, efq);
            if (z) {
#pragma unroll
                for (int a = 0; a < 2; ++a)
#pragma unroll
                    for (int b = 0; b < 2; ++b)
#pragma unroll
                        for (int m = 0; m < 4; ++m)
#pragma unroll
                            for (int n = 0; n < 2; ++n) acc[a][b][m][n] = (f32x4){0.f, 0.f, 0.f, 0.f};
            }
            if (!has_next) break;
            if (wr == 1) PG8_BAR;
        } else if (!has_next) { if (wr == 0) PG8_BAR; break; }
        cur = nxt; cA = nA; cB = nB; ++ui;
        if constexpr (GATHER) { gst[0] = gst[2]; gst[1] = gst[3]; }
    }
    PG8_WAIT_V(0);
    PG8_BAR;
#undef PG8_SA
#undef PG8_SB
#undef PG8_STAGE
#undef PG8_STAGE_A
#undef PG8_GV
#undef PG8_LDA
#undef PG8_LDB
#undef PG8_MMA
#undef PG8_WAIT_V
#undef PG8_WAIT_L
#undef PG8_BAR
#undef PG8_SCHED
}
}
namespace fk {
struct In { const float *x, *c, *ctx, *c_ctx, *w_mod, *b_mod, *w_in, *lam_q1, *lam_k1, *lam_q2, *lam_k2, *subln_g, *a_re, *a_im, *log_dt, *b_re, *b_im, *c_re, *c_im, *ssm_d,
  *w_glu, *b_glu, *w_pa, *w_ps, *w_o, *ln1_g, *ln1_b, *rg_w, *rg_b, *re_w, *re_b, *w1, *w3, *w2, *ln2_g, *ln2_b; };
struct WSet { bf16_t *Win, *Wglu, *Wpa, *Wps, *Wo, *W13, *W2; };
struct SSet { bf16_t *Smat, *TO; float *SAL, *WR; };
struct Params {
  In in; float* out;
  unsigned* bar;
  unsigned* ctl;
  float* MOD;
  float* ROPE;
  float* XL;
  bf16_t* X1b;
  bf16_t* Hb;
  bf16_t* Kc; bf16_t* Vc;
  bf16_t* Qb;
  bf16_t* Ug;
  bf16_t* RG; bf16_t* GSb;
  bf16_t* ATTb;
  float* SST;
  bf16_t* YG;
  bf16_t* S2;
  bf16_t* Mb;
  bf16_t* H2b;
  int* ROUTE;
  float* RW;
  int* TOK;
  bf16_t* Hm;
  bf16_t* Yo;
  SSet s[4];
  WSet w[2];
  int ph_lo, ph_hi;
  int pad0, pad1;
};
typedef const __attribute__((address_space(4))) Params& KP; typedef const __attribute__((address_space(4))) WSet& KW; typedef const __attribute__((address_space(4))) SSet& KS;
constexpr int CTL_CNT = 0;
constexpr int CTL_TILE = 64 * 32 + 64;
constexpr int CTL_XC = CTL_TILE + 72 * 16;
constexpr int CTL_DONE = CTL_XC + 16 * 16;
constexpr int CTL_WORDS = CTL_XC + 5 * 272;

__device__ __forceinline__ int modrow_of_tile(int pm) { return pm < 64 ? (pm >> 3) : 8; }
__device__ __forceinline__ int kvrow0_of_tile(int pm) { return pm < 64 ? (pm >> 3) * KVB + CTX + (pm & 7) * 256 : (pm - 64) * KVB; }

struct SchedPlain {
  const char* A; const char* B; int lda, ldb, nM, nN, nt, G, c, nunits; int epi; int atile;
  __device__ __forceinline__ bool next(int i, Seg& s) const {
    const int L = i * G + c; if (L >= nunits) return false;
    int pm, pn; tile_order(L, nM, nN, pm, pn);
    s.A = A + (size_t)pm * atile; s.B = B + (size_t)pn * 256 * ldb; s.nt = nt; s.epi = epi; s.pm = pm; s.pn = pn; s.aux = 0; s.aux2 = 0; return true; }
};
struct SchedMerge {
  const char* A1; const char* B1; const char* A2; const char* B2; int nM, nN, G, c, nunits;
  __device__ __forceinline__ bool next(int i, Seg& s) const {
    const int L = (i >> 1) * G + c; if (L >= nunits) return false;
    int pm, pn; tile_order(L, nM, nN, pm, pn); s.pm = pm; s.pn = pn; s.aux = 0; s.aux2 = 0;
    if ((i & 1) == 0) { s.A = A1 + (size_t)pm * 256 * 2048; s.B = B1 + (size_t)pn * 256 * 2048; s.nt = 16; s.epi = 2; }
    else { s.A = A2 + (size_t)pm * 256 * 2048; s.B = B2 + (size_t)pn * 256 * 2048; s.nt = 8; s.epi = 1; }
    return true; }
};
struct SchedMergeOne {
  const char* A1; const char* B1; const char* A2; const char* B2; int pm, pn;
  __device__ __forceinline__ bool next(int i, Seg& s) const {
    if (i >= 2) return false; s.pm = pm; s.pn = pn; s.aux = 0; s.aux2 = 0;
    if (i == 0) { s.A = A1 + (size_t)pm * 256 * 2048; s.B = B1 + (size_t)pn * 256 * 2048; s.nt = 16; s.epi = 2; }
    else { s.A = A2 + (size_t)pm * 256 * 2048; s.B = B2 + (size_t)pn * 256 * 2048; s.nt = 8; s.epi = 1; }
    return true; }
};
struct SchedPlainOne {
  const char* A; const char* B; int nt, pm, pn;
  __device__ __forceinline__ bool next(int i, Seg& s) const {
    if (i >= 1) return false; s.A = A + (size_t)pm * 256 * 2048; s.B = B + (size_t)pn * 256 * 2048; s.nt = nt; s.epi = 1; s.pm = pm; s.pn = pn; s.aux = 0; s.aux2 = 0; return true; }
};
struct SchedSsm1 {
  const char* Ug; const char* Smat; int G, c;
  __device__ __forceinline__ bool next(int i, Seg& s) const {
    const int L = i * G + c; if (L >= NG * 3) return false;
    const int g = L / 3, pm = L % 3;
    s.A = Ug + (size_t)g * NCHP * 1536 + (size_t)pm * 256 * 1536; s.B = Smat + (size_t)g * 256 * 1536; s.nt = 8; s.epi = 1; s.pm = pm; s.pn = 0; s.aux = g; s.aux2 = 0; return true; }
};
struct SchedSsm3 {
  const char* Ug; const char* TO; int G, c;
  __device__ __forceinline__ bool next(int i, Seg& s) const {
    const int L = i * G + c; if (L >= NG * 6) return false;
    const int g = L / 6, r = L % 6, pm = r >> 1, pn = r & 1; s.pm = pm; s.pn = pn; s.aux = g; s.aux2 = 0;
    s.A = Ug + (size_t)g * NCHP * 1536 + (size_t)pm * 256 * 1536; s.B = TO + (size_t)g * 512 * 1536 + (size_t)pn * 256 * 1536; s.nt = 12; s.epi = 1; return true; }
};
struct MoeTab { int ntiles; int tileE[176]; int tileR0[176]; int cnt[32]; int tbase[33]; };
struct SchedMoe {
  const char* A; const char* B; int lda, ldb; size_t estride; const LAS MoeTab* tab; const int* TOK; int nN, nt, G, c; bool gather; int i0, i1;
  __device__ __forceinline__ bool next(int i, Seg& s) const {
    if (i0 + i >= i1) return false;
    const int L = (i0 + i) * G + c; if (L >= __builtin_amdgcn_readfirstlane(tab->ntiles) * nN) return false;
    const int t = L / nN, pn = L % nN; const int e = __builtin_amdgcn_readfirstlane(tab->tileE[t]);
    s.A = gather ? A : A + (size_t)t * 256 * lda; s.B = B + (size_t)e * estride + (size_t)pn * 256 * ldb; s.nt = nt; s.epi = 1; s.pm = t; s.pn = pn; s.aux = e; s.aux2 = __builtin_amdgcn_readfirstlane(tab->tileR0[t]); return true; }
  __device__ __forceinline__ unsigned grow(const Seg& s, int R) const { const int r = s.aux2 + R, cnt = tab->cnt[s.aux]; const unsigned v = (unsigned)TOK[(size_t)s.aux * NR + (r < cnt ? r : cnt - 1)]; return r < cnt ? v : 0u; }
};
struct SchedG1 {
  const char* A; const char* B; int G, c, u0, u1; bool last;
  __device__ __forceinline__ bool next(int i, Seg& s) const {
    const int L = u0 + i * G + c; if (L >= u1) return false; int pm, pn;
    if (!last) { if (L < 144) { pm = L >> 1; pn = 8 + (L & 1); } else { int q; tile_order(L - 144, NR / 256, 20, pm, q); pn = q < 8 ? q : q + 2; } }
    else { if (L < 1408) tile_order(L, NLAT / 256, 22, pm, pn); else { const int L2 = L - 1408; pm = 64 + L2 / 10; pn = L2 % 10; } }
    s.A = A + (size_t)pm * 256 * 2048; s.B = B + (size_t)pn * 256 * 2048; s.nt = 16; s.epi = 1; s.pm = pm; s.pn = pn; s.aux = 0; s.aux2 = 0; return true; }
};
#define EPI_LOOP_AM for (int ai = 0; ai < 2; ++ai) _Pragma("unroll") for (int m = 0; m < 4; ++m)
struct EpiIn {
  const float* ROPE; bf16_t* Kc; bf16_t* Vc; bf16_t* Ug; bf16_t* Qb; bf16_t* RG; bf16_t* GSb; int rowmask;
  __device__ __forceinline__ bool operator()(f32x4 (&acc)[2][2][4][2], const Seg& s, int wr, int wc, int fr, int fq) const {
    const int pm = s.pm, pn = s.pn; const int rin0 = (wr * 64 + fr) & rowmask;
    if (pn < 4 || (pn >= 10 && pn < 14)) {
      const bool isq = pn >= 10; const int pt = isq ? pn - 10 : pn; const int axis = wc & 1;
      bf16_t* dst = isq ? Qb : Kc; const int drow0 = isq ? pm * 256 : kvrow0_of_tile(pm); const bool lat = pm < 64;
#pragma unroll
      for (int ai = 0; ai < 2; ++ai) { f32x4 csv[4], snv[4];
        if (lat) {
#pragma unroll
          for (int m = 0; m < 4; ++m) { const int rin = ((ai * 128 + m * 16) & rowmask) + rin0; const int t = (pm * 256 + rin) & (SEQ - 1); const float* rp = ROPE + ((size_t)t * 2 + axis) * 32 + fq * 4; csv[m] = *(const f32x4*)rp; snv[m] = *(const f32x4*)(rp + 16); }
          __builtin_amdgcn_sched_barrier(0); }
#pragma unroll
      for (int m = 0; m < 4; ++m) { const int rin = ((ai * 128 + m * 16) & rowmask) + rin0; const f32x4 cs = csv[m], sn = snv[m];
#pragma unroll
        for (int bj = 0; bj < 2; ++bj) { f32x4 o1 = acc[ai][bj][m][0], o2 = acc[ai][bj][m][1]; if (lat) { const f32x4 t1 = o1, t2 = o2; o1 = t1 * cs - t2 * sn; o2 = t1 * sn + t2 * cs; }
          if (isq) { o1 *= 0.18033688011112042f; o2 *= 0.18033688011112042f; }
          *(u32x4*)(dst + (size_t)(drow0 + rin) * 1024 + (2 * pt + bj) * 128 + wc * 32 + fq * 8) = pack8(o1, o2); } } }
    } else if (pn < 8) {
      const int drow0 = kvrow0_of_tile(pm);
#pragma unroll
      EPI_LOOP_AM { const int rin = ((ai * 128 + m * 16) & rowmask) + rin0;
#pragma unroll
        for (int bj = 0; bj < 2; ++bj) *(u32x4*)(Vc + (size_t)(drow0 + rin) * 1024 + (pn - 4) * 256 + bj * 128 + wc * 32 + fq * 8) = pack8(acc[ai][bj][m][0], acc[ai][bj][m][1]); }
    } else if (pn < 10) {
#pragma unroll
      EPI_LOOP_AM { const int rin = ((ai * 128 + m * 16) & rowmask) + rin0;
#pragma unroll
        for (int bj = 0; bj < 2; ++bj) { const int c0 = (pn - 8) * 256 + bj * 128 + wc * 32 + fq * 8; const int g = c0 >> 4, co = c0 & 15;
          const int R = pm * 256 + rin; *(u32x4*)(Ug + ((size_t)g * NCHP + (R >> 5)) * 768 + (R & 31) * 16 + co) = pack8(acc[ai][bj][m][0], acc[ai][bj][m][1]); } }
    } else {
      const int c0 = (pn - 14) * 128 + wc * 32 + fq * 8;
#pragma unroll
      EPI_LOOP_AM { const int rin = ((ai * 128 + m * 16) & rowmask) + rin0; f32x4 r[2], g[2];
#pragma unroll
        for (int n = 0; n < 2; ++n)
#pragma unroll
          for (int j = 0; j < 4; ++j) { const float ea = __builtin_amdgcn_exp2f(-1.4426950408889634f * acc[ai][0][m][n][j]); const float es = __builtin_amdgcn_exp2f(-1.4426950408889634f * fmaxf(acc[ai][1][m][n][j], -60.f));
            g[n][j] = __builtin_amdgcn_rcpf(1.f + es); r[n][j] = (1.f + es) * __builtin_amdgcn_rcpf(1.f + ea); }
        *(u32x4*)(RG + (size_t)(pm * 256 + rin) * 1024 + c0) = pack8(r[0], r[1]); *(u32x4*)(GSb + (size_t)(pm * 256 + rin) * 1024 + c0) = pack8(g[0], g[1]); }
    }
    return true;
  }
};
struct EpiNone { __device__ __forceinline__ bool operator()(f32x4 (&acc)[2][2][4][2], const Seg& s, int wr, int wc, int fr, int fq) const { asm volatile("" :: "v"(acc[0][0][0][0][0]), "v"(acc[1][1][3][1][3])); return true; } };
template <int NST> struct EpiLinT {
  bf16_t* Yo;
  __device__ __forceinline__ bool operator()(f32x4 (&acc)[2][2][4][2], const Seg& s, int wr, int wc, int fr, int fq) const {
    const int lane = fr + 16 * fq; const int w = wr * 4 + wc; int k = 0;
#pragma unroll
    EPI_LOOP_AM {
#pragma unroll
      for (int bj = 0; bj < 2; ++bj) { if (k < NST) *(u32x4*)(Yo + ((size_t)s.pm * 256 * 1024) + (size_t)(s.pn & 3) * 65536 + ((w * 16 + k) * 64 + lane) * 8) = pack8(acc[ai][bj][m][0], acc[ai][bj][m][1]); else asm volatile("" :: "v"(acc[ai][bj][m][0][0]), "v"(acc[ai][bj][m][1][3])); ++k; } }
    return true;
  }
};
struct EpiLin {
  bf16_t* Yo;
  __device__ __forceinline__ bool operator()(f32x4 (&acc)[2][2][4][2], const Seg& s, int wr, int wc, int fr, int fq) const {
    const int lane = fr + 16 * fq; const int w = wr * 4 + wc; int k = 0;
#pragma unroll
    EPI_LOOP_AM {
#pragma unroll
      for (int bj = 0; bj < 2; ++bj) { *(u32x4*)(Yo + ((size_t)s.pm * 256 * 1024) + (size_t)(s.pn & 3) * 65536 + ((w * 16 + k) * 64 + lane) * 8) = pack8(acc[ai][bj][m][0], acc[ai][bj][m][1]); ++k; } }
    return true;
  }
};
struct EpiState {
  float* SST;
  __device__ __forceinline__ bool operator()(f32x4 (&acc)[2][2][4][2], const Seg& s, int wr, int wc, int fr, int fq) const {
    const int g = s.aux;
#pragma unroll
    EPI_LOOP_AM { const int row = s.pm * 256 + ai * 128 + m * 16 + wr * 64 + fr;
      if (row < NCHR) {
#pragma unroll
        for (int bj = 0; bj < 2; ++bj) { float* p = SST + ((size_t)g * NCHP + row) * 256 + bj * 128 + wc * 32 + fq * 8; *(f32x4*)p = acc[ai][bj][m][0]; *(f32x4*)(p + 4) = acc[ai][bj][m][1]; } } }
    return true;
  }
};
struct EpiSsmOut {
  bf16_t* YG;
  __device__ __forceinline__ bool operator()(f32x4 (&acc)[2][2][4][2], const Seg& s, int wr, int wc, int fr, int fq) const {
    const int g = s.aux;
#pragma unroll
    EPI_LOOP_AM { const int row = s.pm * 256 + ai * 128 + m * 16 + wr * 64 + fr;
      if (row < NCHR) {
#pragma unroll
        for (int bj = 0; bj < 2; ++bj) { const int c0 = s.pn * 256 + bj * 128 + wc * 32 + fq * 8; const int t = c0 >> 4, co = c0 & 15; f32x4 a = acc[ai][bj][m][0], b = acc[ai][bj][m][1];
#pragma unroll
          for (int j = 0; j < 4; ++j) { a[j] = gelu_tanh_f(a[j]); b[j] = gelu_tanh_f(b[j]); }
          *(u32x4*)(YG + ((size_t)g * NR + (size_t)row * CHUNK + t) * 16 + co) = pack8(a, b); } } }
    return true;
  }
};
struct EpiGlu {
  const bf16_t* YG; bf16_t* S2; const float* bias;
  __device__ __forceinline__ bool operator()(f32x4 (&acc)[2][2][4][2], const Seg& s, int wr, int wc, int fr, int fq) const {
#pragma unroll
    for (int bj = 0; bj < 2; ++bj) { const int c0 = s.pn * 256 + bj * 128 + wc * 32 + fq * 8; const f32x4 b0 = *(const f32x4*)(bias + c0), b1 = *(const f32x4*)(bias + c0 + 4);
#pragma unroll
      for (int ai = 0; ai < 2; ++ai) { u32x4 yw[4];
#pragma unroll
        for (int m = 0; m < 4; ++m) yw[m] = *(const u32x4*)(YG + ((size_t)(c0 >> 4) * NR + (s.pm * 256 + ai * 128 + m * 16 + wr * 64 + fr)) * 16 + (c0 & 15));
        __builtin_amdgcn_sched_barrier(0);
#pragma unroll
        for (int m = 0; m < 4; ++m) { const int row = s.pm * 256 + ai * 128 + m * 16 + wr * 64 + fr; f32x4 y0, y1; unpack8(yw[m], y0, y1);
          f32x4 z0 = acc[ai][bj][m][0] + b0, z1 = acc[ai][bj][m][1] + b1;
#pragma unroll
          for (int j = 0; j < 4; ++j) { z0[j] = y0[j] * fast_sigmoid(z0[j]); z1[j] = y1[j] * fast_sigmoid(z1[j]); }
          *(u32x4*)(S2 + (size_t)row * 1024 + c0) = pack8(z0, z1); } } }
    return true;
  }
};
struct EpiMerge {
  const bf16_t* RG; const bf16_t* GSb; bf16_t* Mb;
  __device__ __forceinline__ bool operator()(f32x4 (&acc)[2][2][4][2], const Seg& s, int wr, int wc, int fr, int fq) const {
    const bool mid = s.epi == 2; const bf16_t* src = mid ? RG : GSb;
#pragma unroll
    for (int ai = 0; ai < 2; ++ai) { u32x4 w[4][2];
#pragma unroll
      for (int m = 0; m < 4; ++m)
#pragma unroll
        for (int bj = 0; bj < 2; ++bj) w[m][bj] = *(const u32x4*)(src + (size_t)(s.pm * 256 + ai * 128 + m * 16 + wr * 64 + fr) * 1024 + s.pn * 256 + bj * 128 + wc * 32 + fq * 8);
      __builtin_amdgcn_sched_barrier(0);
#pragma unroll
      for (int m = 0; m < 4; ++m)
#pragma unroll
        for (int bj = 0; bj < 2; ++bj) { f32x4 g0, g1; unpack8(w[m][bj], g0, g1); acc[ai][bj][m][0] *= g0; acc[ai][bj][m][1] *= g1; }
      if (!mid) {
#pragma unroll
        for (int m = 0; m < 4; ++m)
#pragma unroll
          for (int bj = 0; bj < 2; ++bj) *(u32x4*)(Mb + (size_t)(s.pm * 256 + ai * 128 + m * 16 + wr * 64 + fr) * 1024 + s.pn * 256 + bj * 128 + wc * 32 + fq * 8) = pack8(acc[ai][bj][m][0], acc[ai][bj][m][1]); } }
    return !mid;
  }
};
struct EpiWo {
  bf16_t* D1; const float* MODl;
  __device__ __forceinline__ bool operator()(f32x4 (&acc)[2][2][4][2], const Seg& s, int wr, int wc, int fr, int fq) const {
    const int pm = s.pm; const float* gate = MODl + (size_t)modrow_of_tile(pm) * 6144 + 2 * 1024;
#pragma unroll
    for (int bj = 0; bj < 2; ++bj) { const int c0 = s.pn * 256 + bj * 128 + wc * 32 + fq * 8; const f32x4 g0 = *(const f32x4*)(gate + c0), g1 = *(const f32x4*)(gate + c0 + 4);
#pragma unroll
      EPI_LOOP_AM { const int rin = ai * 128 + m * 16 + wr * 64 + fr;
        *(u32x4*)(D1 + (size_t)(pm * 256 + rin) * 1024 + c0) = pack8(g0 * acc[ai][bj][m][0], g1 * acc[ai][bj][m][1]); } }
    return true;
  }
};
struct EpiMoe1 {
  bf16_t* Hm;
  __device__ __forceinline__ bool operator()(f32x4 (&acc)[2][2][4][2], const Seg& s, int wr, int wc, int fr, int fq) const {
    const int c0 = s.pn * 128 + wc * 32 + fq * 8;
#pragma unroll
    EPI_LOOP_AM { const int row = s.pm * 256 + ai * 128 + m * 16 + wr * 64 + fr; f32x4 h0, h1;
#pragma unroll
      for (int j = 0; j < 4; ++j) { h0[j] = fast_silu(acc[ai][0][m][0][j]) * acc[ai][1][m][0][j]; h1[j] = fast_silu(acc[ai][0][m][1][j]) * acc[ai][1][m][1][j]; }
      *(u32x4*)(Hm + (size_t)row * EH + c0) = pack8(h0, h1); }
    return true;
  }
};
struct EpiMoe2 {
  bf16_t* Yo;
  __device__ __forceinline__ bool operator()(f32x4 (&acc)[2][2][4][2], const Seg& s, int wr, int wc, int fr, int fq) const {
#pragma unroll
    EPI_LOOP_AM { const int row = s.pm * 256 + ai * 128 + m * 16 + wr * 64 + fr;
#pragma unroll
      for (int bj = 0; bj < 2; ++bj) *(u32x4*)(Yo + (size_t)row * 1024 + s.pn * 256 + bj * 128 + wc * 32 + fq * 8) = pack8(acc[ai][bj][m][0], acc[ai][bj][m][1]); }
    return true;
  }
};
}
namespace fk {
constexpr int ATT_SHM_V = 64 * 128 * 2, ATT_SHM_K = 64 * 128 * 2;
constexpr int ATT_LDS = 4 * ATT_SHM_V + 4 * ATT_SHM_K + 8 * 256;
#define KSWZ(row, colB) ((row) * 256 + ((colB) ^ (((row) & 15) << 4)))
#define SBAR() __builtin_amdgcn_sched_barrier(0)
__device__ __forceinline__ int crow(int r, int hi) { return (r & 3) + 8 * (r >> 2) + 4 * hi; }
constexpr float ATT_THR2 = 11.5f;
template <int VAR = 0> __device__ __forceinline__ void partialSM(f32x16& p0, f32x16& p1, float& m_reg, float& alpha) {
  if (VAR == 1) { alpha = 1.f; return; }
  float pmax = p0[0];
#pragma unroll
  for (int r = 1; r < 16; ++r) pmax = fmaxf(pmax, p0[r]);
#pragma unroll
  for (int r = 0; r < 16; ++r) pmax = fmaxf(pmax, p1[r]);
  { auto rr = __builtin_amdgcn_permlane32_swap(__float_as_uint(pmax), __float_as_uint(pmax), false, false);
    pmax = fmaxf(__uint_as_float(rr[0]), __uint_as_float(rr[1])); }
  if (__builtin_expect(__all(pmax <= ATT_THR2 && pmax >= -2.f * ATT_THR2), 1)) { alpha = 1.f; }
  else { const float d = pmax; alpha = __builtin_amdgcn_exp2f(-d); m_reg += d;
#pragma unroll
    for (int r = 0; r < 16; ++r) { p0[r] -= d; p1[r] -= d; } }
#pragma unroll
  for (int r = 0; r < 16; ++r) p0[r] = __builtin_amdgcn_exp2f(p0[r]);
}
template <int VAR = 0> __device__ __forceinline__ void finishSM(f32x16& p0, f32x16& p1, float alpha, float& l_reg, bf16x8& pa0, bf16x8& pa1, bf16x8& pa2, bf16x8& pa3) {
  if (VAR != 1) {
#pragma unroll
  for (int r = 0; r < 16; ++r) p1[r] = __builtin_amdgcn_exp2f(p1[r]);
  float ps = 0;
#pragma unroll
  for (int r = 0; r < 16; ++r) ps += p0[r];
#pragma unroll
  for (int r = 0; r < 16; ++r) ps += p1[r];
  { auto rr = __builtin_amdgcn_permlane32_swap(__float_as_uint(ps), __float_as_uint(ps), false, false);
    ps = __uint_as_float(rr[0]) + __uint_as_float(rr[1]); }
  l_reg = l_reg * alpha + ps; } else l_reg += 1.f;
#define PK4(P, BASE, OUT) do { unsigned a0 = cvt_pk_bf16(P[BASE + 0], P[BASE + 1]), a1 = cvt_pk_bf16(P[BASE + 2], P[BASE + 3]);   \
    unsigned b0 = cvt_pk_bf16(P[BASE + 4], P[BASE + 5]), b1 = cvt_pk_bf16(P[BASE + 6], P[BASE + 7]);                              \
    auto r0 = __builtin_amdgcn_permlane32_swap(a0, b0, false, false); auto r1 = __builtin_amdgcn_permlane32_swap(a1, b1, false, false); \
    u32x4 w = {r0[0], r1[0], r0[1], r1[1]}; OUT = *reinterpret_cast<bf16x8*>(&w); } while (0)
  PK4(p0, 0, pa0); PK4(p0, 8, pa1); PK4(p1, 0, pa2); PK4(p1, 8, pa3);
#undef PK4
}
template <int VAR = 0> __device__ __forceinline__ void qkt(f32x16& p0, f32x16& p1, const LAS char* Ks, const bf16x8* qr, int mapcolB, int r32, int hi, float negm) {
#pragma unroll
  for (int r = 0; r < 16; ++r) { p0[r] = negm; p1[r] = negm; }
  if (VAR == 3) return;
#pragma unroll
  for (int d0 = 0; d0 < 4; ++d0) { const int cb = mapcolB + (d0 * 16 + hi * 8) * 2;
    const bf16x8 b0 = *(const LAS bf16x8*)(Ks + KSWZ(r32, cb));
    const bf16x8 b1 = *(const LAS bf16x8*)(Ks + KSWZ(32 + r32, cb));
    p0 = __builtin_amdgcn_mfma_f32_32x32x16_bf16(b0, qr[d0], p0, 0, 0, 0);
    p1 = __builtin_amdgcn_mfma_f32_32x32x16_bf16(b1, qr[d0], p1, 0, 0, 0); }
}
__device__ __forceinline__ int v_st(int k, int c) { const int kk = (k & ~0xC) | ((k & 4) << 1) | ((k & 8) >> 1); return ((kk >> 3) * 4 + (c >> 5)) * 512 + ((kk & 7) * 32 + (c & 31)) * 2; }
__device__ __forceinline__ int v_rd_base(int lane) { return ((lane & 3) << 3) | (((lane >> 2) & 3) << 6) | (((lane >> 4) & 1) << 5) | (((lane >> 5) & 1) << 8); }
constexpr int v_rd_off(int d0, int ks, int half) { return d0 * 512 + ks * 4096 + half * 2048; }
template <int OFF> __device__ __forceinline__ s16x4 tr_read(int vb) {
  s16x4 r; asm volatile("ds_read_b64_tr_b16 %0, %1 offset:%2" : "=&v"(r) : "v"(vb), "i"(OFF) : "memory"); return r;
}
struct VFrag { s16x4 l0, h0, l1, h1, l2, h2, l3, h3; };
template <int D0> __device__ __forceinline__ void v_issue(VFrag& f, int vb) {
  f.l0 = tr_read<v_rd_off(D0, 0, 0)>(vb); f.h0 = tr_read<v_rd_off(D0, 0, 1)>(vb); f.l1 = tr_read<v_rd_off(D0, 1, 0)>(vb); f.h1 = tr_read<v_rd_off(D0, 1, 1)>(vb);
  f.l2 = tr_read<v_rd_off(D0, 2, 0)>(vb); f.h2 = tr_read<v_rd_off(D0, 2, 1)>(vb); f.l3 = tr_read<v_rd_off(D0, 3, 0)>(vb); f.h3 = tr_read<v_rd_off(D0, 3, 1)>(vb);
}
__device__ __forceinline__ void v_mma(f32x16& od, const VFrag& f, bf16x8 pa0, bf16x8 pa1, bf16x8 pa2, bf16x8 pa3) {
#define PK(L, H) (bf16x8){L[0], L[1], L[2], L[3], H[0], H[1], H[2], H[3]}
  od = __builtin_amdgcn_mfma_f32_32x32x16_bf16(pa0, PK(f.l0, f.h0), od, 0, 0, 0);
  od = __builtin_amdgcn_mfma_f32_32x32x16_bf16(pa1, PK(f.l1, f.h1), od, 0, 0, 0);
  od = __builtin_amdgcn_mfma_f32_32x32x16_bf16(pa2, PK(f.l2, f.h2), od, 0, 0, 0);
  od = __builtin_amdgcn_mfma_f32_32x32x16_bf16(pa3, PK(f.l3, f.h3), od, 0, 0, 0);
#undef PK
}
template <int VAR = 0> __device__ __forceinline__ void pv_d0(f32x16* o, int vb, bf16x8 pa0, bf16x8 pa1, bf16x8 pa2, bf16x8 pa3) {
  if (VAR == 2) { asm volatile("" :: "v"(pa0), "v"(pa1), "v"(pa2), "v"(pa3)); return; }
  VFrag fa, fb;
  v_issue<0>(fa, vb); v_issue<1>(fb, vb);
  asm volatile("s_waitcnt lgkmcnt(8)" ::: "memory"); SBAR(); v_mma(o[0], fa, pa0, pa1, pa2, pa3);
  v_issue<2>(fa, vb);
  asm volatile("s_waitcnt lgkmcnt(8)" ::: "memory"); SBAR(); v_mma(o[1], fb, pa0, pa1, pa2, pa3);
  v_issue<3>(fb, vb);
  asm volatile("s_waitcnt lgkmcnt(8)" ::: "memory"); SBAR(); v_mma(o[2], fa, pa0, pa1, pa2, pa3);
  asm volatile("s_waitcnt lgkmcnt(0)" ::: "memory"); SBAR(); v_mma(o[3], fb, pa0, pa1, pa2, pa3);
}
template <int VAR = 0> __device__ __forceinline__ void attn_unit(const bf16_t* __restrict__ Qg, const bf16_t* __restrict__ Kg, const bf16_t* __restrict__ Vg, bf16_t* __restrict__ Og,
                                          int qrow0, int kv0, int nkeys, int h, float lam, float lam_init, const float* __restrict__ subg, LAS char* lds, const int g_wv) {
  const int tid = otid(), wid = g_wv, lane = tid & 63, r32 = lane & 31, hi = lane >> 5, map = wid >> 2, wq = wid & 3;
  LAS char* V_lds = lds; LAS char* K_lds = lds + 4 * ATT_SHM_V;
  LAS float* wsf = (LAS float*)(lds + 4 * ATT_SHM_V + 4 * ATT_SHM_K) + wid * 64; LAS float* li_l = wsf; LAS float* al_l = wsf + 32;
  float m_reg = 0.f, l_reg = 0; f32x16 o[4] = {}; bf16x8 qr[4];
  const bf16_t* Qw = Qg + (size_t)(qrow0 + wq * 32 + r32) * 1024 + h * 128 + map * 64 + hi * 8;
#pragma unroll
  for (int d0 = 0; d0 < 4; ++d0) qr[d0] = *(const bf16x8*)(Qw + d0 * 16);
  const bf16_t* Kh = Kg + (size_t)kv0 * 1024 + h * 128; const bf16_t* Vh = Vg + (size_t)kv0 * 1024 + h * 128;
  const int vb0 = (int)(uintptr_t)V_lds + v_rd_base(lane);
  const int mapcolB = map * 128;
  unsigned offK0, offK1, offV0, offV1;
  { const int kr0 = 4 * wid + (lane >> 4), kr1 = 32 + kr0, kp = (lane & 15) * 16;
    offK0 = (unsigned)(kr0 * 2048 + (kp ^ ((kr0 & 15) << 4))); offK1 = (unsigned)(kr1 * 2048 + (kp ^ ((kr1 & 15) << 4)));
#pragma unroll
    for (int u = 0; u < 2; ++u) { const int B = 2 * (8 * u + wid) + (lane >> 5); const int kk = (B >> 2) * 8 + ((lane & 31) >> 2); const int k = (kk & ~0xC) | ((kk & 4) << 1) | ((kk & 8) >> 1); const int c = (B & 3) * 32 + (lane & 3) * 8;
      const unsigned o = (unsigned)(k * 2048 + c * 2); if (u == 0) offV0 = o; else offV1 = o; } }
#define SLOT(t) (((t) & 3) * ATT_SHM_V)
#define SLOAD(k0, bo) do { const char* kb_ = (const char*)Kh + (size_t)(k0) * 2048; const char* vb_ = (const char*)Vh + (size_t)(k0) * 2048; \
    __builtin_amdgcn_global_load_lds((const unsigned*)(vb_ + offV0), (LAS unsigned*)(V_lds + (bo) + wid * 1024), 16, 0, 0); \
    __builtin_amdgcn_global_load_lds((const unsigned*)(vb_ + offV1), (LAS unsigned*)(V_lds + (bo) + (8 + wid) * 1024), 16, 0, 0); \
    __builtin_amdgcn_global_load_lds((const unsigned*)(kb_ + offK0), (LAS unsigned*)(K_lds + (bo) + wid * 1024), 16, 0, 0); \
    __builtin_amdgcn_global_load_lds((const unsigned*)(kb_ + offK1), (LAS unsigned*)(K_lds + (bo) + (8 + wid) * 1024), 16, 0, 0); } while (0)
#define SWRITE(bo) do { } while (0)
#define SWAIT() asm volatile("s_waitcnt vmcnt(0)" ::: "memory")
#define RESC(a) do { if (__any((a) != 1.f)) { if (hi == 0) al_l[r32] = (a); asm volatile("s_waitcnt lgkmcnt(0)" ::: "memory"); \
    _Pragma("unroll") for (int d = 0; d < 4; ++d) _Pragma("unroll") for (int r = 0; r < 16; ++r) o[d][r] *= al_l[crow(r, hi)]; } } while (0)
  f32x16 pA0, pA1, pB0, pB1; float alA, alB; bf16x8 pa0, pa1, pa2, pa3; const int NT = nkeys / 64;
  SLOAD(0, SLOT(0)); SLOAD(64, SLOT(1)); asm volatile("s_waitcnt vmcnt(0)" ::: "memory"); __syncthreads();
  if (g_wv < 4) {
    qkt<VAR>(pA0, pA1, K_lds, qr, mapcolB, r32, hi, -m_reg); partialSM<VAR>(pA0, pA1, m_reg, alA);
    __syncthreads();
    for (int j = 1; j + 1 < NT; j += 2) {
      SBAR(); { qkt<VAR>(pB0, pB1, K_lds + SLOT(j), qr, mapcolB, r32, hi, -m_reg);
      finishSM<VAR>(pA0, pA1, alA, l_reg, pa0, pa1, pa2, pa3); } SBAR();
      SLOAD((j + 1) * 64, SLOT(j + 1)); SBAR();
      pv_d0<VAR>(o, vb0 + SLOT(j - 1), pa0, pa1, pa2, pa3); partialSM<VAR>(pB0, pB1, m_reg, alB);
      SWAIT(); SWRITE(SLOT(j + 1));
      RESC(alB); __syncthreads();
      SBAR(); { qkt<VAR>(pA0, pA1, K_lds + SLOT(j + 1), qr, mapcolB, r32, hi, -m_reg);
      finishSM<VAR>(pB0, pB1, alB, l_reg, pa0, pa1, pa2, pa3); } SBAR();
      SLOAD((j + 2) * 64, SLOT(j + 2)); SBAR();
      pv_d0<VAR>(o, vb0 + SLOT(j), pa0, pa1, pa2, pa3); partialSM<VAR>(pA0, pA1, m_reg, alA);
      SWAIT(); SWRITE(SLOT(j + 2));
      RESC(alA); __syncthreads();
    }
    SBAR(); { qkt<VAR>(pB0, pB1, K_lds + SLOT(NT - 1), qr, mapcolB, r32, hi, -m_reg);
    finishSM<VAR>(pA0, pA1, alA, l_reg, pa0, pa1, pa2, pa3); } SBAR();
    pv_d0<VAR>(o, vb0 + SLOT(NT - 2), pa0, pa1, pa2, pa3); partialSM<VAR>(pB0, pB1, m_reg, alB);
    RESC(alB);
    finishSM<VAR>(pB0, pB1, alB, l_reg, pa0, pa1, pa2, pa3); SBAR();
    pv_d0<VAR>(o, vb0 + SLOT(NT - 1), pa0, pa1, pa2, pa3);
  } else {
    qkt<VAR>(pA0, pA1, K_lds, qr, mapcolB, r32, hi, -m_reg);
    __syncthreads();
    for (int k = 1; k + 1 < NT; k += 2) {
      SLOAD((k + 1) * 64, SLOT(k + 1)); SBAR();
      if (k >= 2) pv_d0<VAR>(o, vb0 + SLOT(k - 2), pa0, pa1, pa2, pa3);
      partialSM<VAR>(pA0, pA1, m_reg, alA); RESC(alA);
      SBAR(); { qkt<VAR>(pB0, pB1, K_lds + SLOT(k), qr, mapcolB, r32, hi, -m_reg);
      finishSM<VAR>(pA0, pA1, alA, l_reg, pa0, pa1, pa2, pa3); } SBAR();
      SWAIT(); SWRITE(SLOT(k + 1)); __syncthreads();
      SLOAD((k + 2) * 64, SLOT(k + 2)); SBAR();
      pv_d0<VAR>(o, vb0 + SLOT(k - 1), pa0, pa1, pa2, pa3); partialSM<VAR>(pB0, pB1, m_reg, alB); RESC(alB);
      SBAR(); { qkt<VAR>(pA0, pA1, K_lds + SLOT(k + 1), qr, mapcolB, r32, hi, -m_reg);
      finishSM<VAR>(pB0, pB1, alB, l_reg, pa0, pa1, pa2, pa3); } SBAR();
      SWAIT(); SWRITE(SLOT(k + 2)); __syncthreads();
    }
    pv_d0<VAR>(o, vb0 + SLOT(NT - 3), pa0, pa1, pa2, pa3); partialSM<VAR>(pA0, pA1, m_reg, alA); RESC(alA);
    SBAR(); { qkt<VAR>(pB0, pB1, K_lds + SLOT(NT - 1), qr, mapcolB, r32, hi, -m_reg);
    finishSM<VAR>(pA0, pA1, alA, l_reg, pa0, pa1, pa2, pa3); } SBAR();
    pv_d0<VAR>(o, vb0 + SLOT(NT - 2), pa0, pa1, pa2, pa3); partialSM<VAR>(pB0, pB1, m_reg, alB); RESC(alB);
    finishSM<VAR>(pB0, pB1, alB, l_reg, pa0, pa1, pa2, pa3); SBAR();
    pv_d0<VAR>(o, vb0 + SLOT(NT - 1), pa0, pa1, pa2, pa3);
  }
  if (hi == 0) li_l[r32] = l_reg; asm volatile("s_waitcnt lgkmcnt(0)" ::: "memory");
  float rli[16]; const float fac = map ? lam : 1.f;
#pragma unroll
  for (int r = 0; r < 16; ++r) rli[r] = fac * __builtin_amdgcn_rcpf(li_l[crow(r, hi)]);
  __syncthreads();
  LAS float* stg = (LAS float*)lds + wid * (32 * 128);
#pragma unroll
  for (int r = 0; r < 16; ++r)
#pragma unroll
    for (int d0 = 0; d0 < 4; ++d0) stg[crow(r, hi) * 128 + d0 * 32 + r32] = o[d0][r] * rli[r];
  __syncthreads();
  {
    const int qi = 16 * map + (lane >> 2), qt = lane & 3;
    const LAS float* pa = (const LAS float*)lds + wq * (32 * 128) + qi * 128 + qt * 32;
    const LAS float* pb = (const LAS float*)lds + (4 + wq) * (32 * 128) + qi * 128 + qt * 32;
    float v[32]; float ss = 0.f; f32x4 gv[8];
#pragma unroll
    for (int k = 0; k < 8; ++k) gv[k] = *(const f32x4*)(subg + qt * 32 + 4 * k);
#pragma unroll
    for (int k = 0; k < 8; ++k) { const f32x4 a = *(const LAS f32x4*)(pa + 4 * k), b = *(const LAS f32x4*)(pb + 4 * k);
#pragma unroll
      for (int j = 0; j < 4; ++j) { const float x = a[j] - b[j]; v[4 * k + j] = x; ss += x * x; } }
    ss += dpp_f<0xB1, 0xF>(ss); ss += dpp_f<0x4E, 0xF>(ss);
    float li_ = lam_init; asm volatile("" : "+s"(li_));
    const float rn = __builtin_amdgcn_rsqf(ss * (1.f / 128.f) + 1e-5f) * (1.f - li_);
    bf16_t* op = Og + (size_t)(qrow0 + wq * 32 + qi) * 1024 + h * 128 + qt * 32;
#pragma unroll
    for (int k = 0; k < 4; ++k) { f32x4 a, b;
#pragma unroll
      for (int j = 0; j < 4; ++j) { a[j] = v[8 * k + j] * rn * gv[2 * k][j]; b[j] = v[8 * k + 4 + j] * rn * gv[2 * k + 1][j]; }
      *(u32x4*)(op + 8 * k) = pack8(a, b); }
  }
  __syncthreads();
#undef SLOT
#undef SLOAD
#undef SWRITE
#undef SWAIT
#undef RESC
}
template <int VAR = 0> __device__ __forceinline__ void attn_phase(KP p, int l, LAS char* lds, const int g_wv) {
  const int tid = otid(), lane = tid & 63; const bool last = (l == DEPTH - 1);
  float s1 = p.in.lam_q1[l * 64 + lane] * p.in.lam_k1[l * 64 + lane], s2 = p.in.lam_q2[l * 64 + lane] * p.in.lam_k2[l * 64 + lane];
  s1 = wave_sum_u(s1); s2 = wave_sum_u(s2);
  const float lam_init_v = 0.8f - 0.6f * expf(-0.3f * (float)l); const float lam_v = expf(s1) - expf(s2) + lam_init_v;
  const float lam_init = __builtin_bit_cast(float, __builtin_amdgcn_readfirstlane(__builtin_bit_cast(int, lam_init_v))), lam = __builtin_bit_cast(float, __builtin_amdgcn_readfirstlane(__builtin_bit_cast(int, lam_v)));
  const int c = obid(), x = c & 7, jl = c >> 3, per = ogd() >> 3;
  const int nu = (!last && jl >= 24) ? 6 : 4;
  for (int u = 0; u < nu; ++u) { const int q = u < 4 ? jl + per * u : 128 + (jl - 24) * 2 + (u - 4);
    int qrow0, nkeys, h;
    if (q < 128) { h = q >> 4; qrow0 = x * SEQ + (q & 15) * 128; nkeys = KVB; }
    else { const int qq = q - 128; h = qq >> 1; qrow0 = NLAT + x * CTX + (qq & 1) * 128; nkeys = CTX; }
    attn_unit<VAR>(p.Qb, p.Kc, p.Vc, p.ATTb, qrow0, x * KVB, nkeys, h, lam, lam_init, p.in.subln_g + l * 128, lds, g_wv);
  }
}

__device__ __forceinline__ float wave_sum(float v) { return wave_sum_u(v); }
__device__ __forceinline__ void row_ld(const float* p, int lane, f32x4 (&v)[4]) {
#pragma unroll
  for (int i = 0; i < 4; ++i) v[i] = *(const f32x4*)(p + 4 * lane + 256 * i); }
__device__ __forceinline__ void row_st(float* p, int lane, const f32x4 (&v)[4]) {
#pragma unroll
  for (int i = 0; i < 4; ++i) *(f32x4*)(p + 4 * lane + 256 * i) = v[i]; }
__device__ __forceinline__ void row_st_bf16(bf16_t* p, int lane, const f32x4 (&v)[4]) {
#pragma unroll
  for (int i = 0; i < 4; ++i) { u32x2 w; w.x = cvt_pk_bf16(v[i][0], v[i][1]); w.y = cvt_pk_bf16(v[i][2], v[i][3]); *(u32x2*)(p + 4 * lane + 256 * i) = w; } }
__device__ __forceinline__ void row_st_h16(bf16_t* p, int lane, const f32x4 (&v)[4]) {
#pragma unroll
  for (int i = 0; i < 4; ++i) { u32x2 w; w.x = pk_h16(v[i][0], v[i][1]); w.y = pk_h16(v[i][2], v[i][3]); *(u32x2*)(p + 4 * lane + 256 * i) = w; } }
__device__ __forceinline__ void row_ld_bf16(const bf16_t* p, int lane, f32x4 (&v)[4]) {
#pragma unroll
  for (int i = 0; i < 4; ++i) { const u32x2 w = *(const u32x2*)(p + 4 * lane + 256 * i); v[i] = (f32x4){bflo(w.x), bfhi(w.x), bflo(w.y), bfhi(w.y)}; } }
__device__ __forceinline__ void row_ln(f32x4 (&v)[4], const float* g, const float* b, int lane) {
  float s = 0.f;
#pragma unroll
  for (int i = 0; i < 4; ++i) s += (v[i][0] + v[i][1]) + (v[i][2] + v[i][3]);
  const float mean = wave_sum(s) * (1.f / 1024.f); float q = 0.f;
#pragma unroll
  for (int i = 0; i < 4; ++i) { v[i] -= mean; q += (v[i][0] * v[i][0] + v[i][1] * v[i][1]) + (v[i][2] * v[i][2] + v[i][3] * v[i][3]); }
  const float rs = __builtin_amdgcn_rsqf(wave_sum(q) * (1.f / 1024.f) + 1e-5f);
#pragma unroll
  for (int i = 0; i < 4; ++i) { const f32x4 gg = *(const f32x4*)(g + 4 * lane + 256 * i), bb = *(const f32x4*)(b + 4 * lane + 256 * i); v[i] = v[i] * rs * gg + bb; }
}
__device__ __forceinline__ void row_ln_r(f32x4 (&v)[4], const f32x4 (&gg)[4], const f32x4 (&bb)[4]) {
  float s = 0.f;
#pragma unroll
  for (int i = 0; i < 4; ++i) s += (v[i][0] + v[i][1]) + (v[i][2] + v[i][3]);
  const float mean = wave_sum(s) * (1.f / 1024.f); float q = 0.f;
#pragma unroll
  for (int i = 0; i < 4; ++i) { v[i] -= mean; q += (v[i][0] * v[i][0] + v[i][1] * v[i][1]) + (v[i][2] * v[i][2] + v[i][3] * v[i][3]); }
  const float rs = __builtin_amdgcn_rsqf(wave_sum(q) * (1.f / 1024.f) + 1e-5f);
#pragma unroll
  for (int i = 0; i < 4; ++i) v[i] = v[i] * rs * gg[i] + bb[i];
}
__device__ __forceinline__ void row_mod(f32x4 (&h)[4], const f32x4 (&v)[4], const float* modrow, int shift_idx, int scale_idx, int lane) {
#pragma unroll
  for (int i = 0; i < 4; ++i) { const f32x4 sc = *(const f32x4*)(modrow + scale_idx * 1024 + 4 * lane + 256 * i), sh = *(const f32x4*)(modrow + shift_idx * 1024 + 4 * lane + 256 * i); h[i] = v[i] * (1.f + sc) + sh; }
}
__device__ __forceinline__ int modrow_of_row(int r) { return r < NLAT ? (r >> 11) : 8; }

__device__ __forceinline__ void h0_phase(KP p, const int g_wv) {
  const int tid = otid(); const int lane = tid & 63, gw = obid() * 8 + (tid >> 6), nw = ogd() * 8;
  const int per = (NR + nw - 1) / nw;
  f32x4 v[9][4], scr[4], shr[4]; int mrow = -1;
#pragma unroll
  for (int i = 0; i < 9; ++i) { const int r = gw * per + i; if (i < per && r < NR) row_ld(r < NLAT ? p.in.x + (size_t)r * D : p.in.ctx + (size_t)(r - NLAT) * D, lane, v[i]); }
#pragma unroll
  for (int i = 0; i < 9; ++i) { const int r = gw * per + i; if (i < per && r < NR) {
    if (modrow_of_row(r) != mrow) { mrow = modrow_of_row(r); const float* mn = p.MOD + (size_t)mrow * 6144 + 4 * lane;
#pragma unroll
      for (int q = 0; q < 4; ++q) { shr[q] = *(const f32x4*)(mn + 256 * q); scr[q] = *(const f32x4*)(mn + 1024 + 256 * q); } }
    f32x4 h[4];
#pragma unroll
    for (int q = 0; q < 4; ++q) h[q] = v[i][q] * (1.f + scr[q]) + shr[q];
    row_st_bf16(p.Hb + (size_t)r * D, lane, h); } }
}
constexpr int LN1_RS = 1032, LN1_HXB = 32 * LN1_RS * 2, LN1_OFF_SUM = 2 * LN1_HXB, LN1_OFF_LCNT = LN1_OFF_SUM + 64 * 32 * 4, LN1_OFF_LBASE = LN1_OFF_LCNT + 128, LN1_OFF_ENT = LN1_OFF_LBASE + 128, LN1_END = LN1_OFF_ENT + 72 * 16;
__device__ __forceinline__ void ln1_phase(KP p, int l, LAS char* lds, const int g_wv) {
  const int tid = otid(), lane = tid & 63, wid = tid >> 6, gw = obid() * 8 + wid; const bool last = (l == DEPTH - 1);
  LAS bf16_t* HXhi = (LAS bf16_t*)lds; LAS bf16_t* HXlo = (LAS bf16_t*)(lds + LN1_HXB); LAS float* RED = (LAS float*)lds;
  LAS int* lcnt = (LAS int*)(lds + LN1_OFF_LCNT); LAS int* lbase = (LAS int*)(lds + LN1_OFF_LBASE); LAS int* ent = (LAS int*)(lds + LN1_OFF_ENT);
  if (tid < 32) lcnt[tid] = 0;
  const float* MODl = p.MOD + (size_t)l * 9 * 6144; const bf16_t* WRh = (const bf16_t*)p.s[l].WR; const bf16_t* WRl = WRh + 64 * 1024;
  const int nrow = last ? NLAT : NR, ni = nrow / 2048; const int c32 = lane & 31, hh = lane >> 5;
  u32x4 vn[3][4];
#define LN1_XROW(r) ((r) < NLAT ? p.in.x + (size_t)(r) * D : p.in.ctx + (size_t)((r) - NLAT) * D)
#define LN1_LD(j, r) do { if (l == 0) { const float* s_ = LN1_XROW(r); _Pragma("unroll") for (int q_ = 0; q_ < 4; ++q_) vn[j][q_] = *(const u32x4*)(s_ + 4 * lane + 256 * q_); } \
    else { _Pragma("unroll") for (int q_ = 0; q_ < 4; ++q_) { const u32x2 t_ = *(const u32x2*)((const bf16_t*)p.XL + (size_t)(r) * D + 4 * lane + 256 * q_); vn[j][q_].x = t_.x; vn[j][q_].y = t_.y; } } } while (0)
#define LN1_LDD(r) do { _Pragma("unroll") for (int q_ = 0; q_ < 4; ++q_) dq[q_] = *(const u32x2*)(p.ATTb + (size_t)(r) * D + 4 * lane + 256 * q_); } while (0)
#pragma unroll
  for (int j = 0; j < 3; ++j) if (j < ni) LN1_LD(j, gw * ni + j);
  f32x4 scr[4], shr[4]; int mrow = -1;
  u32x2 dq[4];
  LN1_LDD(gw * ni);
#pragma unroll 1
  for (int i0 = 0; i0 < ni; i0 += 3) {
#pragma unroll
    for (int j = 0; j < 3; ++j) { const int r = gw * ni + (i0 + j); const int slot = wid * 3 + j;
      if (i0 + j < ni) { f32x4 v[4], h[4];
#pragma unroll
        for (int q = 0; q < 4; ++q) { const f32x4 xi = l == 0 ? __builtin_bit_cast(f32x4, vn[j][q]) : (f32x4){h16lo(vn[j][q].x), h16hi(vn[j][q].x), h16lo(vn[j][q].y), h16hi(vn[j][q].y)};
          v[q] = xi * ALPHA + (f32x4){bflo(dq[q].x), bfhi(dq[q].x), bflo(dq[q].y), bfhi(dq[q].y)}; }
        if (i0 + j + 1 < ni) LN1_LDD(r + 1);
        if (i0 + 3 + j < ni) LN1_LD(j, r + 3);
        if (modrow_of_row(r) != mrow) { mrow = modrow_of_row(r); const float* mn = MODl + (size_t)mrow * 6144 + 4 * lane;
#pragma unroll
          for (int q = 0; q < 4; ++q) { shr[q] = *(const f32x4*)(mn + 3 * 1024 + 256 * q); scr[q] = *(const f32x4*)(mn + 4 * 1024 + 256 * q); } }
        { f32x4 gg[4], bb[4];
#pragma unroll
          for (int q = 0; q < 4; ++q) { gg[q] = *(const f32x4*)(p.in.ln1_g + l * D + 4 * lane + 256 * q); bb[q] = *(const f32x4*)(p.in.ln1_b + l * D + 4 * lane + 256 * q); }
          __builtin_amdgcn_sched_barrier(0);
          row_ln_r(v, gg, bb); }
        row_st_h16(p.X1b + (size_t)r * D, lane, v);
#pragma unroll
        for (int q = 0; q < 4; ++q) h[q] = v[q] * (1.f + scr[q]) + shr[q];
#pragma unroll
        for (int q = 0; q < 4; ++q) { u32x2 wh; wh.x = cvt_pk_bf16(h[q][0], h[q][1]); wh.y = cvt_pk_bf16(h[q][2], h[q][3]); *(u32x2*)(p.H2b + (size_t)r * D + 4 * lane + 256 * q) = wh;
          u32x2 wl; wl.x = cvt_pk_bf16(h[q][0] - bflo(wh.x), h[q][1] - bfhi(wh.x)); wl.y = cvt_pk_bf16(h[q][2] - bflo(wh.y), h[q][3] - bfhi(wh.y));
          *(LAS u32x2*)(HXhi + slot * LN1_RS + 4 * lane + 256 * q) = wh; *(LAS u32x2*)(HXlo + slot * LN1_RS + 4 * lane + 256 * q) = wl; } }
      else {
#pragma unroll
        for (int q = 0; q < 4; ++q) { *(LAS u32x2*)(HXhi + slot * LN1_RS + 4 * lane + 256 * q) = (u32x2){0u, 0u}; *(LAS u32x2*)(HXlo + slot * LN1_RS + 4 * lane + 256 * q) = (u32x2){0u, 0u}; } } }
    __syncthreads();
#ifdef PROBE_G0
    if (p.pad0 & 1) continue;
#endif
    f32x16 acc0 = {}, acc1 = {};
#pragma unroll 1
    for (int s4 = 0; s4 < 8; s4 += 4) { bf16x8 wf[4][4];
#pragma unroll
      for (int u = 0; u < 4; ++u) { const int ko = (wid * 8 + s4 + u) * 16 + hh * 8;
        wf[u][0] = *(const bf16x8*)(WRh + (size_t)c32 * 1024 + ko); wf[u][1] = *(const bf16x8*)(WRl + (size_t)c32 * 1024 + ko);
        wf[u][2] = *(const bf16x8*)(WRh + (size_t)(32 + c32) * 1024 + ko); wf[u][3] = *(const bf16x8*)(WRl + (size_t)(32 + c32) * 1024 + ko); }
      __builtin_amdgcn_sched_barrier(0);
#pragma unroll
      for (int u = 0; u < 4; ++u) { const int ko = (wid * 8 + s4 + u) * 16 + hh * 8;
        const bf16x8 bh = *(const LAS bf16x8*)(HXhi + c32 * LN1_RS + ko), bl = *(const LAS bf16x8*)(HXlo + c32 * LN1_RS + ko);
        acc0 = __builtin_amdgcn_mfma_f32_32x32x16_bf16(wf[u][0], bh, acc0, 0, 0, 0); acc0 = __builtin_amdgcn_mfma_f32_32x32x16_bf16(wf[u][0], bl, acc0, 0, 0, 0); acc0 = __builtin_amdgcn_mfma_f32_32x32x16_bf16(wf[u][1], bh, acc0, 0, 0, 0);
        acc1 = __builtin_amdgcn_mfma_f32_32x32x16_bf16(wf[u][2], bh, acc1, 0, 0, 0); acc1 = __builtin_amdgcn_mfma_f32_32x32x16_bf16(wf[u][2], bl, acc1, 0, 0, 0); acc1 = __builtin_amdgcn_mfma_f32_32x32x16_bf16(wf[u][3], bh, acc1, 0, 0, 0); } }
    __syncthreads();
#pragma unroll
    for (int r = 0; r < 16; ++r) { RED[(wid * 64 + crow(r, hh)) * 32 + c32] = acc0[r]; RED[(wid * 64 + 32 + crow(r, hh)) * 32 + c32] = acc1[r]; }
    __syncthreads();
    { LAS float* SUM = (LAS float*)(lds + LN1_OFF_SUM);
#pragma unroll
      for (int k = 0; k < 4; ++k) { const int idx = tid + 512 * k; float sacc = 0.f;
#pragma unroll
        for (int w = 0; w < 8; ++w) sacc += RED[w * 2048 + idx];
        SUM[idx] = sacc; } }
    __syncthreads();
    if (wid == 0 && lane < 24) { const int ws = lane / 3, j = lane - 3 * ws;
      if (i0 + j < ni) { const int r = (obid() * 8 + ws) * ni + (i0 + j); float lg[36]; const LAS float* SUM = (const LAS float*)(lds + LN1_OFF_SUM);
#pragma unroll
        for (int e = 0; e < 36; ++e) lg[e] = SUM[e * 32 + lane] + (e < 4 ? p.in.rg_b[l * 4 + e] : p.in.re_b[l * 32 + e - 4]);
        int gi = 0; float gm = lg[0];
#pragma unroll
        for (int q = 1; q < 4; ++q) if (lg[q] > gm) { gm = lg[q]; gi = q; }
        float gs = 0.f;
#pragma unroll
        for (int q = 0; q < 4; ++q) gs += expf(lg[q] - gm);
        const float gtop = 1.f / gs; float el[8];
#pragma unroll
        for (int q = 0; q < 8; ++q) el[q] = gi == 0 ? lg[4 + q] : gi == 1 ? lg[12 + q] : gi == 2 ? lg[20 + q] : lg[28 + q];
        int i0e = 0; float v0 = el[0];
#pragma unroll
        for (int q = 1; q < 8; ++q) if (el[q] > v0) { v0 = el[q]; i0e = q; }
        int i1e = -1; float v1 = -3.0e38f;
#pragma unroll
        for (int q = 0; q < 8; ++q) if (q != i0e && el[q] > v1) { v1 = el[q]; i1e = q; }
        const float e1 = expf(v1 - v0); const float w0 = gtop / (1.f + e1), w1 = gtop * e1 / (1.f + e1);
        const int e0i = gi * 8 + i0e, e1i = gi * 8 + i1e;
        const int lr0 = __hip_atomic_fetch_add(&lcnt[e0i], 1, __ATOMIC_RELAXED, __HIP_MEMORY_SCOPE_WORKGROUP); const int lr1 = __hip_atomic_fetch_add(&lcnt[e1i], 1, __ATOMIC_RELAXED, __HIP_MEMORY_SCOPE_WORKGROUP);
        { LAS int* ep = ent + ((i0 + j) * 8 + ws) * 4; ep[0] = e0i; ep[1] = e1i; ep[2] = lr0; ep[3] = lr1; } *(float2*)(p.RW + (size_t)r * 2) = make_float2(w0, w1); } }
  }
  __syncthreads();
#ifdef PROBE_G0
  if (p.pad0 & 1) return;
#endif
  if (tid < 32) lbase[tid] = (int)atomicAdd(p.ctl + l * CTL_WORDS + CTL_CNT + 64 * tid, (unsigned)lcnt[tid]);
  __syncthreads();
  if (tid < ni * 8) { const int i = tid >> 3, w = tid & 7; const int r = (obid() * 8 + w) * ni + i; const LAS int* ep = ent + tid * 4; const int4 en = make_int4(ep[0], ep[1], ep[2], ep[3]); const int g0 = lbase[en.x] + en.z, g1 = lbase[en.y] + en.w;
    p.TOK[(size_t)en.x * NR + g0] = r; p.TOK[(size_t)en.y * NR + g1] = r; *(int4*)(p.ROUTE + (size_t)r * 4) = make_int4(en.x, en.y, g0, g1); }
}
__device__ __forceinline__ void moe_table(KP p, int l, LAS MoeTab* tab, const int g_wv) {
  const int tid = otid();
  if (tid < 32) tab->cnt[tid] = (int)__hip_atomic_load(p.ctl + l * CTL_WORDS + CTL_CNT + 64 * tid, __ATOMIC_RELAXED, __HIP_MEMORY_SCOPE_AGENT);
  __syncthreads();
  if (tid < 32) {
    const int n = (tab->cnt[tid] + 255) >> 8; int t0 = 0, tot = 0;
#pragma unroll
    for (int e = 0; e < 32; ++e) { const int ne = (tab->cnt[e] + 255) >> 8; if (e < tid) t0 += ne; tot += ne; }
    tab->tbase[tid] = t0; for (int i = 0; i < n; ++i) { tab->tileE[t0 + i] = tid; tab->tileR0[t0 + i] = i * 256; }
    if (tid == 0) { tab->tbase[32] = tot; tab->ntiles = tot; } }
  __syncthreads();
}
__device__ __forceinline__ void ln2_phase(KP p, int l, LAS char* lds, const int g_wv) {
  const int tid = otid(), lane = tid & 63, wid = tid >> 6, gw = obid() * 8 + wid; const bool last = (l == DEPTH - 1);
  LAS MoeTab* tab = (LAS MoeTab*)lds; moe_table(p, l, tab, g_wv);
  const float* MODl = p.MOD + (size_t)l * 9 * 6144; const int ni = last ? NLAT / 2048 : NR / 2048;
  int4 rt[9]; float2 rw[9]; f32x4 gg[4], bb[4];
#pragma unroll
  for (int q = 0; q < 4; ++q) { gg[q] = *(const f32x4*)(p.in.ln2_g + l * D + 4 * lane + 256 * q); bb[q] = *(const f32x4*)(p.in.ln2_b + l * D + 4 * lane + 256 * q); }
#pragma unroll
  for (int i = 0; i < 9; ++i) if (i < ni) { const int r = gw * ni + i; rt[i] = *(const int4*)(p.ROUTE + (size_t)r * 4); rw[i] = *(const float2*)(p.RW + (size_t)r * 2); }
  u32x2 xb[4], ya[4], yb[4];
#define LN2_LOAD(i) do { const int r_ = gw * ni + (i); const int p0_ = (tab->tbase[rt[i].x] + (rt[i].z >> 8)) * 256 + (rt[i].z & 255), p1_ = (tab->tbase[rt[i].y] + (rt[i].w >> 8)) * 256 + (rt[i].w & 255); \
    _Pragma("unroll") for (int q_ = 0; q_ < 4; ++q_) { xb[q_] = *(const u32x2*)(p.X1b + (size_t)r_ * D + 4 * lane + 256 * q_); ya[q_] = *(const u32x2*)(p.Yo + (size_t)p0_ * D + 4 * lane + 256 * q_); yb[q_] = *(const u32x2*)(p.Yo + (size_t)p1_ * D + 4 * lane + 256 * q_); } } while (0)
  LN2_LOAD(0);
  f32x4 g2r[4], scr[4], shr[4]; int mrow = -1;
#pragma unroll
  for (int i = 0; i < 9; ++i) if (i < ni) { const int r = gw * ni + i; const float2 w = rw[i]; f32x4 x[4];
    if (modrow_of_row(r) != mrow) { mrow = modrow_of_row(r); const float* mr = MODl + (size_t)mrow * 6144 + 5 * 1024 + 4 * lane; const float* mn = p.MOD + ((size_t)(last ? l : l + 1) * 9 + mrow) * 6144 + 4 * lane;
#pragma unroll
      for (int q = 0; q < 4; ++q) { g2r[q] = *(const f32x4*)(mr + 256 * q); shr[q] = *(const f32x4*)(mn + 256 * q); scr[q] = *(const f32x4*)(mn + 1024 + 256 * q); } }
#pragma unroll
    for (int q = 0; q < 4; ++q) { const f32x4 g2 = g2r[q]; const f32x4 y0 = (f32x4){bflo(ya[q].x), bfhi(ya[q].x), bflo(ya[q].y), bfhi(ya[q].y)}, y1 = (f32x4){bflo(yb[q].x), bfhi(yb[q].x), bflo(yb[q].y), bfhi(yb[q].y)};
      x[q] = (f32x4){h16lo(xb[q].x), h16hi(xb[q].x), h16lo(xb[q].y), h16hi(xb[q].y)} * ALPHA + g2 * (y0 * w.x + y1 * w.y); }
    if (i + 1 < ni) LN2_LOAD(i + 1);
    row_ln_r(x, gg, bb);
    if (!last) { row_st_h16((bf16_t*)p.XL + (size_t)r * D, lane, x); f32x4 h[4];
#pragma unroll
      for (int q = 0; q < 4; ++q) h[q] = x[q] * (1.f + scr[q]) + shr[q];
      row_st_bf16(p.Hb + (size_t)r * D, lane, h); }
    else row_st(p.out + (size_t)r * D, lane, x); }
#undef LN2_LOAD
}
__device__ __forceinline__ void s2_phase(KP p, int l, const int g_wv) {
  const int tid = otid(); const int it = (tid >> 7) * 96 + obid(); if (it >= NG * 8) return;
  const int g = it >> 3, b = it & 7, dir = (tid >> 6) & 1, pp = tid & 63;
  const f32x2 aL = *(const f32x2*)(p.s[l].SAL + ((size_t)(g * 2 + dir) * 64 + pp) * 2);
  const float* S = p.SST + (size_t)g * NCHP * 256 + dir * 128 + 2 * pp; bf16_t* A = p.Ug + (size_t)g * NCHP * 768 + 512 + dir * 128 + 2 * pp;
  float hr = 0.f, hi = 0.f;
#pragma unroll 1
  for (int s0 = 0; s0 < 72; s0 += 24) {
    f32x2 sv[24];
#pragma unroll
    for (int k = 0; k < 24; ++k) { const int s = s0 + k; int row; if (dir == 0) row = s < 8 ? 512 + b * 8 + s : b * 64 + (s - 8); else row = s < 8 ? 512 + b * 8 + (7 - s) : b * 64 + (63 - (s - 8));
      sv[k] = *(const f32x2*)(S + (size_t)row * 256); }
#pragma unroll
    for (int k = 0; k < 24; ++k) { const int s = s0 + k; int row; if (dir == 0) row = s < 8 ? 512 + b * 8 + s : b * 64 + (s - 8); else row = s < 8 ? 512 + b * 8 + (7 - s) : b * 64 + (63 - (s - 8));
      *(unsigned*)(A + (size_t)row * 768) = cvt_pk_bf16(hr, hi);
      const float nr = aL.x * hr - aL.y * hi + sv[k].x, ni = aL.x * hi + aL.y * hr + sv[k].y; hr = nr; hi = ni; }
  }
}

struct ConvJob { const float* src; const float* src2; bf16_t* dst; int ldd, lds_, kind, nK; };
__device__ __forceinline__ void conv_step(const ConvJob& j, int nt, int kt, int lane) {
  const int q = lane & 15, kq = lane >> 4; const int n = nt * 64 + 4 * q, k0 = kt * 64 + kq * 8; const float* s = j.src; int col;
  if (j.kind == 0) col = (n & ~31) + perm32(n & 31);
  else if (j.kind == 1) { const int pn = n >> 8; if (pn < 4 || (pn >= 10 && pn < 14)) col = n; else if (pn < 10) col = (n & ~31) + perm32(n & 31);
    else { const int bj = (n >> 7) & 1, w = n & 127; col = (bj ? 4608 : 3584) + (pn - 14) * 128 + (w & ~31) + perm32(w & 31); } }
  else { const int bj = (n >> 7) & 1, w = n & 127; col = (n >> 8) * 128 + (w & ~31) + perm32(w & 31); if (bj) s = j.src2; }
  const float* sp = s + (size_t)k0 * j.lds_ + col; f32x4 v[16];
#pragma unroll
  for (int i = 0; i < 8; ++i) { v[i] = __builtin_nontemporal_load((const f32x4*)(sp + (size_t)i * j.lds_)); v[8 + i] = __builtin_nontemporal_load((const f32x4*)(sp + (size_t)(32 + i) * j.lds_)); }
  bf16_t* dp = j.dst + (size_t)n * j.ldd + k0;
#pragma unroll
  for (int r = 0; r < 4; ++r) {
    *(u32x4*)(dp + (size_t)r * j.ldd) = pack8((f32x4){v[0][r], v[1][r], v[2][r], v[3][r]}, (f32x4){v[4][r], v[5][r], v[6][r], v[7][r]});
    *(u32x4*)(dp + (size_t)r * j.ldd + 32) = pack8((f32x4){v[8][r], v[9][r], v[10][r], v[11][r]}, (f32x4){v[12][r], v[13][r], v[14][r], v[15][r]}); }
}
__device__ __forceinline__ void ssm_mats(KP p, KS W, int l, int g, int hf, LAS char* lds, const int g_wv) {
  const int tid = otid();
  LAS f32x2* AP = (LAS f32x2*)lds;
  LAS f32x2* BB = AP + 2 * 64 * 34;
  LAS f32x2* CC = BB + 2 * 64 * 16;
  LAS float* KT = (LAS float*)(CC + 2 * 16 * 64);
  LAS float* DS = KT + 32 * 260 + 256;
  const size_t so = (size_t)l * 2 * NG * NP;
  if (tid < 128) { const int dir = tid >> 6, pp = tid & 63; const size_t gp = so + ((size_t)dir * NG + g) * NP + pp;
    const float dtf = expf(p.in.log_dt[(size_t)l * 2 * NG + dir * NG + g]); const double are = p.in.a_re[gp], aim = p.in.a_im[gp], dt = (double)dtf;
    double ang = aim * dt; ang -= 6.283185307179586476925 * (double)(long long)(ang * 0.15915494309189533577 + (ang >= 0 ? 0.5 : -0.5));
    const float e1f = expf((float)(are * dt)), angf = (float)ang; const double c1r = (double)(e1f * cosf(angf)), c1i = (double)(e1f * sinf(angf));
    { float onef = 1.f; asm volatile("" : "+v"(onef)); double cr = (double)onef, ci = 0.0;
      for (int t = 0; t < 34; ++t) { AP[(dir * 64 + pp) * 34 + t] = (f32x2){(float)cr, (float)ci}; if (t == 32 && hf == 0) *(f32x2*)(W.SAL + ((size_t)(g * 2 + dir) * 64 + pp) * 2) = (f32x2){(float)cr, (float)ci}; const double nr2 = cr * c1r - ci * c1i, ni2 = cr * c1i + ci * c1r; cr = nr2; ci = ni2; } }
    const float sh = sinf(0.5f * angf); const double nr = (double)(expm1f((float)(are * dt)) * cosf(angf) - 2.f * sh * sh), ni = c1i, den = are * are + aim * aim; const double fr = (nr * are + ni * aim) / den, fi = (ni * are - nr * aim) / den;
    f32x4 brv[4], biv[4];
#pragma unroll
    for (int c = 0; c < 4; ++c) { brv[c] = *(const f32x4*)(p.in.b_re + gp * 16 + 4 * c); biv[c] = *(const f32x4*)(p.in.b_im + gp * 16 + 4 * c); }
#pragma unroll
    for (int c = 0; c < 16; ++c) { const double br = brv[c >> 2][c & 3], bi = biv[c >> 2][c & 3]; BB[(dir * 64 + pp) * 16 + c] = (f32x2){(float)(fr * br - fi * bi), (float)(fr * bi + fi * br)}; }
  }
  if (tid >= 496) DS[tid - 496] = p.in.ssm_d[l * SSMW + g * 16 + (tid - 496)];
  for (int i = tid; i < 2 * 16 * 64; i += 512) { const int dir = i >> 10, c = (i >> 6) & 15, pp = i & 63; const size_t ci = (so + ((size_t)dir * NG + g) * NP) * 16 + (size_t)c * NP + pp; CC[i] = (f32x2){p.in.c_re[ci], p.in.c_im[ci]}; }
  __syncthreads();
  LAS float* K0o = KT + 32 * 260;
  { const int half = tid >> 8, co = (tid >> 4) & 15, ci = tid & 15; float acc[16];
#pragma unroll
    for (int t = 0; t < 16; ++t) acc[t] = 0.f;
#pragma unroll 2
    for (int pp = 0; pp < 64; ++pp) { const f32x2 c = CC[(hf * 16 + co) * 64 + pp], bq = BB[(hf * 64 + pp) * 16 + ci];
      const LAS f32x4* ap = (const LAS f32x4*)(AP + (hf * 64 + pp) * 34) + half * 8; f32x4 a[8];
#pragma unroll
      for (int t2 = 0; t2 < 8; ++t2) a[t2] = ap[t2];
      __builtin_amdgcn_sched_barrier(0);
      const float cbr = c.x * bq.x - c.y * bq.y, cbi = c.x * bq.y + c.y * bq.x;
#pragma unroll
      for (int t2 = 0; t2 < 8; ++t2) { acc[2 * t2] += cbr * a[t2][0] - cbi * a[t2][1]; acc[2 * t2 + 1] += cbr * a[t2][2] - cbi * a[t2][3]; } }
#pragma unroll
    for (int t = 0; t < 16; ++t) KT[(half * 16 + t) * 260 + co * 16 + ci] = acc[t];
    if (tid < 256) { const int dir = 1 - hf; float s0 = 0.f;
      for (int pp = 0; pp < 64; ++pp) { const f32x2 c = CC[(dir * 16 + co) * 64 + pp], bq = BB[(dir * 64 + pp) * 16 + ci]; s0 += c.x * bq.x - c.y * bq.y; }
      K0o[co * 16 + ci] = s0; } }
  __syncthreads();
#ifdef PROBE_G0
  if (p.pad0 & 128) { __syncthreads(); return; }
#endif
  bf16_t* Sm = W.Smat + (size_t)g * 256 * 768;
  for (int i = tid; i < 128 * 64; i += 512) { const int n = hf * 128 + (i >> 6), k8 = (i & 63) * 8; const int Lc = (n & ~31) + perm32(n & 31); const int dir = Lc >> 7, pp = (Lc & 127) >> 1, ri = Lc & 1; const int t = k8 >> 4, c0 = k8 & 15;
    const f32x2 a = AP[(dir * 64 + pp) * 34 + (dir == 0 ? 31 - t : t)]; float v[8];
#pragma unroll
    for (int q = 0; q < 8; ++q) { const f32x2 bq = BB[(dir * 64 + pp) * 16 + c0 + q]; v[q] = ri == 0 ? a.x * bq.x - a.y * bq.y : a.x * bq.y + a.y * bq.x; }
    *(u32x4*)(Sm + (size_t)n * 768 + k8) = pack8((f32x4){v[0], v[1], v[2], v[3]}, (f32x4){v[4], v[5], v[6], v[7]}); }
  bf16_t* To = W.TO + (size_t)g * 512 * 768;
#ifdef PROBE_G0
  if (p.pad0 & 16) { __syncthreads(); return; }
#endif
  for (int i = tid; i < 512 * 64; i += 512) { const int n = i >> 6, k8 = (i & 63) * 8; const int Lc = (n & ~31) + perm32(n & 31); const int t = Lc >> 4, co = Lc & 15; const int s = k8 >> 4, c0 = k8 & 15;
    if (hf == 0 ? s > t : s <= t) continue;
    const int tau = hf == 0 ? t - s : s - t; const LAS f32x4* kk = (const LAS f32x4*)(KT + tau * 260 + co * 16 + c0); f32x4 v0 = kk[0], v1 = kk[1];
    if (s == t) { const LAS f32x4* ko = (const LAS f32x4*)(K0o + co * 16 + c0); v0 += ko[0]; v1 += ko[1]; const float dv = DS[co]; const int qd = co - c0;
#pragma unroll
      for (int q = 0; q < 4; ++q) { if (qd == q) v0[q] += dv; if (qd == 4 + q) v1[q] += dv; } }
    *(u32x4*)(To + (size_t)n * 768 + k8) = pack8(v0, v1); }
  for (int i = tid; i < 512 * 16; i += 512) { const int n = i >> 4, k8 = 512 + hf * 128 + (i & 15) * 8; const int Lc = (n & ~31) + perm32(n & 31); const int t = Lc >> 4, co = Lc & 15;
    const int dir = hf, pp0 = (i & 15) * 4; float v[8];
#pragma unroll
    for (int q = 0; q < 4; ++q) { const f32x2 a = AP[(dir * 64 + pp0 + q) * 34 + (dir == 0 ? t + 1 : 32 - t)], c = CC[(dir * 16 + co) * 64 + pp0 + q];
      v[2 * q] = c.x * a.x - c.y * a.y; v[2 * q + 1] = -(c.x * a.y + c.y * a.x); }
    *(u32x4*)(To + (size_t)n * 768 + k8) = pack8((f32x4){v[0], v[1], v[2], v[3]}, (f32x4){v[4], v[5], v[6], v[7]}); }
  __syncthreads();
}
__device__ __forceinline__ void mod_item(KP p, int l, int j0, LAS char* lds, const int g_wv) {
  const int tid = otid(); LAS float* sl = (LAS float*)lds;
  LAS float* part = sl + 9 * 1024;
  for (int i = tid; i < 9 * 1024; i += 512) { const int r = i >> 10, k = i & 1023; const float v = r < 8 ? p.in.c[r * 1024 + k] : p.in.c_ctx[k]; sl[i] = v / (1.f + expf(-v)); }
  __syncthreads();
  const int jj = tid & 63, ks = tid >> 6; float acc[9];
#pragma unroll
  for (int r = 0; r < 9; ++r) acc[r] = 0.f;
  const float* w = p.in.w_mod + (size_t)l * 1024 * 6144 + j0 + jj;
  for (int k0 = ks * 128; k0 < ks * 128 + 128; k0 += 16) { float wv[16];
#pragma unroll
    for (int u = 0; u < 16; ++u) wv[u] = __builtin_nontemporal_load(w + (size_t)(k0 + u) * 6144);
    __builtin_amdgcn_sched_barrier(0);
#pragma unroll
    for (int r = 0; r < 9; ++r)
#pragma unroll
      for (int u4 = 0; u4 < 4; ++u4) { const f32x4 sv = *(const LAS f32x4*)(sl + r * 1024 + k0 + 4 * u4); acc[r] += sv[0] * wv[4 * u4] + sv[1] * wv[4 * u4 + 1] + sv[2] * wv[4 * u4 + 2] + sv[3] * wv[4 * u4 + 3]; } }
#pragma unroll
  for (int r = 0; r < 9; ++r) part[(ks * 9 + r) * 64 + jj] = acc[r];
  __syncthreads();
  for (int i = tid; i < 9 * 64; i += 512) { const int r = i >> 6, j = i & 63; float s = 0.f;
#pragma unroll
    for (int k = 0; k < 8; ++k) s += part[(k * 9 + r) * 64 + j];
    p.MOD[((size_t)l * 9 + r) * 6144 + j0 + j] = s + p.in.b_mod[l * 6144 + j0 + j]; }
  __syncthreads();
}
constexpr int CONV_NONMOE = 2112;
__device__ __forceinline__ void conv_steps(KP p, int lc, int s0, int s1, int gw, int nw, int lane) {
  for (int t0 = s0 + gw; t0 < s1; t0 += nw) { int t = t0; ConvJob j; int nK;
    const int l = lc + 1; if (l >= DEPTH) continue;
    KW W = p.w[l & 1];
    if (t < 1408) { j.src = p.in.w_in + (size_t)l * 1024 * INW; j.src2 = nullptr; j.dst = W.Win; j.ldd = 1024; j.lds_ = INW; j.kind = 1; nK = 16; }
    else if ((t -= 1408) < 64) { j.src = p.in.w_glu + (size_t)l * 512 * 512; j.src2 = nullptr; j.dst = W.Wglu; j.ldd = 512; j.lds_ = 512; j.kind = 0; nK = 8; }
    else if ((t -= 64) < 256) { j.src = p.in.w_pa + (size_t)l * 1024 * 1024; j.src2 = nullptr; j.dst = W.Wpa; j.ldd = 1024; j.lds_ = 1024; j.kind = 0; nK = 16; }
    else if ((t -= 256) < 128) { j.src = p.in.w_ps + (size_t)l * 512 * 1024; j.src2 = nullptr; j.dst = W.Wps; j.ldd = 1024; j.lds_ = 1024; j.kind = 0; nK = 8; }
    else if ((t -= 128) < 256) { j.src = p.in.w_o + (size_t)l * 1024 * 1024; j.src2 = nullptr; j.dst = W.Wo; j.ldd = 1024; j.lds_ = 1024; j.kind = 0; nK = 16; }
    else if ((t -= 256) < 8192) { const int e = t >> 8; t &= 255; j.src = p.in.w1 + ((size_t)l * NE + e) * 1024 * 512; j.src2 = p.in.w3 + ((size_t)l * NE + e) * 1024 * 512; j.dst = W.W13 + (size_t)e * 1024 * 1024; j.ldd = 1024; j.lds_ = 512; j.kind = 2; nK = 16; }
    else { t -= 8192; const int e = t >> 7; t &= 127; j.src = p.in.w2 + ((size_t)l * NE + e) * 512 * 1024; j.src2 = nullptr; j.dst = W.W2 + (size_t)e * 1024 * 512; j.ldd = 512; j.lds_ = 1024; j.kind = 0; nK = 8; }
    conv_step(j, t / nK, t % nK, lane); }
}
__device__ __forceinline__ void router_tab(KP p, KS W, int l, int tid) {
  bf16_t* Wh = (bf16_t*)W.WR; bf16_t* Wl = Wh + 64 * 1024;
  for (int q = tid; q < 64 * 1024; q += 512) { const int e = q >> 10, k = q & 1023; const float w = e < 4 ? p.in.rg_w[((size_t)l * 1024 + k) * 4 + e] : e < 36 ? p.in.re_w[((size_t)l * 1024 + k) * 32 + (e - 4)] : 0.f;
    const unsigned hi = cvt_pk_bf16(w, 0.f) & 0xffffu; const unsigned lo = cvt_pk_bf16(w - bflo(hi), 0.f) & 0xffffu; Wh[q] = (bf16_t)hi; Wl[q] = (bf16_t)lo; }
}
constexpr int CONV_STEPS = 14400, CONV_S1 = 3250, CONV_S2 = 3250, CONV_S3 = 3250, CONV_S4 = 4594;
__device__ __forceinline__ void conv_phase(KP p, int l, LAS char* lds, const int g_wv) {
  const int tid = otid(); const int b = obid(); const int nb = ogd();
#ifdef PROBE_G0
  const int pf = p.pad0;
  if (pf) { if (!(pf & 2)) { for (int it = b; it < ((pf & 8) ? 2 : 1) * DEPTH * 2 * NG; it += nb) { const int ls = (it >> 6) & 3, r = it & 63; ssm_mats(p, p.s[ls], ls, r >> 1, r & 1, lds, g_wv); } }
    if (!(pf & 4)) { for (int it = b; it < 4 * 96; it += nb) mod_item(p, it / 96, (it % 96) * 64, lds, g_wv); }
    if (!(pf & 1)) conv_steps(p, -1, 0, CONV_STEPS, b * 8 + (tid >> 6), nb * 8, tid & 63);
    return; }
#endif
  const int hb = (b >> 3) & 1, ib = ((b >> 4) << 3) | (b & 7);
  if (hb) { for (int it = b; it < DEPTH * 2 * NG; it += nb) { const int ls = it >> 6, r = it & 63; ssm_mats(p, p.s[ls], ls, r >> 1, r & 1, lds, g_wv); } }
  else conv_steps(p, -1, 0, CONV_STEPS, ib * 8 + (tid >> 6), (nb >> 1) * 8 * 2, tid & 63);
  if (b < DEPTH) router_tab(p, p.s[b], b, tid);
  if (b == 4) { for (int q = tid; q < 2048 * 32; q += 512) { const int t = q >> 5, axis = (q >> 4) & 1, f = q & 15; const float pos = axis == 0 ? (float)(t >> 6) : (float)(t & 63);
      const float inv = 1.0f / powf(10000.0f, (float)(2 * f) / 32.0f); const float ang = pos * inv; p.ROPE[((size_t)t * 2 + axis) * 32 + f] = cosf(ang); p.ROPE[((size_t)t * 2 + axis) * 32 + 16 + f] = sinf(ang); } }
  for (int it = b; it < 4 * 96; it += nb) mod_item(p, it / 96, (it % 96) * 64, lds, g_wv);
  if (hb) conv_steps(p, -1, 0, CONV_STEPS, ((nb >> 1) + ib) * 8 + (tid >> 6), (nb >> 1) * 8 * 2, tid & 63);
  else { for (int it = b; it < DEPTH * 2 * NG; it += nb) { const int ls = it >> 6, r = it & 63; ssm_mats(p, p.s[ls], ls, r >> 1, r & 1, lds, g_wv); } }
}
__device__ __forceinline__ void conv_tail(KP p, int l, int part, const int g_wv) {
  const int b = obid(); const int tid = otid();
  if (part == 2) { if (b >= 144) conv_steps(p, l, 0, CONV_S1, (b - 144) * 8 + (tid >> 6), (ogd() - 144) * 8, tid & 63); return; }
  if (part == 3) { if (b >= 192) conv_steps(p, l, CONV_S2, CONV_S3, (b - 192) * 8 + (tid >> 6), (ogd() - 192) * 8, tid & 63); return; }
  if (part == 4) { if (b >= 144) conv_steps(p, l, CONV_S3, CONV_S4, (b - 144) * 8 + (tid >> 6), (ogd() - 144) * 8, tid & 63); return; }
  if (b < 32) return;
  if (b < 64) conv_steps(p, l, CONV_S4, CONV_S4 + 768, (b - 32) * 8 + (tid >> 6), 32 * 8, tid & 63);
  else conv_steps(p, l, CONV_S4 + 768, CONV_STEPS, (b - 64) * 8 + (tid >> 6), (ogd() - 64) * 8, tid & 63);
}
}
namespace fk {
constexpr int LDS_BYTES = 149504;
#ifndef STAG_G1
#define STAG_G1 450
#endif
#ifndef PROBE_MASK
#define PROBE_MASK 0
#endif
constexpr int NPH = 14;
enum { PH_CONV = 0, PH_H0, PH_GEMM1, PH_S1, PH_S2, PH_S3, PH_ATT, PH_GLU, PH_MERGE, PH_WO, PH_LN1, PH_MOE1, PH_MOE2, PH_LN2 };

__device__ __forceinline__ void run_phase(KP p, int l, int ph, LAS unsigned char* lds, const int g_wv) {
  const int G = ogd(), c = obid(); const bool last = (l == DEPTH - 1);
  const float* MODl = p.MOD + (size_t)l * 9 * 6144; KW W = p.w[l & 1]; KS SS = p.s[l];
  switch (ph) {
    case PH_CONV: if (l == 0) conv_phase(p, l, (LAS char*)lds, g_wv); break;
    case PH_H0: if (l == 0) h0_phase(p, g_wv); break;
    case PH_GEMM1: { SchedG1 S{(const char*)p.Hb, (const char*)W.Win, G, c, 0, last ? 1488 : 1536, last};
      EpiIn E{p.ROPE, p.Kc, p.Vc, p.Ug, p.Qb, p.RG, p.GSb, ~0}; gemm_stream(lds, 2048, 2048, S, E, g_wv); } break;
    case PH_S1: { unsigned* sp = p.ctl + l * CTL_WORDS + CTL_XC + 3 * 272; volatile LAS unsigned* xst = (volatile LAS unsigned*)(lds + LDS_BYTES - 16);
      if (c < 96) { SchedSsm1 S{(const char*)p.Ug, (const char*)SS.Smat, 96, c}; EpiState E{p.SST}; gemm_stream(lds, 1536, 1536, S, E, g_wv); }
      split_arrive(p.bar, xst, sp, sp + 256);
      if (c < 96) { split_wait(p.bar, xst, sp + 256); s2_phase(p, l, g_wv); } }
      if (c < 96) { }
      else if (!last && c < 144) { SchedG1 S{(const char*)p.Hb, (const char*)W.Win, 48, c - 96, 1536, 1584, false}; EpiIn E{p.ROPE, p.Kc, p.Vc, p.Ug, p.Qb, p.RG, p.GSb, ~0}; gemm_stream(lds, 2048, 2048, S, E, g_wv); }
      else conv_tail(p, l, 2, g_wv);
      break;
    case PH_S2: break;
    case PH_S3: break;
    case PH_ATT: {
      unsigned* sp = p.ctl + l * CTL_WORDS + CTL_XC + 4 * 272; volatile LAS unsigned* xst = (volatile LAS unsigned*)(lds + LDS_BYTES - 16);
      if ((c >> 3) < 24) { SchedSsm3 S{(const char*)p.Ug, (const char*)SS.TO, 256, (c & 7) * 24 + (c >> 3)}; EpiSsmOut E{p.YG}; gemm_stream(lds, 1536, 1536, S, E, g_wv); }
      split_arrive(p.bar, xst, sp, sp + 256);
      attn_phase(p, l, (LAS char*)lds, g_wv);
      split_wait(p.bar, xst, sp + 256);
      { SchedPlain S; S.A = (const char*)p.YG; S.B = (const char*)W.Wglu; S.lda = NR * 32; S.ldb = 1024; S.nM = last ? NLAT / 256 : NR / 256; S.nN = 2; S.nt = 8; S.G = G; S.c = c; S.nunits = S.nM * 2; S.epi = 1; S.atile = 256 * 32;
        EpiGlu E{p.YG, p.S2, p.in.b_glu + l * SSMW}; gemm_stream<EpiGlu, SchedPlain, false, 1>(lds, NR * 32, 1024, S, E, g_wv); } conv_tail(p, l, 4, g_wv); } break;
    case PH_GLU: break;
    case PH_MERGE: {
      unsigned* tc = p.ctl + l * CTL_WORDS + CTL_TILE; volatile LAS unsigned* xst = (volatile LAS unsigned*)(lds + LDS_BYTES - 16);
#ifdef PROBE_G0
      const int pf = p.pad0;
      const int nmu = (pf & 4) ? 0 : ((!last && c < 32 && !(pf & 8)) ? 2 : 1);
#define PF_SKIP(b) (pf & (b))
#else
#define PF_SKIP(b) false
      const int nmu = (!last && c < 32) ? 2 : 1;
#endif
      for (int k = 0; k < nmu; ++k) { int pm, pn; if (k == 0) tile_order(c, 64, 4, pm, pn); else { pm = 64 + (c & 7); pn = c >> 3; }
        pm = __builtin_amdgcn_readfirstlane(pm); pn = __builtin_amdgcn_readfirstlane(pn);
        SchedMergeOne S{(const char*)p.ATTb, (const char*)W.Wpa, (const char*)p.S2, (const char*)W.Wps, pm, pn}; EpiMerge E{p.RG, p.GSb, p.Mb}; gemm_stream(lds, 2048, 2048, S, E, g_wv);
        if (k == 0) split_arrive(p.bar, xst, p.ctl + l * CTL_WORDS + CTL_XC, p.ctl + l * CTL_WORDS + CTL_DONE); else tile_signal(tc + pm * 16); }
      const bool cf = ((c >> 3) & 1);
      if (cf && !PF_SKIP(1)) conv_tail(p, l, 1, g_wv);
      const int nwu = PF_SKIP(2) ? 0 : ((!last && c >= 32 && c < 64 && !PF_SKIP(16)) ? 2 : 1);
      for (int k = 0; k < nwu; ++k) { int pm, pn;
        if (last) tile_order(c, 64, 4, pm, pn); else if (c < 32) { pm = 64 + (c & 7); pn = c >> 3; } else tile_order(k == 0 ? c - 32 : 192 + c, 64, 4, pm, pn);
        pm = __builtin_amdgcn_readfirstlane(pm); pn = __builtin_amdgcn_readfirstlane(pn);
        if (pm >= 64) tile_wait(tc + pm * 16, 4u, p.bar); else if (k == 0) split_wait(p.bar, xst, p.ctl + l * CTL_WORDS + CTL_DONE);
        SchedPlainOne S{(const char*)p.Mb, (const char*)W.Wo, 16, pm, pn};
        EpiWo E{p.ATTb, MODl}; gemm_stream(lds, 2048, 2048, S, E, g_wv); }
      if (!cf && !PF_SKIP(1)) conv_tail(p, l, 1, g_wv); } break;
#undef PF_SKIP
    case PH_WO: break;
    case PH_LN1: ln1_phase(p, l, (LAS char*)lds, g_wv); break;
    case PH_MOE1: {
      LAS MoeTab* tab = (LAS MoeTab*)(lds + STAGE_BYTES); moe_table(p, l, tab, g_wv);
      const int nU = __builtin_amdgcn_readfirstlane(tab->ntiles) * 4, R = nU >> 8, rem = nU & 255;
      const int cc = ((c & 7) << 5) | (c >> 3);
      const int r2 = cc >= rem ? cc - rem : cc + 256 - rem;
      unsigned* sp = p.ctl + l * CTL_WORDS + CTL_XC + 272; volatile LAS unsigned* xst = (volatile LAS unsigned*)(lds + LDS_BYTES - 16);
      for (int st = 0; st < 2; ++st) {
        { SchedMoe S{(const char*)p.H2b, (const char*)W.W13, 2048, 2048, (size_t)1024 * 2048, tab, p.TOK, 4, 16, G, cc, true, st ? R : 0, st ? R + 1 : R}; EpiMoe1 E{p.Hm}; gemm_stream<EpiMoe1, SchedMoe, true>(lds, 2048, 2048, S, E, g_wv); }
        split_arrive(p.bar, xst, sp + st * 272, sp + st * 272 + 256); }
      for (int st = 0; st < 2; ++st) { if (st && r2 >= rem) break;
        split_wait(p.bar, xst, sp + st * 272 + 256);
        SchedMoe S{(const char*)p.Hm, (const char*)W.W2, 1024, 1024, (size_t)1024 * 1024, tab, p.TOK, 4, 8, G, r2, false, st ? R : 0, st ? R + 1 : R}; EpiMoe2 E{p.Yo}; gemm_stream(lds, 1024, 1024, S, E, g_wv); } } break;
    case PH_MOE2: break;
    case PH_LN2: ln2_phase(p, l, (LAS char*)lds, g_wv); break;
#if PROBE_MASK
    case 15: { SchedG1 S{(const char*)p.Hb, (const char*)W.Win, G, c, 0, 1536, false}; EpiIn E{p.ROPE, p.Kc, p.Vc, p.Ug, p.Qb, p.RG, p.GSb, 0}; gemm_stream(lds, 2048, 2048, S, E, g_wv); } break;
    case 16: { SchedG1 S{(const char*)p.Hb, (const char*)W.Win, G, c, 0, 1536, false}; EpiMoe2 E{p.Yo}; gemm_stream(lds, 2048, 2048, S, E, g_wv); } break;
    case 17: { SchedG1 S{(const char*)p.Hb, (const char*)W.Win, G, c, 0, 1536, false}; EpiLin E{p.Yo}; gemm_stream(lds, 2048, 2048, S, E, g_wv); } break;
    case 18: { SchedG1 S{(const char*)p.Hb, (const char*)W.Win, G, c, 0, 1536, false}; EpiLinT<8> E{p.Yo}; gemm_stream(lds, 2048, 2048, S, E, g_wv); } break;
    case 19: { SchedG1 S{(const char*)p.Hb, (const char*)W.Win, G, c, 0, 1536, false}; EpiLinT<2> E{p.Yo}; gemm_stream(lds, 2048, 2048, S, E, g_wv); } break;
    case 20: attn_phase<1>(p, l, (LAS char*)lds, g_wv); break;
    case 21: attn_phase<2>(p, l, (LAS char*)lds, g_wv); break;
    case 22: attn_phase<3>(p, l, (LAS char*)lds, g_wv); break;
    case 14: { SchedG1 S{(const char*)p.Hb, (const char*)W.Win, G, c, 0, 1536, false}; EpiNone E; gemm_stream(lds, 2048, 2048, S, E, g_wv); } break;
#endif
  }
}

__global__ void __launch_bounds__(512, 2) mega(Params p) {
  extern __shared__ __attribute__((aligned(16))) unsigned char smem[];
  LAS unsigned char* lds = (LAS unsigned char*)smem;
  LAS unsigned* xbw = (LAS unsigned*)(lds + LDS_BYTES - 16);
  if (threadIdx.x == 0) { xbw[0] = 0u; xbw[1] = 0u; xbw[2] = 0u; xbw[3] = 0u; }
  __syncthreads();
  XcdBarrier bar = xcd_barrier_post(p.bar, (volatile LAS unsigned*)xbw);
  const int ph_lo = p.ph_lo, ph_hi = p.ph_hi; const int g_wv = __builtin_amdgcn_readfirstlane((int)threadIdx.x >> 6);
#if PROBE_MASK
  if (ph_lo >= 1000) { run_phase(*(const __attribute__((address_space(4))) Params*)__builtin_amdgcn_kernarg_segment_ptr(), 1, ph_lo - 1000, lds, g_wv); return; }
#endif
  for (int l = 0; l < DEPTH; ++l) {
#define PHASE(ID) do { const int gph = l * NPH + (ID); if (gph >= ph_lo && gph < ph_hi && !(((ID) == PH_H0 || (ID) == PH_CONV) && l > 0)) { \
      const __attribute__((address_space(4))) Params* kp = (const __attribute__((address_space(4))) Params*)__builtin_amdgcn_kernarg_segment_ptr(); int lv = l; int wvp = g_wv; \
      asm volatile("" : "+s"(kp), "+s"(lv), "+s"(wvp));     \
      run_phase(*kp, lv, (ID), lds, wvp); if (gph + 1 < ph_hi) xcd_barrier(bar); } } while (0)
    PHASE(PH_CONV); PHASE(PH_H0); PHASE(PH_GEMM1); PHASE(PH_S1); PHASE(PH_ATT); PHASE(PH_MERGE);
    PHASE(PH_LN1); PHASE(PH_MOE1); PHASE(PH_LN2);
#undef PHASE
  }
}

struct Host { Params p; size_t ws_used; };
inline size_t al256(size_t x) { return (x + 255) & ~(size_t)255; }
inline Host make_params(void* const* d_in, void* d_out, void* d_ws) {
  Host H; memset(&H, 0, sizeof(H)); Params& p = H.p;
  const float** ip = (const float**)&p.in; for (int i = 0; i < 36; ++i) ip[i] = (const float*)d_in[i];
  p.out = (float*)d_out;
  char* base = (char*)d_ws; size_t off = 0;
  auto take = [&](size_t bytes) { char* r = base + off; off = al256(off + bytes); return r; };
  p.bar = (unsigned*)take(XCD_BAR_WORDS * 4); p.ctl = (unsigned*)take((size_t)DEPTH * CTL_WORDS * 4);
  p.MOD = (float*)take((size_t)DEPTH * 9 * 6144 * 4); p.ROPE = (float*)take((size_t)2048 * 64 * 4);
  p.ROUTE = (int*)take((size_t)NR * 4 * 4); p.RW = (float*)take((size_t)NR * 2 * 4); p.TOK = (int*)take((size_t)NE * NR * 4);
  p.XL = (float*)take((size_t)NR * D * 4); p.X1b = (bf16_t*)take((size_t)NR * D * 2); p.Hb = (bf16_t*)take((size_t)NR * D * 2); p.H2b = (bf16_t*)take((size_t)NR * D * 2); p.Mb = (bf16_t*)take((size_t)NR * D * 2);
  for (int k = 0; k < 4; ++k) { SSet& w = p.s[k]; w.SAL = (float*)take((size_t)NG * 2 * 64 * 2 * 4); w.WR = (float*)take((size_t)2 * 64 * 1024 * 2);
    w.Smat = (bf16_t*)take((size_t)NG * 256 * 768 * 2); w.TO = (bf16_t*)take((size_t)NG * 512 * 768 * 2); }
  for (int k = 0; k < 2; ++k) { WSet& w = p.w[k];
    w.Win = (bf16_t*)take((size_t)INW * 1024 * 2); w.Wglu = (bf16_t*)take((size_t)512 * 512 * 2); w.Wpa = (bf16_t*)take((size_t)1024 * 1024 * 2); w.Wps = (bf16_t*)take((size_t)1024 * 1024 * 2);
    w.Wo = (bf16_t*)take((size_t)1024 * 1024 * 2); w.W13 = (bf16_t*)take((size_t)NE * 1024 * 1024 * 2); w.W2 = (bf16_t*)take((size_t)NE * 1024 * 512 * 2); }
  const size_t mix0 = off;
  p.Kc = (bf16_t*)take((size_t)NB * KVB * D * 2); p.Vc = (bf16_t*)take((size_t)NB * KVB * D * 2); p.Qb = (bf16_t*)take((size_t)NR * D * 2);
  p.Ug = (bf16_t*)take((size_t)NG * NCHP * 768 * 2 + 4096); p.RG = (bf16_t*)take((size_t)NR * D * 2); p.GSb = (bf16_t*)take((size_t)NR * D * 2); p.ATTb = (bf16_t*)take((size_t)NR * D * 2);
  p.SST = (float*)take((size_t)NG * NCHP * 256 * 4); p.YG = (bf16_t*)take((size_t)NR * SSMW * 2); p.S2 = (bf16_t*)take((size_t)NR * D * 2);
  const size_t mix1 = off; off = mix0;
  p.Hm = (bf16_t*)take((size_t)MOE_ROWS * EH * 2); p.Yo = (bf16_t*)take((size_t)MOE_ROWS * D * 2);
  if (off < mix1) off = mix1;
  H.ws_used = off; p.ph_lo = 0; p.ph_hi = DEPTH * NPH; p.pad0 = 0; p.pad1 = 0;
  return H;
}
inline int grid_size() {
  static int grid = 0;
  if (!grid) { hipFuncSetAttribute((const void*)mega, hipFuncAttributeMaxDynamicSharedMemorySize, LDS_BYTES);
    int dev = 0, cus = 0, per_cu = 0; hipGetDevice(&dev); hipDeviceGetAttribute(&cus, hipDeviceAttributeMultiprocessorCount, dev);
    hipOccupancyMaxActiveBlocksPerMultiprocessor(&per_cu, mega, 512, LDS_BYTES);
    grid = (per_cu >= 1 && cus >= 256) ? 256 : 0;
    if (!grid) fprintf(stderr, "mega: cannot be resident (cus %d per_cu %d)\n", cus, per_cu); }
  return grid;
}
inline void launch_range(Host& H, int lo, int hi, hipStream_t st) {
  const int grid = grid_size(); if (!grid) return;
  H.p.ph_lo = lo; H.p.ph_hi = hi;
  hipLaunchKernelGGL(mega, dim3(grid), dim3(512), LDS_BYTES, st, H.p);
}
}
#ifndef PROBE_K
#define PROBE_K 8
#endif
extern "C" void kernel_launch(void* const* d_in, const int* in_sizes, int n_in, void* d_out, int out_size, void* d_ws, size_t ws_size, hipStream_t stream) {
  fk::Host H = fk::make_params(d_in, d_out, d_ws);
  if (H.ws_used > ws_size) { fprintf(stderr, "ws too small: need %zu have %zu\n", H.ws_used, ws_size); return; }
  hipMemsetAsync(H.p.bar, 0, (size_t)((char*)H.p.MOD - (char*)H.p.bar), stream);
  fk::launch_range(H, 0, fk::DEPTH * fk::NPH, stream);
#if PROBE_MASK
  for (int id = 0; id < 24; ++id) if ((PROBE_MASK >> id) & 1) { const int g = id >= fk::NPH ? 1000 + id : fk::NPH + id;
    for (int k = 0; k < PROBE_K; ++k) { hipMemsetAsync(H.p.bar, 0, XCD_BAR_WORDS * 4, stream); fk::launch_range(H, g, g + 1, stream); } }
#endif
#ifdef PROBE_G0
#ifdef PROBE_PF
  H.p.pad0 = PROBE_PF;
#endif
  for (int k = 0; k < PROBE_K; ++k) { hipMemsetAsync(H.p.bar, 0, XCD_BAR_WORDS * 4, stream); fk::launch_range(H, PROBE_G0, PROBE_G0 + 1, stream); }
#endif
}
```
